# Optimizing an MI355X kernel written in HIP

```python
import math
import jax, jax.numpy as jnp
from jax import lax
import numpy as np

D_MODEL = 1024
BATCH = 2
SEQ = 16384
DEPTH = 1
DEC_BATCH = 8
DEC_SEQ = 16
PAST_LEN = 4096

CHUNK = 64
D_FF = 2816
A_WIDTH = 512
A_HEADS = 4
A_HEAD_DIM = A_WIDTH // A_HEADS
A_CHUNK = 128
B_WIDTH = 512
B_GROUP = 16
B_GROUPS = B_WIDTH // B_GROUP
B_STATE = 64
D_MIX = A_WIDTH + B_WIDTH
D_IN = 2 * A_WIDTH + B_WIDTH
EPS = 1e-6
DT_MIN = 1e-3
DT_MAX = 1e-1

kernel_name = 'hymba_style_gmlp_s5_macaron_stream'


def _rmsnorm(x, g):
    xf = x.astype(jnp.float32)
    y = xf * lax.rsqrt(jnp.mean(xf * xf, axis=-1, keepdims=True) + EPS)
    return (y * g.astype(jnp.float32)).astype(x.dtype)


def _swiglu(x, w_gate, w_up, w_down):
    return (jax.nn.silu(x @ w_gate) * (x @ w_up)) @ w_down


def _gmlp_mixer(z, g_v, w_s, b_s):
    bsz, length, _ = z.shape
    z = jax.nn.gelu(z)
    u, v = jnp.split(z, 2, axis=-1)
    v = _rmsnorm(v.reshape(bsz, length, A_HEADS, A_HEAD_DIM), g_v.reshape(A_HEADS, A_HEAD_DIM))
    c = min(length, A_CHUNK)
    mask = jnp.tril(jnp.ones((c, c), dtype=bool))
    ws = jnp.where(mask, w_s[:, :c, :c], 0)
    vc = v.reshape(bsz, length // c, c, A_HEADS, A_HEAD_DIM)
    s = jnp.einsum('hts,bnshd->bnthd', ws, vc) + b_s[:, :c].T[None, None, :, :, None]
    out = u * s.reshape(bsz, length, A_WIDTH)
    return out, v.reshape(bsz, length, A_WIDTH)


def _s5_mixer(xb, s0, lam_re, lam_im, log_dt, b_re, b_im, c_re, c_im, d_skip, w_glu, b_glu):
    bsz, length, _ = xb.shape
    f32 = jnp.float32
    lam = lax.complex(lam_re.astype(f32), lam_im.astype(f32))
    dt = jnp.exp(log_dt.astype(f32))[:, None]
    lam_bar = jnp.exp(lam * dt)
    b_bar = ((lam_bar - 1.0) / lam)[:, :, None] * lax.complex(b_re.astype(f32), b_im.astype(f32))
    c_mat = lax.complex(c_re.astype(f32), c_im.astype(f32))
    u = xb.astype(f32).reshape(bsz, length, B_GROUPS, B_GROUP)
    bu = jnp.einsum('gpn,blgn->blgp', b_bar, u.astype(jnp.complex64))
    bu = bu.at[:, 0].add(lam_bar[None] * s0)
    a = jnp.broadcast_to(lam_bar, bu.shape)

    def combine(left, right):
        a_l, b_l = left
        a_r, b_r = right
        return a_l * a_r, a_r * b_l + b_r

    _, states = lax.associative_scan(combine, (a, bu), axis=1)
    y = jnp.einsum('gnp,blgp->blgn', c_mat, states).real + d_skip.astype(f32).reshape(B_GROUPS, B_GROUP) * u
    y = jax.nn.gelu(y.reshape(bsz, length, B_WIDTH))
    y = y * jax.nn.sigmoid(y @ w_glu.astype(f32) + b_glu.astype(f32))
    return y.astype(xb.dtype), states[:, -1]


def _layer(x, s0, g_ffn1_pre, w_ffn1_gate, w_ffn1_up, w_ffn1_down, g_ffn1_post,
           g_mix_pre, w_in, gmlp_g_v, gmlp_w_s, gmlp_b_s,
           s5_lam_re, s5_lam_im, s5_log_dt, s5_b_re, s5_b_im, s5_c_re, s5_c_im, s5_d,
           s5_w_glu, s5_b_glu, g_a_out, g_b_out, w_out, g_mix_post,
           g_ffn2_pre, w_ffn2_gate, w_ffn2_up, w_ffn2_down, g_ffn2_post):
    h = x + 0.5 * _rmsnorm(_swiglu(_rmsnorm(x, g_ffn1_pre), w_ffn1_gate, w_ffn1_up, w_ffn1_down), g_ffn1_post)
    proj = _rmsnorm(h, g_mix_pre) @ w_in
    a_out, v_rows = _gmlp_mixer(proj[..., :2 * A_WIDTH], gmlp_g_v, gmlp_w_s, gmlp_b_s)
    b_out, s_last = _s5_mixer(proj[..., 2 * A_WIDTH:], s0, s5_lam_re, s5_lam_im, s5_log_dt,
                              s5_b_re, s5_b_im, s5_c_re, s5_c_im, s5_d, s5_w_glu, s5_b_glu)
    mixed = jnp.concatenate([_rmsnorm(a_out, g_a_out), _rmsnorm(b_out, g_b_out)], axis=-1) @ w_out
    h = h + _rmsnorm(mixed, g_mix_post)
    h = h + 0.5 * _rmsnorm(_swiglu(_rmsnorm(h, g_ffn2_pre), w_ffn2_gate, w_ffn2_up, w_ffn2_down), g_ffn2_post)
    return h, v_rows, s_last


def setup_inputs(seed: int = 0) -> dict:
    key = jax.random.key(seed)
    ks = iter(jax.random.split(key, 64))
    f32 = jnp.float32

    def nrm(shape, scale):
        return scale * jax.random.normal(next(ks), shape, f32)

    def gain(n):
        return 1.0 + nrm((DEPTH, n), 0.02)

    L = DEPTH
    inp = {}
    inp['x_prompt'] = nrm((BATCH, SEQ, D_MODEL), 1.0)
    inp['x_sample'] = nrm((DEC_BATCH, DEC_SEQ, D_MODEL), 1.0)
    inp['state_ssm_re'] = nrm((L, DEC_BATCH, B_GROUPS, B_STATE), 0.1)
    inp['state_ssm_im'] = nrm((L, DEC_BATCH, B_GROUPS, B_STATE), 0.1)
    inp['g_ffn1_pre'] = gain(D_MODEL)
    inp['w_ffn1_gate'] = nrm((L, D_MODEL, D_FF), D_MODEL ** -0.5)
    inp['w_ffn1_up'] = nrm((L, D_MODEL, D_FF), D_MODEL ** -0.5)
    inp['w_ffn1_down'] = nrm((L, D_FF, D_MODEL), D_FF ** -0.5)
    inp['g_ffn1_post'] = gain(D_MODEL)
    inp['g_mix_pre'] = gain(D_MODEL)
    inp['w_in'] = nrm((L, D_MODEL, D_IN), D_MODEL ** -0.5)
    inp['gmlp_g_v'] = gain(A_WIDTH)
    inp['gmlp_w_s'] = nrm((L, A_HEADS, A_CHUNK, A_CHUNK), A_CHUNK ** -0.5)
    inp['gmlp_b_s'] = 1.0 + nrm((L, A_HEADS, A_CHUNK), 0.02)
    inp['s5_lam_re'] = -0.5 + nrm((L, B_GROUPS, B_STATE), 0.01)
    inp['s5_lam_im'] = jnp.pi * jnp.arange(B_STATE, dtype=f32) + nrm((L, B_GROUPS, B_STATE), 0.01)
    inp['s5_log_dt'] = jax.random.uniform(next(ks), (L, B_GROUPS), f32, math.log(DT_MIN), math.log(DT_MAX))
    inp['s5_b_re'] = nrm((L, B_GROUPS, B_STATE, B_GROUP), (2.0 * B_GROUP) ** -0.5)
    inp['s5_b_im'] = nrm((L, B_GROUPS, B_STATE, B_GROUP), (2.0 * B_GROUP) ** -0.5)
    inp['s5_c_re'] = nrm((L, B_GROUPS, B_GROUP, B_STATE), (2.0 * B_STATE) ** -0.5)
    inp['s5_c_im'] = nrm((L, B_GROUPS, B_GROUP, B_STATE), (2.0 * B_STATE) ** -0.5)
    inp['s5_d'] = nrm((L, B_WIDTH), 1.0)
    inp['s5_w_glu'] = nrm((L, B_WIDTH, B_WIDTH), B_WIDTH ** -0.5)
    inp['s5_b_glu'] = nrm((L, B_WIDTH), 0.02)
    inp['g_a_out'] = gain(A_WIDTH)
    inp['g_b_out'] = gain(B_WIDTH)
    inp['w_out'] = nrm((L, D_MIX, D_MODEL), D_MIX ** -0.5)
    inp['g_mix_post'] = gain(D_MODEL)
    inp['g_ffn2_pre'] = gain(D_MODEL)
    inp['w_ffn2_gate'] = nrm((L, D_MODEL, D_FF), D_MODEL ** -0.5)
    inp['w_ffn2_up'] = nrm((L, D_MODEL, D_FF), D_MODEL ** -0.5)
    inp['w_ffn2_down'] = nrm((L, D_FF, D_MODEL), D_FF ** -0.5)
    inp['g_ffn2_post'] = gain(D_MODEL)
    return inp


def reference(x_prompt, x_sample, state_ssm_re, state_ssm_im,
              g_ffn1_pre, w_ffn1_gate, w_ffn1_up, w_ffn1_down, g_ffn1_post,
              g_mix_pre, w_in, gmlp_g_v, gmlp_w_s, gmlp_b_s,
              s5_lam_re, s5_lam_im, s5_log_dt, s5_b_re, s5_b_im, s5_c_re, s5_c_im, s5_d,
              s5_w_glu, s5_b_glu, g_a_out, g_b_out, w_out, g_mix_post,
              g_ffn2_pre, w_ffn2_gate, w_ffn2_up, w_ffn2_down, g_ffn2_post):
    if x_sample.shape[1] > CHUNK:
        raise ValueError('a later-chunk request holds at most CHUNK frames')
    weights = (g_ffn1_pre, w_ffn1_gate, w_ffn1_up, w_ffn1_down, g_ffn1_post,
               g_mix_pre, w_in, gmlp_g_v, gmlp_w_s, gmlp_b_s,
               s5_lam_re, s5_lam_im, s5_log_dt, s5_b_re, s5_b_im, s5_c_re, s5_c_im, s5_d,
               s5_w_glu, s5_b_glu, g_a_out, g_b_out, w_out, g_mix_post,
               g_ffn2_pre, w_ffn2_gate, w_ffn2_up, w_ffn2_down, g_ffn2_post)
    y_p, y_s = x_prompt, x_sample
    fin_p_list, fin_s_list, v_s_list = [], [], []
    for l in range(DEPTH):
        lw = [w[l] for w in weights]
        s0_p = jnp.zeros((x_prompt.shape[0], B_GROUPS, B_STATE), jnp.complex64)
        s0_s = lax.complex(state_ssm_re[l].astype(jnp.float32), state_ssm_im[l].astype(jnp.float32))
        y_p, _, fin_p = _layer(y_p, s0_p, *lw)
        y_s, v_s, fin_s = _layer(y_s, s0_s, *lw)
        fin_p_list.append(fin_p)
        fin_s_list.append(fin_s)
        v_s_list.append(v_s)
    fin_p = jnp.stack(fin_p_list)
    fin_s = jnp.stack(fin_s_list)
    sdt = state_ssm_re.dtype
    state_ssm_re_prompt = fin_p.real.astype(sdt)
    state_ssm_im_prompt = fin_p.imag.astype(sdt)
    state_ssm_re_sample = fin_s.real.astype(sdt)
    state_ssm_im_sample = fin_s.imag.astype(sdt)
    state_gmlp_v_sample = jnp.stack(v_s_list)
    return (y_p, y_s, state_ssm_re_prompt, state_ssm_im_prompt, state_ssm_re_sample, state_ssm_im_sample, state_gmlp_v_sample)
```

```cpp
#include <hip/hip_runtime.h>
#include <hip/hip_cooperative_groups.h>
#include <cstdio>
#include <cstdint>
namespace cg = cooperative_groups;
namespace pg8 {
#define PG8_LAS __attribute__((address_space(3)))
typedef unsigned short bf16_t;
typedef short bf16x8 __attribute__((ext_vector_type(8)));
typedef float f32x4 __attribute__((ext_vector_type(4)));
typedef unsigned u32x4 __attribute__((ext_vector_type(4)));
constexpr int BM = 256, BK = 64, HALF = 128, HTB = HALF * BK * 2  , STAGE_BYTES = 8 * HTB, NXCD = 8, WGM = 8;

__host__ __device__ __forceinline__ int lds_byte(int r, int c) { const int st = (r >> 4) * 2 + (c >> 5), rr = r & 15, cc = c & 31, ob = rr * 64 + cc * 2; return st * 1024 + (ob ^ (((ob >> 9) & 1) << 5)); }
__host__ __device__ __forceinline__ void stage_rc(int b, int& R, int& C) { const int st = b / 1024, sb = b % 1024, swz = sb ^ (((sb >> 9) & 1) << 5); R = (st >> 1) * 16 + swz / 64; C = (st & 1) * 32 + (swz % 64) / 2; }
__host__ __device__ __forceinline__ int perm32(int rho) { const int n = rho >> 4, i = rho & 15; return 8 * (i >> 2) + 4 * n + (i & 3); }

struct Unit { int pm, pn; };
struct Gemm { const bf16_t* A; const bf16_t* Bt; int M, N, K; };

struct StaticOrder {
    int nM, nN, nwg, G, c;
    __host__ __device__ void init(int M, int N, int G_, int c_) { nM = M / BM; nN = N / BM; nwg = nM * nN; G = G_; c = c_; }
    __host__ __device__ bool next(int i, Unit& u) const {
        const long L = (long)i * G + c; if (L >= nwg) return false;
        int wgid = (int)L; { const int q = nwg / NXCD, r = nwg % NXCD, xcd = wgid % NXCD, off = wgid / NXCD; wgid = (xcd < r ? xcd * (q + 1) : r * (q + 1) + (xcd - r) * q) + off; }
        const int nig = WGM * nN, gid = wgid / nig, fm = gid * WGM, gsz = (nM - fm) < WGM ? (nM - fm) : WGM;
        u.pm = fm + ((wgid % nig) % gsz); u.pn = (wgid % nig) / gsz; return true;
    }
    __device__ __forceinline__ void a_ready(const Unit&) const {}
    __device__ __forceinline__ void done(const Unit&) const {}
};

__device__ __forceinline__ unsigned cvt_pk_bf16(float lo, float hi) { unsigned r; asm volatile("v_cvt_pk_bf16_f32 %0, %1, %2" : "=v"(r) : "v"(lo), "v"(hi)); return r; }
__device__ __forceinline__ float bf_lo(unsigned w) { return __uint_as_float(w << 16); }
__device__ __forceinline__ float bf_hi(unsigned w) { return __uint_as_float(w & 0xffff0000u); }
__device__ __forceinline__ float sigmoid_f(float x) { return __builtin_amdgcn_rcpf(1.0f + __expf(-x)); }
__device__ __forceinline__ float silu_f(float x) { return x * sigmoid_f(x); }
__device__ __forceinline__ float gelu_t(float x) { const float u = 1.5957691216057308f * (x + 0.044715f * x * x * x); return x * sigmoid_f(u); }

struct EpiSwiglu {
    static constexpr bool PERM = true, AFTER_DRAIN = false;
    bf16_t* O; int ldc;
    __device__ __forceinline__ void operator()(const f32x4 (&acc)[2][2][4][2], const Unit& u, int wr, int wc, int fr, int fq) const {
        const int row0 = u.pm * BM + wr * 64 + fr; const int col0 = u.pn * HALF + wc * 32 + 8 * fq;
#pragma unroll
        for (int ai = 0; ai < 2; ++ai)
#pragma unroll
            for (int m = 0; m < 4; ++m) {
                bf16_t* rowp = O + (size_t)(row0 + ai * HALF + m * 16) * ldc + col0;
                const f32x4 g0 = acc[ai][0][m][0], g1 = acc[ai][0][m][1], u0 = acc[ai][1][m][0], u1 = acc[ai][1][m][1];
                u32x4 w;
                w.x = cvt_pk_bf16(silu_f(g0[0]) * u0[0], silu_f(g0[1]) * u0[1]); w.y = cvt_pk_bf16(silu_f(g0[2]) * u0[2], silu_f(g0[3]) * u0[3]);
                w.z = cvt_pk_bf16(silu_f(g1[0]) * u1[0], silu_f(g1[1]) * u1[1]); w.w = cvt_pk_bf16(silu_f(g1[2]) * u1[2], silu_f(g1[3]) * u1[3]);
                *(u32x4*)rowp = w;
            }
    }
};
template <int MODE> struct EpiBf16 {
    static constexpr bool PERM = true, AFTER_DRAIN = false;
    bf16_t* O; int ldc; int act_cols; const float* bias; const bf16_t* Y; int ldy;
    __device__ __forceinline__ void operator()(const f32x4 (&acc)[2][2][4][2], const Unit& u, int wr, int wc, int fr, int fq) const {
        const int row0 = u.pm * BM + wr * 64 + fr; const int col0 = u.pn * BM + wc * 32 + 8 * fq;
#pragma unroll
        for (int bj = 0; bj < 2; ++bj) {
            const int col = col0 + bj * HALF;
            f32x4 b0 = (f32x4){0.f, 0.f, 0.f, 0.f}, b1 = b0;
            if (MODE == 2) { b0 = *(const f32x4*)(bias + col); b1 = *(const f32x4*)(bias + col + 4); }
            const bool act = (MODE == 1) && (col < act_cols);
#pragma unroll
            for (int ai = 0; ai < 2; ++ai)
#pragma unroll
                for (int m = 0; m < 4; ++m) {
                    const size_t row = (size_t)(row0 + ai * HALF + m * 16);
                    f32x4 v0 = acc[ai][bj][m][0], v1 = acc[ai][bj][m][1];
                    if (MODE == 1) { if (act) {
#pragma unroll
                        for (int j = 0; j < 4; ++j) { v0[j] = gelu_t(v0[j]); v1[j] = gelu_t(v1[j]); } } }
                    if (MODE == 2) {
                        const u32x4 y = *(const u32x4*)(Y + row * ldy + col);
                        v0 = v0 + b0; v1 = v1 + b1;
                        v0[0] = bf_lo(y.x) * sigmoid_f(v0[0]); v0[1] = bf_hi(y.x) * sigmoid_f(v0[1]); v0[2] = bf_lo(y.y) * sigmoid_f(v0[2]); v0[3] = bf_hi(y.y) * sigmoid_f(v0[3]);
                        v1[0] = bf_lo(y.z) * sigmoid_f(v1[0]); v1[1] = bf_hi(y.z) * sigmoid_f(v1[1]); v1[2] = bf_lo(y.w) * sigmoid_f(v1[2]); v1[3] = bf_hi(y.w) * sigmoid_f(v1[3]);
                    }
                    u32x4 w; w.x = cvt_pk_bf16(v0[0], v0[1]); w.y = cvt_pk_bf16(v0[2], v0[3]); w.z = cvt_pk_bf16(v1[0], v1[1]); w.w = cvt_pk_bf16(v1[2], v1[3]);
                    *(u32x4*)(O + row * ldc + col) = w;
                }
        }
    }
};

template <class Epi, class Sched, bool ALIGN_EPI = false, bool SP2 = false>
__device__ __forceinline__ void gemm_phase(PG8_LAS unsigned char* lds, const Gemm g, const Sched& S, const Epi& E) {
    const int tid = threadIdx.x, wid = __builtin_amdgcn_readfirstlane(tid >> 6), lane = tid & 63, wr = wid >> 2, wc = wid & 3, fr = lane & 15, fq = lane >> 4;
    const int K = g.K, nt = K / BK;
    unsigned voffA[2], voffB[2];
#pragma unroll
    for (int i = 0; i < 2; ++i) { int R, C; stage_rc(tid * 16 + i * 8192, R, C); const int Rb = Epi::PERM ? ((R & ~31) + perm32(R & 31)) : R;
        voffA[i] = (unsigned)(R * K + C) * 2u; voffB[i] = (unsigned)(Rb * K + C) * 2u; }
    const size_t kstep = (size_t)(BK * 2);
    const size_t hstep = (size_t)HALF * K * 2;
    const size_t tstep = 2 * hstep;
    const unsigned ldsw = (unsigned)wid * 1024u;
    const int aoff = lds_byte(wr * 64 + fr, fq * 8), boff = lds_byte(wc * 32 + fr, fq * 8);
#define PG8_SA(b, h) (((b) * 2 + (h)) * HTB)
#define PG8_SB(b, h) ((4 + (b) * 2 + (h)) * HTB)
#define PG8_STAGE(bufoff, gbase, voff) do { _Pragma("unroll") for (int _i = 0; _i < 2; ++_i) \
        __builtin_amdgcn_global_load_lds((const unsigned*)((const char*)(gbase) + (voff)[_i]), (PG8_LAS unsigned*)(lds + (bufoff) + ldsw + _i * 8192), 16, 0, 0); } while (0)
#define PG8_LDA(dst, b, h) do { _Pragma("unroll") for (int m = 0; m < 4; ++m) _Pragma("unroll") for (int k = 0; k < 2; ++k) dst[m][k] = *(const PG8_LAS bf16x8*)(lds + PG8_SA(b, h) + aoff + m * 2048 + k * 1024); } while (0)
#define PG8_LDB(dst, b, h) do { _Pragma("unroll") for (int n = 0; n < 2; ++n) _Pragma("unroll") for (int k = 0; k < 2; ++k) dst[n][k] = *(const PG8_LAS bf16x8*)(lds + PG8_SB(b, h) + boff + n * 2048 + k * 1024); } while (0)
#define PG8_MMA(ai, bj, At, Bt) do { __builtin_amdgcn_s_setprio(1); _Pragma("unroll") for (int m = 0; m < 4; ++m) _Pragma("unroll") for (int n = 0; n < 2; ++n) _Pragma("unroll") for (int k = 0; k < 2; ++k) \
        acc[ai][bj][m][n] = __builtin_amdgcn_mfma_f32_16x16x32_bf16(Bt[n][k], At[m][k], acc[ai][bj][m][n], 0, 0, 0); __builtin_amdgcn_s_setprio(0); } while (0)
#define PG8_WAIT_V(n) asm volatile("s_waitcnt vmcnt(" #n ")" ::: "memory")
#define PG8_WAIT_L(n) asm volatile("s_waitcnt lgkmcnt(" #n ")" ::: "memory")
#define PG8_BAR __builtin_amdgcn_s_barrier()
#define PG8_SCHED __builtin_amdgcn_sched_barrier(0)
    Unit cur, nxt; int ui = 0;
    if (!S.next(0, cur)) return;
    f32x4 acc[2][2][4][2];
#pragma unroll
    for (int a = 0; a < 2; ++a)
#pragma unroll
        for (int b = 0; b < 2; ++b)
#pragma unroll
            for (int m = 0; m < 4; ++m)
#pragma unroll
                for (int n = 0; n < 2; ++n) acc[a][b][m][n] = (f32x4){0.f, 0.f, 0.f, 0.f};
    bf16x8 At[4][2], B0[2][2], B1[2][2];
    const char* cA = (const char*)g.A + (size_t)cur.pm * tstep; const char* cB = (const char*)g.Bt + (size_t)cur.pn * tstep;
    S.a_ready(cur);
    if constexpr (SP2) {
        PG8_STAGE(PG8_SB(0, 0), cB, voffB); PG8_STAGE(PG8_SB(0, 1), cB + hstep, voffB); PG8_STAGE(PG8_SA(0, 0), cA, voffA); PG8_STAGE(PG8_SA(0, 1), cA + hstep, voffA);
        if (wr == 1) PG8_BAR;
        PG8_WAIT_V(2); PG8_BAR;
        PG8_STAGE(PG8_SB(1, 0), cB + kstep, voffB); PG8_STAGE(PG8_SA(1, 0), cA + kstep, voffA); PG8_STAGE(PG8_SB(1, 1), cB + hstep + kstep, voffB);
        PG8_WAIT_V(6); PG8_BAR;
    } else {
        PG8_STAGE(PG8_SB(0, 0), cB, voffB); PG8_STAGE(PG8_SA(0, 0), cA, voffA); PG8_STAGE(PG8_SB(0, 1), cB + hstep, voffB); PG8_STAGE(PG8_SA(0, 1), cA + hstep, voffA);
        if (wr == 1) PG8_BAR;
        PG8_WAIT_V(4); PG8_BAR;
        PG8_STAGE(PG8_SB(1, 0), cB + kstep, voffB); PG8_STAGE(PG8_SA(1, 0), cA + kstep, voffA); PG8_STAGE(PG8_SB(1, 1), cB + hstep + kstep, voffB);
        PG8_WAIT_V(6); PG8_BAR;
    }
    for (;;) {
        const bool has_next = S.next(ui + 1, nxt);
        const char* nA = has_next ? (const char*)g.A + (size_t)nxt.pm * tstep : cA; const char* nB = has_next ? (const char*)g.Bt + (size_t)nxt.pn * tstep : cB;
        for (int t = 0; t < nt; t += 2) {
            const bool last = (t == nt - 2);
            const char* a1 = cA + (size_t)(t + 1) * kstep;
            const char* a2 = last ? nA : cA + (size_t)(t + 2) * kstep; const char* b2 = last ? nB : cB + (size_t)(t + 2) * kstep;
            const char* a3 = a2 + kstep; const char* b3 = b2 + kstep;
            if (last && has_next) S.a_ready(nxt);
            if constexpr (SP2) {
            PG8_LDB(B0, 0, 0); PG8_LDB(B1, 0, 1); PG8_SCHED; PG8_LDA(At, 0, 0); PG8_STAGE(PG8_SA(1, 1), a1 + hstep, voffA);
            PG8_WAIT_V(8); PG8_WAIT_L(0); PG8_BAR; PG8_MMA(0, 0, At, B0); PG8_MMA(0, 1, At, B1); PG8_BAR; PG8_SCHED;
            PG8_LDA(At, 0, 1); PG8_STAGE(PG8_SB(0, 0), b2, voffB); PG8_STAGE(PG8_SB(0, 1), b2 + hstep, voffB); PG8_STAGE(PG8_SA(0, 0), a2, voffA);
            PG8_WAIT_V(8); PG8_WAIT_L(0); PG8_BAR; PG8_MMA(1, 0, At, B0); PG8_MMA(1, 1, At, B1); PG8_BAR; PG8_SCHED;
            PG8_LDB(B0, 1, 0); PG8_LDB(B1, 1, 1); PG8_SCHED; PG8_LDA(At, 1, 0); PG8_STAGE(PG8_SA(0, 1), a2 + hstep, voffA);
            PG8_WAIT_V(8); PG8_WAIT_L(0); PG8_BAR; PG8_MMA(0, 0, At, B0); PG8_MMA(0, 1, At, B1); PG8_BAR; PG8_SCHED;
            PG8_LDA(At, 1, 1); PG8_STAGE(PG8_SB(1, 0), b3, voffB); PG8_STAGE(PG8_SB(1, 1), b3 + hstep, voffB); PG8_STAGE(PG8_SA(1, 0), a3, voffA);
            PG8_WAIT_V(8); PG8_WAIT_L(0); PG8_BAR; PG8_MMA(1, 0, At, B0); PG8_MMA(1, 1, At, B1); PG8_BAR; PG8_SCHED;
            } else {
            PG8_LDB(B0, 0, 0); PG8_SCHED; PG8_LDA(At, 0, 0); PG8_STAGE(PG8_SA(1, 1), a1 + hstep, voffA);
            PG8_WAIT_L(8); PG8_BAR; PG8_WAIT_L(0); PG8_MMA(0, 0, At, B0); PG8_BAR; PG8_SCHED;
            PG8_LDB(B1, 0, 1); PG8_STAGE(PG8_SB(0, 0), b2, voffB);
            PG8_BAR; PG8_WAIT_L(0); PG8_MMA(0, 1, At, B1); PG8_BAR;
            PG8_LDA(At, 0, 1); PG8_STAGE(PG8_SA(0, 0), a2, voffA);
            PG8_BAR; PG8_WAIT_L(0); PG8_MMA(1, 0, At, B0); PG8_BAR; PG8_SCHED;
            PG8_STAGE(PG8_SB(0, 1), b2 + hstep, voffB);
            PG8_WAIT_V(6); PG8_BAR; PG8_MMA(1, 1, At, B1); PG8_BAR;
            PG8_LDB(B0, 1, 0); PG8_SCHED; PG8_LDA(At, 1, 0); PG8_STAGE(PG8_SA(0, 1), a2 + hstep, voffA);
            PG8_WAIT_L(8); PG8_BAR; PG8_WAIT_L(0); PG8_MMA(0, 0, At, B0); PG8_BAR; PG8_SCHED;
            PG8_LDB(B1, 1, 1); PG8_STAGE(PG8_SB(1, 0), b3, voffB);
            PG8_BAR; PG8_WAIT_L(0); PG8_MMA(0, 1, At, B1); PG8_BAR;
            PG8_LDA(At, 1, 1); PG8_STAGE(PG8_SA(1, 0), a3, voffA);
            PG8_BAR; PG8_WAIT_L(0); PG8_MMA(1, 0, At, B0); PG8_BAR; PG8_SCHED;
            PG8_STAGE(PG8_SB(1, 1), b3 + hstep, voffB);
            PG8_WAIT_V(6); PG8_BAR; PG8_MMA(1, 1, At, B1); PG8_BAR;
            }
        }
        if constexpr (ALIGN_EPI) { if (wr == 0) PG8_BAR; }
        if constexpr (!Epi::AFTER_DRAIN) { E(acc, cur, wr, wc, fr, fq); S.done(cur); }
        if (!has_next) break;
#pragma unroll
        for (int a = 0; a < 2; ++a)
#pragma unroll
            for (int b = 0; b < 2; ++b)
#pragma unroll
                for (int m = 0; m < 4; ++m)
#pragma unroll
                    for (int n = 0; n < 2; ++n) acc[a][b][m][n] = (f32x4){0.f, 0.f, 0.f, 0.f};
        cur = nxt; cA = nA; cB = nB; ++ui;
        if constexpr (ALIGN_EPI) { if (wr == 1) PG8_BAR; }
    }
    PG8_WAIT_V(0);
    if constexpr (!ALIGN_EPI) { if (wr == 0) PG8_BAR; }
    PG8_BAR;
    if constexpr (Epi::AFTER_DRAIN) { E.fused(acc, cur, wr, wc, fr, fq, lds, wid, lane); S.done(cur); }
#undef PG8_SA
#undef PG8_SB
#undef PG8_STAGE
#undef PG8_LDA
#undef PG8_LDB
#undef PG8_MMA
#undef PG8_WAIT_V
#undef PG8_WAIT_L
#undef PG8_BAR
#undef PG8_SCHED
}
}

constexpr int DM = 1024, SEQ = 16384, NBATCH = 2, MPROMPT = NBATCH * SEQ, DEC_B = 8, DEC_S = 16;
constexpr int M = MPROMPT + DEC_B * DEC_S;
constexpr int MPAD = 33024;
constexpr int DFF = 2816, DIN = 1536, AW = 512, BWD = 512, NG = 32, NP = 64, GN = 16;
constexpr int NTILE = M / 128;
constexpr float EPS = 1e-6f;
constexpr int NWAVES = 8, NTHREADS = 512;

constexpr size_t MiB = 1u << 20;
constexpr size_t WS_WGU1 = 1 * MiB, WS_WD1 = 12 * MiB, WS_WIN = 18 * MiB, WS_WGLU = 21 * MiB, WS_WOUT = 22 * MiB, WS_WGU2 = 24 * MiB, WS_WD2 = 35 * MiB;
constexpr size_t WS_WEFF = 41 * MiB, WS_BB = 42 * MiB, WS_CM = 42 * MiB + 131072, WS_LAM = 42 * MiB + 262144, WS_E = 43 * MiB;
constexpr size_t WS_XN = 48 * MiB, WS_D = 113 * MiB, WS_H = 178 * MiB, WS_Z = 178 * MiB, WS_YB = 275 * MiB, WS_MIX = 356 * MiB, WS_END = 421 * MiB;
static_assert(WS_XN + (size_t)MPAD * DM * 2 <= WS_D && WS_D + (size_t)MPAD * DM * 2 <= WS_H && WS_H + (size_t)MPAD * DFF * 2 <= WS_MIX, "ws map");
static_assert(WS_Z + (size_t)MPAD * DIN * 2 <= WS_YB && WS_YB + (size_t)MPAD * BWD * 2 <= WS_H + (size_t)MPAD * DFF * 2 && WS_MIX + (size_t)MPAD * DM * 2 <= WS_END, "ws map 2");
static_assert(WS_E + (size_t)NTILE * NG * NP * 8 <= WS_XN, "ws map 3");

constexpr size_t OFF_Y = 0, OFF_SRE_P = (size_t)M * DM, OFF_SIM_P = OFF_SRE_P + NBATCH * NG * NP, OFF_SRE_S = OFF_SIM_P + NBATCH * NG * NP,
                 OFF_SIM_S = OFF_SRE_S + DEC_B * NG * NP, OFF_V_S = OFF_SIM_S + DEC_B * NG * NP;

constexpr int GEMM_LDS = 131072;
constexpr int S5_ROW = 132;
constexpr int S5_WAVE_BYTES = 32 * S5_ROW * 4;
constexpr int VT_STRIDE = 136;
constexpr int LDS_BYTES = 147456;
static_assert(NWAVES * S5_WAVE_BYTES <= LDS_BYTES && 128 * VT_STRIDE * 2 + 4096 <= LDS_BYTES, "lds map");

#define LAS __attribute__((address_space(3)))
typedef unsigned short bf16;
typedef float v4f __attribute__((ext_vector_type(4)));
typedef float v2f __attribute__((ext_vector_type(2)));
typedef float v16f __attribute__((ext_vector_type(16)));
typedef unsigned v4u __attribute__((ext_vector_type(4)));
typedef unsigned v2u __attribute__((ext_vector_type(2)));
typedef short bfx8 __attribute__((ext_vector_type(8)));
#define LDS_FENCE() asm volatile("s_waitcnt lgkmcnt(0)" ::: "memory")

using pg8::cvt_pk_bf16; using pg8::bf_lo; using pg8::bf_hi; using pg8::gelu_t;

__device__ __forceinline__ float wave_sum(float v) {
#pragma unroll
    for (int o = 1; o < 64; o <<= 1) v += __shfl_xor(v, o);
    return v;
}
__device__ __forceinline__ bf16 f2bf(float f) { return (bf16)(cvt_pk_bf16(f, 0.f) & 0xffffu); }


__device__ __forceinline__ double dexp(double x) {
    const double y = x * (1.0 / 256.0); double t = 1.0;
#pragma unroll
    for (int i = 12; i >= 1; --i) t = 1.0 + t * y / (double)i;
#pragma unroll
    for (int i = 0; i < 8; ++i) t = t * t;
    return t;
}
__device__ __forceinline__ void dsincos(double x, double& s, double& c) {
    const double twopi = 6.283185307179586476925286766559;
    const double k = rint(x / twopi); const double r = x - k * twopi, r2 = r * r;
    double ts = r, tc = 1.0; s = r; c = 1.0;
#pragma unroll
    for (int i = 1; i <= 15; ++i) { tc = -tc * r2 / (double)((2 * i - 1) * (2 * i)); ts = -ts * r2 / (double)((2 * i) * (2 * i + 1)); c += tc; s += ts; }
}

typedef const float* cfp_t;
typedef __attribute__((address_space(4))) cfp_t const* kin_t;
__device__ __forceinline__ const float* karg_in(int i) {
    auto k = __builtin_amdgcn_kernarg_segment_ptr();
    asm volatile("" : "+s"(k));
    return ((kin_t)k)[i];
}
struct Ctx {
    __device__ __forceinline__ const float* in(int i) const { return karg_in(i); }
    __device__ __forceinline__ float* out() const { return (float*)karg_in(33); }
    __device__ __forceinline__ unsigned char* ws() const { return (unsigned char*)karg_in(34); }
#define WSP(name, T, off) __device__ __forceinline__ T* name() const { return (T*)(ws() + (off)); }
    WSP(Wgu1, bf16, WS_WGU1) WSP(Wd1, bf16, WS_WD1) WSP(Win, bf16, WS_WIN) WSP(Wglu, bf16, WS_WGLU) WSP(Wout, bf16, WS_WOUT) WSP(Wgu2, bf16, WS_WGU2) WSP(Wd2, bf16, WS_WD2)
    WSP(Weff, bf16, WS_WEFF) WSP(BB, bf16, WS_BB) WSP(CM, bf16, WS_CM) WSP(XN, bf16, WS_XN) WSP(D, bf16, WS_D) WSP(H, bf16, WS_H) WSP(Z, bf16, WS_Z) WSP(YB, bf16, WS_YB) WSP(MIX, bf16, WS_MIX)
    WSP(LAM, float, WS_LAM) WSP(E, float, WS_E)
#undef WSP
};

__device__ __forceinline__ void p0_transpose_item(const float* W, int N, bf16* WT, int K, int k0, int n0, int drow0, LAS float* scr, int lane) {
#pragma unroll 8
    for (int i = 0; i < 32; ++i) { const int kk = 2 * i + (lane >> 5); scr[kk * 33 + (lane & 31)] = W[(size_t)(k0 + kk) * N + n0 + (lane & 31)]; }
    LDS_FENCE();
    const int c = lane & 7;
#pragma unroll
    for (int j = 0; j < 4; ++j) { const int n = (lane >> 3) + 8 * j; const LAS float* s = scr + (8 * c) * 33 + n;
        v4u o; o.x = cvt_pk_bf16(s[0 * 33], s[1 * 33]); o.y = cvt_pk_bf16(s[2 * 33], s[3 * 33]); o.z = cvt_pk_bf16(s[4 * 33], s[5 * 33]); o.w = cvt_pk_bf16(s[6 * 33], s[7 * 33]);
        *(v4u*)(WT + (size_t)(drow0 + n) * K + k0 + 8 * c) = o; }
    LDS_FENCE();
}
__device__ __forceinline__ void p0_matrix_item(const float* W, int K, int N, bf16* WT, int mode, int item, LAS float* scr, int lane) {
    const int nblk = N / 32, kb = item / nblk, nb = item % nblk, n0 = 32 * nb;
    const int drow0 = (mode == 0) ? n0 : (256 * (n0 / 128) + (n0 % 128) + (mode == 2 ? 128 : 0));
    p0_transpose_item(W, N, WT, K, 64 * kb, n0, drow0, scr, lane);
}
__device__ __forceinline__ const float* xrow_ptr(const Ctx& C, int row) { return row < MPROMPT ? C.in(0) + (size_t)row * DM : C.in(1) + (size_t)(row - MPROMPT) * DM; }

__device__ __forceinline__ void row_xn(const float* xrow, const float* g, bf16* orow, int lane) {
    v4f v[4]; float s = 0.f;
#pragma unroll
    for (int j = 0; j < 4; ++j) { v[j] = *(const v4f*)(xrow + 4 * lane + 256 * j); s += (v[j].x * v[j].x + v[j].y * v[j].y) + (v[j].z * v[j].z + v[j].w * v[j].w); }
    const float r = rsqrtf(wave_sum(s) * (1.f / DM) + EPS);
#pragma unroll
    for (int j = 0; j < 4; ++j) { const v4f gg = *(const v4f*)(g + 4 * lane + 256 * j); const v4f o = v[j] * r * gg;
        v2u w; w.x = cvt_pk_bf16(o.x, o.y); w.y = cvt_pk_bf16(o.z, o.w); *(v2u*)(orow + 4 * lane + 256 * j) = w; }
}
__device__ __forceinline__ void row_res(const float* base, const bf16* drow, const float* gpost, float scale, float* out, const float* gnext, bf16* xn, int lane) {
    v4f d[4]; float s = 0.f;
#pragma unroll
    for (int j = 0; j < 4; ++j) { const v2u w = *(const v2u*)(drow + 4 * lane + 256 * j); d[j] = (v4f){bf_lo(w.x), bf_hi(w.x), bf_lo(w.y), bf_hi(w.y)};
        s += (d[j].x * d[j].x + d[j].y * d[j].y) + (d[j].z * d[j].z + d[j].w * d[j].w); }
    const float r1 = rsqrtf(wave_sum(s) * (1.f / DM) + EPS) * scale; float s2 = 0.f;
#pragma unroll
    for (int j = 0; j < 4; ++j) { const v4f b = *(const v4f*)(base + 4 * lane + 256 * j); const v4f gp = *(const v4f*)(gpost + 4 * lane + 256 * j);
        d[j] = b + d[j] * r1 * gp; s2 += (d[j].x * d[j].x + d[j].y * d[j].y) + (d[j].z * d[j].z + d[j].w * d[j].w);
        *(v4f*)(out + 4 * lane + 256 * j) = d[j]; }
    if (xn) {
        const float r2 = rsqrtf(wave_sum(s2) * (1.f / DM) + EPS);
#pragma unroll
        for (int j = 0; j < 4; ++j) { const v4f gg = *(const v4f*)(gnext + 4 * lane + 256 * j); const v4f o = d[j] * r2 * gg;
            v2u w; w.x = cvt_pk_bf16(o.x, o.y); w.y = cvt_pk_bf16(o.z, o.w); *(v2u*)(xn + 4 * lane + 256 * j) = w; }
    }
}
__device__ __forceinline__ void row_norm512(bf16* row, const float* g, int lane) {
    const v4u w = *(const v4u*)(row + 8 * lane);
    float v[8] = {bf_lo(w.x), bf_hi(w.x), bf_lo(w.y), bf_hi(w.y), bf_lo(w.z), bf_hi(w.z), bf_lo(w.w), bf_hi(w.w)};
    float s = 0.f;
#pragma unroll
    for (int i = 0; i < 8; ++i) s += v[i] * v[i];
    const float r = rsqrtf(wave_sum(s) * (1.f / 512.f) + EPS);
    const v4f g0 = *(const v4f*)(g + 8 * lane), g1 = *(const v4f*)(g + 8 * lane + 4);
    v4u o; o.x = cvt_pk_bf16(v[0] * r * g0.x, v[1] * r * g0.y); o.y = cvt_pk_bf16(v[2] * r * g0.z, v[3] * r * g0.w);
    o.z = cvt_pk_bf16(v[4] * r * g1.x, v[5] * r * g1.y); o.w = cvt_pk_bf16(v[6] * r * g1.z, v[7] * r * g1.w);
    *(v4u*)(row + 8 * lane) = o;
}

__device__ __forceinline__ void p0_prologue(const Ctx& C, LAS unsigned char* lds, int wave, int lane, int tid) {
    LAS float* scr = (LAS float*)(lds + wave * 16384);
    const int gw = blockIdx.x * NWAVES + wave, NGW = gridDim.x * NWAVES;
    constexpr int I_GU = (DM / 64) * (DFF / 32), I_D = (DFF / 64) * (DM / 32), I_IN = (DM / 64) * (DIN / 32), I_GLU = (BWD / 64) * (BWD / 32), I_OUT = (DM / 64) * (DM / 32);
    constexpr int NITEMS = 4 * I_GU + 2 * I_D + I_IN + I_GLU + I_OUT;
    for (int it = gw; it < NITEMS; it += NGW) {
        int r = it;
        if (r < I_GU) { p0_matrix_item(C.in(5), DM, DFF, C.Wgu1(), 1, r, scr, lane); continue; } r -= I_GU;
        if (r < I_GU) { p0_matrix_item(C.in(6), DM, DFF, C.Wgu1(), 2, r, scr, lane); continue; } r -= I_GU;
        if (r < I_GU) { p0_matrix_item(C.in(29), DM, DFF, C.Wgu2(), 1, r, scr, lane); continue; } r -= I_GU;
        if (r < I_GU) { p0_matrix_item(C.in(30), DM, DFF, C.Wgu2(), 2, r, scr, lane); continue; } r -= I_GU;
        if (r < I_D) { p0_matrix_item(C.in(7), DFF, DM, C.Wd1(), 0, r, scr, lane); continue; } r -= I_D;
        if (r < I_D) { p0_matrix_item(C.in(31), DFF, DM, C.Wd2(), 0, r, scr, lane); continue; } r -= I_D;
        if (r < I_IN) { p0_matrix_item(C.in(10), DM, DIN, C.Win(), 0, r, scr, lane); continue; } r -= I_IN;
        if (r < I_GLU) { p0_matrix_item(C.in(22), BWD, BWD, C.Wglu(), 0, r, scr, lane); continue; } r -= I_GLU;
        p0_matrix_item(C.in(26), DM, DM, C.Wout(), 0, r, scr, lane);
    }
    for (int m = gw; m < M; m += NGW) row_xn(xrow_ptr(C, m), C.in(4), C.XN() + (size_t)m * DM, lane);
    const int gt = blockIdx.x * NTHREADS + tid, NGT = gridDim.x * NTHREADS;
    for (int idx = gt; idx < NG * NP; idx += NGT) {
        const int g = idx / NP, p = idx % NP;
        const double lr = (double)C.in(14)[idx], li = (double)C.in(15)[idx], dt = dexp((double)C.in(16)[g]);
        double s1, c1, s8, c8; dsincos(li * dt, s1, c1); dsincos(li * dt * 128.0, s8, c8);
        const double er = dexp(lr * dt), lbr = er * c1, lbi = er * s1;
        const double e8 = dexp(lr * dt * 128.0), l8r = e8 * c8, l8i = e8 * s8;
        C.LAM()[0 * 2048 + idx] = (float)lbr; C.LAM()[1 * 2048 + idx] = (float)lbi; C.LAM()[2 * 2048 + idx] = (float)l8r; C.LAM()[3 * 2048 + idx] = (float)l8i;
        const double a = lbr - 1.0, b = lbi, den = lr * lr + li * li, cr = (a * lr + b * li) / den, ci = (b * lr - a * li) / den;
        for (int n = 0; n < GN; ++n) {
            const double br = (double)C.in(17)[(size_t)idx * GN + n], bi = (double)C.in(18)[(size_t)idx * GN + n];
            C.BB()[((size_t)g * 128 + p) * GN + n] = f2bf((float)(cr * br - ci * bi));
            C.BB()[((size_t)g * 128 + 64 + p) * GN + n] = f2bf((float)(cr * bi + ci * br));
            C.CM()[((size_t)g * GN + n) * 128 + p] = f2bf(C.in(19)[((size_t)g * GN + n) * NP + p]);
            C.CM()[((size_t)g * GN + n) * 128 + 64 + p] = f2bf(-C.in(20)[((size_t)g * GN + n) * NP + p]);
        }
    }
    for (int idx = gt; idx < 2 * 4 * 128 * 128; idx += NGT) {
        const int s = idx & 127, t = (idx >> 7) & 127, h = (idx >> 14) & 3, mode = idx >> 16;
        float v;
        if (mode == 0) v = (s <= t) ? C.in(12)[((size_t)h * 128 + t) * 128 + s] : 0.f;
        else v = ((s >> 4) == (t >> 4) && (s & 15) <= (t & 15)) ? C.in(12)[((size_t)h * 128 + (t & 15)) * 128 + (s & 15)] : 0.f;
        C.Weff()[idx] = f2bf(v);
    }
}

template <bool PASS2>
__device__ __forceinline__ void s5_tile(const Ctx& C, int T, LAS unsigned char* lds, int wave, int lane) {
    const bool sample = (T == NTILE - 1);
    const int r0 = T * 128;
    LAS float* BU = (LAS float*)(lds + wave * S5_WAVE_BYTES);
    const int tl = lane & 31, hh = lane >> 5, fr = lane & 15, kq = lane >> 4;
    for (int gi = 0; gi < 4; ++gi) {
        const int g = wave * 4 + gi;
        const float lr = C.LAM()[0 * 2048 + g * 64 + lane], li = C.LAM()[1 * 2048 + g * 64 + lane];
        bfx8 bb[4];
#pragma unroll
        for (int cb = 0; cb < 4; ++cb) bb[cb] = *(const bfx8*)(C.BB() + ((size_t)(g * 128 + cb * 32 + tl)) * GN + 8 * hh);
        float sr = 0.f, si = 0.f;
        bfx8 cm[4]; float dsk = 0.f;
        if (PASS2) {
#pragma unroll
            for (int ks = 0; ks < 4; ++ks) cm[ks] = *(const bfx8*)(C.CM() + ((size_t)(g * GN + fr)) * 128 + 32 * ks + 8 * kq);
            dsk = C.in(21)[16 * g + fr];
            if (!sample) {
                const int k = T & 127, tb = T - k;
                const float l8r = C.LAM()[2 * 2048 + g * 64 + lane], l8i = C.LAM()[3 * 2048 + g * 64 + lane];
                const v2f* Ep = (const v2f*)C.E() + ((size_t)tb * NG + g) * NP + lane;
#pragma unroll 8
                for (int j = 0; j < k; ++j) { const v2f e = Ep[(size_t)j * NG * NP]; const float nr = fmaf(l8r, sr, fmaf(-l8i, si, e.x)), ni = fmaf(l8r, si, fmaf(l8i, sr, e.y)); sr = nr; si = ni; }
            }
        }
        for (int sb = 0; sb < 4; ++sb) {
            const int rb0 = r0 + 32 * sb;
            const bf16* zcol = C.Z() + (size_t)1024 + 16 * g;
            const bfx8 a = *(const bfx8*)(zcol + (size_t)(rb0 + tl) * DIN + 8 * hh);
#pragma unroll
            for (int cb = 0; cb < 4; ++cb) {
                v16f acc;
#pragma unroll
                for (int r = 0; r < 16; ++r) acc[r] = 0.f;
                acc = __builtin_amdgcn_mfma_f32_32x32x16_bf16(a, bb[cb], acc, 0, 0, 0);
#pragma unroll
                for (int r = 0; r < 16; ++r) BU[((r & 3) + 8 * (r >> 2) + 4 * hh) * S5_ROW + cb * 32 + tl] = acc[r];
            }
            LDS_FENCE();
#pragma unroll 4
            for (int t = 0; t < 32; ++t) {
                if (sample && (t & 15) == 0) { const int seq = 2 * sb + (t >> 4); sr = C.in(2)[((size_t)seq * NG + g) * NP + lane]; si = C.in(3)[((size_t)seq * NG + g) * NP + lane]; }
                const float re = BU[t * S5_ROW + lane], im = BU[t * S5_ROW + 64 + lane];
                const float nr = fmaf(lr, sr, fmaf(-li, si, re)), ni = fmaf(lr, si, fmaf(li, sr, im));
                sr = nr; si = ni;
                if (PASS2) {
                    const unsigned w = cvt_pk_bf16(sr, si);
                    LAS bf16* srow = (LAS bf16*)(BU + t * S5_ROW);
                    srow[lane] = (bf16)(w & 0xffffu); srow[64 + lane] = (bf16)(w >> 16);
                    if (sample && (t & 15) == 15) { const int seq = 2 * sb + (t >> 4);
                        C.out()[OFF_SRE_S + ((size_t)seq * NG + g) * NP + lane] = sr; C.out()[OFF_SIM_S + ((size_t)seq * NG + g) * NP + lane] = si; }
                }
            }
            LDS_FENCE();
            if (PASS2) {
#pragma unroll
                for (int rb = 0; rb < 2; ++rb) {
                    v4f acc = (v4f){0.f, 0.f, 0.f, 0.f};
#pragma unroll
                    for (int ks = 0; ks < 4; ++ks) {
                        const bfx8 sa = *(const LAS bfx8*)((const LAS unsigned char*)BU + (16 * rb + fr) * (S5_ROW * 4) + (32 * ks + 8 * kq) * 2);
                        acc = __builtin_amdgcn_mfma_f32_16x16x32_bf16(sa, cm[ks], acc, 0, 0, 0);
                    }
#pragma unroll
                    for (int r = 0; r < 4; ++r) {
                        const int row = rb0 + 16 * rb + 4 * kq + r;
                        const float u = __uint_as_float((unsigned)zcol[(size_t)row * DIN + fr] << 16);
                        C.YB()[(size_t)row * BWD + 16 * g + fr] = f2bf(gelu_t(acc[r] + dsk * u));
                    }
                }
                LDS_FENCE();
            }
        }
        if (!PASS2) { v2f* Ep = (v2f*)C.E() + ((size_t)T * NG + g) * NP + lane; *Ep = (v2f){sr, si}; }
        else if (!sample && (T & 127) == 127) { const int b = T >> 7;
            C.out()[OFF_SRE_P + ((size_t)b * NG + g) * NP + lane] = sr; C.out()[OFF_SIM_P + ((size_t)b * NG + g) * NP + lane] = si; }
    }
}

__device__ __forceinline__ void gmlp_tile(const Ctx& C, int T, LAS unsigned char* lds, int wave, int lane, int tid) {
    const int mode = (T == NTILE - 1) ? 1 : 0;
    const int r0 = T * 128;
    LAS bf16* VT = (LAS bf16*)lds;
    LAS float* SSQ = (LAS float*)(lds + 128 * VT_STRIDE * 2);
    const int tb = wave & 3, dh = wave >> 2, tl = lane & 31, hh = lane >> 5;
    const int t = 32 * tb + tl;
    unsigned outp[4][2][8]; float ssq = 0.f;
    const bf16* zt = C.Z() + (size_t)(r0 + t) * DIN;
#pragma unroll
    for (int h = 0; h < 4; ++h) {
        __syncthreads();
        {
            const int row = tid >> 2, q = tid & 3;
            const bf16* src = C.Z() + (size_t)(r0 + row) * DIN + 512 + h * 128 + q * 32;
            float v[32]; float s = 0.f;
#pragma unroll
            for (int i = 0; i < 4; ++i) { const v4u w = *(const v4u*)(src + 8 * i);
                v[8 * i + 0] = bf_lo(w.x); v[8 * i + 1] = bf_hi(w.x); v[8 * i + 2] = bf_lo(w.y); v[8 * i + 3] = bf_hi(w.y);
                v[8 * i + 4] = bf_lo(w.z); v[8 * i + 5] = bf_hi(w.z); v[8 * i + 6] = bf_lo(w.w); v[8 * i + 7] = bf_hi(w.w); }
#pragma unroll
            for (int i = 0; i < 32; ++i) s += v[i] * v[i];
            s += __shfl_xor(s, 1); s += __shfl_xor(s, 2);
            const float r = rsqrtf(s * (1.f / 128.f) + EPS);
            const float* gv = C.in(11) + h * 128 + q * 32;
#pragma unroll
            for (int i = 0; i < 32; ++i) { v[i] = v[i] * r * gv[i]; VT[(q * 32 + i) * VT_STRIDE + row] = f2bf(v[i]); }
            if (mode) { float* ov = C.out() + OFF_V_S + (size_t)row * AW + h * 128 + q * 32;
#pragma unroll
                for (int i = 0; i < 8; ++i) *(v4f*)(ov + 4 * i) = (v4f){v[4 * i], v[4 * i + 1], v[4 * i + 2], v[4 * i + 3]}; }
        }
        __syncthreads();
        bfx8 wf[8];
        const bf16* wrow = C.Weff() + ((size_t)(mode * 4 + h) * 128 + t) * 128 + 8 * hh;
#pragma unroll
        for (int ks = 0; ks < 8; ++ks) wf[ks] = *(const bfx8*)(wrow + 16 * ks);
        const float bias = C.in(13)[h * 128 + (mode ? (t & 15) : t)];
#pragma unroll
        for (int dbi = 0; dbi < 2; ++dbi) {
            const int db = 2 * dh + dbi;
            v16f acc;
#pragma unroll
            for (int r = 0; r < 16; ++r) acc[r] = 0.f;
#pragma unroll
            for (int ks = 0; ks < 8; ++ks) {
                const bfx8 va = *(const LAS bfx8*)(VT + (32 * db + tl) * VT_STRIDE + 16 * ks + 8 * hh);
                acc = __builtin_amdgcn_mfma_f32_32x32x16_bf16(va, wf[ks], acc, 0, 0, 0);
            }
#pragma unroll
            for (int rg = 0; rg < 4; ++rg) {
                const int d0 = 32 * db + 8 * rg + 4 * hh;
                const v2u uw = *(const v2u*)(zt + h * 128 + d0);
                const float o0 = bf_lo(uw.x) * (acc[4 * rg + 0] + bias), o1 = bf_hi(uw.x) * (acc[4 * rg + 1] + bias);
                const float o2 = bf_lo(uw.y) * (acc[4 * rg + 2] + bias), o3 = bf_hi(uw.y) * (acc[4 * rg + 3] + bias);
                ssq += (o0 * o0 + o1 * o1) + (o2 * o2 + o3 * o3);
                outp[h][dbi][2 * rg] = cvt_pk_bf16(o0, o1); outp[h][dbi][2 * rg + 1] = cvt_pk_bf16(o2, o3);
            }
        }
    }
    ssq += __shfl_xor(ssq, 32);
    if (hh == 0) SSQ[t * 2 + dh] = ssq;
    __syncthreads();
    const float rstd = rsqrtf((SSQ[t * 2] + SSQ[t * 2 + 1]) * (1.f / 512.f) + EPS);
    bf16* orow = C.MIX() + (size_t)(r0 + t) * DM;
#pragma unroll
    for (int h = 0; h < 4; ++h)
#pragma unroll
        for (int dbi = 0; dbi < 2; ++dbi)
#pragma unroll
            for (int rg = 0; rg < 4; ++rg) {
                const int c = h * 128 + 32 * (2 * dh + dbi) + 8 * rg + 4 * hh;
                const v4f ga = *(const v4f*)(C.in(24) + c);
                const unsigned w0 = outp[h][dbi][2 * rg], w1 = outp[h][dbi][2 * rg + 1];
                v2u o; o.x = cvt_pk_bf16(bf_lo(w0) * rstd * ga.x, bf_hi(w0) * rstd * ga.y); o.y = cvt_pk_bf16(bf_lo(w1) * rstd * ga.z, bf_hi(w1) * rstd * ga.w);
                *(v2u*)(orow + c) = o;
            }
    __syncthreads();
}

struct Args { const float* in[33]; float* out; unsigned char* ws; };
#ifndef PH_LO
#define PH_LO 0
#endif
#ifndef PH_HI
#define PH_HI 14
#endif

__global__ void __launch_bounds__(NTHREADS, 2) fwd_kernel(Args args) {
    extern __shared__ __attribute__((aligned(16))) unsigned char lds_raw[];
    cg::grid_group grid = cg::this_grid();
    LAS unsigned char* lds = (LAS unsigned char*)lds_raw;
    Ctx C;
#define TID ((int)threadIdx.x)
#define LANE ((int)(threadIdx.x & 63))
#define WAVE (__builtin_amdgcn_readfirstlane((int)(threadIdx.x >> 6)))
#define GSZ ((int)gridDim.x)
#define BX ((int)blockIdx.x)
#define GWV (BX * NWAVES + WAVE)
#define NGWV (GSZ * NWAVES)
    p0_prologue(C, lds, WAVE, LANE, TID);
    grid.sync();
    { pg8::Gemm g{C.XN(), C.Wgu1(), MPAD, 2 * DFF, DM}; pg8::StaticOrder S; S.init(MPAD, 2 * DFF, GSZ, BX); pg8::EpiSwiglu E{C.H(), DFF};
      pg8::gemm_phase<pg8::EpiSwiglu, pg8::StaticOrder, true, true>(lds, g, S, E); }
    grid.sync();
    { pg8::Gemm g{C.H(), C.Wd1(), MPAD, DM, DFF}; pg8::StaticOrder S; S.init(MPAD, DM, GSZ, BX); pg8::EpiBf16<0> E{C.D(), DM, 0, nullptr, nullptr, 0};
      pg8::gemm_phase<pg8::EpiBf16<0>, pg8::StaticOrder, true, true>(lds, g, S, E); }
    grid.sync();
    for (int m = GWV; m < M; m += NGWV) row_res(xrow_ptr(C, m), C.D() + (size_t)m * DM, C.in(8), 0.5f, C.out() + (size_t)m * DM, C.in(9), C.XN() + (size_t)m * DM, LANE);
    grid.sync();
    { pg8::Gemm g{C.XN(), C.Win(), MPAD, DIN, DM}; pg8::StaticOrder S; S.init(MPAD, DIN, GSZ, BX); pg8::EpiBf16<1> E{C.Z(), DIN, 2 * AW, nullptr, nullptr, 0};
      pg8::gemm_phase<pg8::EpiBf16<1>, pg8::StaticOrder, true, true>(lds, g, S, E); }
    grid.sync();
    for (int T = BX; T < NTILE; T += GSZ) {
        if (T < NTILE - 1) s5_tile<false>(C, T, lds, WAVE, LANE);
        gmlp_tile(C, T, lds, WAVE, LANE, TID);
    }
    grid.sync();
    for (int T = BX; T < NTILE; T += GSZ) s5_tile<true>(C, T, lds, WAVE, LANE);
    grid.sync();
    { pg8::Gemm g{C.YB(), C.Wglu(), MPAD, BWD, BWD}; pg8::StaticOrder S; S.init(MPAD, BWD, GSZ, BX); pg8::EpiBf16<2> E{C.MIX() + AW, DM, 0, C.in(23), C.YB(), BWD};
      pg8::gemm_phase<pg8::EpiBf16<2>, pg8::StaticOrder, true, true>(lds, g, S, E); }
    grid.sync();
    for (int m = GWV; m < M; m += NGWV) row_norm512(C.MIX() + (size_t)m * DM + AW, C.in(25), LANE);
    grid.sync();
    { pg8::Gemm g{C.MIX(), C.Wout(), MPAD, DM, DM}; pg8::StaticOrder S; S.init(MPAD, DM, GSZ, BX); pg8::EpiBf16<0> E{C.D(), DM, 0, nullptr, nullptr, 0};
      pg8::gemm_phase<pg8::EpiBf16<0>, pg8::StaticOrder, true, true>(lds, g, S, E); }
    grid.sync();
    for (int m = GWV; m < M; m += NGWV) row_res(C.out() + (size_t)m * DM, C.D() + (size_t)m * DM, C.in(27), 1.0f, C.out() + (size_t)m * DM, C.in(28), C.XN() + (size_t)m * DM, LANE);
    grid.sync();
    { pg8::Gemm g{C.XN(), C.Wgu2(), MPAD, 2 * DFF, DM}; pg8::StaticOrder S; S.init(MPAD, 2 * DFF, GSZ, BX); pg8::EpiSwiglu E{C.H(), DFF};
      pg8::gemm_phase<pg8::EpiSwiglu, pg8::StaticOrder, true, true>(lds, g, S, E); }
    grid.sync();
    { pg8::Gemm g{C.H(), C.Wd2(), MPAD, DM, DFF}; pg8::StaticOrder S; S.init(MPAD, DM, GSZ, BX); pg8::EpiBf16<0> E{C.D(), DM, 0, nullptr, nullptr, 0};
      pg8::gemm_phase<pg8::EpiBf16<0>, pg8::StaticOrder, true, true>(lds, g, S, E); }
    grid.sync();
    for (int m = GWV; m < M; m += NGWV) row_res(C.out() + (size_t)m * DM, C.D() + (size_t)m * DM, C.in(32), 0.5f, C.out() + (size_t)m * DM, nullptr, nullptr, LANE);
}

extern "C" void kernel_launch(void* const* d_in, const int* in_sizes, int n_in, void* d_out, int out_size, void* d_ws, size_t ws_size, hipStream_t stream) {
    static int grid = 0;
    if (grid == 0) {
        if (n_in != 33 || ws_size < WS_END) { fprintf(stderr, "kernel_launch: unexpected n_in %d / ws %zu\n", n_in, ws_size); grid = -1; return; }
        int dev = 0, cus = 0, per_cu = 0;
        hipGetDevice(&dev);
        hipDeviceGetAttribute(&cus, hipDeviceAttributeMultiprocessorCount, dev);
        hipFuncSetAttribute((const void*)fwd_kernel, hipFuncAttributeMaxDynamicSharedMemorySize, LDS_BYTES);
        hipOccupancyMaxActiveBlocksPerMultiprocessor(&per_cu, (const void*)fwd_kernel, NTHREADS, LDS_BYTES);
        if (per_cu < 1) { fprintf(stderr, "kernel_launch: occupancy query says %d blocks per CU\n", per_cu); per_cu = 1; }
        grid = cus * per_cu;
    }
    if (grid < 0) return;
    Args a{};
    for (int i = 0; i < 33; ++i) a.in[i] = (const float*)d_in[i];
    a.out = (float*)d_out; a.ws = (unsigned char*)d_ws;
    void* params[] = {&a};
    hipError_t e = hipLaunchCooperativeKernel((const void*)fwd_kernel, dim3(grid), dim3(NTHREADS), params, LDS_BYTES, stream);
    if (e != hipSuccess) fprintf(stderr, "cooperative launch failed: %s (grid %d)\n", hipGetErrorString(e), grid);
}
```

```cpp
#include <hip/hip_runtime.h>
#include <hip/hip_cooperative_groups.h>
#include <cstdio>
#include <cstdint>
namespace cg = cooperative_groups;
__device__ __forceinline__ int fresh_tid() { int t = (int)threadIdx.x; asm volatile("" : "+v"(t)); return t; }
namespace pg8 {
#define PG8_LAS __attribute__((address_space(3)))
typedef unsigned short bf16_t;
typedef short bf16x8 __attribute__((ext_vector_type(8)));
typedef float f32x4 __attribute__((ext_vector_type(4)));
typedef unsigned u32x4 __attribute__((ext_vector_type(4)));
constexpr int BM = 256, BK = 64, HALF = 128, HTB = HALF * BK * 2  , STAGE_BYTES = 8 * HTB, NXCD = 8, WGM = 8;

__host__ __device__ __forceinline__ int lds_byte(int r, int c) { const int st = (r >> 4) * 2 + (c >> 5), rr = r & 15, cc = c & 31, ob = rr * 64 + cc * 2; return st * 1024 + (ob ^ (((ob >> 9) & 1) << 5)); }
__host__ __device__ __forceinline__ void stage_rc(int b, int& R, int& C) { const int st = b / 1024, sb = b % 1024, swz = sb ^ (((sb >> 9) & 1) << 5); R = (st >> 1) * 16 + swz / 64; C = (st & 1) * 32 + (swz % 64) / 2; }
__host__ __device__ __forceinline__ int perm32(int rho) { const int n = rho >> 4, i = rho & 15; return 8 * (i >> 2) + 4 * n + (i & 3); }

struct Unit { int pm, pn; };
struct Gemm { const bf16_t* A; const bf16_t* Bt; int M, N, K; };

struct StaticOrder {
    int nM, nN, nwg, G, c;
    __host__ __device__ void init(int M, int N, int G_, int c_) { nM = M / BM; nN = N / BM; nwg = nM * nN; G = G_; c = c_; }
    __host__ __device__ bool next(int i, Unit& u) const {
        const long L = (long)i * G + c; if (L >= nwg) return false;
        int wgid = (int)L; { const int q = nwg / NXCD, r = nwg % NXCD, xcd = wgid % NXCD, off = wgid / NXCD; wgid = (xcd < r ? xcd * (q + 1) : r * (q + 1) + (xcd - r) * q) + off; }
        const int nig = WGM * nN, gid = wgid / nig, fm = gid * WGM, gsz = (nM - fm) < WGM ? (nM - fm) : WGM;
        u.pm = fm + ((wgid % nig) % gsz); u.pn = (wgid % nig) / gsz; return true;
    }
    __device__ __forceinline__ void a_ready(const Unit&) const {}
    __device__ __forceinline__ void done(const Unit&) const {}
};

__device__ __forceinline__ unsigned cvt_pk_bf16(float lo, float hi) { unsigned r; asm volatile("v_cvt_pk_bf16_f32 %0, %1, %2" : "=v"(r) : "v"(lo), "v"(hi)); return r; }
__device__ __forceinline__ float bf_lo(unsigned w) { return __uint_as_float(w << 16); }
__device__ __forceinline__ float bf_hi(unsigned w) { return __uint_as_float(w & 0xffff0000u); }
__device__ __forceinline__ float sigmoid_f(float x) { return __builtin_amdgcn_rcpf(1.0f + __expf(-x)); }
__device__ __forceinline__ float silu_f(float x) { return x * sigmoid_f(x); }
__device__ __forceinline__ float gelu_t(float x) { const float u = 1.5957691216057308f * (x + 0.044715f * x * x * x); return x * sigmoid_f(u); }

struct EpiSwiglu {
    static constexpr bool PERM = true, AFTER_DRAIN = false;
    bf16_t* O; int ldc;
    __device__ __forceinline__ void operator()(const f32x4 (&acc)[2][2][4][2], const Unit& u, int wr, int wc, int fr, int fq) const {
        const int row0 = u.pm * BM + wr * 64 + fr; const int col0 = u.pn * HALF + wc * 32 + 8 * fq;
#pragma unroll
        for (int ai = 0; ai < 2; ++ai)
#pragma unroll
            for (int m = 0; m < 4; ++m) {
                bf16_t* rowp = O + (size_t)(row0 + ai * HALF + m * 16) * ldc + col0;
                const f32x4 g0 = acc[ai][0][m][0], g1 = acc[ai][0][m][1], u0 = acc[ai][1][m][0], u1 = acc[ai][1][m][1];
                u32x4 w;
                w.x = cvt_pk_bf16(silu_f(g0[0]) * u0[0], silu_f(g0[1]) * u0[1]); w.y = cvt_pk_bf16(silu_f(g0[2]) * u0[2], silu_f(g0[3]) * u0[3]);
                w.z = cvt_pk_bf16(silu_f(g1[0]) * u1[0], silu_f(g1[1]) * u1[1]); w.w = cvt_pk_bf16(silu_f(g1[2]) * u1[2], silu_f(g1[3]) * u1[3]);
                *(u32x4*)rowp = w;
            }
    }
};
template <int MODE> struct EpiBf16 {
    static constexpr bool PERM = true, AFTER_DRAIN = false;
    bf16_t* O; int ldc; int act_cols; const float* bias; const bf16_t* Y; int ldy;
    __device__ __forceinline__ void operator()(const f32x4 (&acc)[2][2][4][2], const Unit& u, int wr, int wc, int fr, int fq) const {
        const int row0 = u.pm * BM + wr * 64 + fr; const int col0 = u.pn * BM + wc * 32 + 8 * fq;
#pragma unroll
        for (int bj = 0; bj < 2; ++bj) {
            const int col = col0 + bj * HALF;
            f32x4 b0 = (f32x4){0.f, 0.f, 0.f, 0.f}, b1 = b0;
            if (MODE == 2) { b0 = *(const f32x4*)(bias + col); b1 = *(const f32x4*)(bias + col + 4); }
            const bool act = (MODE == 1) && (col < act_cols);
#pragma unroll
            for (int ai = 0; ai < 2; ++ai)
#pragma unroll
                for (int m = 0; m < 4; ++m) {
                    const size_t row = (size_t)(row0 + ai * HALF + m * 16);
                    f32x4 v0 = acc[ai][bj][m][0], v1 = acc[ai][bj][m][1];
                    if (MODE == 1) { if (act) {
#pragma unroll
                        for (int j = 0; j < 4; ++j) { v0[j] = gelu_t(v0[j]); v1[j] = gelu_t(v1[j]); } } }
                    if (MODE == 2) {
                        const u32x4 y = *(const u32x4*)(Y + row * ldy + col);
                        v0 = v0 + b0; v1 = v1 + b1;
                        v0[0] = bf_lo(y.x) * sigmoid_f(v0[0]); v0[1] = bf_hi(y.x) * sigmoid_f(v0[1]); v0[2] = bf_lo(y.y) * sigmoid_f(v0[2]); v0[3] = bf_hi(y.y) * sigmoid_f(v0[3]);
                        v1[0] = bf_lo(y.z) * sigmoid_f(v1[0]); v1[1] = bf_hi(y.z) * sigmoid_f(v1[1]); v1[2] = bf_lo(y.w) * sigmoid_f(v1[2]); v1[3] = bf_hi(y.w) * sigmoid_f(v1[3]);
                    }
                    u32x4 w; w.x = cvt_pk_bf16(v0[0], v0[1]); w.y = cvt_pk_bf16(v0[2], v0[3]); w.z = cvt_pk_bf16(v1[0], v1[1]); w.w = cvt_pk_bf16(v1[2], v1[3]);
                    *(u32x4*)(O + row * ldc + col) = w;
                }
        }
    }
};

template <class Epi, class Sched, bool ALIGN_EPI = false, bool SP2 = false>
__device__ __forceinline__ void gemm_phase(PG8_LAS unsigned char* lds, const Gemm g, const Sched& S, const Epi& E) {
    const int tid = fresh_tid(), wid = __builtin_amdgcn_readfirstlane(tid >> 6), lane = tid & 63, wr = wid >> 2, wc = wid & 3, fr = lane & 15, fq = lane >> 4;
    const int K = g.K, nt = K / BK;
    unsigned voffA[2], voffB[2];
#pragma unroll
    for (int i = 0; i < 2; ++i) { int R, C; stage_rc(tid * 16 + i * 8192, R, C); const int Rb = Epi::PERM ? ((R & ~31) + perm32(R & 31)) : R;
        voffA[i] = (unsigned)(R * K + C) * 2u; voffB[i] = (unsigned)(Rb * K + C) * 2u; }
    const size_t kstep = (size_t)(BK * 2);
    const size_t hstep = (size_t)HALF * K * 2;
    const size_t tstep = 2 * hstep;
    const unsigned ldsw = (unsigned)wid * 1024u;
    const int aoff = lds_byte(wr * 64 + fr, fq * 8), boff = lds_byte(wc * 32 + fr, fq * 8);
#define PG8_SA(b, h) (((b) * 2 + (h)) * HTB)
#define PG8_SB(b, h) ((4 + (b) * 2 + (h)) * HTB)
#define PG8_STAGE(bufoff, gbase, voff) do { _Pragma("unroll") for (int _i = 0; _i < 2; ++_i) \
        __builtin_amdgcn_global_load_lds((const unsigned*)((const char*)(gbase) + (voff)[_i]), (PG8_LAS unsigned*)(lds + (bufoff) + ldsw + _i * 8192), 16, 0, 0); } while (0)
#define PG8_LDA(dst, b, h) do { _Pragma("unroll") for (int m = 0; m < 4; ++m) _Pragma("unroll") for (int k = 0; k < 2; ++k) dst[m][k] = *(const PG8_LAS bf16x8*)(lds + PG8_SA(b, h) + aoff + m * 2048 + k * 1024); } while (0)
#define PG8_LDB(dst, b, h) do { _Pragma("unroll") for (int n = 0; n < 2; ++n) _Pragma("unroll") for (int k = 0; k < 2; ++k) dst[n][k] = *(const PG8_LAS bf16x8*)(lds + PG8_SB(b, h) + boff + n * 2048 + k * 1024); } while (0)
#define PG8_MMA(ai, bj, At, Bt) do { __builtin_amdgcn_s_setprio(1); _Pragma("unroll") for (int m = 0; m < 4; ++m) _Pragma("unroll") for (int n = 0; n < 2; ++n) _Pragma("unroll") for (int k = 0; k < 2; ++k) \
        acc[ai][bj][m][n] = __builtin_amdgcn_mfma_f32_16x16x32_bf16(Bt[n][k], At[m][k], acc[ai][bj][m][n], 0, 0, 0); __builtin_amdgcn_s_setprio(0); } while (0)
#define PG8_WAIT_V(n) asm volatile("s_waitcnt vmcnt(" #n ")" ::: "memory")
#define PG8_WAIT_L(n) asm volatile("s_waitcnt lgkmcnt(" #n ")" ::: "memory")
#define PG8_BAR __builtin_amdgcn_s_barrier()
#define PG8_SCHED __builtin_amdgcn_sched_barrier(0)
    Unit cur, nxt; int ui = 0;
    if (!S.next(0, cur)) return;
    f32x4 acc[2][2][4][2];
#pragma unroll
    for (int a = 0; a < 2; ++a)
#pragma unroll
        for (int b = 0; b < 2; ++b)
#pragma unroll
            for (int m = 0; m < 4; ++m)
#pragma unroll
                for (int n = 0; n < 2; ++n) acc[a][b][m][n] = (f32x4){0.f, 0.f, 0.f, 0.f};
    bf16x8 At[4][2], B0[2][2], B1[2][2];
    const char* cA = (const char*)g.A + (size_t)cur.pm * tstep; const char* cB = (const char*)g.Bt + (size_t)cur.pn * tstep;
    S.a_ready(cur);
    if constexpr (SP2) {
        PG8_STAGE(PG8_SB(0, 0), cB, voffB); PG8_STAGE(PG8_SB(0, 1), cB + hstep, voffB); PG8_STAGE(PG8_SA(0, 0), cA, voffA); PG8_STAGE(PG8_SA(0, 1), cA + hstep, voffA);
        if (wr == 1) PG8_BAR;
        PG8_WAIT_V(2); PG8_BAR;
        PG8_STAGE(PG8_SB(1, 0), cB + kstep, voffB); PG8_STAGE(PG8_SA(1, 0), cA + kstep, voffA); PG8_STAGE(PG8_SB(1, 1), cB + hstep + kstep, voffB);
        PG8_WAIT_V(6); PG8_BAR;
    } else {
        PG8_STAGE(PG8_SB(0, 0), cB, voffB); PG8_STAGE(PG8_SA(0, 0), cA, voffA); PG8_STAGE(PG8_SB(0, 1), cB + hstep, voffB); PG8_STAGE(PG8_SA(0, 1), cA + hstep, voffA);
        if (wr == 1) PG8_BAR;
        PG8_WAIT_V(4); PG8_BAR;
        PG8_STAGE(PG8_SB(1, 0), cB + kstep, voffB); PG8_STAGE(PG8_SA(1, 0), cA + kstep, voffA); PG8_STAGE(PG8_SB(1, 1), cB + hstep + kstep, voffB);
        PG8_WAIT_V(6); PG8_BAR;
    }
    for (;;) {
        const bool has_next = S.next(ui + 1, nxt);
        const char* nA = has_next ? (const char*)g.A + (size_t)nxt.pm * tstep : cA; const char* nB = has_next ? (const char*)g.Bt + (size_t)nxt.pn * tstep : cB;
        for (int t = 0; t < nt; t += 2) {
            const bool last = (t == nt - 2);
            const char* a1 = cA + (size_t)(t + 1) * kstep;
            const char* a2 = last ? nA : cA + (size_t)(t + 2) * kstep; const char* b2 = last ? nB : cB + (size_t)(t + 2) * kstep;
            const char* a3 = a2 + kstep; const char* b3 = b2 + kstep;
            if (last && has_next) S.a_ready(nxt);
            if constexpr (SP2) {
            PG8_LDB(B0, 0, 0); PG8_LDB(B1, 0, 1); PG8_SCHED; PG8_LDA(At, 0, 0); PG8_STAGE(PG8_SA(1, 1), a1 + hstep, voffA);
            PG8_WAIT_V(8); PG8_WAIT_L(0); PG8_BAR; PG8_MMA(0, 0, At, B0); PG8_MMA(0, 1, At, B1); PG8_BAR; PG8_SCHED;
            PG8_LDA(At, 0, 1); PG8_STAGE(PG8_SB(0, 0), b2, voffB); PG8_STAGE(PG8_SB(0, 1), b2 + hstep, voffB); PG8_STAGE(PG8_SA(0, 0), a2, voffA);
            PG8_WAIT_V(8); PG8_WAIT_L(0); PG8_BAR; PG8_MMA(1, 0, At, B0); PG8_MMA(1, 1, At, B1); PG8_BAR; PG8_SCHED;
            PG8_LDB(B0, 1, 0); PG8_LDB(B1, 1, 1); PG8_SCHED; PG8_LDA(At, 1, 0); PG8_STAGE(PG8_SA(0, 1), a2 + hstep, voffA);
            PG8_WAIT_V(8); PG8_WAIT_L(0); PG8_BAR; PG8_MMA(0, 0, At, B0); PG8_MMA(0, 1, At, B1); PG8_BAR; PG8_SCHED;
            PG8_LDA(At, 1, 1); PG8_STAGE(PG8_SB(1, 0), b3, voffB); PG8_STAGE(PG8_SB(1, 1), b3 + hstep, voffB); PG8_STAGE(PG8_SA(1, 0), a3, voffA);
            PG8_WAIT_V(8); PG8_WAIT_L(0); PG8_BAR; PG8_MMA(1, 0, At, B0); PG8_MMA(1, 1, At, B1); PG8_BAR; PG8_SCHED;
            } else {
            PG8_LDB(B0, 0, 0); PG8_SCHED; PG8_LDA(At, 0, 0); PG8_STAGE(PG8_SA(1, 1), a1 + hstep, voffA);
            PG8_WAIT_L(8); PG8_BAR; PG8_WAIT_L(0); PG8_MMA(0, 0, At, B0); PG8_BAR; PG8_SCHED;
            PG8_LDB(B1, 0, 1); PG8_STAGE(PG8_SB(0, 0), b2, voffB);
            PG8_BAR; PG8_WAIT_L(0); PG8_MMA(0, 1, At, B1); PG8_BAR;
            PG8_LDA(At, 0, 1); PG8_STAGE(PG8_SA(0, 0), a2, voffA);
            PG8_BAR; PG8_WAIT_L(0); PG8_MMA(1, 0, At, B0); PG8_BAR; PG8_SCHED;
            PG8_STAGE(PG8_SB(0, 1), b2 + hstep, voffB);
            PG8_WAIT_V(6); PG8_BAR; PG8_MMA(1, 1, At, B1); PG8_BAR;
            PG8_LDB(B0, 1, 0); PG8_SCHED; PG8_LDA(At, 1, 0); PG8_STAGE(PG8_SA(0, 1), a2 + hstep, voffA);
            PG8_WAIT_L(8); PG8_BAR; PG8_WAIT_L(0); PG8_MMA(0, 0, At, B0); PG8_BAR; PG8_SCHED;
            PG8_LDB(B1, 1, 1); PG8_STAGE(PG8_SB(1, 0), b3, voffB);
            PG8_BAR; PG8_WAIT_L(0); PG8_MMA(0, 1, At, B1); PG8_BAR;
            PG8_LDA(At, 1, 1); PG8_STAGE(PG8_SA(1, 0), a3, voffA);
            PG8_BAR; PG8_WAIT_L(0); PG8_MMA(1, 0, At, B0); PG8_BAR; PG8_SCHED;
            PG8_STAGE(PG8_SB(1, 1), b3 + hstep, voffB);
            PG8_WAIT_V(6); PG8_BAR; PG8_MMA(1, 1, At, B1); PG8_BAR;
            }
        }
        if constexpr (ALIGN_EPI) { if (wr == 0) PG8_BAR; }
        if constexpr (!Epi::AFTER_DRAIN) { E(acc, cur, wr, wc, fr, fq); S.done(cur); }
        if (!has_next) break;
#pragma unroll
        for (int a = 0; a < 2; ++a)
#pragma unroll
            for (int b = 0; b < 2; ++b)
#pragma unroll
                for (int m = 0; m < 4; ++m)
#pragma unroll
                    for (int n = 0; n < 2; ++n) acc[a][b][m][n] = (f32x4){0.f, 0.f, 0.f, 0.f};
        cur = nxt; cA = nA; cB = nB; ++ui;
        if constexpr (ALIGN_EPI) { if (wr == 1) PG8_BAR; }
    }
    PG8_WAIT_V(0);
    if constexpr (!ALIGN_EPI) { if (wr == 0) PG8_BAR; }
    PG8_BAR;
    if constexpr (Epi::AFTER_DRAIN) { E.fused(acc, cur, wr, wc, fr, fq, lds, wid, lane); S.done(cur); }
#undef PG8_SA
#undef PG8_SB
#undef PG8_STAGE
#undef PG8_LDA
#undef PG8_LDB
#undef PG8_MMA
#undef PG8_WAIT_V
#undef PG8_WAIT_L
#undef PG8_BAR
#undef PG8_SCHED
}
}

constexpr int DM = 1024, SEQ = 16384, NBATCH = 2, MPROMPT = NBATCH * SEQ, DEC_B = 8, DEC_S = 16;
constexpr int M = MPROMPT + DEC_B * DEC_S;
constexpr int MPAD = 33024;
constexpr int DFF = 2816, DIN = 1536, AW = 512, BWD = 512, NG = 32, NP = 64, GN = 16;
constexpr int NTILE = M / 128;
constexpr float EPS = 1e-6f;
constexpr int NWAVES = 8, NTHREADS = 512;

constexpr size_t MiB = 1u << 20;
constexpr size_t WS_WGU1 = 1 * MiB, WS_WD1 = 12 * MiB, WS_WIN = 18 * MiB, WS_WGLU = 21 * MiB, WS_WOUT = 22 * MiB, WS_WGU2 = 24 * MiB, WS_WD2 = 35 * MiB;
constexpr size_t WS_WEFF = 41 * MiB, WS_BB = 42 * MiB, WS_CM = 42 * MiB + 131072, WS_LAM = 42 * MiB + 262144, WS_E = 43 * MiB;
constexpr size_t WS_XN = 48 * MiB, WS_D = 113 * MiB, WS_H = 178 * MiB, WS_Z = 178 * MiB, WS_YB = 275 * MiB, WS_MIX = 356 * MiB, WS_END = 421 * MiB;
static_assert(WS_XN + (size_t)MPAD * DM * 2 <= WS_D && WS_D + (size_t)MPAD * DM * 2 <= WS_H && WS_H + (size_t)MPAD * DFF * 2 <= WS_MIX, "ws map");
static_assert(WS_Z + (size_t)MPAD * DIN * 2 <= WS_YB && WS_YB + (size_t)MPAD * BWD * 2 <= WS_H + (size_t)MPAD * DFF * 2 && WS_MIX + (size_t)MPAD * DM * 2 <= WS_END, "ws map 2");
static_assert(WS_E + (size_t)NTILE * NG * NP * 8 <= WS_XN, "ws map 3");

constexpr size_t OFF_Y = 0, OFF_SRE_P = (size_t)M * DM, OFF_SIM_P = OFF_SRE_P + NBATCH * NG * NP, OFF_SRE_S = OFF_SIM_P + NBATCH * NG * NP,
                 OFF_SIM_S = OFF_SRE_S + DEC_B * NG * NP, OFF_V_S = OFF_SIM_S + DEC_B * NG * NP;

constexpr int GEMM_LDS = 131072;
constexpr int S5_ROW = 132;
constexpr int S5_WAVE_BYTES = 32 * S5_ROW * 4;
constexpr int VT_STRIDE = 136;
constexpr int LDS_BYTES = 147456;
static_assert(NWAVES * S5_WAVE_BYTES <= LDS_BYTES && 128 * VT_STRIDE * 2 + 4096 <= LDS_BYTES, "lds map");

#define LAS __attribute__((address_space(3)))
typedef unsigned short bf16;
typedef float v4f __attribute__((ext_vector_type(4)));
typedef float v2f __attribute__((ext_vector_type(2)));
typedef float v16f __attribute__((ext_vector_type(16)));
typedef unsigned v4u __attribute__((ext_vector_type(4)));
typedef unsigned v2u __attribute__((ext_vector_type(2)));
typedef short bfx8 __attribute__((ext_vector_type(8)));
#define LDS_FENCE() asm volatile("s_waitcnt lgkmcnt(0)" ::: "memory")

using pg8::cvt_pk_bf16; using pg8::bf_lo; using pg8::bf_hi; using pg8::gelu_t;

__device__ __forceinline__ float wave_sum(float v) {
#pragma unroll
    for (int o = 1; o < 64; o <<= 1) v += __shfl_xor(v, o);
    return v;
}
__device__ __forceinline__ bf16 f2bf(float f) { return (bf16)(cvt_pk_bf16(f, 0.f) & 0xffffu); }


__device__ __forceinline__ double dexp(double x) {
    const double y = x * (1.0 / 256.0); double t = 1.0;
#pragma unroll
    for (int i = 12; i >= 1; --i) t = 1.0 + t * y / (double)i;
#pragma unroll
    for (int i = 0; i < 8; ++i) t = t * t;
    return t;
}
__device__ __forceinline__ void dsincos(double x, double& s, double& c) {
    const double twopi = 6.283185307179586476925286766559;
    const double k = rint(x / twopi); const double r = x - k * twopi, r2 = r * r;
    double ts = r, tc = 1.0; s = r; c = 1.0;
#pragma unroll
    for (int i = 1; i <= 15; ++i) { tc = -tc * r2 / (double)((2 * i - 1) * (2 * i)); ts = -ts * r2 / (double)((2 * i) * (2 * i + 1)); c += tc; s += ts; }
}

typedef const float* cfp_t;
typedef __attribute__((address_space(4))) cfp_t const* kin_t;
__device__ __forceinline__ const float* karg_in(int i) {
    auto k = __builtin_amdgcn_kernarg_segment_ptr();
    asm volatile("" : "+s"(k));
    return ((kin_t)k)[i];
}
struct Ctx {
    __device__ __forceinline__ const float* in(int i) const { return karg_in(i); }
    __device__ __forceinline__ float* out() const { return (float*)karg_in(33); }
    __device__ __forceinline__ unsigned char* ws() const { return (unsigned char*)karg_in(34); }
#define WSP(name, T, off) __device__ __forceinline__ T* name() const { return (T*)(ws() + (off)); }
    WSP(Wgu1, bf16, WS_WGU1) WSP(Wd1, bf16, WS_WD1) WSP(Win, bf16, WS_WIN) WSP(Wglu, bf16, WS_WGLU) WSP(Wout, bf16, WS_WOUT) WSP(Wgu2, bf16, WS_WGU2) WSP(Wd2, bf16, WS_WD2)
    WSP(Weff, bf16, WS_WEFF) WSP(BB, bf16, WS_BB) WSP(CM, bf16, WS_CM) WSP(XN, bf16, WS_XN) WSP(D, bf16, WS_D) WSP(H, bf16, WS_H) WSP(Z, bf16, WS_Z) WSP(YB, bf16, WS_YB) WSP(MIX, bf16, WS_MIX)
    WSP(LAM, float, WS_LAM) WSP(E, float, WS_E)
#undef WSP
};

__device__ __forceinline__ void p0_transpose_item(const float* W, int N, bf16* WT, int K, int k0, int n0, int drow0, LAS float* scr, int lane) {
#pragma unroll 8
    for (int i = 0; i < 32; ++i) { const int kk = 2 * i + (lane >> 5); scr[kk * 33 + (lane & 31)] = W[(size_t)(k0 + kk) * N + n0 + (lane & 31)]; }
    LDS_FENCE();
    const int c = lane & 7;
#pragma unroll
    for (int j = 0; j < 4; ++j) { const int n = (lane >> 3) + 8 * j; const LAS float* s = scr + (8 * c) * 33 + n;
        v4u o; o.x = cvt_pk_bf16(s[0 * 33], s[1 * 33]); o.y = cvt_pk_bf16(s[2 * 33], s[3 * 33]); o.z = cvt_pk_bf16(s[4 * 33], s[5 * 33]); o.w = cvt_pk_bf16(s[6 * 33], s[7 * 33]);
        *(v4u*)(WT + (size_t)(drow0 + n) * K + k0 + 8 * c) = o; }
    LDS_FENCE();
}
__device__ __forceinline__ void p0_matrix_item(const float* W, int K, int N, bf16* WT, int mode, int item, LAS float* scr, int lane) {
    const int nblk = N / 32, kb = item / nblk, nb = item % nblk, n0 = 32 * nb;
    const int drow0 = (mode == 0) ? n0 : (256 * (n0 / 128) + (n0 % 128) + (mode == 2 ? 128 : 0));
    p0_transpose_item(W, N, WT, K, 64 * kb, n0, drow0, scr, lane);
}
__device__ __forceinline__ const float* xrow_ptr(const Ctx& C, int row) { return row < MPROMPT ? C.in(0) + (size_t)row * DM : C.in(1) + (size_t)(row - MPROMPT) * DM; }

__device__ __forceinline__ void row_xn(const float* xrow, const float* g, bf16* orow, int lane) {
    v4f v[4]; float s = 0.f;
#pragma unroll
    for (int j = 0; j < 4; ++j) { v[j] = *(const v4f*)(xrow + 4 * lane + 256 * j); s += (v[j].x * v[j].x + v[j].y * v[j].y) + (v[j].z * v[j].z + v[j].w * v[j].w); }
    const float r = rsqrtf(wave_sum(s) * (1.f / DM) + EPS);
#pragma unroll
    for (int j = 0; j < 4; ++j) { const v4f gg = *(const v4f*)(g + 4 * lane + 256 * j); const v4f o = v[j] * r * gg;
        v2u w; w.x = cvt_pk_bf16(o.x, o.y); w.y = cvt_pk_bf16(o.z, o.w); *(v2u*)(orow + 4 * lane + 256 * j) = w; }
}
__device__ __forceinline__ void row_res(const float* base, const bf16* drow, const float* gpost, float scale, float* out, const float* gnext, bf16* xn, int lane) {
    v4f d[4]; float s = 0.f;
#pragma unroll
    for (int j = 0; j < 4; ++j) { const v2u w = *(const v2u*)(drow + 4 * lane + 256 * j); d[j] = (v4f){bf_lo(w.x), bf_hi(w.x), bf_lo(w.y), bf_hi(w.y)};
        s += (d[j].x * d[j].x + d[j].y * d[j].y) + (d[j].z * d[j].z + d[j].w * d[j].w); }
    const float r1 = rsqrtf(wave_sum(s) * (1.f / DM) + EPS) * scale; float s2 = 0.f;
#pragma unroll
    for (int j = 0; j < 4; ++j) { const v4f b = *(const v4f*)(base + 4 * lane + 256 * j); const v4f gp = *(const v4f*)(gpost + 4 * lane + 256 * j);
        d[j] = b + d[j] * r1 * gp; s2 += (d[j].x * d[j].x + d[j].y * d[j].y) + (d[j].z * d[j].z + d[j].w * d[j].w);
        *(v4f*)(out + 4 * lane + 256 * j) = d[j]; }
    if (xn) {
        const float r2 = rsqrtf(wave_sum(s2) * (1.f / DM) + EPS);
#pragma unroll
        for (int j = 0; j < 4; ++j) { const v4f gg = *(const v4f*)(gnext + 4 * lane + 256 * j); const v4f o = d[j] * r2 * gg;
            v2u w; w.x = cvt_pk_bf16(o.x, o.y); w.y = cvt_pk_bf16(o.z, o.w); *(v2u*)(xn + 4 * lane + 256 * j) = w; }
    }
}
__device__ __forceinline__ void row_norm512(bf16* row, const float* g, int lane) {
    const v4u w = *(const v4u*)(row + 8 * lane);
    float v[8] = {bf_lo(w.x), bf_hi(w.x), bf_lo(w.y), bf_hi(w.y), bf_lo(w.z), bf_hi(w.z), bf_lo(w.w), bf_hi(w.w)};
    float s = 0.f;
#pragma unroll
    for (int i = 0; i < 8; ++i) s += v[i] * v[i];
    const float r = rsqrtf(wave_sum(s) * (1.f / 512.f) + EPS);
    const v4f g0 = *(const v4f*)(g + 8 * lane), g1 = *(const v4f*)(g + 8 * lane + 4);
    v4u o; o.x = cvt_pk_bf16(v[0] * r * g0.x, v[1] * r * g0.y); o.y = cvt_pk_bf16(v[2] * r * g0.z, v[3] * r * g0.w);
    o.z = cvt_pk_bf16(v[4] * r * g1.x, v[5] * r * g1.y); o.w = cvt_pk_bf16(v[6] * r * g1.z, v[7] * r * g1.w);
    *(v4u*)(row + 8 * lane) = o;
}

__device__ __forceinline__ void p0_prologue(const Ctx& C, LAS unsigned char* lds, int wave, int lane, int tid) {
    LAS float* scr = (LAS float*)(lds + wave * 16384);
    const int gw = blockIdx.x * NWAVES + wave, NGW = gridDim.x * NWAVES;
    constexpr int I_GU = (DM / 64) * (DFF / 32), I_D = (DFF / 64) * (DM / 32), I_IN = (DM / 64) * (DIN / 32), I_GLU = (BWD / 64) * (BWD / 32), I_OUT = (DM / 64) * (DM / 32);
    constexpr int NITEMS = 4 * I_GU + 2 * I_D + I_IN + I_GLU + I_OUT;
    for (int it = gw; it < NITEMS; it += NGW) {
        int r = it;
        if (r < I_GU) { p0_matrix_item(C.in(5), DM, DFF, C.Wgu1(), 1, r, scr, lane); continue; } r -= I_GU;
        if (r < I_GU) { p0_matrix_item(C.in(6), DM, DFF, C.Wgu1(), 2, r, scr, lane); continue; } r -= I_GU;
        if (r < I_GU) { p0_matrix_item(C.in(29), DM, DFF, C.Wgu2(), 1, r, scr, lane); continue; } r -= I_GU;
        if (r < I_GU) { p0_matrix_item(C.in(30), DM, DFF, C.Wgu2(), 2, r, scr, lane); continue; } r -= I_GU;
        if (r < I_D) { p0_matrix_item(C.in(7), DFF, DM, C.Wd1(), 0, r, scr, lane); continue; } r -= I_D;
        if (r < I_D) { p0_matrix_item(C.in(31), DFF, DM, C.Wd2(), 0, r, scr, lane); continue; } r -= I_D;
        if (r < I_IN) { p0_matrix_item(C.in(10), DM, DIN, C.Win(), 0, r, scr, lane); continue; } r -= I_IN;
        if (r < I_GLU) { p0_matrix_item(C.in(22), BWD, BWD, C.Wglu(), 0, r, scr, lane); continue; } r -= I_GLU;
        p0_matrix_item(C.in(26), DM, DM, C.Wout(), 0, r, scr, lane);
    }
    for (int m = gw; m < M; m += NGW) row_xn(xrow_ptr(C, m), C.in(4), C.XN() + (size_t)m * DM, lane);
    const int gt = blockIdx.x * NTHREADS + tid, NGT = gridDim.x * NTHREADS;
    for (int idx = gt; idx < NG * NP; idx += NGT) {
        const int g = idx / NP, p = idx % NP;
        const double lr = (double)C.in(14)[idx], li = (double)C.in(15)[idx], dt = dexp((double)C.in(16)[g]);
        double s1, c1, s8, c8; dsincos(li * dt, s1, c1); dsincos(li * dt * 128.0, s8, c8);
        const double er = dexp(lr * dt), lbr = er * c1, lbi = er * s1;
        const double e8 = dexp(lr * dt * 128.0), l8r = e8 * c8, l8i = e8 * s8;
        C.LAM()[0 * 2048 + idx] = (float)lbr; C.LAM()[1 * 2048 + idx] = (float)lbi; C.LAM()[2 * 2048 + idx] = (float)l8r; C.LAM()[3 * 2048 + idx] = (float)l8i;
        const double a = lbr - 1.0, b = lbi, den = lr * lr + li * li, cr = (a * lr + b * li) / den, ci = (b * lr - a * li) / den;
        for (int n = 0; n < GN; ++n) {
            const double br = (double)C.in(17)[(size_t)idx * GN + n], bi = (double)C.in(18)[(size_t)idx * GN + n];
            C.BB()[((size_t)g * 128 + p) * GN + n] = f2bf((float)(cr * br - ci * bi));
            C.BB()[((size_t)g * 128 + 64 + p) * GN + n] = f2bf((float)(cr * bi + ci * br));
            C.CM()[((size_t)g * GN + n) * 128 + p] = f2bf(C.in(19)[((size_t)g * GN + n) * NP + p]);
            C.CM()[((size_t)g * GN + n) * 128 + 64 + p] = f2bf(-C.in(20)[((size_t)g * GN + n) * NP + p]);
        }
    }
    for (int idx = gt; idx < 2 * 4 * 128 * 128; idx += NGT) {
        const int s = idx & 127, t = (idx >> 7) & 127, h = (idx >> 14) & 3, mode = idx >> 16;
        float v;
        if (mode == 0) v = (s <= t) ? C.in(12)[((size_t)h * 128 + t) * 128 + s] : 0.f;
        else v = ((s >> 4) == (t >> 4) && (s & 15) <= (t & 15)) ? C.in(12)[((size_t)h * 128 + (t & 15)) * 128 + (s & 15)] : 0.f;
        C.Weff()[idx] = f2bf(v);
    }
}

template <bool PASS2>
__device__ __forceinline__ void s5_tile(const Ctx& C, int T, LAS unsigned char* lds, int wave, int lane) {
    const bool sample = (T == NTILE - 1);
    const int r0 = T * 128;
    LAS float* BU = (LAS float*)(lds + wave * S5_WAVE_BYTES);
    const int tl = lane & 31, hh = lane >> 5, fr = lane & 15, kq = lane >> 4;
    for (int gi = 0; gi < 4; ++gi) {
        const int g = wave * 4 + gi;
        const float lr = C.LAM()[0 * 2048 + g * 64 + lane], li = C.LAM()[1 * 2048 + g * 64 + lane];
        bfx8 bb[4];
#pragma unroll
        for (int cb = 0; cb < 4; ++cb) bb[cb] = *(const bfx8*)(C.BB() + ((size_t)(g * 128 + cb * 32 + tl)) * GN + 8 * hh);
        float sr = 0.f, si = 0.f;
        bfx8 cm[4]; float dsk = 0.f;
        if (PASS2) {
#pragma unroll
            for (int ks = 0; ks < 4; ++ks) cm[ks] = *(const bfx8*)(C.CM() + ((size_t)(g * GN + fr)) * 128 + 32 * ks + 8 * kq);
            dsk = C.in(21)[16 * g + fr];
            if (!sample) {
                const int k = T & 127, tb = T - k;
                const float l8r = C.LAM()[2 * 2048 + g * 64 + lane], l8i = C.LAM()[3 * 2048 + g * 64 + lane];
                const v2f* Ep = (const v2f*)C.E() + ((size_t)tb * NG + g) * NP + lane;
#pragma unroll 8
                for (int j = 0; j < k; ++j) { const v2f e = Ep[(size_t)j * NG * NP]; const float nr = fmaf(l8r, sr, fmaf(-l8i, si, e.x)), ni = fmaf(l8r, si, fmaf(l8i, sr, e.y)); sr = nr; si = ni; }
            }
        }
        for (int sb = 0; sb < 4; ++sb) {
            const int rb0 = r0 + 32 * sb;
            const bf16* zcol = C.Z() + (size_t)1024 + 16 * g;
            const bfx8 a = *(const bfx8*)(zcol + (size_t)(rb0 + tl) * DIN + 8 * hh);
#pragma unroll
            for (int cb = 0; cb < 4; ++cb) {
                v16f acc;
#pragma unroll
                for (int r = 0; r < 16; ++r) acc[r] = 0.f;
                acc = __builtin_amdgcn_mfma_f32_32x32x16_bf16(a, bb[cb], acc, 0, 0, 0);
#pragma unroll
                for (int r = 0; r < 16; ++r) BU[((r & 3) + 8 * (r >> 2) + 4 * hh) * S5_ROW + cb * 32 + tl] = acc[r];
            }
            LDS_FENCE();
#pragma unroll 4
            for (int t = 0; t < 32; ++t) {
                if (sample && (t & 15) == 0) { const int seq = 2 * sb + (t >> 4); sr = C.in(2)[((size_t)seq * NG + g) * NP + lane]; si = C.in(3)[((size_t)seq * NG + g) * NP + lane]; }
                const float re = BU[t * S5_ROW + lane], im = BU[t * S5_ROW + 64 + lane];
                const float nr = fmaf(lr, sr, fmaf(-li, si, re)), ni = fmaf(lr, si, fmaf(li, sr, im));
                sr = nr; si = ni;
                if (PASS2) {
                    const unsigned w = cvt_pk_bf16(sr, si);
                    LAS bf16* srow = (LAS bf16*)(BU + t * S5_ROW);
                    srow[lane] = (bf16)(w & 0xffffu); srow[64 + lane] = (bf16)(w >> 16);
                    if (sample && (t & 15) == 15) { const int seq = 2 * sb + (t >> 4);
                        C.out()[OFF_SRE_S + ((size_t)seq * NG + g) * NP + lane] = sr; C.out()[OFF_SIM_S + ((size_t)seq * NG + g) * NP + lane] = si; }
                }
            }
            LDS_FENCE();
            if (PASS2) {
#pragma unroll
                for (int rb = 0; rb < 2; ++rb) {
                    v4f acc = (v4f){0.f, 0.f, 0.f, 0.f};
#pragma unroll
                    for (int ks = 0; ks < 4; ++ks) {
                        const bfx8 sa = *(const LAS bfx8*)((const LAS unsigned char*)BU + (16 * rb + fr) * (S5_ROW * 4) + (32 * ks + 8 * kq) * 2);
                        acc = __builtin_amdgcn_mfma_f32_16x16x32_bf16(sa, cm[ks], acc, 0, 0, 0);
                    }
#pragma unroll
                    for (int r = 0; r < 4; ++r) {
                        const int row = rb0 + 16 * rb + 4 * kq + r;
                        const float u = __uint_as_float((unsigned)zcol[(size_t)row * DIN + fr] << 16);
                        C.YB()[(size_t)row * BWD + 16 * g + fr] = f2bf(gelu_t(acc[r] + dsk * u));
                    }
                }
                LDS_FENCE();
            }
        }
        if (!PASS2) { v2f* Ep = (v2f*)C.E() + ((size_t)T * NG + g) * NP + lane; *Ep = (v2f){sr, si}; }
        else if (!sample && (T & 127) == 127) { const int b = T >> 7;
            C.out()[OFF_SRE_P + ((size_t)b * NG + g) * NP + lane] = sr; C.out()[OFF_SIM_P + ((size_t)b * NG + g) * NP + lane] = si; }
    }
}

__device__ __forceinline__ void gmlp_tile(const Ctx& C, int T, LAS unsigned char* lds, int wave, int lane, int tid) {
    const int mode = (T == NTILE - 1) ? 1 : 0;
    const int r0 = T * 128;
    LAS bf16* VT = (LAS bf16*)lds;
    LAS float* SSQ = (LAS float*)(lds + 128 * VT_STRIDE * 2);
    const int tb = wave & 3, dh = wave >> 2, tl = lane & 31, hh = lane >> 5;
    const int t = 32 * tb + tl;
    unsigned outp[4][2][8]; float ssq = 0.f;
    const bf16* zt = C.Z() + (size_t)(r0 + t) * DIN;
#pragma unroll
    for (int h = 0; h < 4; ++h) {
        __syncthreads();
        {
            const int row = tid >> 2, q = tid & 3;
            const bf16* src = C.Z() + (size_t)(r0 + row) * DIN + 512 + h * 128 + q * 32;
            float v[32]; float s = 0.f;
#pragma unroll
            for (int i = 0; i < 4; ++i) { const v4u w = *(const v4u*)(src + 8 * i);
                v[8 * i + 0] = bf_lo(w.x); v[8 * i + 1] = bf_hi(w.x); v[8 * i + 2] = bf_lo(w.y); v[8 * i + 3] = bf_hi(w.y);
                v[8 * i + 4] = bf_lo(w.z); v[8 * i + 5] = bf_hi(w.z); v[8 * i + 6] = bf_lo(w.w); v[8 * i + 7] = bf_hi(w.w); }
#pragma unroll
            for (int i = 0; i < 32; ++i) s += v[i] * v[i];
            s += __shfl_xor(s, 1); s += __shfl_xor(s, 2);
            const float r = rsqrtf(s * (1.f / 128.f) + EPS);
            const float* gv = C.in(11) + h * 128 + q * 32;
#pragma unroll
            for (int i = 0; i < 32; ++i) { v[i] = v[i] * r * gv[i]; VT[(q * 32 + i) * VT_STRIDE + row] = f2bf(v[i]); }
            if (mode) { float* ov = C.out() + OFF_V_S + (size_t)row * AW + h * 128 + q * 32;
#pragma unroll
                for (int i = 0; i < 8; ++i) *(v4f*)(ov + 4 * i) = (v4f){v[4 * i], v[4 * i + 1], v[4 * i + 2], v[4 * i + 3]}; }
        }
        __syncthreads();
        bfx8 wf[8];
        const bf16* wrow = C.Weff() + ((size_t)(mode * 4 + h) * 128 + t) * 128 + 8 * hh;
#pragma unroll
        for (int ks = 0; ks < 8; ++ks) wf[ks] = *(const bfx8*)(wrow + 16 * ks);
        const float bias = C.in(13)[h * 128 + (mode ? (t & 15) : t)];
#pragma unroll
        for (int dbi = 0; dbi < 2; ++dbi) {
            const int db = 2 * dh + dbi;
            v16f acc;
#pragma unroll
            for (int r = 0; r < 16; ++r) acc[r] = 0.f;
#pragma unroll
            for (int ks = 0; ks < 8; ++ks) {
                const bfx8 va = *(const LAS bfx8*)(VT + (32 * db + tl) * VT_STRIDE + 16 * ks + 8 * hh);
                acc = __builtin_amdgcn_mfma_f32_32x32x16_bf16(va, wf[ks], acc, 0, 0, 0);
            }
#pragma unroll
            for (int rg = 0; rg < 4; ++rg) {
                const int d0 = 32 * db + 8 * rg + 4 * hh;
                const v2u uw = *(const v2u*)(zt + h * 128 + d0);
                const float o0 = bf_lo(uw.x) * (acc[4 * rg + 0] + bias), o1 = bf_hi(uw.x) * (acc[4 * rg + 1] + bias);
                const float o2 = bf_lo(uw.y) * (acc[4 * rg + 2] + bias), o3 = bf_hi(uw.y) * (acc[4 * rg + 3] + bias);
                ssq += (o0 * o0 + o1 * o1) + (o2 * o2 + o3 * o3);
                outp[h][dbi][2 * rg] = cvt_pk_bf16(o0, o1); outp[h][dbi][2 * rg + 1] = cvt_pk_bf16(o2, o3);
            }
        }
    }
    ssq += __shfl_xor(ssq, 32);
    if (hh == 0) SSQ[t * 2 + dh] = ssq;
    __syncthreads();
    const float rstd = rsqrtf((SSQ[t * 2] + SSQ[t * 2 + 1]) * (1.f / 512.f) + EPS);
    bf16* orow = C.MIX() + (size_t)(r0 + t) * DM;
#pragma unroll
    for (int h = 0; h < 4; ++h)
#pragma unroll
        for (int dbi = 0; dbi < 2; ++dbi)
#pragma unroll
            for (int rg = 0; rg < 4; ++rg) {
                const int c = h * 128 + 32 * (2 * dh + dbi) + 8 * rg + 4 * hh;
                const v4f ga = *(const v4f*)(C.in(24) + c);
                const unsigned w0 = outp[h][dbi][2 * rg], w1 = outp[h][dbi][2 * rg + 1];
                v2u o; o.x = cvt_pk_bf16(bf_lo(w0) * rstd * ga.x, bf_hi(w0) * rstd * ga.y); o.y = cvt_pk_bf16(bf_lo(w1) * rstd * ga.z, bf_hi(w1) * rstd * ga.w);
                *(v2u*)(orow + c) = o;
            }
    __syncthreads();
}

#define FTID const int ftid_ = fresh_tid()
#define TID (ftid_)
#define LANE (ftid_ & 63)
#define WAVE (__builtin_amdgcn_readfirstlane(ftid_ >> 6))
#define GSZ ((int)gridDim.x)
#define BX ((int)blockIdx.x)
#define GWV (BX * NWAVES + WAVE)
#define NGWV (GSZ * NWAVES)


constexpr size_t WS_CTL = 0, CTL_ZERO_BYTES = 16384;
constexpr int MISC_OFF = LDS_BYTES - 64;
#define XB_TMO      128
#define XB_XCNT(j)  (256  + 64 * (j))
#define XB_XSUB(j)  (1280 + 64 * (j))
#define XB_XGEN(j)  (2304 + 64 * (j))
#define XB_TOP      3328
#define XB_TOPGEN   3392
#define XCD_BAR_WORDS 3456
#define XB_SPIN_CAP (1u << 18)

__device__ __forceinline__ unsigned xb_ld(unsigned* p)              { return __hip_atomic_load(p, __ATOMIC_RELAXED, __HIP_MEMORY_SCOPE_AGENT); }
__device__ __forceinline__ unsigned xb_add(unsigned* p, unsigned v) { return __hip_atomic_fetch_add(p, v, __ATOMIC_RELAXED, __HIP_MEMORY_SCOPE_AGENT); }
__device__ __forceinline__ unsigned xb_xcc_id() { return (unsigned)__builtin_amdgcn_s_getreg((3 << 11) | 20) & 0xFu; }
#define XB_SPIN(cond, bar) do { unsigned _sp = 0; while (cond) { __builtin_amdgcn_s_sleep(1); \
    if ((++_sp & 255u) == 0u) { if (xb_ld(&(bar)[XB_TMO])) break; if (_sp > XB_SPIN_CAP) { atomicAdd(&(bar)[XB_TMO], 1u); break; } } } } while (0)

struct XcdBarrier {
    unsigned* bar; unsigned x;
    volatile LAS unsigned* st;
};

__device__ __forceinline__ XcdBarrier xcd_barrier_post(unsigned* bar, volatile LAS unsigned* st) {
    XcdBarrier b; b.bar = bar; b.x = xb_xcc_id(); b.st = st;
    if (threadIdx.x == 0) (void)xb_add(&bar[XB_XCNT(b.x)], 1u);
    return b;
}
__device__ __forceinline__ void xcd_barrier_complete(unsigned* bar, unsigned x, unsigned& nloc, unsigned& nx) {
    const unsigned G = gridDim.x * gridDim.y * gridDim.z;
    unsigned sum, cnt, mine, sp = 0u;
    for (;;) {
        sum = 0u; cnt = 0u; mine = 0u;
#pragma unroll
        for (unsigned j = 0; j < 16; ++j) { const unsigned c = xb_ld(&bar[XB_XCNT(j)]); sum += c; cnt += (c > 0u) ? 1u : 0u; mine = (j == x) ? c : mine; }
        if (sum == G) break;
        __builtin_amdgcn_s_sleep(1);
        if ((++sp & 255u) == 0u) { if (xb_ld(&bar[XB_TMO])) break; if (sp > XB_SPIN_CAP) { atomicAdd(&bar[XB_TMO], 1u); break; } }
    }
    nloc = mine > 0u ? mine : 1u; nx = cnt > 0u ? cnt : 1u;
}

__device__ __forceinline__ void xcd_barrier(const XcdBarrier& b) {
    asm volatile("s_waitcnt vmcnt(0)" ::: "memory");
    __syncthreads();
    if (threadIdx.x == 0) {
        unsigned* bar = b.bar;
        __builtin_amdgcn_s_waitcnt(0);
        unsigned nloc = b.st[0], nx = b.st[1];
        if (nloc == 0u) { xcd_barrier_complete(bar, b.x, nloc, nx); b.st[0] = nloc; b.st[1] = nx; }
        const unsigned old = xb_add(&bar[XB_XSUB(b.x)], 1u);
        const unsigned gen = old / nloc;
        if (old + 1u == (gen + 1u) * nloc) {
            __builtin_amdgcn_fence(__ATOMIC_RELEASE, "agent");
            asm volatile("s_waitcnt vmcnt(0)" ::: "memory");
            const unsigned og = xb_add(&bar[XB_TOP], 1u);
            const unsigned tg = og / nx;
            if (og + 1u == (tg + 1u) * nx) xb_add(&bar[XB_TOPGEN], 1u);
            else XB_SPIN(xb_ld(&bar[XB_TOPGEN]) == tg, bar);
            __builtin_amdgcn_fence(__ATOMIC_ACQUIRE, "agent");
            xb_add(&bar[XB_XGEN(b.x)], 1u);
            asm volatile("s_waitcnt vmcnt(0)" ::: "memory");
        } else {
            XB_SPIN(xb_ld(&bar[XB_XGEN(b.x)]) == gen, bar);
            __builtin_amdgcn_fence(__ATOMIC_ACQUIRE, "agent");
            asm volatile("s_waitcnt vmcnt(0)" ::: "memory");
        }
    }
    __syncthreads();
}

template <int MODE>
__device__ __forceinline__ void small_gemm(LAS unsigned char* lds, const bf16* A, const bf16* Bt, int N, int K, bf16* O, int ldc, int act_cols, const float* bias, const bf16* Yv, int ldy) {
    FTID; const int wave = WAVE, lane = LANE, tl = lane & 31, hh = lane >> 5;
    LAS float* red = (LAS float*)lds;
    const int nct = N / 32, nitems = 4 * nct, kw = K / 8, nks = kw / 16;
    for (int item = BX; item < nitems; item += GSZ) {
        const int rt = item & 3, ct = item >> 2;
        const int hc = 32 * ct + tl;
        const int brow = (MODE == 3) ? (256 * (hc >> 7) + (hc & 127)) : hc;
        const bf16* ap = A + (size_t)(32 * rt + tl) * K + wave * kw + 8 * hh;
        const bf16* bp = Bt + (size_t)brow * K + wave * kw + 8 * hh;
        v16f acc0, acc1;
#pragma unroll
        for (int r = 0; r < 16; ++r) { acc0[r] = 0.f; acc1[r] = 0.f; }
#pragma unroll 4
        for (int ks = 0; ks < nks; ++ks) {
            const bfx8 a = *(const bfx8*)(ap + 16 * ks);
            const bfx8 b0 = *(const bfx8*)(bp + 16 * ks);
            acc0 = __builtin_amdgcn_mfma_f32_32x32x16_bf16(b0, a, acc0, 0, 0, 0);
            if (MODE == 3) { const bfx8 b1 = *(const bfx8*)(bp + (size_t)128 * K + 16 * ks); acc1 = __builtin_amdgcn_mfma_f32_32x32x16_bf16(b1, a, acc1, 0, 0, 0); }
        }
        __syncthreads();
#pragma unroll
        for (int r = 0; r < 16; ++r) { red[(wave * 16 + r) * 64 + lane] = acc0[r]; if (MODE == 3) red[8192 + (wave * 16 + r) * 64 + lane] = acc1[r]; }
        __syncthreads();
        float v0[2], v1[2];
#pragma unroll
        for (int e = 0; e < 2; ++e) { float s0 = 0.f, s1 = 0.f;
#pragma unroll
            for (int w = 0; w < 8; ++w) { s0 += red[(w * 16 + 2 * wave + e) * 64 + lane]; if (MODE == 3) s1 += red[8192 + (w * 16 + 2 * wave + e) * 64 + lane]; }
            v0[e] = s0; v1[e] = s1; }
        const int reg = 2 * wave;
        const int col = 32 * ct + (reg & 3) + 8 * (reg >> 2) + 4 * hh;
        const size_t row = (size_t)(32 * rt + tl);
        float o0 = v0[0], o1 = v0[1];
        if (MODE == 1) { if (col < act_cols) { o0 = gelu_t(o0); o1 = gelu_t(o1); } }
        if (MODE == 2) { const unsigned y = *(const unsigned*)(Yv + row * ldy + col); o0 = bf_lo(y) * pg8::sigmoid_f(o0 + bias[col]); o1 = bf_hi(y) * pg8::sigmoid_f(o1 + bias[col + 1]); }
        if (MODE == 3) { o0 = pg8::silu_f(o0) * v1[0]; o1 = pg8::silu_f(o1) * v1[1]; }
        *(unsigned*)(O + row * ldc + col) = cvt_pk_bf16(o0, o1);
    }
    __syncthreads();
}
struct Args { const float* in[33]; float* out; unsigned char* ws; };
#ifndef PROBE
#define PROBE 0
#endif
#ifndef PH_LO
#define PH_LO 0
#endif
#ifndef PH_HI
#define PH_HI 14
#endif

__global__ void __launch_bounds__(NTHREADS, 2) fwd_kernel(Args args) {
    extern __shared__ __attribute__((aligned(16))) unsigned char lds_raw[];
    cg::grid_group grid = cg::this_grid();
    LAS unsigned char* lds = (LAS unsigned char*)lds_raw;
    Ctx C;
    if (threadIdx.x < 16) ((volatile LAS unsigned*)(lds + MISC_OFF))[threadIdx.x] = 0u;
    __syncthreads();
    (void)xcd_barrier_post((unsigned*)(C.ws() + WS_CTL), (volatile LAS unsigned*)(lds + MISC_OFF));
#define XBAR() do { XcdBarrier b_; b_.bar = (unsigned*)(C.ws() + WS_CTL); b_.x = xb_xcc_id(); b_.st = (volatile LAS unsigned*)(lds + MISC_OFF); xcd_barrier(b_); } while (0)
    { FTID; p0_prologue(C, lds, WAVE, LANE, TID); }
    grid.sync();
    { pg8::Gemm g{C.XN(), C.Wgu1(), MPROMPT, 2 * DFF, DM}; pg8::StaticOrder S; S.init(MPROMPT, 2 * DFF, GSZ, BX); pg8::EpiSwiglu E{C.H(), DFF};
      pg8::gemm_phase<pg8::EpiSwiglu, pg8::StaticOrder, true, true>(lds, g, S, E); }
    small_gemm<3>(lds, C.XN() + (size_t)MPROMPT * DM, C.Wgu1(), DFF, DM, C.H() + (size_t)MPROMPT * DFF, DFF, 0, nullptr, nullptr, 0);
    XBAR();
    { pg8::Gemm g{C.H(), C.Wd1(), MPROMPT, DM, DFF}; pg8::StaticOrder S; S.init(MPROMPT, DM, GSZ, BX); pg8::EpiBf16<0> E{C.D(), DM, 0, nullptr, nullptr, 0};
      pg8::gemm_phase<pg8::EpiBf16<0>, pg8::StaticOrder, true, true>(lds, g, S, E); }
    small_gemm<0>(lds, C.H() + (size_t)MPROMPT * DFF, C.Wd1(), DM, DFF, C.D() + (size_t)MPROMPT * DM, DM, 0, nullptr, nullptr, 0);
    XBAR();
    { FTID; for (int m = GWV; m < M; m += NGWV) row_res(xrow_ptr(C, m), C.D() + (size_t)m * DM, C.in(8), 0.5f, C.out() + (size_t)m * DM, C.in(9), C.XN() + (size_t)m * DM, LANE); }
    XBAR();
    { pg8::Gemm g{C.XN(), C.Win(), MPROMPT, DIN, DM}; pg8::StaticOrder S; S.init(MPROMPT, DIN, GSZ, BX); pg8::EpiBf16<1> E{C.Z(), DIN, 2 * AW, nullptr, nullptr, 0};
      pg8::gemm_phase<pg8::EpiBf16<1>, pg8::StaticOrder, true, true>(lds, g, S, E); }
    small_gemm<1>(lds, C.XN() + (size_t)MPROMPT * DM, C.Win(), DIN, DM, C.Z() + (size_t)MPROMPT * DIN, DIN, 2 * AW, nullptr, nullptr, 0);
    XBAR();
    { FTID; for (int T = BX; T < NTILE; T += GSZ) {
        if (T < NTILE - 1) s5_tile<false>(C, T, lds, WAVE, LANE);
        gmlp_tile(C, T, lds, WAVE, LANE, TID);
    } }
    XBAR();
    { FTID; for (int T = BX; T < NTILE; T += GSZ) s5_tile<true>(C, T, lds, WAVE, LANE); }
    XBAR();
    { pg8::Gemm g{C.YB(), C.Wglu(), MPROMPT, BWD, BWD}; pg8::StaticOrder S; S.init(MPROMPT, BWD, GSZ, BX); pg8::EpiBf16<2> E{C.MIX() + AW, DM, 0, C.in(23), C.YB(), BWD};
      pg8::gemm_phase<pg8::EpiBf16<2>, pg8::StaticOrder, true, true>(lds, g, S, E); }
    small_gemm<2>(lds, C.YB() + (size_t)MPROMPT * BWD, C.Wglu(), BWD, BWD, C.MIX() + (size_t)MPROMPT * DM + AW, DM, 0, C.in(23), C.YB() + (size_t)MPROMPT * BWD, BWD);
    XBAR();
    { FTID; for (int m = GWV; m < M; m += NGWV) row_norm512(C.MIX() + (size_t)m * DM + AW, C.in(25), LANE); }
    XBAR();
    { pg8::Gemm g{C.MIX(), C.Wout(), MPROMPT, DM, DM}; pg8::StaticOrder S; S.init(MPROMPT, DM, GSZ, BX); pg8::EpiBf16<0> E{C.D(), DM, 0, nullptr, nullptr, 0};
      pg8::gemm_phase<pg8::EpiBf16<0>, pg8::StaticOrder, true, true>(lds, g, S, E); }
    small_gemm<0>(lds, C.MIX() + (size_t)MPROMPT * DM, C.Wout(), DM, DM, C.D() + (size_t)MPROMPT * DM, DM, 0, nullptr, nullptr, 0);
    XBAR();
    { FTID; for (int m = GWV; m < M; m += NGWV) row_res(C.out() + (size_t)m * DM, C.D() + (size_t)m * DM, C.in(27), 1.0f, C.out() + (size_t)m * DM, C.in(28), C.XN() + (size_t)m * DM, LANE); }
    XBAR();
    { pg8::Gemm g{C.XN(), C.Wgu2(), MPROMPT, 2 * DFF, DM}; pg8::StaticOrder S; S.init(MPROMPT, 2 * DFF, GSZ, BX); pg8::EpiSwiglu E{C.H(), DFF};
      pg8::gemm_phase<pg8::EpiSwiglu, pg8::StaticOrder, true, true>(lds, g, S, E); }
    small_gemm<3>(lds, C.XN() + (size_t)MPROMPT * DM, C.Wgu2(), DFF, DM, C.H() + (size_t)MPROMPT * DFF, DFF, 0, nullptr, nullptr, 0);
    XBAR();
    { pg8::Gemm g{C.H(), C.Wd2(), MPROMPT, DM, DFF}; pg8::StaticOrder S; S.init(MPROMPT, DM, GSZ, BX); pg8::EpiBf16<0> E{C.D(), DM, 0, nullptr, nullptr, 0};
      pg8::gemm_phase<pg8::EpiBf16<0>, pg8::StaticOrder, true, true>(lds, g, S, E); }
    small_gemm<0>(lds, C.H() + (size_t)MPROMPT * DFF, C.Wd2(), DM, DFF, C.D() + (size_t)MPROMPT * DM, DM, 0, nullptr, nullptr, 0);
    XBAR();
    { FTID; for (int m = GWV; m < M; m += NGWV) row_res(C.out() + (size_t)m * DM, C.D() + (size_t)m * DM, C.in(32), 0.5f, C.out() + (size_t)m * DM, nullptr, nullptr, LANE); }
}

extern "C" void kernel_launch(void* const* d_in, const int* in_sizes, int n_in, void* d_out, int out_size, void* d_ws, size_t ws_size, hipStream_t stream) {
    static int grid = 0;
    if (grid == 0) {
        if (n_in != 33 || ws_size < WS_END) { fprintf(stderr, "kernel_launch: unexpected n_in %d / ws %zu\n", n_in, ws_size); grid = -1; return; }
        int dev = 0, cus = 0, per_cu = 0;
        hipGetDevice(&dev);
        hipDeviceGetAttribute(&cus, hipDeviceAttributeMultiprocessorCount, dev);
        hipFuncSetAttribute((const void*)fwd_kernel, hipFuncAttributeMaxDynamicSharedMemorySize, LDS_BYTES);
        hipOccupancyMaxActiveBlocksPerMultiprocessor(&per_cu, (const void*)fwd_kernel, NTHREADS, LDS_BYTES);
        if (per_cu < 1) { fprintf(stderr, "kernel_launch: occupancy query says %d blocks per CU\n", per_cu); per_cu = 1; }
        grid = cus * per_cu;
    }
    if (grid < 0) return;
    if (hipMemsetAsync((char*)d_ws + WS_CTL, 0, CTL_ZERO_BYTES, stream) != hipSuccess) { fprintf(stderr, "memset failed\n"); return; }
    Args a{};
    for (int i = 0; i < 33; ++i) a.in[i] = (const float*)d_in[i];
    a.out = (float*)d_out; a.ws = (unsigned char*)d_ws;
    void* params[] = {&a};
    hipError_t e = hipLaunchCooperativeKernel((const void*)fwd_kernel, dim3(grid), dim3(NTHREADS), params, LDS_BYTES, stream);
    if (e != hipSuccess) fprintf(stderr, "cooperative launch failed: %s (grid %d)\n", hipGetErrorString(e), grid);
}
```

```cpp
#include <hip/hip_runtime.h>
#include <hip/hip_cooperative_groups.h>
#include <cstdio>
#include <cstdint>
namespace cg = cooperative_groups;
__device__ __forceinline__ int fresh_tid() { int t = (int)threadIdx.x; asm volatile("" : "+v"(t)); return t; }
namespace pg8 {
#define PG8_LAS __attribute__((address_space(3)))
typedef unsigned short bf16_t;
typedef short bf16x8 __attribute__((ext_vector_type(8)));
typedef float f32x4 __attribute__((ext_vector_type(4)));
typedef unsigned u32x4 __attribute__((ext_vector_type(4)));
constexpr int BM = 256, BK = 64, HALF = 128, HTB = HALF * BK * 2  , STAGE_BYTES = 8 * HTB, NXCD = 8, WGM = 8;

__host__ __device__ __forceinline__ int lds_byte(int r, int c) { const int st = (r >> 4) * 2 + (c >> 5), rr = r & 15, cc = c & 31, ob = rr * 64 + cc * 2; return st * 1024 + (ob ^ (((ob >> 9) & 1) << 5)); }
__host__ __device__ __forceinline__ void stage_rc(int b, int& R, int& C) { const int st = b / 1024, sb = b % 1024, swz = sb ^ (((sb >> 9) & 1) << 5); R = (st >> 1) * 16 + swz / 64; C = (st & 1) * 32 + (swz % 64) / 2; }
__host__ __device__ __forceinline__ int perm32(int rho) { const int n = rho >> 4, i = rho & 15; return 8 * (i >> 2) + 4 * n + (i & 3); }

struct Unit { int pm, pn; };
struct Gemm { const bf16_t* A; const bf16_t* Bt; int M, N, K; };

struct StaticOrder {
    int nM, nN, nwg, G, c;
    __host__ __device__ void init(int M, int N, int G_, int c_) { nM = M / BM; nN = N / BM; nwg = nM * nN; G = G_; c = c_; }
    __host__ __device__ bool next(int i, Unit& u) const {
        const long L = (long)i * G + c; if (L >= nwg) return false;
        int wgid = (int)L; { const int q = nwg / NXCD, r = nwg % NXCD, xcd = wgid % NXCD, off = wgid / NXCD; wgid = (xcd < r ? xcd * (q + 1) : r * (q + 1) + (xcd - r) * q) + off; }
        const int nig = WGM * nN, gid = wgid / nig, fm = gid * WGM, gsz = (nM - fm) < WGM ? (nM - fm) : WGM;
        u.pm = fm + ((wgid % nig) % gsz); u.pn = (wgid % nig) / gsz; return true;
    }
    __device__ __forceinline__ void a_ready(const Unit&) const {}
    __device__ __forceinline__ void done(const Unit&) const {}
};

__device__ __forceinline__ unsigned cvt_pk_bf16(float lo, float hi) { unsigned r; asm volatile("v_cvt_pk_bf16_f32 %0, %1, %2" : "=v"(r) : "v"(lo), "v"(hi)); return r; }
__device__ __forceinline__ float bf_lo(unsigned w) { return __uint_as_float(w << 16); }
__device__ __forceinline__ float bf_hi(unsigned w) { return __uint_as_float(w & 0xffff0000u); }
__device__ __forceinline__ float sigmoid_f(float x) { return __builtin_amdgcn_rcpf(1.0f + __expf(-x)); }
__device__ __forceinline__ float silu_f(float x) { return x * sigmoid_f(x); }
__device__ __forceinline__ float gelu_t(float x) { const float u = 1.5957691216057308f * (x + 0.044715f * x * x * x); return x * sigmoid_f(u); }

struct EpiSwiglu {
    static constexpr bool PERM = true, AFTER_DRAIN = false;
    bf16_t* O; int ldc;
    __device__ __forceinline__ void operator()(const f32x4 (&acc)[2][2][4][2], const Unit& u, int wr, int wc, int fr, int fq) const {
        const int row0 = u.pm * BM + wr * 64 + fr; const int col0 = u.pn * HALF + wc * 32 + 8 * fq;
#pragma unroll
        for (int ai = 0; ai < 2; ++ai)
#pragma unroll
            for (int m = 0; m < 4; ++m) {
                bf16_t* rowp = O + (size_t)(row0 + ai * HALF + m * 16) * ldc + col0;
                const f32x4 g0 = acc[ai][0][m][0], g1 = acc[ai][0][m][1], u0 = acc[ai][1][m][0], u1 = acc[ai][1][m][1];
                u32x4 w;
                w.x = cvt_pk_bf16(silu_f(g0[0]) * u0[0], silu_f(g0[1]) * u0[1]); w.y = cvt_pk_bf16(silu_f(g0[2]) * u0[2], silu_f(g0[3]) * u0[3]);
                w.z = cvt_pk_bf16(silu_f(g1[0]) * u1[0], silu_f(g1[1]) * u1[1]); w.w = cvt_pk_bf16(silu_f(g1[2]) * u1[2], silu_f(g1[3]) * u1[3]);
                *(u32x4*)rowp = w;
            }
    }
};
template <int MODE> struct EpiBf16 {
    static constexpr bool PERM = true, AFTER_DRAIN = false;
    bf16_t* O; int ldc; int act_cols; const float* bias; const bf16_t* Y; int ldy;
    __device__ __forceinline__ void operator()(const f32x4 (&acc)[2][2][4][2], const Unit& u, int wr, int wc, int fr, int fq) const {
        const int row0 = u.pm * BM + wr * 64 + fr; const int col0 = u.pn * BM + wc * 32 + 8 * fq;
#pragma unroll
        for (int bj = 0; bj < 2; ++bj) {
            const int col = col0 + bj * HALF;
            f32x4 b0 = (f32x4){0.f, 0.f, 0.f, 0.f}, b1 = b0;
            if (MODE == 2) { b0 = *(const f32x4*)(bias + col); b1 = *(const f32x4*)(bias + col + 4); }
            const bool act = (MODE == 1) && (col < act_cols);
#pragma unroll
            for (int ai = 0; ai < 2; ++ai)
#pragma unroll
                for (int m = 0; m < 4; ++m) {
                    const size_t row = (size_t)(row0 + ai * HALF + m * 16);
                    f32x4 v0 = acc[ai][bj][m][0], v1 = acc[ai][bj][m][1];
                    if (MODE == 1) { if (act) {
#pragma unroll
                        for (int j = 0; j < 4; ++j) { v0[j] = gelu_t(v0[j]); v1[j] = gelu_t(v1[j]); } } }
                    if (MODE == 2) {
                        const u32x4 y = *(const u32x4*)(Y + row * ldy + col);
                        v0 = v0 + b0; v1 = v1 + b1;
                        v0[0] = bf_lo(y.x) * sigmoid_f(v0[0]); v0[1] = bf_hi(y.x) * sigmoid_f(v0[1]); v0[2] = bf_lo(y.y) * sigmoid_f(v0[2]); v0[3] = bf_hi(y.y) * sigmoid_f(v0[3]);
                        v1[0] = bf_lo(y.z) * sigmoid_f(v1[0]); v1[1] = bf_hi(y.z) * sigmoid_f(v1[1]); v1[2] = bf_lo(y.w) * sigmoid_f(v1[2]); v1[3] = bf_hi(y.w) * sigmoid_f(v1[3]);
                    }
                    u32x4 w; w.x = cvt_pk_bf16(v0[0], v0[1]); w.y = cvt_pk_bf16(v0[2], v0[3]); w.z = cvt_pk_bf16(v1[0], v1[1]); w.w = cvt_pk_bf16(v1[2], v1[3]);
                    *(u32x4*)(O + row * ldc + col) = w;
                }
        }
    }
};

template <class Epi, class Sched, bool ALIGN_EPI = false, bool SP2 = false>
__device__ __forceinline__ void gemm_phase(PG8_LAS unsigned char* lds, const Gemm g, const Sched& S, const Epi& E) {
    const int tid = fresh_tid(), wid = __builtin_amdgcn_readfirstlane(tid >> 6), lane = tid & 63, wr = wid >> 2, wc = wid & 3, fr = lane & 15, fq = lane >> 4;
    const int K = g.K, nt = K / BK;
    unsigned voffA[2], voffB[2];
#pragma unroll
    for (int i = 0; i < 2; ++i) { int R, C; stage_rc(tid * 16 + i * 8192, R, C); const int Rb = Epi::PERM ? ((R & ~31) + perm32(R & 31)) : R;
        voffA[i] = (unsigned)(R * K + C) * 2u; voffB[i] = (unsigned)(Rb * K + C) * 2u; }
    const size_t kstep = (size_t)(BK * 2);
    const size_t hstep = (size_t)HALF * K * 2;
    const size_t tstep = 2 * hstep;
    const unsigned ldsw = (unsigned)wid * 1024u;
    const int aoff = lds_byte(wr * 64 + fr, fq * 8), boff = lds_byte(wc * 32 + fr, fq * 8);
#define PG8_SA(b, h) (((b) * 2 + (h)) * HTB)
#define PG8_SB(b, h) ((4 + (b) * 2 + (h)) * HTB)
#define PG8_STAGE(bufoff, gbase, voff) do { _Pragma("unroll") for (int _i = 0; _i < 2; ++_i) \
        __builtin_amdgcn_global_load_lds((const unsigned*)((const char*)(gbase) + (voff)[_i]), (PG8_LAS unsigned*)(lds + (bufoff) + ldsw + _i * 8192), 16, 0, 0); } while (0)
#define PG8_LDA(dst, b, h) do { _Pragma("unroll") for (int m = 0; m < 4; ++m) _Pragma("unroll") for (int k = 0; k < 2; ++k) dst[m][k] = *(const PG8_LAS bf16x8*)(lds + PG8_SA(b, h) + aoff + m * 2048 + k * 1024); } while (0)
#define PG8_LDB(dst, b, h) do { _Pragma("unroll") for (int n = 0; n < 2; ++n) _Pragma("unroll") for (int k = 0; k < 2; ++k) dst[n][k] = *(const PG8_LAS bf16x8*)(lds + PG8_SB(b, h) + boff + n * 2048 + k * 1024); } while (0)
#define PG8_MMA(ai, bj, At, Bt) do { __builtin_amdgcn_s_setprio(1); _Pragma("unroll") for (int m = 0; m < 4; ++m) _Pragma("unroll") for (int n = 0; n < 2; ++n) _Pragma("unroll") for (int k = 0; k < 2; ++k) \
        acc[ai][bj][m][n] = __builtin_amdgcn_mfma_f32_16x16x32_bf16(Bt[n][k], At[m][k], acc[ai][bj][m][n], 0, 0, 0); __builtin_amdgcn_s_setprio(0); } while (0)
#define PG8_WAIT_V(n) asm volatile("s_waitcnt vmcnt(" #n ")" ::: "memory")
#define PG8_WAIT_L(n) asm volatile("s_waitcnt lgkmcnt(" #n ")" ::: "memory")
#define PG8_BAR __builtin_amdgcn_s_barrier()
#define PG8_SCHED __builtin_amdgcn_sched_barrier(0)
    Unit cur, nxt; int ui = 0;
    if (!S.next(0, cur)) return;
    f32x4 acc[2][2][4][2];
#pragma unroll
    for (int a = 0; a < 2; ++a)
#pragma unroll
        for (int b = 0; b < 2; ++b)
#pragma unroll
            for (int m = 0; m < 4; ++m)
#pragma unroll
                for (int n = 0; n < 2; ++n) acc[a][b][m][n] = (f32x4){0.f, 0.f, 0.f, 0.f};
    bf16x8 At[4][2], B0[2][2], B1[2][2];
    const char* cA = (const char*)g.A + (size_t)cur.pm * tstep; const char* cB = (const char*)g.Bt + (size_t)cur.pn * tstep;
    S.a_ready(cur);
    if constexpr (SP2) {
        PG8_STAGE(PG8_SB(0, 0), cB, voffB); PG8_STAGE(PG8_SB(0, 1), cB + hstep, voffB); PG8_STAGE(PG8_SA(0, 0), cA, voffA); PG8_STAGE(PG8_SA(0, 1), cA + hstep, voffA);
        if (wr == 1) PG8_BAR;
        PG8_WAIT_V(2); PG8_BAR;
        PG8_STAGE(PG8_SB(1, 0), cB + kstep, voffB); PG8_STAGE(PG8_SA(1, 0), cA + kstep, voffA); PG8_STAGE(PG8_SB(1, 1), cB + hstep + kstep, voffB);
        PG8_WAIT_V(6); PG8_BAR;
    } else {
        PG8_STAGE(PG8_SB(0, 0), cB, voffB); PG8_STAGE(PG8_SA(0, 0), cA, voffA); PG8_STAGE(PG8_SB(0, 1), cB + hstep, voffB); PG8_STAGE(PG8_SA(0, 1), cA + hstep, voffA);
        if (wr == 1) PG8_BAR;
        PG8_WAIT_V(4); PG8_BAR;
        PG8_STAGE(PG8_SB(1, 0), cB + kstep, voffB); PG8_STAGE(PG8_SA(1, 0), cA + kstep, voffA); PG8_STAGE(PG8_SB(1, 1), cB + hstep + kstep, voffB);
        PG8_WAIT_V(6); PG8_BAR;
    }
    for (;;) {
        const bool has_next = S.next(ui + 1, nxt);
        const char* nA = has_next ? (const char*)g.A + (size_t)nxt.pm * tstep : cA; const char* nB = has_next ? (const char*)g.Bt + (size_t)nxt.pn * tstep : cB;
        for (int t = 0; t < nt; t += 2) {
            const bool last = (t == nt - 2);
            const char* a1 = cA + (size_t)(t + 1) * kstep;
            const char* a2 = last ? nA : cA + (size_t)(t + 2) * kstep; const char* b2 = last ? nB : cB + (size_t)(t + 2) * kstep;
            const char* a3 = a2 + kstep; const char* b3 = b2 + kstep;
            if (last && has_next) S.a_ready(nxt);
            if constexpr (SP2) {
            PG8_LDB(B0, 0, 0); PG8_LDB(B1, 0, 1); PG8_SCHED; PG8_LDA(At, 0, 0); PG8_STAGE(PG8_SA(1, 1), a1 + hstep, voffA);
            PG8_WAIT_V(8); PG8_WAIT_L(0); PG8_BAR; PG8_MMA(0, 0, At, B0); PG8_MMA(0, 1, At, B1); PG8_BAR; PG8_SCHED;
            PG8_LDA(At, 0, 1); PG8_STAGE(PG8_SB(0, 0), b2, voffB); PG8_STAGE(PG8_SB(0, 1), b2 + hstep, voffB); PG8_STAGE(PG8_SA(0, 0), a2, voffA);
            PG8_WAIT_V(8); PG8_WAIT_L(0); PG8_BAR; PG8_MMA(1, 0, At, B0); PG8_MMA(1, 1, At, B1); PG8_BAR; PG8_SCHED;
            PG8_LDB(B0, 1, 0); PG8_LDB(B1, 1, 1); PG8_SCHED; PG8_LDA(At, 1, 0); PG8_STAGE(PG8_SA(0, 1), a2 + hstep, voffA);
            PG8_WAIT_V(8); PG8_WAIT_L(0); PG8_BAR; PG8_MMA(0, 0, At, B0); PG8_MMA(0, 1, At, B1); PG8_BAR; PG8_SCHED;
            PG8_LDA(At, 1, 1); PG8_STAGE(PG8_SB(1, 0), b3, voffB); PG8_STAGE(PG8_SB(1, 1), b3 + hstep, voffB); PG8_STAGE(PG8_SA(1, 0), a3, voffA);
            PG8_WAIT_V(8); PG8_WAIT_L(0); PG8_BAR; PG8_MMA(1, 0, At, B0); PG8_MMA(1, 1, At, B1); PG8_BAR; PG8_SCHED;
            } else {
            PG8_LDB(B0, 0, 0); PG8_SCHED; PG8_LDA(At, 0, 0); PG8_STAGE(PG8_SA(1, 1), a1 + hstep, voffA);
            PG8_WAIT_L(8); PG8_BAR; PG8_WAIT_L(0); PG8_MMA(0, 0, At, B0); PG8_BAR; PG8_SCHED;
            PG8_LDB(B1, 0, 1); PG8_STAGE(PG8_SB(0, 0), b2, voffB);
            PG8_BAR; PG8_WAIT_L(0); PG8_MMA(0, 1, At, B1); PG8_BAR;
            PG8_LDA(At, 0, 1); PG8_STAGE(PG8_SA(0, 0), a2, voffA);
            PG8_BAR; PG8_WAIT_L(0); PG8_MMA(1, 0, At, B0); PG8_BAR; PG8_SCHED;
            PG8_STAGE(PG8_SB(0, 1), b2 + hstep, voffB);
            PG8_WAIT_V(6); PG8_BAR; PG8_MMA(1, 1, At, B1); PG8_BAR;
            PG8_LDB(B0, 1, 0); PG8_SCHED; PG8_LDA(At, 1, 0); PG8_STAGE(PG8_SA(0, 1), a2 + hstep, voffA);
            PG8_WAIT_L(8); PG8_BAR; PG8_WAIT_L(0); PG8_MMA(0, 0, At, B0); PG8_BAR; PG8_SCHED;
            PG8_LDB(B1, 1, 1); PG8_STAGE(PG8_SB(1, 0), b3, voffB);
            PG8_BAR; PG8_WAIT_L(0); PG8_MMA(0, 1, At, B1); PG8_BAR;
            PG8_LDA(At, 1, 1); PG8_STAGE(PG8_SA(1, 0), a3, voffA);
            PG8_BAR; PG8_WAIT_L(0); PG8_MMA(1, 0, At, B0); PG8_BAR; PG8_SCHED;
            PG8_STAGE(PG8_SB(1, 1), b3 + hstep, voffB);
            PG8_WAIT_V(6); PG8_BAR; PG8_MMA(1, 1, At, B1); PG8_BAR;
            }
        }
        if constexpr (ALIGN_EPI) { if (wr == 0) PG8_BAR; }
        if constexpr (!Epi::AFTER_DRAIN) { E(acc, cur, wr, wc, fr, fq); S.done(cur); }
        if (!has_next) break;
#pragma unroll
        for (int a = 0; a < 2; ++a)
#pragma unroll
            for (int b = 0; b < 2; ++b)
#pragma unroll
                for (int m = 0; m < 4; ++m)
#pragma unroll
                    for (int n = 0; n < 2; ++n) acc[a][b][m][n] = (f32x4){0.f, 0.f, 0.f, 0.f};
        cur = nxt; cA = nA; cB = nB; ++ui;
        if constexpr (ALIGN_EPI) { if (wr == 1) PG8_BAR; }
    }
    PG8_WAIT_V(0);
    if constexpr (!ALIGN_EPI) { if (wr == 0) PG8_BAR; }
    PG8_BAR;
    if constexpr (Epi::AFTER_DRAIN) { E.fused(acc, cur, wr, wc, fr, fq, lds, wid, lane); S.done(cur); }
#undef PG8_SA
#undef PG8_SB
#undef PG8_STAGE
#undef PG8_LDA
#undef PG8_LDB
#undef PG8_MMA
#undef PG8_WAIT_V
#undef PG8_WAIT_L
#undef PG8_BAR
#undef PG8_SCHED
}
}

constexpr int DM = 1024, SEQ = 16384, NBATCH = 2, MPROMPT = NBATCH * SEQ, DEC_B = 8, DEC_S = 16;
constexpr int M = MPROMPT + DEC_B * DEC_S;
constexpr int MPAD = 33024;
constexpr int DFF = 2816, DIN = 1536, AW = 512, BWD = 512, NG = 32, NP = 64, GN = 16;
constexpr int NTILE = M / 128;
constexpr float EPS = 1e-6f;
constexpr int NWAVES = 8, NTHREADS = 512;

constexpr size_t MiB = 1u << 20;
constexpr size_t WS_WGU1 = 1 * MiB, WS_WD1 = 12 * MiB, WS_WIN = 18 * MiB, WS_WGLU = 21 * MiB, WS_WOUT = 22 * MiB, WS_WGU2 = 24 * MiB, WS_WD2 = 35 * MiB;
constexpr size_t WS_WEFF = 41 * MiB, WS_BB = 42 * MiB, WS_CM = 42 * MiB + 131072, WS_LAM = 42 * MiB + 262144, WS_E = 43 * MiB;
constexpr size_t WS_XN = 48 * MiB, WS_D = 113 * MiB, WS_H = 178 * MiB, WS_Z = 178 * MiB, WS_YB = 275 * MiB, WS_MIX = 356 * MiB, WS_CR = 421 * MiB, WS_END = 426 * MiB;
static_assert(WS_XN + (size_t)MPAD * DM * 2 <= WS_D && WS_D + (size_t)MPAD * DM * 2 <= WS_H && WS_H + (size_t)MPAD * DFF * 2 <= WS_MIX, "ws map");
static_assert(WS_Z + (size_t)MPAD * DIN * 2 <= WS_YB && WS_YB + (size_t)MPAD * BWD * 2 <= WS_H + (size_t)MPAD * DFF * 2 && WS_MIX + (size_t)MPAD * DM * 2 <= WS_CR && WS_CR + (size_t)NTILE * NG * NP * 8 <= WS_END, "ws map 2");
static_assert(WS_E + (size_t)NTILE * NG * NP * 8 <= WS_XN, "ws map 3");

constexpr size_t OFF_Y = 0, OFF_SRE_P = (size_t)M * DM, OFF_SIM_P = OFF_SRE_P + NBATCH * NG * NP, OFF_SRE_S = OFF_SIM_P + NBATCH * NG * NP,
                 OFF_SIM_S = OFF_SRE_S + DEC_B * NG * NP, OFF_V_S = OFF_SIM_S + DEC_B * NG * NP;

constexpr int GEMM_LDS = 131072;
constexpr int S5_ROW = 132;
constexpr int S5_WAVE_BYTES = 32 * S5_ROW * 4;
constexpr int VT_STRIDE = 136;
constexpr int LDS_BYTES = 147456;
static_assert(NWAVES * (S5_WAVE_BYTES + 1024) <= LDS_BYTES - 64 && 128 * VT_STRIDE * 2 + 4096 <= LDS_BYTES - 64, "lds map");

#define LAS __attribute__((address_space(3)))
typedef unsigned short bf16;
typedef float v4f __attribute__((ext_vector_type(4)));
typedef float v2f __attribute__((ext_vector_type(2)));
typedef float v16f __attribute__((ext_vector_type(16)));
typedef unsigned v4u __attribute__((ext_vector_type(4)));
typedef unsigned v2u __attribute__((ext_vector_type(2)));
typedef short bfx8 __attribute__((ext_vector_type(8)));
#define LDS_FENCE() asm volatile("s_waitcnt lgkmcnt(0)" ::: "memory")

using pg8::cvt_pk_bf16; using pg8::bf_lo; using pg8::bf_hi; using pg8::gelu_t;

__device__ __forceinline__ float wave_sum(float v) {
#pragma unroll
    for (int o = 1; o < 64; o <<= 1) v += __shfl_xor(v, o);
    return v;
}
__device__ __forceinline__ unsigned cvt_pk_nv(float lo, float hi) { unsigned r; asm("v_cvt_pk_bf16_f32 %0, %1, %2" : "=v"(r) : "v"(lo), "v"(hi)); return r; }
__device__ __forceinline__ bf16 f2bf(float f) { return (bf16)(cvt_pk_nv(f, 0.f) & 0xffffu); }


__device__ __forceinline__ double dexp(double x) {
    const double y = x * (1.0 / 256.0); double t = 1.0;
#pragma unroll
    for (int i = 12; i >= 1; --i) t = 1.0 + t * y / (double)i;
#pragma unroll
    for (int i = 0; i < 8; ++i) t = t * t;
    return t;
}
__device__ __forceinline__ void dsincos(double x, double& s, double& c) {
    const double twopi = 6.283185307179586476925286766559;
    const double k = rint(x / twopi); const double r = x - k * twopi, r2 = r * r;
    double ts = r, tc = 1.0; s = r; c = 1.0;
#pragma unroll
    for (int i = 1; i <= 15; ++i) { tc = -tc * r2 / (double)((2 * i - 1) * (2 * i)); ts = -ts * r2 / (double)((2 * i) * (2 * i + 1)); c += tc; s += ts; }
}

typedef const float* cfp_t;
typedef __attribute__((address_space(4))) cfp_t const* kin_t;
__device__ __forceinline__ const float* karg_in(int i) {
    auto k = __builtin_amdgcn_kernarg_segment_ptr();
    asm volatile("" : "+s"(k));
    return ((kin_t)k)[i];
}
struct Ctx {
    __device__ __forceinline__ const float* in(int i) const { return karg_in(i); }
    __device__ __forceinline__ float* out() const { return (float*)karg_in(33); }
    __device__ __forceinline__ unsigned char* ws() const { return (unsigned char*)karg_in(34); }
#define WSP(name, T, off) __device__ __forceinline__ T* name() const { return (T*)(ws() + (off)); }
    WSP(Wgu1, bf16, WS_WGU1) WSP(Wd1, bf16, WS_WD1) WSP(Win, bf16, WS_WIN) WSP(Wglu, bf16, WS_WGLU) WSP(Wout, bf16, WS_WOUT) WSP(Wgu2, bf16, WS_WGU2) WSP(Wd2, bf16, WS_WD2)
    WSP(Weff, bf16, WS_WEFF) WSP(BB, bf16, WS_BB) WSP(CM, bf16, WS_CM) WSP(XN, bf16, WS_XN) WSP(D, bf16, WS_D) WSP(H, bf16, WS_H) WSP(Z, bf16, WS_Z) WSP(YB, bf16, WS_YB) WSP(MIX, bf16, WS_MIX)
    WSP(LAM, float, WS_LAM) WSP(E, float, WS_E)
#undef WSP
};

__device__ __forceinline__ void p0_transpose_item(const float* W, int N, bf16* WT, int K, int k0, int n0, int drow0, LAS float* scr, int lane) {
#pragma unroll 8
    for (int i = 0; i < 32; ++i) { const int kk = 2 * i + (lane >> 5); scr[kk * 33 + (lane & 31)] = W[(size_t)(k0 + kk) * N + n0 + (lane & 31)]; }
    LDS_FENCE();
    const int c = lane & 7;
#pragma unroll
    for (int j = 0; j < 4; ++j) { const int n = (lane >> 3) + 8 * j; const LAS float* s = scr + (8 * c) * 33 + n;
        v4u o; o.x = cvt_pk_bf16(s[0 * 33], s[1 * 33]); o.y = cvt_pk_bf16(s[2 * 33], s[3 * 33]); o.z = cvt_pk_bf16(s[4 * 33], s[5 * 33]); o.w = cvt_pk_bf16(s[6 * 33], s[7 * 33]);
        *(v4u*)(WT + (size_t)(drow0 + n) * K + k0 + 8 * c) = o; }
    LDS_FENCE();
}
__device__ __forceinline__ void p0_matrix_item(const float* W, int K, int N, bf16* WT, int mode, int item, LAS float* scr, int lane) {
    const int nblk = N / 32, kb = item / nblk, nb = item % nblk, n0 = 32 * nb;
    const int drow0 = (mode == 0) ? n0 : (256 * (n0 / 128) + (n0 % 128) + (mode == 2 ? 128 : 0));
    p0_transpose_item(W, N, WT, K, 64 * kb, n0, drow0, scr, lane);
}
__device__ __forceinline__ const float* xrow_ptr(const Ctx& C, int row) { return row < MPROMPT ? C.in(0) + (size_t)row * DM : C.in(1) + (size_t)(row - MPROMPT) * DM; }

__device__ __forceinline__ void row_xn(const float* xrow, const float* g, bf16* orow, int lane) {
    v4f v[4]; float s = 0.f;
#pragma unroll
    for (int j = 0; j < 4; ++j) { v[j] = *(const v4f*)(xrow + 4 * lane + 256 * j); s += (v[j].x * v[j].x + v[j].y * v[j].y) + (v[j].z * v[j].z + v[j].w * v[j].w); }
    const float r = rsqrtf(wave_sum(s) * (1.f / DM) + EPS);
#pragma unroll
    for (int j = 0; j < 4; ++j) { const v4f gg = *(const v4f*)(g + 4 * lane + 256 * j); const v4f o = v[j] * r * gg;
        v2u w; w.x = cvt_pk_bf16(o.x, o.y); w.y = cvt_pk_bf16(o.z, o.w); *(v2u*)(orow + 4 * lane + 256 * j) = w; }
}
__device__ __forceinline__ void row_res(const float* base, const bf16* drow, const float* gpost, float scale, float* out, const float* gnext, bf16* xn, int lane) {
    v4f d[4]; float s = 0.f;
#pragma unroll
    for (int j = 0; j < 4; ++j) { const v2u w = *(const v2u*)(drow + 4 * lane + 256 * j); d[j] = (v4f){bf_lo(w.x), bf_hi(w.x), bf_lo(w.y), bf_hi(w.y)};
        s += (d[j].x * d[j].x + d[j].y * d[j].y) + (d[j].z * d[j].z + d[j].w * d[j].w); }
    const float r1 = rsqrtf(wave_sum(s) * (1.f / DM) + EPS) * scale; float s2 = 0.f;
#pragma unroll
    for (int j = 0; j < 4; ++j) { const v4f b = *(const v4f*)(base + 4 * lane + 256 * j); const v4f gp = *(const v4f*)(gpost + 4 * lane + 256 * j);
        d[j] = b + d[j] * r1 * gp; s2 += (d[j].x * d[j].x + d[j].y * d[j].y) + (d[j].z * d[j].z + d[j].w * d[j].w);
        *(v4f*)(out + 4 * lane + 256 * j) = d[j]; }
    if (xn) {
        const float r2 = rsqrtf(wave_sum(s2) * (1.f / DM) + EPS);
#pragma unroll
        for (int j = 0; j < 4; ++j) { const v4f gg = *(const v4f*)(gnext + 4 * lane + 256 * j); const v4f o = d[j] * r2 * gg;
            v2u w; w.x = cvt_pk_bf16(o.x, o.y); w.y = cvt_pk_bf16(o.z, o.w); *(v2u*)(xn + 4 * lane + 256 * j) = w; }
    }
}
__device__ __forceinline__ void row_norm512(bf16* row, const float* g, int lane) {
    const v4u w = *(const v4u*)(row + 8 * lane);
    float v[8] = {bf_lo(w.x), bf_hi(w.x), bf_lo(w.y), bf_hi(w.y), bf_lo(w.z), bf_hi(w.z), bf_lo(w.w), bf_hi(w.w)};
    float s = 0.f;
#pragma unroll
    for (int i = 0; i < 8; ++i) s += v[i] * v[i];
    const float r = rsqrtf(wave_sum(s) * (1.f / 512.f) + EPS);
    const v4f g0 = *(const v4f*)(g + 8 * lane), g1 = *(const v4f*)(g + 8 * lane + 4);
    v4u o; o.x = cvt_pk_bf16(v[0] * r * g0.x, v[1] * r * g0.y); o.y = cvt_pk_bf16(v[2] * r * g0.z, v[3] * r * g0.w);
    o.z = cvt_pk_bf16(v[4] * r * g1.x, v[5] * r * g1.y); o.w = cvt_pk_bf16(v[6] * r * g1.z, v[7] * r * g1.w);
    *(v4u*)(row + 8 * lane) = o;
}

__device__ __forceinline__ void p0_prologue(const Ctx& C, LAS unsigned char* lds, int wave, int lane, int tid) {
    LAS float* scr = (LAS float*)(lds + wave * 16384);
    const int gw = blockIdx.x * NWAVES + wave, NGW = gridDim.x * NWAVES;
    constexpr int I_GU = (DM / 64) * (DFF / 32), I_D = (DFF / 64) * (DM / 32), I_IN = (DM / 64) * (DIN / 32), I_GLU = (BWD / 64) * (BWD / 32), I_OUT = (DM / 64) * (DM / 32);
    constexpr int NITEMS = 4 * I_GU + 2 * I_D + I_IN + I_GLU + I_OUT;
    for (int it = gw; it < NITEMS; it += NGW) {
        int r = it;
        if (r < I_GU) { p0_matrix_item(C.in(5), DM, DFF, C.Wgu1(), 1, r, scr, lane); continue; } r -= I_GU;
        if (r < I_GU) { p0_matrix_item(C.in(6), DM, DFF, C.Wgu1(), 2, r, scr, lane); continue; } r -= I_GU;
        if (r < I_GU) { p0_matrix_item(C.in(29), DM, DFF, C.Wgu2(), 1, r, scr, lane); continue; } r -= I_GU;
        if (r < I_GU) { p0_matrix_item(C.in(30), DM, DFF, C.Wgu2(), 2, r, scr, lane); continue; } r -= I_GU;
        if (r < I_D) { p0_matrix_item(C.in(7), DFF, DM, C.Wd1(), 0, r, scr, lane); continue; } r -= I_D;
        if (r < I_D) { p0_matrix_item(C.in(31), DFF, DM, C.Wd2(), 0, r, scr, lane); continue; } r -= I_D;
        if (r < I_IN) { p0_matrix_item(C.in(10), DM, DIN, C.Win(), 0, r, scr, lane); continue; } r -= I_IN;
        if (r < I_GLU) { p0_matrix_item(C.in(22), BWD, BWD, C.Wglu(), 0, r, scr, lane); continue; } r -= I_GLU;
        p0_matrix_item(C.in(26), DM, DM, C.Wout(), 0, r, scr, lane);
    }
    for (int m = gw; m < M; m += NGW) row_xn(xrow_ptr(C, m), C.in(4), C.XN() + (size_t)m * DM, lane);
    const int gt = blockIdx.x * NTHREADS + tid, NGT = gridDim.x * NTHREADS;
    for (int idx = gt; idx < NG * NP; idx += NGT) {
        const int g = idx / NP, p = idx % NP;
        const double lr = (double)C.in(14)[idx], li = (double)C.in(15)[idx], dt = dexp((double)C.in(16)[g]);
        double s1, c1, s8, c8; dsincos(li * dt, s1, c1); dsincos(li * dt * 128.0, s8, c8);
        const double er = dexp(lr * dt), lbr = er * c1, lbi = er * s1;
        const double e8 = dexp(lr * dt * 128.0), l8r = e8 * c8, l8i = e8 * s8;
        C.LAM()[0 * 2048 + idx] = (float)lbr; C.LAM()[1 * 2048 + idx] = (float)lbi; C.LAM()[2 * 2048 + idx] = (float)l8r; C.LAM()[3 * 2048 + idx] = (float)l8i;
        const double a = lbr - 1.0, b = lbi, den = lr * lr + li * li, cr = (a * lr + b * li) / den, ci = (b * lr - a * li) / den;
        for (int n = 0; n < GN; ++n) {
            const double br = (double)C.in(17)[(size_t)idx * GN + n], bi = (double)C.in(18)[(size_t)idx * GN + n];
            C.BB()[((size_t)g * 128 + 2 * p) * GN + n] = f2bf((float)(cr * br - ci * bi));
            C.BB()[((size_t)g * 128 + 2 * p + 1) * GN + n] = f2bf((float)(cr * bi + ci * br));
            C.CM()[((size_t)g * GN + n) * 128 + 2 * p] = f2bf(C.in(19)[((size_t)g * GN + n) * NP + p]);
            C.CM()[((size_t)g * GN + n) * 128 + 2 * p + 1] = f2bf(-C.in(20)[((size_t)g * GN + n) * NP + p]);
        }
    }
    for (int idx = gt; idx < 2 * 4 * 128 * 128; idx += NGT) {
        const int s = idx & 127, t = (idx >> 7) & 127, h = (idx >> 14) & 3, mode = idx >> 16;
        float v;
        if (mode == 0) v = (s <= t) ? C.in(12)[((size_t)h * 128 + t) * 128 + s] : 0.f;
        else v = ((s >> 4) == (t >> 4) && (s & 15) <= (t & 15)) ? C.in(12)[((size_t)h * 128 + (t & 15)) * 128 + (s & 15)] : 0.f;
        C.Weff()[idx] = f2bf(v);
    }
}

template <bool PASS2>
__device__ __forceinline__ void s5_tile(const Ctx& C, int T, int sb_lo, int sb_hi, LAS unsigned char* lds, int wave, int lane) {
    const bool sample = (T == NTILE - 1);
    const int r0 = T * 128;
    LAS float* BU = (LAS float*)(lds + wave * S5_WAVE_BYTES);
    LAS bf16* UL = (LAS bf16*)(lds + NWAVES * S5_WAVE_BYTES + wave * 1024);
    float* CR = (float*)(C.ws() + WS_CR) + ((size_t)T * NG + wave * 4) * NP * 2;
    const int tl = lane & 31, hh = lane >> 5, fr = lane & 15, kq = lane >> 4;
    const float* LAM = C.LAM();
    const bf16* Zb = C.Z() + (size_t)1024 + 64 * wave;
    if (PASS2 && !sample) {
        const int k = T & 127, tb = T - k;
        float cr[4], ci[4], l8r[4], l8i[4];
#pragma unroll
        for (int gi = 0; gi < 4; ++gi) { cr[gi] = 0.f; ci[gi] = 0.f; l8r[gi] = LAM[2 * 2048 + (wave * 4 + gi) * 64 + lane]; l8i[gi] = LAM[3 * 2048 + (wave * 4 + gi) * 64 + lane]; }
        const v2f* Ep = (const v2f*)C.E() + ((size_t)tb * NG + wave * 4) * NP + lane;
        const int nb = (k + 15) >> 4, j0 = k - 16 * nb;
        for (int jb = 0; jb < nb; ++jb) {
#pragma unroll
            for (int u = 0; u < 16; ++u) {
                const int j = j0 + 16 * jb + u; const bool ok = j >= 0; const int jc = ok ? j : 0;
#pragma unroll
                for (int gi = 0; gi < 4; ++gi) { v2f e = Ep[(size_t)jc * NG * NP + gi * NP]; if (!ok) e = (v2f){0.f, 0.f};
                    const float nr = fmaf(l8r[gi], cr[gi], fmaf(-l8i[gi], ci[gi], e.x)), ni = fmaf(l8r[gi], ci[gi], fmaf(l8i[gi], cr[gi], e.y)); cr[gi] = nr; ci[gi] = ni; }
            }
        }
#pragma unroll
        for (int gi = 0; gi < 4; ++gi) *(v2f*)(CR + (gi * 64 + lane) * 2) = (v2f){cr[gi], ci[gi]};
        asm volatile("s_waitcnt vmcnt(0)" ::: "memory");
    }
    bfx8 ac[4], q1[4], q2[4], q3[4];
#pragma unroll
    for (int sb = 0; sb < 4; ++sb) { const bf16* zp = Zb + (size_t)(r0 + 32 * sb + tl) * DIN + 8 * hh;
        ac[sb] = *(const bfx8*)(zp); q1[sb] = *(const bfx8*)(zp + 16); q2[sb] = *(const bfx8*)(zp + 32); q3[sb] = *(const bfx8*)(zp + 48); }
    for (int gi = 0; gi < 4; ++gi) {
        const int g = wave * 4 + gi;
        const float lr = LAM[0 * 2048 + g * 64 + lane], li = LAM[1 * 2048 + g * 64 + lane];
        bfx8 bb[4];
#pragma unroll
        for (int cb = 0; cb < 4; ++cb) bb[cb] = *(const bfx8*)(C.BB() + ((size_t)(g * 128 + cb * 32 + tl)) * GN + 8 * hh);
        float sr = 0.f, si = 0.f;
        bfx8 cm[4]; float dsk = 0.f;
        if (PASS2) {
#pragma unroll
            for (int ks = 0; ks < 4; ++ks) cm[ks] = *(const bfx8*)(C.CM() + ((size_t)(g * GN + fr)) * 128 + 32 * ks + 8 * kq);
            dsk = C.in(21)[16 * g + fr];
            if (!sample) { const v2f c0 = *(const v2f*)(CR + (gi * 64 + lane) * 2); sr = c0.x; si = c0.y; }
        }
#pragma unroll
        for (int sb = 0; sb < 4; ++sb) {
            if (sb < sb_lo || sb >= sb_hi) continue;
            const int rb0 = r0 + 32 * sb;
            const bfx8 a = ac[sb];
            if (PASS2) *(LAS bfx8*)(UL + tl * 16 + 8 * hh) = a;
#pragma unroll
            for (int cb = 0; cb < 4; ++cb) {
                v16f acc;
#pragma unroll
                for (int r = 0; r < 16; ++r) acc[r] = 0.f;
                acc = __builtin_amdgcn_mfma_f32_32x32x16_bf16(bb[cb], a, acc, 0, 0, 0);
#pragma unroll
                for (int rg = 0; rg < 4; ++rg) *(LAS v4f*)(BU + tl * S5_ROW + cb * 32 + 8 * rg + 4 * hh) = (v4f){acc[4 * rg], acc[4 * rg + 1], acc[4 * rg + 2], acc[4 * rg + 3]};
            }
            LDS_FENCE();
            {
                v2f bu[32];
#pragma unroll
                for (int t = 0; t < 32; ++t) bu[t] = *(const LAS v2f*)(BU + t * S5_ROW + 2 * lane);
                v2f s0a = (v2f){0.f, 0.f}, s0b = s0a;
                if (sample) { const size_t o0 = ((size_t)(2 * sb) * NG + g) * NP + lane, o1 = o0 + (size_t)NG * NP;
                    s0a = (v2f){C.in(2)[o0], C.in(3)[o0]}; s0b = (v2f){C.in(2)[o1], C.in(3)[o1]}; }
                LDS_FENCE();
#pragma unroll
                for (int t = 0; t < 32; ++t) {
                    if (sample && t == 0) { sr = s0a.x; si = s0a.y; }
                    if (sample && t == 16) { sr = s0b.x; si = s0b.y; }
                    const float nr = fmaf(lr, sr, fmaf(-li, si, bu[t].x)), ni = fmaf(lr, si, fmaf(li, sr, bu[t].y));
                    sr = nr; si = ni;
                    if (PASS2) {
                        *(LAS unsigned*)(BU + t * S5_ROW + lane) = cvt_pk_nv(sr, si);
                        if (sample && (t & 15) == 15) { const int seq = 2 * sb + (t >> 4);
                            C.out()[OFF_SRE_S + ((size_t)seq * NG + g) * NP + lane] = sr; C.out()[OFF_SIM_S + ((size_t)seq * NG + g) * NP + lane] = si; }
                    }
                }
            }
            LDS_FENCE();
            if (PASS2) {
#pragma unroll
                for (int rb = 0; rb < 2; ++rb) {
                    v4f acc = (v4f){0.f, 0.f, 0.f, 0.f};
#pragma unroll
                    for (int ks = 0; ks < 4; ++ks) {
                        const bfx8 sa = *(const LAS bfx8*)((const LAS unsigned char*)BU + (16 * rb + fr) * (S5_ROW * 4) + (32 * ks + 8 * kq) * 2);
                        acc = __builtin_amdgcn_mfma_f32_16x16x32_bf16(sa, cm[ks], acc, 0, 0, 0);
                    }
#pragma unroll
                    for (int r = 0; r < 4; ++r) {
                        LAS bf16* up = UL + (16 * rb + 4 * kq + r) * 16 + fr;
                        const float u = __uint_as_float((unsigned)(*up) << 16);
                        *up = f2bf(gelu_t(acc[r] + dsk * u));
                    }
                }
                LDS_FENCE();
                const v4u yv = *(const LAS v4u*)(UL + lane * 8);
                *(v4u*)(C.YB() + (size_t)(rb0 + (lane >> 1)) * BWD + 16 * g + 8 * (lane & 1)) = yv;
                LDS_FENCE();
            }
        }
        if (!PASS2) { v2f* Ep = (v2f*)C.E() + ((size_t)T * NG + g) * NP + lane; *Ep = (v2f){sr, si}; }
        else if (!sample && (T & 127) == 127) { const int b = T >> 7;
            C.out()[OFF_SRE_P + ((size_t)b * NG + g) * NP + lane] = sr; C.out()[OFF_SIM_P + ((size_t)b * NG + g) * NP + lane] = si; }
#pragma unroll
        for (int sb = 0; sb < 4; ++sb) { ac[sb] = q1[sb]; q1[sb] = q2[sb]; q2[sb] = q3[sb]; }
    }
}

__device__ __forceinline__ void gmlp_tile(const Ctx& C, int T, LAS unsigned char* lds, int wave, int lane, int tid) {
    const int mode = (T == NTILE - 1) ? 1 : 0;
    const int r0 = T * 128;
    LAS bf16* VT = (LAS bf16*)lds;
    LAS float* SSQ = (LAS float*)(lds + 128 * VT_STRIDE * 2);
    const int tb = wave & 3, dh = wave >> 2, tl = lane & 31, hh = lane >> 5;
    const int t = 32 * tb + tl;
    unsigned outp[4][2][8]; float ssq = 0.f;
    const bf16* zt = C.Z() + (size_t)(r0 + t) * DIN;
    const int row = tid >> 2, q = tid & 3;
    const bf16* vsrc = C.Z() + (size_t)(r0 + row) * DIN + 512 + q * 32;
    const bf16* Weff = C.Weff();
    v4u vraw[4];
#pragma unroll
    for (int i = 0; i < 4; ++i) vraw[i] = *(const v4u*)(vsrc + 8 * i);
#pragma unroll
    for (int h = 0; h < 4; ++h) {
        bfx8 wf[8];
        const bf16* wrow = Weff + ((size_t)(mode * 4 + h) * 128 + t) * 128 + 8 * hh;
#pragma unroll
        for (int ks = 0; ks < 8; ++ks) wf[ks] = *(const bfx8*)(wrow + 16 * ks);
        v2u uw[2][4];
#pragma unroll
        for (int dbi = 0; dbi < 2; ++dbi)
#pragma unroll
            for (int rg = 0; rg < 4; ++rg) uw[dbi][rg] = *(const v2u*)(zt + h * 128 + 32 * (2 * dh + dbi) + 8 * rg + 4 * hh);
        const float bias = C.in(13)[h * 128 + (mode ? (t & 15) : t)];
        __syncthreads();
        {
            float v[32]; float s = 0.f;
#pragma unroll
            for (int i = 0; i < 4; ++i) { const v4u w = vraw[i];
                v[8 * i + 0] = bf_lo(w.x); v[8 * i + 1] = bf_hi(w.x); v[8 * i + 2] = bf_lo(w.y); v[8 * i + 3] = bf_hi(w.y);
                v[8 * i + 4] = bf_lo(w.z); v[8 * i + 5] = bf_hi(w.z); v[8 * i + 6] = bf_lo(w.w); v[8 * i + 7] = bf_hi(w.w); }
            if (h < 3) {
#pragma unroll
                for (int i = 0; i < 4; ++i) vraw[i] = *(const v4u*)(vsrc + (h + 1) * 128 + 8 * i);
            }
#pragma unroll
            for (int i = 0; i < 32; ++i) s += v[i] * v[i];
            s += __shfl_xor(s, 1); s += __shfl_xor(s, 2);
            const float r = rsqrtf(s * (1.f / 128.f) + EPS);
            const float* gv = C.in(11) + h * 128 + q * 32;
#pragma unroll
            for (int i = 0; i < 32; ++i) { v[i] = v[i] * r * gv[i]; VT[(q * 32 + i) * VT_STRIDE + row] = f2bf(v[i]); }
            if (mode) { float* ov = C.out() + OFF_V_S + (size_t)row * AW + h * 128 + q * 32;
#pragma unroll
                for (int i = 0; i < 8; ++i) *(v4f*)(ov + 4 * i) = (v4f){v[4 * i], v[4 * i + 1], v[4 * i + 2], v[4 * i + 3]}; }
        }
        __syncthreads();
#pragma unroll
        for (int dbi = 0; dbi < 2; ++dbi) {
            const int db = 2 * dh + dbi;
            v16f acc;
#pragma unroll
            for (int r = 0; r < 16; ++r) acc[r] = 0.f;
#pragma unroll
            for (int ks = 0; ks < 8; ++ks) {
                const bfx8 va = *(const LAS bfx8*)(VT + (32 * db + tl) * VT_STRIDE + 16 * ks + 8 * hh);
                acc = __builtin_amdgcn_mfma_f32_32x32x16_bf16(va, wf[ks], acc, 0, 0, 0);
            }
#pragma unroll
            for (int rg = 0; rg < 4; ++rg) {
                const v2u u2 = uw[dbi][rg];
                const float o0 = bf_lo(u2.x) * (acc[4 * rg + 0] + bias), o1 = bf_hi(u2.x) * (acc[4 * rg + 1] + bias);
                const float o2 = bf_lo(u2.y) * (acc[4 * rg + 2] + bias), o3 = bf_hi(u2.y) * (acc[4 * rg + 3] + bias);
                ssq += (o0 * o0 + o1 * o1) + (o2 * o2 + o3 * o3);
                outp[h][dbi][2 * rg] = cvt_pk_bf16(o0, o1); outp[h][dbi][2 * rg + 1] = cvt_pk_bf16(o2, o3);
            }
        }
    }
    ssq += __shfl_xor(ssq, 32);
    if (hh == 0) SSQ[t * 2 + dh] = ssq;
    __syncthreads();
    const float rstd = rsqrtf((SSQ[t * 2] + SSQ[t * 2 + 1]) * (1.f / 512.f) + EPS);
    bf16* orow = C.MIX() + (size_t)(r0 + t) * DM;
    const float* gap = C.in(24);
#pragma unroll
    for (int h = 0; h < 4; ++h)
#pragma unroll
        for (int dbi = 0; dbi < 2; ++dbi)
#pragma unroll
            for (int rg = 0; rg < 4; ++rg) {
                const int c = h * 128 + 32 * (2 * dh + dbi) + 8 * rg + 4 * hh;
                const v4f ga = *(const v4f*)(gap + c);
                const unsigned w0 = outp[h][dbi][2 * rg], w1 = outp[h][dbi][2 * rg + 1];
                v2u o; o.x = cvt_pk_bf16(bf_lo(w0) * rstd * ga.x, bf_hi(w0) * rstd * ga.y); o.y = cvt_pk_bf16(bf_lo(w1) * rstd * ga.z, bf_hi(w1) * rstd * ga.w);
                *(v2u*)(orow + c) = o;
            }
    __syncthreads();
}

#define FTID const int ftid_ = fresh_tid()
#define TID (ftid_)
#define LANE (ftid_ & 63)
#define WAVE (__builtin_amdgcn_readfirstlane(ftid_ >> 6))
#define GSZ ((int)gridDim.x)
#define BX ((int)blockIdx.x)
#define GWV (BX * NWAVES + WAVE)
#define NGWV (GSZ * NWAVES)
constexpr size_t WS_CTL = 0, CTL_ZERO_BYTES = 16384;
constexpr int MISC_OFF = LDS_BYTES - 64;
#define XB_TMO      128
#define XB_XCNT(j)  (256  + 64 * (j))
#define XB_XSUB(j)  (1280 + 64 * (j))
#define XB_XGEN(j)  (2304 + 64 * (j))
#define XB_TOP      3328
#define XB_TOPGEN   3392
#define XCD_BAR_WORDS 3456
#define XB_SPIN_CAP (1u << 18)

__device__ __forceinline__ unsigned xb_ld(unsigned* p)              { return __hip_atomic_load(p, __ATOMIC_RELAXED, __HIP_MEMORY_SCOPE_AGENT); }
__device__ __forceinline__ unsigned xb_add(unsigned* p, unsigned v) { return __hip_atomic_fetch_add(p, v, __ATOMIC_RELAXED, __HIP_MEMORY_SCOPE_AGENT); }
__device__ __forceinline__ unsigned xb_xcc_id() { return (unsigned)__builtin_amdgcn_s_getreg((3 << 11) | 20) & 0xFu; }
#define XB_SPIN(cond, bar) do { unsigned _sp = 0; while (cond) { __builtin_amdgcn_s_sleep(1); \
    if ((++_sp & 255u) == 0u) { if (xb_ld(&(bar)[XB_TMO])) break; if (_sp > XB_SPIN_CAP) { atomicAdd(&(bar)[XB_TMO], 1u); break; } } } } while (0)

struct XcdBarrier {
    unsigned* bar; unsigned x;
    volatile LAS unsigned* st;
};

__device__ __forceinline__ XcdBarrier xcd_barrier_post(unsigned* bar, volatile LAS unsigned* st) {
    XcdBarrier b; b.bar = bar; b.x = xb_xcc_id(); b.st = st;
    if (threadIdx.x == 0) (void)xb_add(&bar[XB_XCNT(b.x)], 1u);
    return b;
}
__device__ __forceinline__ void xcd_barrier_complete(unsigned* bar, unsigned x, unsigned& nloc, unsigned& nx) {
    const unsigned G = gridDim.x * gridDim.y * gridDim.z;
    unsigned sum, cnt, mine, sp = 0u;
    for (;;) {
        sum = 0u; cnt = 0u; mine = 0u;
#pragma unroll
        for (unsigned j = 0; j < 16; ++j) { const unsigned c = xb_ld(&bar[XB_XCNT(j)]); sum += c; cnt += (c > 0u) ? 1u : 0u; mine = (j == x) ? c : mine; }
        if (sum == G) break;
        __builtin_amdgcn_s_sleep(1);
        if ((++sp & 255u) == 0u) { if (xb_ld(&bar[XB_TMO])) break; if (sp > XB_SPIN_CAP) { atomicAdd(&bar[XB_TMO], 1u); break; } }
    }
    nloc = mine > 0u ? mine : 1u; nx = cnt > 0u ? cnt : 1u;
}

__device__ __forceinline__ void xcd_barrier(const XcdBarrier& b) {
    asm volatile("s_waitcnt vmcnt(0)" ::: "memory");
    __syncthreads();
    if (threadIdx.x == 0) {
        unsigned* bar = b.bar;
        __builtin_amdgcn_s_waitcnt(0);
        unsigned nloc = b.st[0], nx = b.st[1];
        if (nloc == 0u) { xcd_barrier_complete(bar, b.x, nloc, nx); b.st[0] = nloc; b.st[1] = nx; }
        const unsigned old = xb_add(&bar[XB_XSUB(b.x)], 1u);
        const unsigned gen = old / nloc;
        if (old + 1u == (gen + 1u) * nloc) {
            __builtin_amdgcn_fence(__ATOMIC_RELEASE, "agent");
            asm volatile("s_waitcnt vmcnt(0)" ::: "memory");
            const unsigned og = xb_add(&bar[XB_TOP], 1u);
            const unsigned tg = og / nx;
            if (og + 1u == (tg + 1u) * nx) xb_add(&bar[XB_TOPGEN], 1u);
            else XB_SPIN(xb_ld(&bar[XB_TOPGEN]) == tg, bar);
            __builtin_amdgcn_fence(__ATOMIC_ACQUIRE, "agent");
            xb_add(&bar[XB_XGEN(b.x)], 1u);
            asm volatile("s_waitcnt vmcnt(0)" ::: "memory");
        } else {
            XB_SPIN(xb_ld(&bar[XB_XGEN(b.x)]) == gen, bar);
            __builtin_amdgcn_fence(__ATOMIC_ACQUIRE, "agent");
            asm volatile("s_waitcnt vmcnt(0)" ::: "memory");
        }
    }
    __syncthreads();
}

template <int MODE>
__device__ __forceinline__ void small_gemm(LAS unsigned char* lds, const bf16* A, const bf16* Bt, int N, int K, bf16* O, int ldc, int act_cols, const float* bias, const bf16* Yv, int ldy) {
    FTID; const int wave = WAVE, lane = LANE, tl = lane & 31, hh = lane >> 5;
    LAS float* red = (LAS float*)lds;
    const int nct = N / 32, nitems = 4 * nct, kw = K / 8, nks = kw / 16;
    for (int item = BX; item < nitems; item += GSZ) {
        const int rt = item & 3, ct = item >> 2;
        const int hc = 32 * ct + tl;
        const int brow = (MODE == 3) ? (256 * (hc >> 7) + (hc & 127)) : hc;
        const bf16* ap = A + (size_t)(32 * rt + tl) * K + wave * kw + 8 * hh;
        const bf16* bp = Bt + (size_t)brow * K + wave * kw + 8 * hh;
        v16f acc0, acc1;
#pragma unroll
        for (int r = 0; r < 16; ++r) { acc0[r] = 0.f; acc1[r] = 0.f; }
#pragma unroll 4
        for (int ks = 0; ks < nks; ++ks) {
            const bfx8 a = *(const bfx8*)(ap + 16 * ks);
            const bfx8 b0 = *(const bfx8*)(bp + 16 * ks);
            acc0 = __builtin_amdgcn_mfma_f32_32x32x16_bf16(b0, a, acc0, 0, 0, 0);
            if (MODE == 3) { const bfx8 b1 = *(const bfx8*)(bp + (size_t)128 * K + 16 * ks); acc1 = __builtin_amdgcn_mfma_f32_32x32x16_bf16(b1, a, acc1, 0, 0, 0); }
        }
        __syncthreads();
#pragma unroll
        for (int r = 0; r < 16; ++r) { red[(wave * 16 + r) * 64 + lane] = acc0[r]; if (MODE == 3) red[8192 + (wave * 16 + r) * 64 + lane] = acc1[r]; }
        __syncthreads();
        float v0[2], v1[2];
#pragma unroll
        for (int e = 0; e < 2; ++e) { float s0 = 0.f, s1 = 0.f;
#pragma unroll
            for (int w = 0; w < 8; ++w) { s0 += red[(w * 16 + 2 * wave + e) * 64 + lane]; if (MODE == 3) s1 += red[8192 + (w * 16 + 2 * wave + e) * 64 + lane]; }
            v0[e] = s0; v1[e] = s1; }
        const int reg = 2 * wave;
        const int col = 32 * ct + (reg & 3) + 8 * (reg >> 2) + 4 * hh;
        const size_t row = (size_t)(32 * rt + tl);
        float o0 = v0[0], o1 = v0[1];
        if (MODE == 1) { if (col < act_cols) { o0 = gelu_t(o0); o1 = gelu_t(o1); } }
        if (MODE == 2) { const unsigned y = *(const unsigned*)(Yv + row * ldy + col); o0 = bf_lo(y) * pg8::sigmoid_f(o0 + bias[col]); o1 = bf_hi(y) * pg8::sigmoid_f(o1 + bias[col + 1]); }
        if (MODE == 3) { o0 = pg8::silu_f(o0) * v1[0]; o1 = pg8::silu_f(o1) * v1[1]; }
        *(unsigned*)(O + row * ldc + col) = cvt_pk_bf16(o0, o1);
    }
    __syncthreads();
}
struct Args { const float* in[33]; float* out; unsigned char* ws; };
#ifndef PROBE
#define PROBE 0
#endif
#ifndef PH_LO
#define PH_LO 0
#endif
#ifndef PH_HI
#define PH_HI 14
#endif

__global__ void __launch_bounds__(NTHREADS, 2) fwd_kernel(Args args) {
    extern __shared__ __attribute__((aligned(16))) unsigned char lds_raw[];
    cg::grid_group grid = cg::this_grid();
    LAS unsigned char* lds = (LAS unsigned char*)lds_raw;
    Ctx C;
    if (threadIdx.x < 16) ((volatile LAS unsigned*)(lds + MISC_OFF))[threadIdx.x] = 0u;
    __syncthreads();
    (void)xcd_barrier_post((unsigned*)(C.ws() + WS_CTL), (volatile LAS unsigned*)(lds + MISC_OFF));
#define XBAR() do { XcdBarrier b_; b_.bar = (unsigned*)(C.ws() + WS_CTL); b_.x = xb_xcc_id(); b_.st = (volatile LAS unsigned*)(lds + MISC_OFF); xcd_barrier(b_); } while (0)
    { FTID; p0_prologue(C, lds, WAVE, LANE, TID); }
    grid.sync();
    { pg8::Gemm g{C.XN(), C.Wgu1(), MPROMPT, 2 * DFF, DM}; pg8::StaticOrder S; S.init(MPROMPT, 2 * DFF, GSZ, BX); pg8::EpiSwiglu E{C.H(), DFF};
      pg8::gemm_phase<pg8::EpiSwiglu, pg8::StaticOrder, true, true>(lds, g, S, E); }
    small_gemm<3>(lds, C.XN() + (size_t)MPROMPT * DM, C.Wgu1(), DFF, DM, C.H() + (size_t)MPROMPT * DFF, DFF, 0, nullptr, nullptr, 0);
    XBAR();
    { pg8::Gemm g{C.H(), C.Wd1(), MPROMPT, DM, DFF}; pg8::StaticOrder S; S.init(MPROMPT, DM, GSZ, BX); pg8::EpiBf16<0> E{C.D(), DM, 0, nullptr, nullptr, 0};
      pg8::gemm_phase<pg8::EpiBf16<0>, pg8::StaticOrder, true, true>(lds, g, S, E); }
    small_gemm<0>(lds, C.H() + (size_t)MPROMPT * DFF, C.Wd1(), DM, DFF, C.D() + (size_t)MPROMPT * DM, DM, 0, nullptr, nullptr, 0);
    XBAR();
    { FTID; for (int m = GWV; m < M; m += NGWV) row_res(xrow_ptr(C, m), C.D() + (size_t)m * DM, C.in(8), 0.5f, C.out() + (size_t)m * DM, C.in(9), C.XN() + (size_t)m * DM, LANE); }
    XBAR();
    { pg8::Gemm g{C.XN(), C.Win(), MPROMPT, DIN, DM}; pg8::StaticOrder S; S.init(MPROMPT, DIN, GSZ, BX); pg8::EpiBf16<1> E{C.Z(), DIN, 2 * AW, nullptr, nullptr, 0};
      pg8::gemm_phase<pg8::EpiBf16<1>, pg8::StaticOrder, true, true>(lds, g, S, E); }
    small_gemm<1>(lds, C.XN() + (size_t)MPROMPT * DM, C.Win(), DIN, DM, C.Z() + (size_t)MPROMPT * DIN, DIN, 2 * AW, nullptr, nullptr, 0);
    XBAR();
    { FTID; for (int T = BX; T < NTILE - 1; T += GSZ) {
        s5_tile<false>(C, T, 0, 4, lds, WAVE, LANE);
        __syncthreads();
        gmlp_tile(C, T, lds, WAVE, LANE, TID);
    } }
    XBAR();
    { FTID; for (int T = BX; T < NTILE - 1; T += GSZ) s5_tile<true>(C, T, 0, 4, lds, WAVE, LANE);
      if (BX >= 1 && BX <= 4) s5_tile<true>(C, NTILE - 1, BX - 1, BX, lds, WAVE, LANE);
      if (BX == 0) { __syncthreads(); gmlp_tile(C, NTILE - 1, lds, WAVE, LANE, TID); } }
    XBAR();
    { pg8::Gemm g{C.YB(), C.Wglu(), MPROMPT, BWD, BWD}; pg8::StaticOrder S; S.init(MPROMPT, BWD, GSZ, BX); pg8::EpiBf16<2> E{C.MIX() + AW, DM, 0, C.in(23), C.YB(), BWD};
      pg8::gemm_phase<pg8::EpiBf16<2>, pg8::StaticOrder, true, true>(lds, g, S, E); }
    small_gemm<2>(lds, C.YB() + (size_t)MPROMPT * BWD, C.Wglu(), BWD, BWD, C.MIX() + (size_t)MPROMPT * DM + AW, DM, 0, C.in(23), C.YB() + (size_t)MPROMPT * BWD, BWD);
    XBAR();
    { FTID; for (int m = GWV; m < M; m += NGWV) row_norm512(C.MIX() + (size_t)m * DM + AW, C.in(25), LANE); }
    XBAR();
    { pg8::Gemm g{C.MIX(), C.Wout(), MPROMPT, DM, DM}; pg8::StaticOrder S; S.init(MPROMPT, DM, GSZ, BX); pg8::EpiBf16<0> E{C.D(), DM, 0, nullptr, nullptr, 0};
      pg8::gemm_phase<pg8::EpiBf16<0>, pg8::StaticOrder, true, true>(lds, g, S, E); }
    small_gemm<0>(lds, C.MIX() + (size_t)MPROMPT * DM, C.Wout(), DM, DM, C.D() + (size_t)MPROMPT * DM, DM, 0, nullptr, nullptr, 0);
    XBAR();
    { FTID; for (int m = GWV; m < M; m += NGWV) row_res(C.out() + (size_t)m * DM, C.D() + (size_t)m * DM, C.in(27), 1.0f, C.out() + (size_t)m * DM, C.in(28), C.XN() + (size_t)m * DM, LANE); }
    XBAR();
    { pg8::Gemm g{C.XN(), C.Wgu2(), MPROMPT, 2 * DFF, DM}; pg8::StaticOrder S; S.init(MPROMPT, 2 * DFF, GSZ, BX); pg8::EpiSwiglu E{C.H(), DFF};
      pg8::gemm_phase<pg8::EpiSwiglu, pg8::StaticOrder, true, true>(lds, g, S, E); }
    small_gemm<3>(lds, C.XN() + (size_t)MPROMPT * DM, C.Wgu2(), DFF, DM, C.H() + (size_t)MPROMPT * DFF, DFF, 0, nullptr, nullptr, 0);
    XBAR();
    { pg8::Gemm g{C.H(), C.Wd2(), MPROMPT, DM, DFF}; pg8::StaticOrder S; S.init(MPROMPT, DM, GSZ, BX); pg8::EpiBf16<0> E{C.D(), DM, 0, nullptr, nullptr, 0};
      pg8::gemm_phase<pg8::EpiBf16<0>, pg8::StaticOrder, true, true>(lds, g, S, E); }
    small_gemm<0>(lds, C.H() + (size_t)MPROMPT * DFF, C.Wd2(), DM, DFF, C.D() + (size_t)MPROMPT * DM, DM, 0, nullptr, nullptr, 0);
    XBAR();
    { FTID; for (int m = GWV; m < M; m += NGWV) row_res(C.out() + (size_t)m * DM, C.D() + (size_t)m * DM, C.in(32), 0.5f, C.out() + (size_t)m * DM, nullptr, nullptr, LANE); }
}

extern "C" void kernel_launch(void* const* d_in, const int* in_sizes, int n_in, void* d_out, int out_size, void* d_ws, size_t ws_size, hipStream_t stream) {
    static int grid = 0;
    if (grid == 0) {
        if (n_in != 33 || ws_size < WS_END) { fprintf(stderr, "kernel_launch: unexpected n_in %d / ws %zu\n", n_in, ws_size); grid = -1; return; }
        int dev = 0, cus = 0, per_cu = 0;
        hipGetDevice(&dev);
        hipDeviceGetAttribute(&cus, hipDeviceAttributeMultiprocessorCount, dev);
        hipFuncSetAttribute((const void*)fwd_kernel, hipFuncAttributeMaxDynamicSharedMemorySize, LDS_BYTES);
        hipOccupancyMaxActiveBlocksPerMultiprocessor(&per_cu, (const void*)fwd_kernel, NTHREADS, LDS_BYTES);
        if (per_cu < 1) { fprintf(stderr, "kernel_launch: occupancy query says %d blocks per CU\n", per_cu); per_cu = 1; }
        grid = cus * per_cu;
    }
    if (grid < 0) return;
    if (hipMemsetAsync((char*)d_ws + WS_CTL, 0, CTL_ZERO_BYTES, stream) != hipSuccess) { fprintf(stderr, "memset failed\n"); return; }
    Args a{};
    for (int i = 0; i < 33; ++i) a.in[i] = (const float*)d_in[i];
    a.out = (float*)d_out; a.ws = (unsigned char*)d_ws;
    void* params[] = {&a};
    hipError_t e = hipLaunchCooperativeKernel((const void*)fwd_kernel, dim3(grid), dim3(NTHREADS), params, LDS_BYTES, stream);
    if (e != hipSuccess) fprintf(stderr, "cooperative launch failed: %s (grid %d)\n", hipGetErrorString(e), grid);
}
```

```cpp
#include <hip/hip_runtime.h>
#include <hip/hip_cooperative_groups.h>
#include <cstdio>
#include <cstdint>
namespace cg = cooperative_groups;
__device__ __forceinline__ int fresh_tid() { int t = (int)threadIdx.x; asm volatile("" : "+v"(t)); return t; }
namespace pg8 {
#define PG8_LAS __attribute__((address_space(3)))
typedef unsigned short bf16_t;
typedef short bf16x8 __attribute__((ext_vector_type(8)));
typedef float f32x4 __attribute__((ext_vector_type(4)));
typedef unsigned u32x4 __attribute__((ext_vector_type(4)));
constexpr int BM = 256, BK = 64, HALF = 128, HTB = HALF * BK * 2  , STAGE_BYTES = 8 * HTB, NXCD = 8, WGM = 8;

__host__ __device__ __forceinline__ int lds_byte(int r, int c) { const int st = (r >> 4) * 2 + (c >> 5), rr = r & 15, cc = c & 31, ob = rr * 64 + cc * 2; return st * 1024 + (ob ^ (((ob >> 9) & 1) << 5)); }
__host__ __device__ __forceinline__ void stage_rc(int b, int& R, int& C) { const int st = b / 1024, sb = b % 1024, swz = sb ^ (((sb >> 9) & 1) << 5); R = (st >> 1) * 16 + swz / 64; C = (st & 1) * 32 + (swz % 64) / 2; }
__host__ __device__ __forceinline__ int perm32(int rho) { const int n = rho >> 4, i = rho & 15; return 8 * (i >> 2) + 4 * n + (i & 3); }

struct Unit { int pm, pn; };
struct Gemm { const bf16_t* A; const bf16_t* Bt; int M, N, K; };

struct StaticOrder {
    int nM, nN, nwg, G, c;
    __host__ __device__ void init(int M, int N, int G_, int c_) { nM = M / BM; nN = N / BM; nwg = nM * nN; G = G_; c = c_; }
    __host__ __device__ bool next(int i, Unit& u) const {
        const long L = (long)i * G + c; if (L >= nwg) return false;
        int wgid = (int)L; { const int q = nwg / NXCD, r = nwg % NXCD, xcd = wgid % NXCD, off = wgid / NXCD; wgid = (xcd < r ? xcd * (q + 1) : r * (q + 1) + (xcd - r) * q) + off; }
        const int nig = WGM * nN, gid = wgid / nig, fm = gid * WGM, gsz = (nM - fm) < WGM ? (nM - fm) : WGM;
        u.pm = fm + ((wgid % nig) % gsz); u.pn = (wgid % nig) / gsz; return true;
    }
    __device__ __forceinline__ void a_ready(const Unit&) const {}
    __device__ __forceinline__ void done(const Unit&) const {}
};

__device__ __forceinline__ unsigned cvt_pk_bf16(float lo, float hi) { unsigned r; asm volatile("v_cvt_pk_bf16_f32 %0, %1, %2" : "=v"(r) : "v"(lo), "v"(hi)); return r; }
__device__ __forceinline__ float bf_lo(unsigned w) { return __uint_as_float(w << 16); }
__device__ __forceinline__ float bf_hi(unsigned w) { return __uint_as_float(w & 0xffff0000u); }
__device__ __forceinline__ float sigmoid_f(float x) { return __builtin_amdgcn_rcpf(1.0f + __expf(-x)); }
__device__ __forceinline__ float silu_f(float x) { return x * sigmoid_f(x); }
__device__ __forceinline__ float gelu_t(float x) { const float u = 1.5957691216057308f * (x + 0.044715f * x * x * x); return x * sigmoid_f(u); }

struct EpiSwiglu {
    static constexpr bool PERM = true, AFTER_DRAIN = false;
    bf16_t* O; int ldc;
    __device__ __forceinline__ void operator()(const f32x4 (&acc)[2][2][4][2], const Unit& u, int wr, int wc, int fr, int fq) const {
        const int row0 = u.pm * BM + wr * 64 + fr; const int col0 = u.pn * HALF + wc * 32 + 8 * fq;
#pragma unroll
        for (int ai = 0; ai < 2; ++ai)
#pragma unroll
            for (int m = 0; m < 4; ++m) {
                bf16_t* rowp = O + (size_t)(row0 + ai * HALF + m * 16) * ldc + col0;
                const f32x4 g0 = acc[ai][0][m][0], g1 = acc[ai][0][m][1], u0 = acc[ai][1][m][0], u1 = acc[ai][1][m][1];
                u32x4 w;
                w.x = cvt_pk_bf16(silu_f(g0[0]) * u0[0], silu_f(g0[1]) * u0[1]); w.y = cvt_pk_bf16(silu_f(g0[2]) * u0[2], silu_f(g0[3]) * u0[3]);
                w.z = cvt_pk_bf16(silu_f(g1[0]) * u1[0], silu_f(g1[1]) * u1[1]); w.w = cvt_pk_bf16(silu_f(g1[2]) * u1[2], silu_f(g1[3]) * u1[3]);
                *(u32x4*)rowp = w;
            }
    }
};
template <int MODE> struct EpiBf16 {
    static constexpr bool PERM = true, AFTER_DRAIN = false;
    bf16_t* O; int ldc; int act_cols; const float* bias; const bf16_t* Y; int ldy;
    __device__ __forceinline__ void operator()(const f32x4 (&acc)[2][2][4][2], const Unit& u, int wr, int wc, int fr, int fq) const {
        const int row0 = u.pm * BM + wr * 64 + fr; const int col0 = u.pn * BM + wc * 32 + 8 * fq;
#pragma unroll
        for (int bj = 0; bj < 2; ++bj) {
            const int col = col0 + bj * HALF;
            f32x4 b0 = (f32x4){0.f, 0.f, 0.f, 0.f}, b1 = b0;
            if (MODE == 2) { b0 = *(const f32x4*)(bias + col); b1 = *(const f32x4*)(bias + col + 4); }
            const bool act = (MODE == 1) && (col < act_cols);
#pragma unroll
            for (int ai = 0; ai < 2; ++ai)
#pragma unroll
                for (int m = 0; m < 4; ++m) {
                    const size_t row = (size_t)(row0 + ai * HALF + m * 16);
                    f32x4 v0 = acc[ai][bj][m][0], v1 = acc[ai][bj][m][1];
                    if (MODE == 1) { if (act) {
#pragma unroll
                        for (int j = 0; j < 4; ++j) { v0[j] = gelu_t(v0[j]); v1[j] = gelu_t(v1[j]); } } }
                    if (MODE == 2) {
                        const u32x4 y = *(const u32x4*)(Y + row * ldy + col);
                        v0 = v0 + b0; v1 = v1 + b1;
                        v0[0] = bf_lo(y.x) * sigmoid_f(v0[0]); v0[1] = bf_hi(y.x) * sigmoid_f(v0[1]); v0[2] = bf_lo(y.y) * sigmoid_f(v0[2]); v0[3] = bf_hi(y.y) * sigmoid_f(v0[3]);
                        v1[0] = bf_lo(y.z) * sigmoid_f(v1[0]); v1[1] = bf_hi(y.z) * sigmoid_f(v1[1]); v1[2] = bf_lo(y.w) * sigmoid_f(v1[2]); v1[3] = bf_hi(y.w) * sigmoid_f(v1[3]);
                    }
                    u32x4 w; w.x = cvt_pk_bf16(v0[0], v0[1]); w.y = cvt_pk_bf16(v0[2], v0[3]); w.z = cvt_pk_bf16(v1[0], v1[1]); w.w = cvt_pk_bf16(v1[2], v1[3]);
                    *(u32x4*)(O + row * ldc + col) = w;
                }
        }
    }
};

struct EpiNull {
    static constexpr bool PERM = true, AFTER_DRAIN = false;
    bf16_t* O;
    __device__ __forceinline__ void operator()(const f32x4 (&acc)[2][2][4][2], const Unit& u, int wr, int wc, int fr, int fq) const {
        float s = 0.f;
#pragma unroll
        for (int ai = 0; ai < 2; ++ai)
#pragma unroll
            for (int bj = 0; bj < 2; ++bj)
#pragma unroll
                for (int m = 0; m < 4; ++m)
#pragma unroll
                    for (int n = 0; n < 2; ++n) s += (acc[ai][bj][m][n][0] + acc[ai][bj][m][n][1]) + (acc[ai][bj][m][n][2] + acc[ai][bj][m][n][3]);
        if (s == 12345.678f) O[u.pm + wr + wc + fr + fq] = 1;
    }
};
template <class Epi, class Sched, bool ALIGN_EPI = false, bool SP2 = false>
__device__ __forceinline__ void gemm_phase(PG8_LAS unsigned char* lds, const Gemm g, const Sched& S, const Epi& E) {
    const int tid = fresh_tid(), wid = __builtin_amdgcn_readfirstlane(tid >> 6), lane = tid & 63, wr = wid >> 2, wc = wid & 3, fr = lane & 15, fq = lane >> 4;
    const int K = g.K, nt = K / BK;
    unsigned voffA[2], voffB[2];
#pragma unroll
    for (int i = 0; i < 2; ++i) { int R, C; stage_rc(tid * 16 + i * 8192, R, C); const int Rb = Epi::PERM ? ((R & ~31) + perm32(R & 31)) : R;
        voffA[i] = (unsigned)(R * K + C) * 2u; voffB[i] = (unsigned)(Rb * K + C) * 2u; }
    const size_t kstep = (size_t)(BK * 2);
    const size_t hstep = (size_t)HALF * K * 2;
    const size_t tstep = 2 * hstep;
    const unsigned ldsw = (unsigned)wid * 1024u;
    const int aoff = lds_byte(wr * 64 + fr, fq * 8), boff = lds_byte(wc * 32 + fr, fq * 8);
#define PG8_SA(b, h) (((b) * 2 + (h)) * HTB)
#define PG8_SB(b, h) ((4 + (b) * 2 + (h)) * HTB)
#define PG8_STAGE(bufoff, gbase, voff) do { _Pragma("unroll") for (int _i = 0; _i < 2; ++_i) \
        __builtin_amdgcn_global_load_lds((const unsigned*)((const char*)(gbase) + (voff)[_i]), (PG8_LAS unsigned*)(lds + (bufoff) + ldsw + _i * 8192), 16, 0, 0); } while (0)
#define PG8_LDA(dst, b, h) do { _Pragma("unroll") for (int m = 0; m < 4; ++m) _Pragma("unroll") for (int k = 0; k < 2; ++k) dst[m][k] = *(const PG8_LAS bf16x8*)(lds + PG8_SA(b, h) + aoff + m * 2048 + k * 1024); } while (0)
#define PG8_LDB(dst, b, h) do { _Pragma("unroll") for (int n = 0; n < 2; ++n) _Pragma("unroll") for (int k = 0; k < 2; ++k) dst[n][k] = *(const PG8_LAS bf16x8*)(lds + PG8_SB(b, h) + boff + n * 2048 + k * 1024); } while (0)
#define PG8_MMA(ai, bj, At, Bt) do { __builtin_amdgcn_s_setprio(1); _Pragma("unroll") for (int m = 0; m < 4; ++m) _Pragma("unroll") for (int n = 0; n < 2; ++n) _Pragma("unroll") for (int k = 0; k < 2; ++k) \
        acc[ai][bj][m][n] = __builtin_amdgcn_mfma_f32_16x16x32_bf16(Bt[n][k], At[m][k], acc[ai][bj][m][n], 0, 0, 0); __builtin_amdgcn_s_setprio(0); } while (0)
#define PG8_WAIT_V(n) asm volatile("s_waitcnt vmcnt(" #n ")" ::: "memory")
#define PG8_WAIT_L(n) asm volatile("s_waitcnt lgkmcnt(" #n ")" ::: "memory")
#define PG8_BAR __builtin_amdgcn_s_barrier()
#define PG8_SCHED __builtin_amdgcn_sched_barrier(0)
    Unit cur, nxt; int ui = 0;
    if (!S.next(0, cur)) return;
    f32x4 acc[2][2][4][2];
#pragma unroll
    for (int a = 0; a < 2; ++a)
#pragma unroll
        for (int b = 0; b < 2; ++b)
#pragma unroll
            for (int m = 0; m < 4; ++m)
#pragma unroll
                for (int n = 0; n < 2; ++n) acc[a][b][m][n] = (f32x4){0.f, 0.f, 0.f, 0.f};
    bf16x8 At[4][2], B0[2][2], B1[2][2];
    const char* cA = (const char*)g.A + (size_t)cur.pm * tstep; const char* cB = (const char*)g.Bt + (size_t)cur.pn * tstep;
    S.a_ready(cur);
    if constexpr (SP2) {
        PG8_STAGE(PG8_SB(0, 0), cB, voffB); PG8_STAGE(PG8_SB(0, 1), cB + hstep, voffB); PG8_STAGE(PG8_SA(0, 0), cA, voffA); PG8_STAGE(PG8_SA(0, 1), cA + hstep, voffA);
        if (wr == 1) PG8_BAR;
        PG8_WAIT_V(2); PG8_BAR;
        PG8_STAGE(PG8_SB(1, 0), cB + kstep, voffB); PG8_STAGE(PG8_SA(1, 0), cA + kstep, voffA); PG8_STAGE(PG8_SB(1, 1), cB + hstep + kstep, voffB);
        PG8_WAIT_V(6); PG8_BAR;
    } else {
        PG8_STAGE(PG8_SB(0, 0), cB, voffB); PG8_STAGE(PG8_SA(0, 0), cA, voffA); PG8_STAGE(PG8_SB(0, 1), cB + hstep, voffB); PG8_STAGE(PG8_SA(0, 1), cA + hstep, voffA);
        if (wr == 1) PG8_BAR;
        PG8_WAIT_V(4); PG8_BAR;
        PG8_STAGE(PG8_SB(1, 0), cB + kstep, voffB); PG8_STAGE(PG8_SA(1, 0), cA + kstep, voffA); PG8_STAGE(PG8_SB(1, 1), cB + hstep + kstep, voffB);
        PG8_WAIT_V(6); PG8_BAR;
    }
    for (;;) {
        const bool has_next = S.next(ui + 1, nxt);
        const char* nA = has_next ? (const char*)g.A + (size_t)nxt.pm * tstep : cA; const char* nB = has_next ? (const char*)g.Bt + (size_t)nxt.pn * tstep : cB;
        for (int t = 0; t < nt; t += 2) {
            const bool last = (t == nt - 2);
            const char* a1 = cA + (size_t)(t + 1) * kstep;
            const char* a2 = last ? nA : cA + (size_t)(t + 2) * kstep; const char* b2 = last ? nB : cB + (size_t)(t + 2) * kstep;
            const char* a3 = a2 + kstep; const char* b3 = b2 + kstep;
            if (last && has_next) S.a_ready(nxt);
            if constexpr (SP2) {
            PG8_LDB(B0, 0, 0); PG8_LDB(B1, 0, 1); PG8_SCHED; PG8_LDA(At, 0, 0); PG8_STAGE(PG8_SA(1, 1), a1 + hstep, voffA);
            PG8_WAIT_V(8); PG8_WAIT_L(0); PG8_BAR; PG8_MMA(0, 0, At, B0); PG8_MMA(0, 1, At, B1); PG8_BAR; PG8_SCHED;
            PG8_LDA(At, 0, 1); PG8_STAGE(PG8_SB(0, 0), b2, voffB); PG8_STAGE(PG8_SB(0, 1), b2 + hstep, voffB); PG8_STAGE(PG8_SA(0, 0), a2, voffA);
            PG8_WAIT_V(8); PG8_WAIT_L(0); PG8_BAR; PG8_MMA(1, 0, At, B0); PG8_MMA(1, 1, At, B1); PG8_BAR; PG8_SCHED;
            PG8_LDB(B0, 1, 0); PG8_LDB(B1, 1, 1); PG8_SCHED; PG8_LDA(At, 1, 0); PG8_STAGE(PG8_SA(0, 1), a2 + hstep, voffA);
            PG8_WAIT_V(8); PG8_WAIT_L(0); PG8_BAR; PG8_MMA(0, 0, At, B0); PG8_MMA(0, 1, At, B1); PG8_BAR; PG8_SCHED;
            PG8_LDA(At, 1, 1); PG8_STAGE(PG8_SB(1, 0), b3, voffB); PG8_STAGE(PG8_SB(1, 1), b3 + hstep, voffB); PG8_STAGE(PG8_SA(1, 0), a3, voffA);
            PG8_WAIT_V(8); PG8_WAIT_L(0); PG8_BAR; PG8_MMA(1, 0, At, B0); PG8_MMA(1, 1, At, B1); PG8_BAR; PG8_SCHED;
            } else {
            PG8_LDB(B0, 0, 0); PG8_SCHED; PG8_LDA(At, 0, 0); PG8_STAGE(PG8_SA(1, 1), a1 + hstep, voffA);
            PG8_WAIT_L(8); PG8_BAR; PG8_WAIT_L(0); PG8_MMA(0, 0, At, B0); PG8_BAR; PG8_SCHED;
            PG8_LDB(B1, 0, 1); PG8_STAGE(PG8_SB(0, 0), b2, voffB);
            PG8_BAR; PG8_WAIT_L(0); PG8_MMA(0, 1, At, B1); PG8_BAR;
            PG8_LDA(At, 0, 1); PG8_STAGE(PG8_SA(0, 0), a2, voffA);
            PG8_BAR; PG8_WAIT_L(0); PG8_MMA(1, 0, At, B0); PG8_BAR; PG8_SCHED;
            PG8_STAGE(PG8_SB(0, 1), b2 + hstep, voffB);
            PG8_WAIT_V(6); PG8_BAR; PG8_MMA(1, 1, At, B1); PG8_BAR;
            PG8_LDB(B0, 1, 0); PG8_SCHED; PG8_LDA(At, 1, 0); PG8_STAGE(PG8_SA(0, 1), a2 + hstep, voffA);
            PG8_WAIT_L(8); PG8_BAR; PG8_WAIT_L(0); PG8_MMA(0, 0, At, B0); PG8_BAR; PG8_SCHED;
            PG8_LDB(B1, 1, 1); PG8_STAGE(PG8_SB(1, 0), b3, voffB);
            PG8_BAR; PG8_WAIT_L(0); PG8_MMA(0, 1, At, B1); PG8_BAR;
            PG8_LDA(At, 1, 1); PG8_STAGE(PG8_SA(1, 0), a3, voffA);
            PG8_BAR; PG8_WAIT_L(0); PG8_MMA(1, 0, At, B0); PG8_BAR; PG8_SCHED;
            PG8_STAGE(PG8_SB(1, 1), b3 + hstep, voffB);
            PG8_WAIT_V(6); PG8_BAR; PG8_MMA(1, 1, At, B1); PG8_BAR;
            }
        }
        if constexpr (ALIGN_EPI) { if (wr == 0) PG8_BAR; }
        if constexpr (!Epi::AFTER_DRAIN) { E(acc, cur, wr, wc, fr, fq); S.done(cur); }
        if (!has_next) break;
#pragma unroll
        for (int a = 0; a < 2; ++a)
#pragma unroll
            for (int b = 0; b < 2; ++b)
#pragma unroll
                for (int m = 0; m < 4; ++m)
#pragma unroll
                    for (int n = 0; n < 2; ++n) acc[a][b][m][n] = (f32x4){0.f, 0.f, 0.f, 0.f};
        cur = nxt; cA = nA; cB = nB; ++ui;
        if constexpr (ALIGN_EPI) { if (wr == 1) PG8_BAR; }
    }
    PG8_WAIT_V(0);
    if constexpr (!ALIGN_EPI) { if (wr == 0) PG8_BAR; }
    PG8_BAR;
    if constexpr (Epi::AFTER_DRAIN) { E.fused(acc, cur, wr, wc, fr, fq, lds, wid, lane); S.done(cur); }
#undef PG8_SA
#undef PG8_SB
#undef PG8_STAGE
#undef PG8_LDA
#undef PG8_LDB
#undef PG8_MMA
#undef PG8_WAIT_V
#undef PG8_WAIT_L
#undef PG8_BAR
#undef PG8_SCHED
}
}

constexpr int DM = 1024, SEQ = 16384, NBATCH = 2, MPROMPT = NBATCH * SEQ, DEC_B = 8, DEC_S = 16;
constexpr int M = MPROMPT + DEC_B * DEC_S;
constexpr int MPAD = 33024;
constexpr int DFF = 2816, DIN = 1536, AW = 512, BWD = 512, NG = 32, NP = 64, GN = 16;
constexpr int NTILE = M / 128;
constexpr float EPS = 1e-6f;
constexpr int NWAVES = 8, NTHREADS = 512;
constexpr int RR = 4;

constexpr size_t MiB = 1u << 20;
constexpr size_t WS_WGU1 = 1 * MiB, WS_WD1 = 12 * MiB, WS_WIN = 18 * MiB, WS_WGLU = 21 * MiB, WS_WOUT = 22 * MiB, WS_WGU2 = 24 * MiB, WS_WD2 = 35 * MiB;
constexpr size_t WS_WEFF = 41 * MiB, WS_BB = 42 * MiB, WS_CM = 42 * MiB + 131072, WS_LAM = 42 * MiB + 262144, WS_RS = 42 * MiB + 524288, WS_E = 43 * MiB;
constexpr size_t WS_XN = 48 * MiB, WS_D = 113 * MiB, WS_H = 178 * MiB, WS_Z = 178 * MiB, WS_YB = 275 * MiB, WS_MIX = 356 * MiB, WS_CR = 421 * MiB, WS_END = 426 * MiB;
static_assert(WS_XN + (size_t)MPAD * DM * 2 <= WS_D && WS_D + (size_t)MPAD * DM * 2 <= WS_H && WS_H + (size_t)MPAD * DFF * 2 <= WS_MIX, "ws map");
static_assert(WS_Z + (size_t)MPAD * DIN * 2 <= WS_YB && WS_YB + (size_t)MPAD * BWD * 2 <= WS_H + (size_t)MPAD * DFF * 2 && WS_MIX + (size_t)MPAD * DM * 2 <= WS_CR && WS_CR + (size_t)NTILE * NG * NP * 8 <= WS_END, "ws map 2");
static_assert(WS_E + (size_t)NTILE * NG * NP * 8 <= WS_XN, "ws map 3");

constexpr size_t OFF_Y = 0, OFF_SRE_P = (size_t)M * DM, OFF_SIM_P = OFF_SRE_P + NBATCH * NG * NP, OFF_SRE_S = OFF_SIM_P + NBATCH * NG * NP,
                 OFF_SIM_S = OFF_SRE_S + DEC_B * NG * NP, OFF_V_S = OFF_SIM_S + DEC_B * NG * NP;

constexpr int GEMM_LDS = 131072;
constexpr int S5_ROW = 132;
constexpr int S5_WAVE_BYTES = 32 * S5_ROW * 4;
constexpr int VT_STRIDE = 136;
constexpr int LDS_BYTES = 147456;
static_assert(NWAVES * (S5_WAVE_BYTES + 1024) <= LDS_BYTES - 64 && 128 * VT_STRIDE * 2 + 4096 <= LDS_BYTES - 64, "lds map");

#define LAS __attribute__((address_space(3)))
typedef unsigned short bf16;
typedef float v4f __attribute__((ext_vector_type(4)));
typedef float v2f __attribute__((ext_vector_type(2)));
typedef float v16f __attribute__((ext_vector_type(16)));
typedef unsigned v4u __attribute__((ext_vector_type(4)));
typedef unsigned v2u __attribute__((ext_vector_type(2)));
typedef short bfx8 __attribute__((ext_vector_type(8)));
#define LDS_FENCE() asm volatile("s_waitcnt lgkmcnt(0)" ::: "memory")

using pg8::cvt_pk_bf16; using pg8::bf_lo; using pg8::bf_hi; using pg8::gelu_t;

__device__ __forceinline__ float wave_sum(float v) {
#pragma unroll
    for (int o = 1; o < 64; o <<= 1) v += __shfl_xor(v, o);
    return v;
}
__device__ __forceinline__ unsigned cvt_pk_nv(float lo, float hi) { unsigned r; asm("v_cvt_pk_bf16_f32 %0, %1, %2" : "=v"(r) : "v"(lo), "v"(hi)); return r; }
__device__ __forceinline__ bf16 f2bf(float f) { return (bf16)(cvt_pk_nv(f, 0.f) & 0xffffu); }


__device__ __forceinline__ double dexp(double x) {
    const double y = x * (1.0 / 256.0); double t = 1.0;
#pragma unroll
    for (int i = 12; i >= 1; --i) t = 1.0 + t * y * (1.0 / (double)i);
#pragma unroll
    for (int i = 0; i < 8; ++i) t = t * t;
    return t;
}
__device__ __forceinline__ void dsincos(double x, double& s, double& c) {
    const double twopi = 6.283185307179586476925286766559;
    const double k = rint(x * (1.0 / twopi)); const double r = x - k * twopi, r2 = r * r;
    double ts = r, tc = 1.0; s = r; c = 1.0;
#pragma unroll
    for (int i = 1; i <= 15; ++i) { tc = -tc * r2 * (1.0 / (double)((2 * i - 1) * (2 * i))); ts = -ts * r2 * (1.0 / (double)((2 * i) * (2 * i + 1))); c += tc; s += ts; }
}

typedef const float* cfp_t;
typedef __attribute__((address_space(4))) cfp_t const* kin_t;
__device__ __forceinline__ const float* karg_in(int i) {
    auto k = __builtin_amdgcn_kernarg_segment_ptr();
    asm volatile("" : "+s"(k));
    return ((kin_t)k)[i];
}
struct Ctx {
    __device__ __forceinline__ const float* in(int i) const { return karg_in(i); }
    __device__ __forceinline__ float* out() const { return (float*)karg_in(33); }
    __device__ __forceinline__ unsigned char* ws() const { return (unsigned char*)karg_in(34); }
#define WSP(name, T, off) __device__ __forceinline__ T* name() const { return (T*)(ws() + (off)); }
    WSP(Wgu1, bf16, WS_WGU1) WSP(Wd1, bf16, WS_WD1) WSP(Win, bf16, WS_WIN) WSP(Wglu, bf16, WS_WGLU) WSP(Wout, bf16, WS_WOUT) WSP(Wgu2, bf16, WS_WGU2) WSP(Wd2, bf16, WS_WD2)
    WSP(Weff, bf16, WS_WEFF) WSP(BB, bf16, WS_BB) WSP(CM, bf16, WS_CM) WSP(XN, bf16, WS_XN) WSP(D, bf16, WS_D) WSP(H, bf16, WS_H) WSP(Z, bf16, WS_Z) WSP(YB, bf16, WS_YB) WSP(MIX, bf16, WS_MIX)
    WSP(LAM, float, WS_LAM) WSP(E, float, WS_E) WSP(RS, float, WS_RS)
#undef WSP
};

__device__ __forceinline__ void p0_transpose_item(const float* W, const float* gk, int N, bf16* WT, int K, int k0, int n0, int drow0, LAS float* scr, int lane) {
    float wv[32];
#pragma unroll
    for (int i = 0; i < 32; ++i) wv[i] = W[(size_t)(k0 + 2 * i + (lane >> 5)) * N + n0 + (lane & 31)];
    if (gk) {
#pragma unroll
        for (int i = 0; i < 32; ++i) wv[i] *= gk[k0 + 2 * i + (lane >> 5)];
    }
#pragma unroll
    for (int i = 0; i < 32; ++i) scr[(2 * i + (lane >> 5)) * 33 + (lane & 31)] = wv[i];
    LDS_FENCE();
    const int c = lane & 7;
#pragma unroll
    for (int j = 0; j < 4; ++j) { const int n = (lane >> 3) + 8 * j; const LAS float* s = scr + (8 * c) * 33 + n;
        v4u o; o.x = cvt_pk_bf16(s[0 * 33], s[1 * 33]); o.y = cvt_pk_bf16(s[2 * 33], s[3 * 33]); o.z = cvt_pk_bf16(s[4 * 33], s[5 * 33]); o.w = cvt_pk_bf16(s[6 * 33], s[7 * 33]);
        *(v4u*)(WT + (size_t)(drow0 + n) * K + k0 + 8 * c) = o; }
    LDS_FENCE();
}
__device__ __forceinline__ void p0_matrix_item(const float* W, const float* gk, int K, int N, bf16* WT, int mode, int item, LAS float* scr, int lane) {
    const int nblk = N / 32, kb = item / nblk, nb = item % nblk, n0 = 32 * nb;
    const int drow0 = (mode == 0) ? n0 : (256 * (n0 / 128) + (n0 % 128) + (mode == 2 ? 128 : 0));
    p0_transpose_item(W, gk, N, WT, K, 64 * kb, n0, drow0, scr, lane);
}
__device__ __forceinline__ const float* xrow_ptr(const Ctx& C, int row) { return row < MPROMPT ? C.in(0) + (size_t)row * DM : C.in(1) + (size_t)(row - MPROMPT) * DM; }

__device__ __forceinline__ v4f ld4_f32(const float* p) { return *(const v4f*)p; }
__device__ __forceinline__ v4f ld4_bf16(const bf16* p) { const v2u w = *(const v2u*)p; return (v4f){bf_lo(w.x), bf_hi(w.x), bf_lo(w.y), bf_hi(w.y)}; }
__device__ __forceinline__ void st4_bf16(bf16* p, v4f o) { v2u w; w.x = cvt_pk_nv(o.x, o.y); w.y = cvt_pk_nv(o.z, o.w); *(v2u*)p = w; }
__device__ __forceinline__ float ssq4(v4f v) { return (v.x * v.x + v.y * v.y) + (v.z * v.z + v.w * v.w); }
template <int R>
__device__ __forceinline__ void rows_x0(const Ctx& C, int m0, int stride, int lane) {
    v4f v[R][4]; float ss[R]; int mr[R]; bool ok[R];
#pragma unroll
    for (int r = 0; r < R; ++r) { mr[r] = m0 + r * stride; ok[r] = mr[r] < M; const float* x = xrow_ptr(C, ok[r] ? mr[r] : m0);
#pragma unroll
        for (int j = 0; j < 4; ++j) v[r][j] = ld4_f32(x + 4 * lane + 256 * j); }
    bf16* XN = C.XN();
#pragma unroll
    for (int r = 0; r < R; ++r) { float s = 0.f;
#pragma unroll
        for (int j = 0; j < 4; ++j) s += ssq4(v[r][j]);
        ss[r] = s; }
#pragma unroll
    for (int r = 0; r < R; ++r) ss[r] = rsqrtf(wave_sum(ss[r]) * (1.f / DM) + EPS);
#pragma unroll
    for (int r = 0; r < R; ++r)
#pragma unroll
        for (int j = 0; j < 4; ++j) if (ok[r]) st4_bf16(XN + (size_t)mr[r] * DM + 4 * lane + 256 * j, v[r][j] * ss[r]);
}
template <int R, bool BASE_F32, bool OUT_F32>
__device__ __forceinline__ void rows_res(const Ctx& C, int m0, int stride, const float* gpost, float scale, int lane) {
    v4f d[R][4], b[R][4]; int mr[R]; bool ok[R]; float r1[R];
    const bf16* D = C.D(); bf16* XN = C.XN();
#pragma unroll
    for (int r = 0; r < R; ++r) { mr[r] = m0 + r * stride; ok[r] = mr[r] < M; const int mm = ok[r] ? mr[r] : m0;
#pragma unroll
        for (int j = 0; j < 4; ++j) d[r][j] = ld4_bf16(D + (size_t)mm * DM + 4 * lane + 256 * j);
        if (BASE_F32) { const float* x = xrow_ptr(C, mm);
#pragma unroll
            for (int j = 0; j < 4; ++j) b[r][j] = ld4_f32(x + 4 * lane + 256 * j);
        } else { const float inv = C.RS()[mm];
#pragma unroll
            for (int j = 0; j < 4; ++j) b[r][j] = ld4_bf16(XN + (size_t)mm * DM + 4 * lane + 256 * j) * inv;
        } }
#pragma unroll
    for (int r = 0; r < R; ++r) { float s = 0.f;
#pragma unroll
        for (int j = 0; j < 4; ++j) s += ssq4(d[r][j]);
        r1[r] = s; }
#pragma unroll
    for (int r = 0; r < R; ++r) r1[r] = rsqrtf(wave_sum(r1[r]) * (1.f / DM) + EPS) * scale;
#pragma unroll
    for (int j = 0; j < 4; ++j) { const v4f gp = ld4_f32(gpost + 4 * lane + 256 * j);
#pragma unroll
        for (int r = 0; r < R; ++r) d[r][j] = b[r][j] + d[r][j] * r1[r] * gp; }
    if (OUT_F32) { float* Y = C.out();
#pragma unroll
        for (int r = 0; r < R; ++r)
#pragma unroll
            for (int j = 0; j < 4; ++j) if (ok[r]) *(v4f*)(Y + (size_t)mr[r] * DM + 4 * lane + 256 * j) = d[r][j];
    } else { float* rs = C.RS(); float t[R];
#pragma unroll
        for (int r = 0; r < R; ++r) { float s = 0.f;
#pragma unroll
            for (int j = 0; j < 4; ++j) s += ssq4(d[r][j]);
            t[r] = s; }
#pragma unroll
        for (int r = 0; r < R; ++r) t[r] = wave_sum(t[r]) * (1.f / DM) + EPS;
#pragma unroll
        for (int r = 0; r < R; ++r) { const float rstd = rsqrtf(t[r]);
#pragma unroll
            for (int j = 0; j < 4; ++j) if (ok[r]) st4_bf16(XN + (size_t)mr[r] * DM + 4 * lane + 256 * j, d[r][j] * rstd);
            if (lane == 0 && ok[r]) rs[mr[r]] = sqrtf(t[r]); }
    }
}
__device__ __forceinline__ void row_norm512(bf16* row, const float* g, int lane) {
    const v4u w = *(const v4u*)(row + 8 * lane);
    float v[8] = {bf_lo(w.x), bf_hi(w.x), bf_lo(w.y), bf_hi(w.y), bf_lo(w.z), bf_hi(w.z), bf_lo(w.w), bf_hi(w.w)};
    float s = 0.f;
#pragma unroll
    for (int i = 0; i < 8; ++i) s += v[i] * v[i];
    const float r = rsqrtf(wave_sum(s) * (1.f / 512.f) + EPS);
    const v4f g0 = *(const v4f*)(g + 8 * lane), g1 = *(const v4f*)(g + 8 * lane + 4);
    v4u o; o.x = cvt_pk_bf16(v[0] * r * g0.x, v[1] * r * g0.y); o.y = cvt_pk_bf16(v[2] * r * g0.z, v[3] * r * g0.w);
    o.z = cvt_pk_bf16(v[4] * r * g1.x, v[5] * r * g1.y); o.w = cvt_pk_bf16(v[6] * r * g1.z, v[7] * r * g1.w);
    *(v4u*)(row + 8 * lane) = o;
}

__device__ __forceinline__ void p0_prologue(const Ctx& C, LAS unsigned char* lds, int wave, int lane, int tid) {
    LAS float* scr = (LAS float*)(lds + wave * 16384);
    const int gw = blockIdx.x * NWAVES + wave, NGW = gridDim.x * NWAVES;
    constexpr int I_GU = (DM / 64) * (DFF / 32), I_D = (DFF / 64) * (DM / 32), I_IN = (DM / 64) * (DIN / 32), I_GLU = (BWD / 64) * (BWD / 32), I_OUT = (DM / 64) * (DM / 32);
    constexpr int NITEMS = 4 * I_GU + 2 * I_D + I_IN + I_GLU + I_OUT;
    for (int it = gw; it < NITEMS; it += NGW) {
        int r = it;
        if (r < I_GU) { p0_matrix_item(C.in(5), C.in(4), DM, DFF, C.Wgu1(), 1, r, scr, lane); continue; } r -= I_GU;
        if (r < I_GU) { p0_matrix_item(C.in(6), C.in(4), DM, DFF, C.Wgu1(), 2, r, scr, lane); continue; } r -= I_GU;
        if (r < I_GU) { p0_matrix_item(C.in(29), C.in(28), DM, DFF, C.Wgu2(), 1, r, scr, lane); continue; } r -= I_GU;
        if (r < I_GU) { p0_matrix_item(C.in(30), C.in(28), DM, DFF, C.Wgu2(), 2, r, scr, lane); continue; } r -= I_GU;
        if (r < I_D) { p0_matrix_item(C.in(7), nullptr, DFF, DM, C.Wd1(), 0, r, scr, lane); continue; } r -= I_D;
        if (r < I_D) { p0_matrix_item(C.in(31), nullptr, DFF, DM, C.Wd2(), 0, r, scr, lane); continue; } r -= I_D;
        if (r < I_IN) { p0_matrix_item(C.in(10), C.in(9), DM, DIN, C.Win(), 0, r, scr, lane); continue; } r -= I_IN;
        if (r < I_GLU) { p0_matrix_item(C.in(22), nullptr, BWD, BWD, C.Wglu(), 0, r, scr, lane); continue; } r -= I_GLU;
        p0_matrix_item(C.in(26), nullptr, DM, DM, C.Wout(), 0, r, scr, lane);
    }
    for (int m = gw; m < M; m += 4 * NGW) rows_x0<4>(C, m, NGW, lane);
    const int gt = blockIdx.x * NTHREADS + tid, NGT = gridDim.x * NTHREADS;
    for (int idx = (tid < 8 ? blockIdx.x * 8 + tid : NG * NP); idx < NG * NP; idx += gridDim.x * 8) {
        const int g = idx / NP, p = idx % NP;
        const double lr = (double)C.in(14)[idx], li = (double)C.in(15)[idx], dt = dexp((double)C.in(16)[g]);
        double s1, c1, s8, c8; dsincos(li * dt, s1, c1); dsincos(li * dt * 128.0, s8, c8);
        const double er = dexp(lr * dt), lbr = er * c1, lbi = er * s1;
        const double e8 = dexp(lr * dt * 128.0), l8r = e8 * c8, l8i = e8 * s8;
        C.LAM()[0 * 2048 + idx] = (float)lbr; C.LAM()[1 * 2048 + idx] = (float)lbi; C.LAM()[2 * 2048 + idx] = (float)l8r; C.LAM()[3 * 2048 + idx] = (float)l8i;
        const double a = lbr - 1.0, b = lbi, den = lr * lr + li * li, cr = (a * lr + b * li) / den, ci = (b * lr - a * li) / den;
        for (int n = 0; n < GN; ++n) {
            const double br = (double)C.in(17)[(size_t)idx * GN + n], bi = (double)C.in(18)[(size_t)idx * GN + n];
            C.BB()[((size_t)g * 128 + 2 * p) * GN + n] = f2bf((float)(cr * br - ci * bi));
            C.BB()[((size_t)g * 128 + 2 * p + 1) * GN + n] = f2bf((float)(cr * bi + ci * br));
            C.CM()[((size_t)g * GN + n) * 128 + 2 * p] = f2bf(C.in(19)[((size_t)g * GN + n) * NP + p]);
            C.CM()[((size_t)g * GN + n) * 128 + 2 * p + 1] = f2bf(-C.in(20)[((size_t)g * GN + n) * NP + p]);
        }
    }
    for (int idx = gt; idx < 2 * 4 * 128 * 128; idx += NGT) {
        const int s = idx & 127, t = (idx >> 7) & 127, h = (idx >> 14) & 3, mode = idx >> 16;
        float v;
        if (mode == 0) v = (s <= t) ? C.in(12)[((size_t)h * 128 + t) * 128 + s] : 0.f;
        else v = ((s >> 4) == (t >> 4) && (s & 15) <= (t & 15)) ? C.in(12)[((size_t)h * 128 + (t & 15)) * 128 + (s & 15)] : 0.f;
        C.Weff()[idx] = f2bf(v);
    }
}

template <bool PASS2>
__device__ __forceinline__ void s5_tile(const Ctx& C, int T, int sb_lo, int sb_hi, LAS unsigned char* lds, int wave, int lane) {
    const bool sample = (T == NTILE - 1);
    const int r0 = T * 128;
    LAS float* BU = (LAS float*)(lds + wave * S5_WAVE_BYTES);
    LAS bf16* UL = (LAS bf16*)(lds + NWAVES * S5_WAVE_BYTES + wave * 1024);
    float* CR = (float*)(C.ws() + WS_CR) + ((size_t)T * NG + wave * 4) * NP * 2;
    const int tl = lane & 31, hh = lane >> 5, fr = lane & 15, kq = lane >> 4;
    const float* LAM = C.LAM();
    const bf16* Zb = C.Z() + (size_t)1024 + 64 * wave;
    if (PASS2 && !sample) {
        const int k = T & 127, tb = T - k;
        float cr[4], ci[4], l8r[4], l8i[4];
#pragma unroll
        for (int gi = 0; gi < 4; ++gi) { cr[gi] = 0.f; ci[gi] = 0.f; l8r[gi] = LAM[2 * 2048 + (wave * 4 + gi) * 64 + lane]; l8i[gi] = LAM[3 * 2048 + (wave * 4 + gi) * 64 + lane]; }
        const v2f* Ep = (const v2f*)C.E() + ((size_t)tb * NG + wave * 4) * NP + lane;
        const int nb = (k + 15) >> 4, j0 = k - 16 * nb;
        for (int jb = 0; jb < nb; ++jb) {
#pragma unroll
            for (int u = 0; u < 16; ++u) {
                const int j = j0 + 16 * jb + u; const bool ok = j >= 0; const int jc = ok ? j : 0;
#pragma unroll
                for (int gi = 0; gi < 4; ++gi) { v2f e = Ep[(size_t)jc * NG * NP + gi * NP]; if (!ok) e = (v2f){0.f, 0.f};
                    const float nr = fmaf(l8r[gi], cr[gi], fmaf(-l8i[gi], ci[gi], e.x)), ni = fmaf(l8r[gi], ci[gi], fmaf(l8i[gi], cr[gi], e.y)); cr[gi] = nr; ci[gi] = ni; }
            }
        }
#pragma unroll
        for (int gi = 0; gi < 4; ++gi) *(v2f*)(CR + (gi * 64 + lane) * 2) = (v2f){cr[gi], ci[gi]};
        asm volatile("s_waitcnt vmcnt(0)" ::: "memory");
    }
    bfx8 ac[4], q1[4], q2[4], q3[4];
#pragma unroll
    for (int sb = 0; sb < 4; ++sb) { const bf16* zp = Zb + (size_t)(r0 + 32 * sb + tl) * DIN + 8 * hh;
        ac[sb] = *(const bfx8*)(zp); q1[sb] = *(const bfx8*)(zp + 16); q2[sb] = *(const bfx8*)(zp + 32); q3[sb] = *(const bfx8*)(zp + 48); }
    for (int gi = 0; gi < 4; ++gi) {
        const int g = wave * 4 + gi;
        const float lr = LAM[0 * 2048 + g * 64 + lane], li = LAM[1 * 2048 + g * 64 + lane];
        bfx8 bb[4];
#pragma unroll
        for (int cb = 0; cb < 4; ++cb) bb[cb] = *(const bfx8*)(C.BB() + ((size_t)(g * 128 + cb * 32 + tl)) * GN + 8 * hh);
        float sr = 0.f, si = 0.f;
        bfx8 cm[4]; float dsk = 0.f;
        if (PASS2) {
#pragma unroll
            for (int ks = 0; ks < 4; ++ks) cm[ks] = *(const bfx8*)(C.CM() + ((size_t)(g * GN + fr)) * 128 + 32 * ks + 8 * kq);
            dsk = C.in(21)[16 * g + fr];
            if (!sample) { const v2f c0 = *(const v2f*)(CR + (gi * 64 + lane) * 2); sr = c0.x; si = c0.y; }
        }
#pragma unroll
        for (int sb = 0; sb < 4; ++sb) {
            if (sb < sb_lo || sb >= sb_hi) continue;
            const int rb0 = r0 + 32 * sb;
            const bfx8 a = ac[sb];
            if (PASS2) *(LAS bfx8*)(UL + tl * 16 + 8 * hh) = a;
#pragma unroll
            for (int cb = 0; cb < 4; ++cb) {
                v16f acc;
#pragma unroll
                for (int r = 0; r < 16; ++r) acc[r] = 0.f;
                acc = __builtin_amdgcn_mfma_f32_32x32x16_bf16(bb[cb], a, acc, 0, 0, 0);
#pragma unroll
                for (int rg = 0; rg < 4; ++rg) *(LAS v4f*)(BU + tl * S5_ROW + cb * 32 + 8 * rg + 4 * hh) = (v4f){acc[4 * rg], acc[4 * rg + 1], acc[4 * rg + 2], acc[4 * rg + 3]};
            }
            LDS_FENCE();
            {
                v2f bu[32];
#pragma unroll
                for (int t = 0; t < 32; ++t) bu[t] = *(const LAS v2f*)(BU + t * S5_ROW + 2 * lane);
                v2f s0a = (v2f){0.f, 0.f}, s0b = s0a;
                if (sample) { const size_t o0 = ((size_t)(2 * sb) * NG + g) * NP + lane, o1 = o0 + (size_t)NG * NP;
                    s0a = (v2f){C.in(2)[o0], C.in(3)[o0]}; s0b = (v2f){C.in(2)[o1], C.in(3)[o1]}; }
                LDS_FENCE();
#pragma unroll
                for (int t = 0; t < 32; ++t) {
                    if (sample && t == 0) { sr = s0a.x; si = s0a.y; }
                    if (sample && t == 16) { sr = s0b.x; si = s0b.y; }
                    const float nr = fmaf(lr, sr, fmaf(-li, si, bu[t].x)), ni = fmaf(lr, si, fmaf(li, sr, bu[t].y));
                    sr = nr; si = ni;
                    if (PASS2) {
                        *(LAS unsigned*)(BU + t * S5_ROW + lane) = cvt_pk_nv(sr, si);
                        if (sample && (t & 15) == 15) { const int seq = 2 * sb + (t >> 4);
                            C.out()[OFF_SRE_S + ((size_t)seq * NG + g) * NP + lane] = sr; C.out()[OFF_SIM_S + ((size_t)seq * NG + g) * NP + lane] = si; }
                    }
                }
            }
            LDS_FENCE();
            if (PASS2) {
#pragma unroll
                for (int rb = 0; rb < 2; ++rb) {
                    v4f acc = (v4f){0.f, 0.f, 0.f, 0.f};
#pragma unroll
                    for (int ks = 0; ks < 4; ++ks) {
                        const bfx8 sa = *(const LAS bfx8*)((const LAS unsigned char*)BU + (16 * rb + fr) * (S5_ROW * 4) + (32 * ks + 8 * kq) * 2);
                        acc = __builtin_amdgcn_mfma_f32_16x16x32_bf16(sa, cm[ks], acc, 0, 0, 0);
                    }
#pragma unroll
                    for (int r = 0; r < 4; ++r) {
                        LAS bf16* up = UL + (16 * rb + 4 * kq + r) * 16 + fr;
                        const float u = __uint_as_float((unsigned)(*up) << 16);
                        *up = f2bf(gelu_t(acc[r] + dsk * u));
                    }
                }
                LDS_FENCE();
                const v4u yv = *(const LAS v4u*)(UL + lane * 8);
                *(v4u*)(C.YB() + (size_t)(rb0 + (lane >> 1)) * BWD + 16 * g + 8 * (lane & 1)) = yv;
                LDS_FENCE();
            }
        }
        if (!PASS2) { v2f* Ep = (v2f*)C.E() + ((size_t)T * NG + g) * NP + lane; *Ep = (v2f){sr, si}; }
        else if (!sample && (T & 127) == 127) { const int b = T >> 7;
            C.out()[OFF_SRE_P + ((size_t)b * NG + g) * NP + lane] = sr; C.out()[OFF_SIM_P + ((size_t)b * NG + g) * NP + lane] = si; }
#pragma unroll
        for (int sb = 0; sb < 4; ++sb) { ac[sb] = q1[sb]; q1[sb] = q2[sb]; q2[sb] = q3[sb]; }
    }
}

__device__ __forceinline__ void gmlp_tile(const Ctx& C, int T, LAS unsigned char* lds, int wave, int lane, int tid) {
    const int mode = (T == NTILE - 1) ? 1 : 0;
    const int r0 = T * 128;
    LAS bf16* VT = (LAS bf16*)lds;
    LAS float* SSQ = (LAS float*)(lds + 128 * VT_STRIDE * 2);
    const int tb = wave & 3, dh = wave >> 2, tl = lane & 31, hh = lane >> 5;
    const int t = 32 * tb + tl;
    unsigned outp[4][2][8]; float ssq = 0.f;
    const bf16* zt = C.Z() + (size_t)(r0 + t) * DIN;
    const int row = tid >> 2, q = tid & 3;
    const bf16* vsrc = C.Z() + (size_t)(r0 + row) * DIN + 512 + q * 32;
    const bf16* Weff = C.Weff();
    v4u vraw[4];
#pragma unroll
    for (int i = 0; i < 4; ++i) vraw[i] = *(const v4u*)(vsrc + 8 * i);
#pragma unroll
    for (int h = 0; h < 4; ++h) {
        bfx8 wf[8];
        const bf16* wrow = Weff + ((size_t)(mode * 4 + h) * 128 + t) * 128 + 8 * hh;
#pragma unroll
        for (int ks = 0; ks < 8; ++ks) wf[ks] = *(const bfx8*)(wrow + 16 * ks);
        v2u uw[2][4];
#pragma unroll
        for (int dbi = 0; dbi < 2; ++dbi)
#pragma unroll
            for (int rg = 0; rg < 4; ++rg) uw[dbi][rg] = *(const v2u*)(zt + h * 128 + 32 * (2 * dh + dbi) + 8 * rg + 4 * hh);
        const float bias = C.in(13)[h * 128 + (mode ? (t & 15) : t)];
        __syncthreads();
        {
            float v[32]; float s = 0.f;
#pragma unroll
            for (int i = 0; i < 4; ++i) { const v4u w = vraw[i];
                v[8 * i + 0] = bf_lo(w.x); v[8 * i + 1] = bf_hi(w.x); v[8 * i + 2] = bf_lo(w.y); v[8 * i + 3] = bf_hi(w.y);
                v[8 * i + 4] = bf_lo(w.z); v[8 * i + 5] = bf_hi(w.z); v[8 * i + 6] = bf_lo(w.w); v[8 * i + 7] = bf_hi(w.w); }
            if (h < 3) {
#pragma unroll
                for (int i = 0; i < 4; ++i) vraw[i] = *(const v4u*)(vsrc + (h + 1) * 128 + 8 * i);
            }
#pragma unroll
            for (int i = 0; i < 32; ++i) s += v[i] * v[i];
            s += __shfl_xor(s, 1); s += __shfl_xor(s, 2);
            const float r = rsqrtf(s * (1.f / 128.f) + EPS);
            const float* gv = C.in(11) + h * 128 + q * 32;
#pragma unroll
            for (int i = 0; i < 32; ++i) { v[i] = v[i] * r * gv[i]; VT[(q * 32 + i) * VT_STRIDE + row] = f2bf(v[i]); }
            if (mode) { float* ov = C.out() + OFF_V_S + (size_t)row * AW + h * 128 + q * 32;
#pragma unroll
                for (int i = 0; i < 8; ++i) *(v4f*)(ov + 4 * i) = (v4f){v[4 * i], v[4 * i + 1], v[4 * i + 2], v[4 * i + 3]}; }
        }
        __syncthreads();
#pragma unroll
        for (int dbi = 0; dbi < 2; ++dbi) {
            const int db = 2 * dh + dbi;
            v16f acc;
#pragma unroll
            for (int r = 0; r < 16; ++r) acc[r] = 0.f;
#pragma unroll
            for (int ks = 0; ks < 8; ++ks) {
                const bfx8 va = *(const LAS bfx8*)(VT + (32 * db + tl) * VT_STRIDE + 16 * ks + 8 * hh);
                acc = __builtin_amdgcn_mfma_f32_32x32x16_bf16(va, wf[ks], acc, 0, 0, 0);
            }
#pragma unroll
            for (int rg = 0; rg < 4; ++rg) {
                const v2u u2 = uw[dbi][rg];
                const float o0 = bf_lo(u2.x) * (acc[4 * rg + 0] + bias), o1 = bf_hi(u2.x) * (acc[4 * rg + 1] + bias);
                const float o2 = bf_lo(u2.y) * (acc[4 * rg + 2] + bias), o3 = bf_hi(u2.y) * (acc[4 * rg + 3] + bias);
                ssq += (o0 * o0 + o1 * o1) + (o2 * o2 + o3 * o3);
                outp[h][dbi][2 * rg] = cvt_pk_bf16(o0, o1); outp[h][dbi][2 * rg + 1] = cvt_pk_bf16(o2, o3);
            }
        }
    }
    ssq += __shfl_xor(ssq, 32);
    if (hh == 0) SSQ[t * 2 + dh] = ssq;
    __syncthreads();
    const float rstd = rsqrtf((SSQ[t * 2] + SSQ[t * 2 + 1]) * (1.f / 512.f) + EPS);
    bf16* orow = C.MIX() + (size_t)(r0 + t) * DM;
    const float* gap = C.in(24);
#pragma unroll
    for (int h = 0; h < 4; ++h)
#pragma unroll
        for (int dbi = 0; dbi < 2; ++dbi)
#pragma unroll
            for (int rg = 0; rg < 4; ++rg) {
                const int c = h * 128 + 32 * (2 * dh + dbi) + 8 * rg + 4 * hh;
                const v4f ga = *(const v4f*)(gap + c);
                const unsigned w0 = outp[h][dbi][2 * rg], w1 = outp[h][dbi][2 * rg + 1];
                v2u o; o.x = cvt_pk_bf16(bf_lo(w0) * rstd * ga.x, bf_hi(w0) * rstd * ga.y); o.y = cvt_pk_bf16(bf_lo(w1) * rstd * ga.z, bf_hi(w1) * rstd * ga.w);
                *(v2u*)(orow + c) = o;
            }
    __syncthreads();
}

#define FTID const int ftid_ = fresh_tid()
#define TID (ftid_)
#define LANE (ftid_ & 63)
#define WAVE (__builtin_amdgcn_readfirstlane(ftid_ >> 6))
#define GSZ ((int)gridDim.x)
#define BX ((int)blockIdx.x)
#define GWV (BX * NWAVES + WAVE)
#define NGWV (GSZ * NWAVES)
constexpr size_t WS_CTL = 0, CTL_ZERO_BYTES = 16384;
constexpr int MISC_OFF = LDS_BYTES - 64;
#define XB_TMO      128
#define XB_XCNT(j)  (256  + 64 * (j))
#define XB_XSUB(j)  (1280 + 64 * (j))
#define XB_XGEN(j)  (2304 + 64 * (j))
#define XB_TOP      3328
#define XB_TOPGEN   3392
#define XCD_BAR_WORDS 3456
#define XB_SPIN_CAP (1u << 18)

__device__ __forceinline__ unsigned xb_ld(unsigned* p)              { return __hip_atomic_load(p, __ATOMIC_RELAXED, __HIP_MEMORY_SCOPE_AGENT); }
__device__ __forceinline__ unsigned xb_add(unsigned* p, unsigned v) { return __hip_atomic_fetch_add(p, v, __ATOMIC_RELAXED, __HIP_MEMORY_SCOPE_AGENT); }
__device__ __forceinline__ unsigned xb_xcc_id() { return (unsigned)__builtin_amdgcn_s_getreg((3 << 11) | 20) & 0xFu; }
#define XB_SPIN(cond, bar) do { unsigned _sp = 0; while (cond) { __builtin_amdgcn_s_sleep(1); \
    if ((++_sp & 255u) == 0u) { if (xb_ld(&(bar)[XB_TMO])) break; if (_sp > XB_SPIN_CAP) { atomicAdd(&(bar)[XB_TMO], 1u); break; } } } } while (0)

struct XcdBarrier {
    unsigned* bar; unsigned x;
    volatile LAS unsigned* st;
};

__device__ __forceinline__ XcdBarrier xcd_barrier_post(unsigned* bar, volatile LAS unsigned* st) {
    XcdBarrier b; b.bar = bar; b.x = xb_xcc_id(); b.st = st;
    if (threadIdx.x == 0) (void)xb_add(&bar[XB_XCNT(b.x)], 1u);
    return b;
}
__device__ __forceinline__ void xcd_barrier_complete(unsigned* bar, unsigned x, unsigned& nloc, unsigned& nx) {
    const unsigned G = gridDim.x * gridDim.y * gridDim.z;
    unsigned sum, cnt, mine, sp = 0u;
    for (;;) {
        sum = 0u; cnt = 0u; mine = 0u;
#pragma unroll
        for (unsigned j = 0; j < 16; ++j) { const unsigned c = xb_ld(&bar[XB_XCNT(j)]); sum += c; cnt += (c > 0u) ? 1u : 0u; mine = (j == x) ? c : mine; }
        if (sum == G) break;
        __builtin_amdgcn_s_sleep(1);
        if ((++sp & 255u) == 0u) { if (xb_ld(&bar[XB_TMO])) break; if (sp > XB_SPIN_CAP) { atomicAdd(&bar[XB_TMO], 1u); break; } }
    }
    nloc = mine > 0u ? mine : 1u; nx = cnt > 0u ? cnt : 1u;
}

__device__ __forceinline__ void xcd_barrier(const XcdBarrier& b) {
    asm volatile("s_waitcnt vmcnt(0)" ::: "memory");
    __syncthreads();
    if (threadIdx.x == 0) {
        unsigned* bar = b.bar;
        __builtin_amdgcn_s_waitcnt(0);
        unsigned nloc = b.st[0], nx = b.st[1];
        if (nloc == 0u) { xcd_barrier_complete(bar, b.x, nloc, nx); b.st[0] = nloc; b.st[1] = nx; }
        const unsigned old = xb_add(&bar[XB_XSUB(b.x)], 1u);
        const unsigned gen = old / nloc;
        if (old + 1u == (gen + 1u) * nloc) {
            __builtin_amdgcn_fence(__ATOMIC_RELEASE, "agent");
            asm volatile("s_waitcnt vmcnt(0)" ::: "memory");
            const unsigned og = xb_add(&bar[XB_TOP], 1u);
            const unsigned tg = og / nx;
            if (og + 1u == (tg + 1u) * nx) xb_add(&bar[XB_TOPGEN], 1u);
            else XB_SPIN(xb_ld(&bar[XB_TOPGEN]) == tg, bar);
            __builtin_amdgcn_fence(__ATOMIC_ACQUIRE, "agent");
            xb_add(&bar[XB_XGEN(b.x)], 1u);
            asm volatile("s_waitcnt vmcnt(0)" ::: "memory");
        } else {
            XB_SPIN(xb_ld(&bar[XB_XGEN(b.x)]) == gen, bar);
            __builtin_amdgcn_fence(__ATOMIC_ACQUIRE, "agent");
            asm volatile("s_waitcnt vmcnt(0)" ::: "memory");
        }
    }
    __syncthreads();
}

template <int MODE>
__device__ __forceinline__ void small_gemm(LAS unsigned char* lds, const bf16* A, const bf16* Bt, int N, int K, bf16* O, int ldc, int act_cols, const float* bias, const bf16* Yv, int ldy, const float* rs) {
    FTID; const int wave = WAVE, lane = LANE, tl = lane & 31, hh = lane >> 5;
    LAS float* red = (LAS float*)lds;
    const int nct = N / 32, nitems = 4 * nct, kw = K / 8, nks = kw / 16;
    for (int item = BX; item < nitems; item += GSZ) {
        const int rt = item & 3, ct = item >> 2;
        const int hc = 32 * ct + tl;
        const int brow = (MODE == 3) ? (256 * (hc >> 7) + (hc & 127)) : hc;
        const bf16* ap = A + (size_t)(32 * rt + tl) * K + wave * kw + 8 * hh;
        const bf16* bp = Bt + (size_t)brow * K + wave * kw + 8 * hh;
        v16f acc0, acc1;
#pragma unroll
        for (int r = 0; r < 16; ++r) { acc0[r] = 0.f; acc1[r] = 0.f; }
#pragma unroll 4
        for (int ks = 0; ks < nks; ++ks) {
            const bfx8 a = *(const bfx8*)(ap + 16 * ks);
            const bfx8 b0 = *(const bfx8*)(bp + 16 * ks);
            acc0 = __builtin_amdgcn_mfma_f32_32x32x16_bf16(b0, a, acc0, 0, 0, 0);
            if (MODE == 3) { const bfx8 b1 = *(const bfx8*)(bp + (size_t)128 * K + 16 * ks); acc1 = __builtin_amdgcn_mfma_f32_32x32x16_bf16(b1, a, acc1, 0, 0, 0); }
        }
        __syncthreads();
#pragma unroll
        for (int r = 0; r < 16; ++r) { red[(wave * 16 + r) * 64 + lane] = acc0[r]; if (MODE == 3) red[8192 + (wave * 16 + r) * 64 + lane] = acc1[r]; }
        __syncthreads();
        float v0[2], v1[2];
#pragma unroll
        for (int e = 0; e < 2; ++e) { float s0 = 0.f, s1 = 0.f;
#pragma unroll
            for (int w = 0; w < 8; ++w) { s0 += red[(w * 16 + 2 * wave + e) * 64 + lane]; if (MODE == 3) s1 += red[8192 + (w * 16 + 2 * wave + e) * 64 + lane]; }
            v0[e] = s0; v1[e] = s1; }
        const int reg = 2 * wave;
        const int col = 32 * ct + (reg & 3) + 8 * (reg >> 2) + 4 * hh;
        const size_t row = (size_t)(32 * rt + tl);
        float o0 = v0[0], o1 = v0[1];
        if (MODE == 1) { if (col < act_cols) { o0 = gelu_t(o0); o1 = gelu_t(o1); } }
        if (MODE == 2) { const unsigned y = *(const unsigned*)(Yv + row * ldy + col); o0 = bf_lo(y) * pg8::sigmoid_f(o0 + bias[col]); o1 = bf_hi(y) * pg8::sigmoid_f(o1 + bias[col + 1]); }
        if (MODE == 3) { o0 = pg8::silu_f(o0) * v1[0]; o1 = pg8::silu_f(o1) * v1[1]; }
        *(unsigned*)(O + row * ldc + col) = cvt_pk_bf16(o0, o1);
    }
    __syncthreads();
}
struct Args { const float* in[33]; float* out; unsigned char* ws; };
#ifndef PROBE
#define PROBE 0
#endif
#ifndef PH_LO
#define PH_LO 0
#endif
#ifndef PH_HI
#define PH_HI 14
#endif

__global__ void __launch_bounds__(NTHREADS, 2) fwd_kernel(Args args) {
    extern __shared__ __attribute__((aligned(16))) unsigned char lds_raw[];
    cg::grid_group grid = cg::this_grid();
    LAS unsigned char* lds = (LAS unsigned char*)lds_raw;
    Ctx C;
    if (threadIdx.x < 16) ((volatile LAS unsigned*)(lds + MISC_OFF))[threadIdx.x] = 0u;
    __syncthreads();
    (void)xcd_barrier_post((unsigned*)(C.ws() + WS_CTL), (volatile LAS unsigned*)(lds + MISC_OFF));
#define XBAR() do { XcdBarrier b_; b_.bar = (unsigned*)(C.ws() + WS_CTL); b_.x = xb_xcc_id(); b_.st = (volatile LAS unsigned*)(lds + MISC_OFF); xcd_barrier(b_); } while (0)
    { FTID; p0_prologue(C, lds, WAVE, LANE, TID); }
    grid.sync();
    { pg8::Gemm g{C.XN(), C.Wgu1(), MPROMPT, 2 * DFF, DM}; pg8::StaticOrder S; S.init(MPROMPT, 2 * DFF, GSZ, BX); pg8::EpiSwiglu E{C.H(), DFF};
      pg8::gemm_phase<pg8::EpiSwiglu, pg8::StaticOrder, true, true>(lds, g, S, E); }
    small_gemm<3>(lds, C.XN() + (size_t)MPROMPT * DM, C.Wgu1(), DFF, DM, C.H() + (size_t)MPROMPT * DFF, DFF, 0, nullptr, nullptr, 0, C.RS() + MPROMPT);
    XBAR();
    { pg8::Gemm g{C.H(), C.Wd1(), MPROMPT, DM, DFF}; pg8::StaticOrder S; S.init(MPROMPT, DM, GSZ, BX); pg8::EpiBf16<0> E{C.D(), DM, 0, nullptr, nullptr, 0};
      pg8::gemm_phase<pg8::EpiBf16<0>, pg8::StaticOrder, true, true>(lds, g, S, E); }
    small_gemm<0>(lds, C.H() + (size_t)MPROMPT * DFF, C.Wd1(), DM, DFF, C.D() + (size_t)MPROMPT * DM, DM, 0, nullptr, nullptr, 0, nullptr);
    XBAR();
    { FTID; const float* gp = C.in(8); for (int m = GWV; m < M; m += RR * NGWV) rows_res<RR, true, false>(C, m, NGWV, gp, 0.5f, LANE); }
    XBAR();
    { pg8::Gemm g{C.XN(), C.Win(), MPROMPT, DIN, DM}; pg8::StaticOrder S; S.init(MPROMPT, DIN, GSZ, BX); pg8::EpiBf16<1> E{C.Z(), DIN, 2 * AW, nullptr, nullptr, 0};
      pg8::gemm_phase<pg8::EpiBf16<1>, pg8::StaticOrder, true, true>(lds, g, S, E); }
    small_gemm<1>(lds, C.XN() + (size_t)MPROMPT * DM, C.Win(), DIN, DM, C.Z() + (size_t)MPROMPT * DIN, DIN, 2 * AW, nullptr, nullptr, 0, C.RS() + MPROMPT);
    XBAR();
    { FTID; for (int T = BX; T < NTILE - 1; T += GSZ) {
        s5_tile<false>(C, T, 0, 4, lds, WAVE, LANE);
        __syncthreads();
        gmlp_tile(C, T, lds, WAVE, LANE, TID);
    } }
    XBAR();
    { FTID; for (int T = BX; T < NTILE - 1; T += GSZ) s5_tile<true>(C, T, 0, 4, lds, WAVE, LANE);
      if (BX >= 1 && BX <= 4) s5_tile<true>(C, NTILE - 1, BX - 1, BX, lds, WAVE, LANE);
      if (BX == 0) { __syncthreads(); gmlp_tile(C, NTILE - 1, lds, WAVE, LANE, TID); } }
    XBAR();
    { pg8::Gemm g{C.YB(), C.Wglu(), MPROMPT, BWD, BWD}; pg8::StaticOrder S; S.init(MPROMPT, BWD, GSZ, BX); pg8::EpiBf16<2> E{C.MIX() + AW, DM, 0, C.in(23), C.YB(), BWD};
      pg8::gemm_phase<pg8::EpiBf16<2>, pg8::StaticOrder, true, true>(lds, g, S, E); }
    small_gemm<2>(lds, C.YB() + (size_t)MPROMPT * BWD, C.Wglu(), BWD, BWD, C.MIX() + (size_t)MPROMPT * DM + AW, DM, 0, C.in(23), C.YB() + (size_t)MPROMPT * BWD, BWD, nullptr);
    XBAR();
    { FTID; const float* gb = C.in(25); for (int m = GWV; m < M; m += NGWV) row_norm512(C.MIX() + (size_t)m * DM + AW, gb, LANE); }
    XBAR();
    { pg8::Gemm g{C.MIX(), C.Wout(), MPROMPT, DM, DM}; pg8::StaticOrder S; S.init(MPROMPT, DM, GSZ, BX); pg8::EpiBf16<0> E{C.D(), DM, 0, nullptr, nullptr, 0};
      pg8::gemm_phase<pg8::EpiBf16<0>, pg8::StaticOrder, true, true>(lds, g, S, E); }
    small_gemm<0>(lds, C.MIX() + (size_t)MPROMPT * DM, C.Wout(), DM, DM, C.D() + (size_t)MPROMPT * DM, DM, 0, nullptr, nullptr, 0, nullptr);
    XBAR();
    { FTID; const float* gp = C.in(27); for (int m = GWV; m < M; m += RR * NGWV) rows_res<RR, false, false>(C, m, NGWV, gp, 1.0f, LANE); }
    XBAR();
    { pg8::Gemm g{C.XN(), C.Wgu2(), MPROMPT, 2 * DFF, DM}; pg8::StaticOrder S; S.init(MPROMPT, 2 * DFF, GSZ, BX); pg8::EpiSwiglu E{C.H(), DFF};
      pg8::gemm_phase<pg8::EpiSwiglu, pg8::StaticOrder, true, true>(lds, g, S, E); }
    small_gemm<3>(lds, C.XN() + (size_t)MPROMPT * DM, C.Wgu2(), DFF, DM, C.H() + (size_t)MPROMPT * DFF, DFF, 0, nullptr, nullptr, 0, C.RS() + MPROMPT);
    XBAR();
    { pg8::Gemm g{C.H(), C.Wd2(), MPROMPT, DM, DFF}; pg8::StaticOrder S; S.init(MPROMPT, DM, GSZ, BX); pg8::EpiBf16<0> E{C.D(), DM, 0, nullptr, nullptr, 0};
      pg8::gemm_phase<pg8::EpiBf16<0>, pg8::StaticOrder, true, true>(lds, g, S, E); }
    small_gemm<0>(lds, C.H() + (size_t)MPROMPT * DFF, C.Wd2(), DM, DFF, C.D() + (size_t)MPROMPT * DM, DM, 0, nullptr, nullptr, 0, nullptr);
    XBAR();
    { FTID; const float* gp = C.in(32); for (int m = GWV; m < M; m += RR * NGWV) rows_res<RR, false, true>(C, m, NGWV, gp, 0.5f, LANE); }
}

extern "C" void kernel_launch(void* const* d_in, const int* in_sizes, int n_in, void* d_out, int out_size, void* d_ws, size_t ws_size, hipStream_t stream) {
    static int grid = 0;
    if (grid == 0) {
        if (n_in != 33 || ws_size < WS_END) { fprintf(stderr, "kernel_launch: unexpected n_in %d / ws %zu\n", n_in, ws_size); grid = -1; return; }
        int dev = 0, cus = 0, per_cu = 0;
        hipGetDevice(&dev);
        hipDeviceGetAttribute(&cus, hipDeviceAttributeMultiprocessorCount, dev);
        hipFuncSetAttribute((const void*)fwd_kernel, hipFuncAttributeMaxDynamicSharedMemorySize, LDS_BYTES);
        hipOccupancyMaxActiveBlocksPerMultiprocessor(&per_cu, (const void*)fwd_kernel, NTHREADS, LDS_BYTES);
        if (per_cu < 1) { fprintf(stderr, "kernel_launch: occupancy query says %d blocks per CU\n", per_cu); per_cu = 1; }
        grid = cus * per_cu;
    }
    if (grid < 0) return;
    if (hipMemsetAsync((char*)d_ws + WS_CTL, 0, CTL_ZERO_BYTES, stream) != hipSuccess) { fprintf(stderr, "memset failed\n"); return; }
    Args a{};
    for (int i = 0; i < 33; ++i) a.in[i] = (const float*)d_in[i];
    a.out = (float*)d_out; a.ws = (unsigned char*)d_ws;
    void* params[] = {&a};
    hipError_t e = hipLaunchCooperativeKernel((const void*)fwd_kernel, dim3(grid), dim3(NTHREADS), params, LDS_BYTES, stream);
    if (e != hipSuccess) fprintf(stderr, "cooperative launch failed: %s (grid %d)\n", hipGetErrorString(e), grid);
}
```

```cpp
#include <hip/hip_runtime.h>
#include <hip/hip_cooperative_groups.h>
#include <cstdio>
#include <cstdint>
namespace cg = cooperative_groups;
__device__ __forceinline__ int fresh_tid() { int t = (int)threadIdx.x; asm volatile("" : "+v"(t)); return t; }
namespace pg8 {
#define PG8_LAS __attribute__((address_space(3)))
typedef unsigned short bf16_t;
typedef short bf16x8 __attribute__((ext_vector_type(8)));
typedef float f32x4 __attribute__((ext_vector_type(4)));
typedef unsigned u32x4 __attribute__((ext_vector_type(4)));
constexpr int BM = 256, BK = 64, HALF = 128, HTB = HALF * BK * 2  , STAGE_BYTES = 8 * HTB, NXCD = 8, WGM = 8;

__host__ __device__ __forceinline__ int lds_byte(int r, int c) { const int st = (r >> 4) * 2 + (c >> 5), rr = r & 15, cc = c & 31, ob = rr * 64 + cc * 2; return st * 1024 + (ob ^ (((ob >> 9) & 1) << 5)); }
__host__ __device__ __forceinline__ void stage_rc(int b, int& R, int& C) { const int st = b / 1024, sb = b % 1024, swz = sb ^ (((sb >> 9) & 1) << 5); R = (st >> 1) * 16 + swz / 64; C = (st & 1) * 32 + (swz % 64) / 2; }
__host__ __device__ __forceinline__ int perm32(int rho) { const int n = rho >> 4, i = rho & 15; return 8 * (i >> 2) + 4 * n + (i & 3); }

struct Unit { int pm, pn; };
struct Gemm { const bf16_t* A; const bf16_t* Bt; int M, N, K; };

struct StaticOrder {
    int nM, nN, nwg, G, c;
    __host__ __device__ void init(int M, int N, int G_, int c_) { nM = M / BM; nN = N / BM; nwg = nM * nN; G = G_; c = c_; }
    __host__ __device__ bool next(int i, Unit& u) const {
        const long L = (long)i * G + c; if (L >= nwg) return false;
        int wgid = (int)L; { const int q = nwg / NXCD, r = nwg % NXCD, xcd = wgid % NXCD, off = wgid / NXCD; wgid = (xcd < r ? xcd * (q + 1) : r * (q + 1) + (xcd - r) * q) + off; }
        const int nig = WGM * nN, gid = wgid / nig, fm = gid * WGM, gsz = (nM - fm) < WGM ? (nM - fm) : WGM;
        u.pm = fm + ((wgid % nig) % gsz); u.pn = (wgid % nig) / gsz; return true;
    }
    __device__ __forceinline__ void a_ready(const Unit&) const {}
    __device__ __forceinline__ void done(const Unit&) const {}
};

__device__ __forceinline__ unsigned cvt_pk_bf16(float lo, float hi) { unsigned r; asm volatile("v_cvt_pk_bf16_f32 %0, %1, %2" : "=v"(r) : "v"(lo), "v"(hi)); return r; }
__device__ __forceinline__ float bf_lo(unsigned w) { return __uint_as_float(w << 16); }
__device__ __forceinline__ float bf_hi(unsigned w) { return __uint_as_float(w & 0xffff0000u); }
__device__ __forceinline__ float sigmoid_f(float x) { return __builtin_amdgcn_rcpf(1.0f + __expf(-x)); }
__device__ __forceinline__ float silu_f(float x) { return x * sigmoid_f(x); }
__device__ __forceinline__ float gelu_t(float x) { const float u = 1.5957691216057308f * (x + 0.044715f * x * x * x); return x * sigmoid_f(u); }

struct EpiSwiglu {
    static constexpr bool PERM = true, AFTER_DRAIN = false;
    bf16_t* O; int ldc;
    __device__ __forceinline__ void operator()(const f32x4 (&acc)[2][2][4][2], const Unit& u, int wr, int wc, int fr, int fq) const {
        const int row0 = u.pm * BM + wr * 64 + fr; const int col0 = u.pn * HALF + wc * 32 + 8 * fq;
#pragma unroll
        for (int ai = 0; ai < 2; ++ai)
#pragma unroll
            for (int m = 0; m < 4; ++m) {
                bf16_t* rowp = O + (size_t)(row0 + ai * HALF + m * 16) * ldc + col0;
                const f32x4 g0 = acc[ai][0][m][0], g1 = acc[ai][0][m][1], u0 = acc[ai][1][m][0], u1 = acc[ai][1][m][1];
                u32x4 w;
                w.x = cvt_pk_bf16(silu_f(g0[0]) * u0[0], silu_f(g0[1]) * u0[1]); w.y = cvt_pk_bf16(silu_f(g0[2]) * u0[2], silu_f(g0[3]) * u0[3]);
                w.z = cvt_pk_bf16(silu_f(g1[0]) * u1[0], silu_f(g1[1]) * u1[1]); w.w = cvt_pk_bf16(silu_f(g1[2]) * u1[2], silu_f(g1[3]) * u1[3]);
                *(u32x4*)rowp = w;
            }
    }
};
template <int MODE> struct EpiBf16 {
    static constexpr bool PERM = true, AFTER_DRAIN = false;
    bf16_t* O; int ldc; int act_cols; const float* bias; const bf16_t* Y; int ldy;
    __device__ __forceinline__ void operator()(const f32x4 (&acc)[2][2][4][2], const Unit& u, int wr, int wc, int fr, int fq) const {
        const int row0 = u.pm * BM + wr * 64 + fr; const int col0 = u.pn * BM + wc * 32 + 8 * fq;
#pragma unroll
        for (int bj = 0; bj < 2; ++bj) {
            const int col = col0 + bj * HALF;
            f32x4 b0 = (f32x4){0.f, 0.f, 0.f, 0.f}, b1 = b0;
            if (MODE == 2) { b0 = *(const f32x4*)(bias + col); b1 = *(const f32x4*)(bias + col + 4); }
            const bool act = (MODE == 1) && (col < act_cols);
#pragma unroll
            for (int ai = 0; ai < 2; ++ai)
#pragma unroll
                for (int m = 0; m < 4; ++m) {
                    const size_t row = (size_t)(row0 + ai * HALF + m * 16);
                    f32x4 v0 = acc[ai][bj][m][0], v1 = acc[ai][bj][m][1];
                    if (MODE == 1) { if (act) {
#pragma unroll
                        for (int j = 0; j < 4; ++j) { v0[j] = gelu_t(v0[j]); v1[j] = gelu_t(v1[j]); } } }
                    if (MODE == 2) {
                        const u32x4 y = *(const u32x4*)(Y + row * ldy + col);
                        v0 = v0 + b0; v1 = v1 + b1;
                        v0[0] = bf_lo(y.x) * sigmoid_f(v0[0]); v0[1] = bf_hi(y.x) * sigmoid_f(v0[1]); v0[2] = bf_lo(y.y) * sigmoid_f(v0[2]); v0[3] = bf_hi(y.y) * sigmoid_f(v0[3]);
                        v1[0] = bf_lo(y.z) * sigmoid_f(v1[0]); v1[1] = bf_hi(y.z) * sigmoid_f(v1[1]); v1[2] = bf_lo(y.w) * sigmoid_f(v1[2]); v1[3] = bf_hi(y.w) * sigmoid_f(v1[3]);
                    }
                    u32x4 w; w.x = cvt_pk_bf16(v0[0], v0[1]); w.y = cvt_pk_bf16(v0[2], v0[3]); w.z = cvt_pk_bf16(v1[0], v1[1]); w.w = cvt_pk_bf16(v1[2], v1[3]);
                    *(u32x4*)(O + row * ldc + col) = w;
                }
        }
    }
};

struct EpiNull {
    static constexpr bool PERM = true, AFTER_DRAIN = false;
    bf16_t* O;
    __device__ __forceinline__ void operator()(const f32x4 (&acc)[2][2][4][2], const Unit& u, int wr, int wc, int fr, int fq) const {
        float s = 0.f;
#pragma unroll
        for (int ai = 0; ai < 2; ++ai)
#pragma unroll
            for (int bj = 0; bj < 2; ++bj)
#pragma unroll
                for (int m = 0; m < 4; ++m)
#pragma unroll
                    for (int n = 0; n < 2; ++n) s += (acc[ai][bj][m][n][0] + acc[ai][bj][m][n][1]) + (acc[ai][bj][m][n][2] + acc[ai][bj][m][n][3]);
        if (s == 12345.678f) O[u.pm + wr + wc + fr + fq] = 1;
    }
};
template <int P> struct EpiSwigluP {
    static constexpr bool PERM = true, AFTER_DRAIN = false;
    bf16_t* O; int ldc;
    __device__ __forceinline__ void operator()(const f32x4 (&acc)[2][2][4][2], const Unit& u, int wr, int wc, int fr, int fq) const {
        const int row0 = u.pm * BM + wr * 64 + fr; const int col0 = u.pn * HALF + wc * 32 + 8 * fq;
#pragma unroll
        for (int ai = 0; ai < 2; ++ai)
#pragma unroll
            for (int m = 0; m < 4; ++m) {
                bf16_t* rowp = O + (size_t)(row0 + ai * HALF + m * 16) * ldc + col0;
                const f32x4 g0 = acc[ai][0][m][0], g1 = acc[ai][0][m][1], u0 = acc[ai][1][m][0], u1 = acc[ai][1][m][1];
                u32x4 w;
                if (P == 1) {
                    w.x = cvt_pk_bf16(silu_f(g0[0]) * u0[0], silu_f(g0[1]) * u0[1]); w.y = cvt_pk_bf16(silu_f(g0[2]) * u0[2], silu_f(g0[3]) * u0[3]);
                    w.z = cvt_pk_bf16(silu_f(g1[0]) * u1[0], silu_f(g1[1]) * u1[1]); w.w = cvt_pk_bf16(silu_f(g1[2]) * u1[2], silu_f(g1[3]) * u1[3]);
                    if ((w.x ^ w.y ^ w.z ^ w.w) == 0x12345678u) *(u32x4*)rowp = w;
                } else {
                    w.x = cvt_pk_bf16(g0[0] + u0[0], g0[1] + u0[1]); w.y = cvt_pk_bf16(g0[2] + u0[2], g0[3] + u0[3]);
                    w.z = cvt_pk_bf16(g1[0] + u1[0], g1[1] + u1[1]); w.w = cvt_pk_bf16(g1[2] + u1[2], g1[3] + u1[3]);
                    *(u32x4*)rowp = w;
                }
            }
    }
};
template <class Epi, class Sched, bool ALIGN_EPI = false, bool SP2 = false>
__device__ __forceinline__ void gemm_phase(PG8_LAS unsigned char* lds, const Gemm g, const Sched& S, const Epi& E) {
    const int tid = fresh_tid(), wid = __builtin_amdgcn_readfirstlane(tid >> 6), lane = tid & 63, wr = wid >> 2, wc = wid & 3, fr = lane & 15, fq = lane >> 4;
    const int K = g.K, nt = K / BK;
    unsigned voffA[2], voffB[2];
#pragma unroll
    for (int i = 0; i < 2; ++i) { int R, C; stage_rc(tid * 16 + i * 8192, R, C); const int Rb = Epi::PERM ? ((R & ~31) + perm32(R & 31)) : R;
        voffA[i] = (unsigned)(R * K + C) * 2u; voffB[i] = (unsigned)(Rb * K + C) * 2u; }
    const size_t kstep = (size_t)(BK * 2);
    const size_t hstep = (size_t)HALF * K * 2;
    const size_t tstep = 2 * hstep;
    const unsigned ldsw = (unsigned)wid * 1024u;
    const int aoff = lds_byte(wr * 64 + fr, fq * 8), boff = lds_byte(wc * 32 + fr, fq * 8);
#define PG8_SA(b, h) (((b) * 2 + (h)) * HTB)
#define PG8_SB(b, h) ((4 + (b) * 2 + (h)) * HTB)
#define PG8_STAGE(bufoff, gbase, voff) do { _Pragma("unroll") for (int _i = 0; _i < 2; ++_i) \
        __builtin_amdgcn_global_load_lds((const unsigned*)((const char*)(gbase) + (voff)[_i]), (PG8_LAS unsigned*)(lds + (bufoff) + ldsw + _i * 8192), 16, 0, 0); } while (0)
#define PG8_LDA(dst, b, h) do { _Pragma("unroll") for (int m = 0; m < 4; ++m) _Pragma("unroll") for (int k = 0; k < 2; ++k) dst[m][k] = *(const PG8_LAS bf16x8*)(lds + PG8_SA(b, h) + aoff + m * 2048 + k * 1024); } while (0)
#define PG8_LDB(dst, b, h) do { _Pragma("unroll") for (int n = 0; n < 2; ++n) _Pragma("unroll") for (int k = 0; k < 2; ++k) dst[n][k] = *(const PG8_LAS bf16x8*)(lds + PG8_SB(b, h) + boff + n * 2048 + k * 1024); } while (0)
#define PG8_MMA(ai, bj, At, Bt) do { __builtin_amdgcn_s_setprio(1); _Pragma("unroll") for (int m = 0; m < 4; ++m) _Pragma("unroll") for (int n = 0; n < 2; ++n) _Pragma("unroll") for (int k = 0; k < 2; ++k) \
        acc[ai][bj][m][n] = __builtin_amdgcn_mfma_f32_16x16x32_bf16(Bt[n][k], At[m][k], acc[ai][bj][m][n], 0, 0, 0); __builtin_amdgcn_s_setprio(0); } while (0)
#define PG8_WAIT_V(n) asm volatile("s_waitcnt vmcnt(" #n ")" ::: "memory")
#define PG8_WAIT_L(n) asm volatile("s_waitcnt lgkmcnt(" #n ")" ::: "memory")
#define PG8_BAR __builtin_amdgcn_s_barrier()
#define PG8_SCHED __builtin_amdgcn_sched_barrier(0)
    Unit cur, nxt; int ui = 0;
    if (!S.next(0, cur)) return;
    f32x4 acc[2][2][4][2];
#pragma unroll
    for (int a = 0; a < 2; ++a)
#pragma unroll
        for (int b = 0; b < 2; ++b)
#pragma unroll
            for (int m = 0; m < 4; ++m)
#pragma unroll
                for (int n = 0; n < 2; ++n) acc[a][b][m][n] = (f32x4){0.f, 0.f, 0.f, 0.f};
    bf16x8 At[4][2], B0[2][2], B1[2][2];
    const char* cA = (const char*)g.A + (size_t)cur.pm * tstep; const char* cB = (const char*)g.Bt + (size_t)cur.pn * tstep;
    S.a_ready(cur);
    if constexpr (SP2) {
        PG8_STAGE(PG8_SB(0, 0), cB, voffB); PG8_STAGE(PG8_SB(0, 1), cB + hstep, voffB); PG8_STAGE(PG8_SA(0, 0), cA, voffA); PG8_STAGE(PG8_SA(0, 1), cA + hstep, voffA);
        if (wr == 1) PG8_BAR;
        PG8_WAIT_V(2); PG8_BAR;
        PG8_STAGE(PG8_SB(1, 0), cB + kstep, voffB); PG8_STAGE(PG8_SA(1, 0), cA + kstep, voffA); PG8_STAGE(PG8_SB(1, 1), cB + hstep + kstep, voffB);
        PG8_WAIT_V(6); PG8_BAR;
    } else {
        PG8_STAGE(PG8_SB(0, 0), cB, voffB); PG8_STAGE(PG8_SA(0, 0), cA, voffA); PG8_STAGE(PG8_SB(0, 1), cB + hstep, voffB); PG8_STAGE(PG8_SA(0, 1), cA + hstep, voffA);
        if (wr == 1) PG8_BAR;
        PG8_WAIT_V(4); PG8_BAR;
        PG8_STAGE(PG8_SB(1, 0), cB + kstep, voffB); PG8_STAGE(PG8_SA(1, 0), cA + kstep, voffA); PG8_STAGE(PG8_SB(1, 1), cB + hstep + kstep, voffB);
        PG8_WAIT_V(6); PG8_BAR;
    }
    for (;;) {
        const bool has_next = S.next(ui + 1, nxt);
        const char* nA = has_next ? (const char*)g.A + (size_t)nxt.pm * tstep : cA; const char* nB = has_next ? (const char*)g.Bt + (size_t)nxt.pn * tstep : cB;
        for (int t = 0; t < nt; t += 2) {
            const bool last = (t == nt - 2);
            const char* a1 = cA + (size_t)(t + 1) * kstep;
            const char* a2 = last ? nA : cA + (size_t)(t + 2) * kstep; const char* b2 = last ? nB : cB + (size_t)(t + 2) * kstep;
            const char* a3 = a2 + kstep; const char* b3 = b2 + kstep;
            if (last && has_next) S.a_ready(nxt);
            if constexpr (SP2) {
            PG8_LDB(B0, 0, 0); PG8_LDB(B1, 0, 1); PG8_SCHED; PG8_LDA(At, 0, 0); PG8_STAGE(PG8_SA(1, 1), a1 + hstep, voffA);
            PG8_WAIT_V(8); PG8_WAIT_L(0); PG8_BAR; PG8_MMA(0, 0, At, B0); PG8_MMA(0, 1, At, B1); PG8_BAR; PG8_SCHED;
            PG8_LDA(At, 0, 1); PG8_STAGE(PG8_SB(0, 0), b2, voffB); PG8_STAGE(PG8_SB(0, 1), b2 + hstep, voffB); PG8_STAGE(PG8_SA(0, 0), a2, voffA);
            PG8_WAIT_V(8); PG8_WAIT_L(0); PG8_BAR; PG8_MMA(1, 0, At, B0); PG8_MMA(1, 1, At, B1); PG8_BAR; PG8_SCHED;
            PG8_LDB(B0, 1, 0); PG8_LDB(B1, 1, 1); PG8_SCHED; PG8_LDA(At, 1, 0); PG8_STAGE(PG8_SA(0, 1), a2 + hstep, voffA);
            PG8_WAIT_V(8); PG8_WAIT_L(0); PG8_BAR; PG8_MMA(0, 0, At, B0); PG8_MMA(0, 1, At, B1); PG8_BAR; PG8_SCHED;
            PG8_LDA(At, 1, 1); PG8_STAGE(PG8_SB(1, 0), b3, voffB); PG8_STAGE(PG8_SB(1, 1), b3 + hstep, voffB); PG8_STAGE(PG8_SA(1, 0), a3, voffA);
            PG8_WAIT_V(8); PG8_WAIT_L(0); PG8_BAR; PG8_MMA(1, 0, At, B0); PG8_MMA(1, 1, At, B1); PG8_BAR; PG8_SCHED;
            } else {
            PG8_LDB(B0, 0, 0); PG8_SCHED; PG8_LDA(At, 0, 0); PG8_STAGE(PG8_SA(1, 1), a1 + hstep, voffA);
            PG8_WAIT_L(8); PG8_BAR; PG8_WAIT_L(0); PG8_MMA(0, 0, At, B0); PG8_BAR; PG8_SCHED;
            PG8_LDB(B1, 0, 1); PG8_STAGE(PG8_SB(0, 0), b2, voffB);
            PG8_BAR; PG8_WAIT_L(0); PG8_MMA(0, 1, At, B1); PG8_BAR;
            PG8_LDA(At, 0, 1); PG8_STAGE(PG8_SA(0, 0), a2, voffA);
            PG8_BAR; PG8_WAIT_L(0); PG8_MMA(1, 0, At, B0); PG8_BAR; PG8_SCHED;
            PG8_STAGE(PG8_SB(0, 1), b2 + hstep, voffB);
            PG8_WAIT_V(6); PG8_BAR; PG8_MMA(1, 1, At, B1); PG8_BAR;
            PG8_LDB(B0, 1, 0); PG8_SCHED; PG8_LDA(At, 1, 0); PG8_STAGE(PG8_SA(0, 1), a2 + hstep, voffA);
            PG8_WAIT_L(8); PG8_BAR; PG8_WAIT_L(0); PG8_MMA(0, 0, At, B0); PG8_BAR; PG8_SCHED;
            PG8_LDB(B1, 1, 1); PG8_STAGE(PG8_SB(1, 0), b3, voffB);
            PG8_BAR; PG8_WAIT_L(0); PG8_MMA(0, 1, At, B1); PG8_BAR;
            PG8_LDA(At, 1, 1); PG8_STAGE(PG8_SA(1, 0), a3, voffA);
            PG8_BAR; PG8_WAIT_L(0); PG8_MMA(1, 0, At, B0); PG8_BAR; PG8_SCHED;
            PG8_STAGE(PG8_SB(1, 1), b3 + hstep, voffB);
            PG8_WAIT_V(6); PG8_BAR; PG8_MMA(1, 1, At, B1); PG8_BAR;
            }
        }
        if constexpr (ALIGN_EPI) { if (wr == 0) PG8_BAR; }
        if constexpr (!Epi::AFTER_DRAIN) { E(acc, cur, wr, wc, fr, fq); S.done(cur); }
        if (!has_next) break;
#pragma unroll
        for (int a = 0; a < 2; ++a)
#pragma unroll
            for (int b = 0; b < 2; ++b)
#pragma unroll
                for (int m = 0; m < 4; ++m)
#pragma unroll
                    for (int n = 0; n < 2; ++n) acc[a][b][m][n] = (f32x4){0.f, 0.f, 0.f, 0.f};
        cur = nxt; cA = nA; cB = nB; ++ui;
        if constexpr (ALIGN_EPI) { if (wr == 1) PG8_BAR; }
    }
    PG8_WAIT_V(0);
    if constexpr (!ALIGN_EPI) { if (wr == 0) PG8_BAR; }
    PG8_BAR;
    if constexpr (Epi::AFTER_DRAIN) { E.fused(acc, cur, wr, wc, fr, fq, lds, wid, lane); S.done(cur); }
#undef PG8_SA
#undef PG8_SB
#undef PG8_STAGE
#undef PG8_LDA
#undef PG8_LDB
#undef PG8_MMA
#undef PG8_WAIT_V
#undef PG8_WAIT_L
#undef PG8_BAR
#undef PG8_SCHED
}
}

constexpr int DM = 1024, SEQ = 16384, NBATCH = 2, MPROMPT = NBATCH * SEQ, DEC_B = 8, DEC_S = 16;
constexpr int M = MPROMPT + DEC_B * DEC_S;
constexpr int MPAD = 33024;
constexpr int DFF = 2816, DIN = 1536, AW = 512, BWD = 512, NG = 32, NP = 64, GN = 16;
constexpr int NTILE = M / 128;
constexpr float EPS = 1e-6f;
constexpr int NWAVES = 8, NTHREADS = 512;
constexpr int RR = 4;

constexpr size_t MiB = 1u << 20;
constexpr size_t WS_WGU1 = 1 * MiB, WS_WD1 = 12 * MiB, WS_WIN = 18 * MiB, WS_WGLU = 21 * MiB, WS_WOUT = 22 * MiB, WS_WGU2 = 24 * MiB, WS_WD2 = 35 * MiB;
constexpr size_t WS_WEFF = 41 * MiB, WS_BB = 42 * MiB, WS_CM = 42 * MiB + 131072, WS_LAM = 42 * MiB + 262144, WS_RS = 42 * MiB + 524288, WS_E = 43 * MiB, WS_BB4 = 47 * MiB + 524288;
constexpr size_t WS_XN = 48 * MiB, WS_D = 113 * MiB, WS_H = 178 * MiB, WS_Z = 178 * MiB, WS_YB = 275 * MiB, WS_MIX = 356 * MiB, WS_CR = 421 * MiB, WS_END = 426 * MiB;
static_assert(WS_XN + (size_t)MPAD * DM * 2 <= WS_D && WS_D + (size_t)MPAD * DM * 2 <= WS_H && WS_H + (size_t)MPAD * DFF * 2 <= WS_MIX, "ws map");
static_assert(WS_Z + (size_t)MPAD * DIN * 2 <= WS_YB && WS_YB + (size_t)MPAD * BWD * 2 <= WS_H + (size_t)MPAD * DFF * 2 && WS_MIX + (size_t)MPAD * DM * 2 <= WS_CR && WS_CR + (size_t)NTILE * NG * NP * 8 <= WS_END, "ws map 2");
static_assert(WS_E + (size_t)NTILE * NG * NP * 8 <= WS_BB4 && WS_BB4 + (size_t)NG * 128 * 64 * 2 <= WS_XN, "ws map 3");

constexpr size_t OFF_Y = 0, OFF_SRE_P = (size_t)M * DM, OFF_SIM_P = OFF_SRE_P + NBATCH * NG * NP, OFF_SRE_S = OFF_SIM_P + NBATCH * NG * NP,
                 OFF_SIM_S = OFF_SRE_S + DEC_B * NG * NP, OFF_V_S = OFF_SIM_S + DEC_B * NG * NP;

constexpr int GEMM_LDS = 131072;
constexpr int S5_ROW = 132;
constexpr int S5_WAVE_BYTES = 32 * S5_ROW * 4;
constexpr int OT_STRIDE = 520;
constexpr int VT_STRIDE = 136;
constexpr int LDS_BYTES = 147456;
static_assert(128 * VT_STRIDE * 2 + 4096 <= LDS_BYTES - 64 && 128 * OT_STRIDE * 2 <= LDS_BYTES - 64, "lds map");

#define LAS __attribute__((address_space(3)))
typedef unsigned short bf16;
typedef float v4f __attribute__((ext_vector_type(4)));
typedef float v2f __attribute__((ext_vector_type(2)));
typedef float v16f __attribute__((ext_vector_type(16)));
typedef unsigned v4u __attribute__((ext_vector_type(4)));
typedef unsigned v2u __attribute__((ext_vector_type(2)));
typedef short bfx8 __attribute__((ext_vector_type(8)));
#define LDS_FENCE() asm volatile("s_waitcnt lgkmcnt(0)" ::: "memory")

using pg8::cvt_pk_bf16; using pg8::bf_lo; using pg8::bf_hi; using pg8::gelu_t;

__device__ __forceinline__ float wave_sum(float v) {
#pragma unroll
    for (int o = 1; o < 64; o <<= 1) v += __shfl_xor(v, o);
    return v;
}
typedef __bf16 bf16x2_t __attribute__((ext_vector_type(2)));
__device__ __forceinline__ unsigned cvt_pk_c(float lo, float hi) { const v2f v = {lo, hi}; const bf16x2_t b = __builtin_convertvector(v, bf16x2_t); return __builtin_bit_cast(unsigned, b); }
__device__ __forceinline__ unsigned cvt_pk_nv(float lo, float hi) { unsigned r; asm("v_cvt_pk_bf16_f32 %0, %1, %2" : "=v"(r) : "v"(lo), "v"(hi)); return r; }
__device__ __forceinline__ bf16 f2bf(float f) { return (bf16)(cvt_pk_nv(f, 0.f) & 0xffffu); }


__device__ __forceinline__ double dexp(double x) {
    const double y = x * (1.0 / 256.0); double t = 1.0;
#pragma unroll
    for (int i = 12; i >= 1; --i) t = 1.0 + t * y * (1.0 / (double)i);
#pragma unroll
    for (int i = 0; i < 8; ++i) t = t * t;
    return t;
}
__device__ __forceinline__ void dsincos(double x, double& s, double& c) {
    const double twopi = 6.283185307179586476925286766559;
    const double k = rint(x * (1.0 / twopi)); const double r = x - k * twopi, r2 = r * r;
    double ts = r, tc = 1.0; s = r; c = 1.0;
#pragma unroll
    for (int i = 1; i <= 15; ++i) { tc = -tc * r2 * (1.0 / (double)((2 * i - 1) * (2 * i))); ts = -ts * r2 * (1.0 / (double)((2 * i) * (2 * i + 1))); c += tc; s += ts; }
}

typedef const float* cfp_t;
typedef __attribute__((address_space(4))) cfp_t const* kin_t;
__device__ __forceinline__ const float* karg_in(int i) {
    auto k = __builtin_amdgcn_kernarg_segment_ptr();
    asm volatile("" : "+s"(k));
    return ((kin_t)k)[i];
}
struct Ctx {
    __device__ __forceinline__ const float* in(int i) const { return karg_in(i); }
    __device__ __forceinline__ float* out() const { return (float*)karg_in(33); }
    __device__ __forceinline__ unsigned char* ws() const { return (unsigned char*)karg_in(34); }
#define WSP(name, T, off) __device__ __forceinline__ T* name() const { return (T*)(ws() + (off)); }
    WSP(Wgu1, bf16, WS_WGU1) WSP(Wd1, bf16, WS_WD1) WSP(Win, bf16, WS_WIN) WSP(Wglu, bf16, WS_WGLU) WSP(Wout, bf16, WS_WOUT) WSP(Wgu2, bf16, WS_WGU2) WSP(Wd2, bf16, WS_WD2)
    WSP(Weff, bf16, WS_WEFF) WSP(BB, bf16, WS_BB) WSP(CM, bf16, WS_CM) WSP(XN, bf16, WS_XN) WSP(D, bf16, WS_D) WSP(H, bf16, WS_H) WSP(Z, bf16, WS_Z) WSP(YB, bf16, WS_YB) WSP(MIX, bf16, WS_MIX)
    WSP(BB4, bf16, WS_BB4) WSP(LAM, float, WS_LAM) WSP(E, float, WS_E) WSP(RS, float, WS_RS)
#undef WSP
};

__device__ __forceinline__ void p0_block_item(const float* W, const float* gk, int K, int N, bf16* WT, int mode, int item, LAS float* tile, int tid) {
    const int nblk = N / 256, kb = item / nblk, nb = item % nblk, k0 = 64 * kb, n0 = 256 * nb;
    const int lr = tid >> 6, lc = 4 * (tid & 63);
    v4f v[8];
#pragma unroll
    for (int i = 0; i < 8; ++i) v[i] = *(const v4f*)(W + (size_t)(k0 + lr + 8 * i) * N + n0 + lc);
    if (gk) {
#pragma unroll
        for (int i = 0; i < 8; ++i) v[i] = v[i] * gk[k0 + lr + 8 * i];
    }
    __syncthreads();
#pragma unroll
    for (int i = 0; i < 8; ++i) { LAS float* p = tile + (lr + 8 * i) * 257 + lc; p[0] = v[i].x; p[1] = v[i].y; p[2] = v[i].z; p[3] = v[i].w; }
    __syncthreads();
    const int c = tid & 7;
#pragma unroll
    for (int j = 0; j < 4; ++j) {
        const int n = (tid >> 3) + 64 * j, ng = n0 + n;
        const int drow = (mode == 0) ? ng : (256 * (ng >> 7) + (ng & 127) + (mode == 2 ? 128 : 0));
        const LAS float* sp = tile + (8 * c) * 257 + n;
        v4u o; o.x = cvt_pk_nv(sp[0 * 257], sp[1 * 257]); o.y = cvt_pk_nv(sp[2 * 257], sp[3 * 257]); o.z = cvt_pk_nv(sp[4 * 257], sp[5 * 257]); o.w = cvt_pk_nv(sp[6 * 257], sp[7 * 257]);
        *(v4u*)(WT + (size_t)drow * K + k0 + 8 * c) = o;
    }
}
__device__ __forceinline__ const float* xrow_ptr(const Ctx& C, int row) { return row < MPROMPT ? C.in(0) + (size_t)row * DM : C.in(1) + (size_t)(row - MPROMPT) * DM; }

__device__ __forceinline__ v4f ld4_f32(const float* p) { return *(const v4f*)p; }
__device__ __forceinline__ v4f ld4_bf16(const bf16* p) { const v2u w = *(const v2u*)p; return (v4f){bf_lo(w.x), bf_hi(w.x), bf_lo(w.y), bf_hi(w.y)}; }
__device__ __forceinline__ void st4_bf16(bf16* p, v4f o) { v2u w; w.x = cvt_pk_nv(o.x, o.y); w.y = cvt_pk_nv(o.z, o.w); *(v2u*)p = w; }
__device__ __forceinline__ float ssq4(v4f v) { return (v.x * v.x + v.y * v.y) + (v.z * v.z + v.w * v.w); }
template <int R>
__device__ __forceinline__ void rows_x0(const Ctx& C, int m0, int stride, int lane) {
    v4f v[R][4]; float ss[R]; int mr[R]; bool ok[R];
#pragma unroll
    for (int r = 0; r < R; ++r) { mr[r] = m0 + r * stride; ok[r] = mr[r] < M; const float* x = xrow_ptr(C, ok[r] ? mr[r] : m0);
#pragma unroll
        for (int j = 0; j < 4; ++j) v[r][j] = ld4_f32(x + 4 * lane + 256 * j); }
    bf16* XN = C.XN();
#pragma unroll
    for (int r = 0; r < R; ++r) { float s = 0.f;
#pragma unroll
        for (int j = 0; j < 4; ++j) s += ssq4(v[r][j]);
        ss[r] = s; }
#pragma unroll
    for (int r = 0; r < R; ++r) ss[r] = rsqrtf(wave_sum(ss[r]) * (1.f / DM) + EPS);
#pragma unroll
    for (int r = 0; r < R; ++r)
#pragma unroll
        for (int j = 0; j < 4; ++j) if (ok[r]) st4_bf16(XN + (size_t)mr[r] * DM + 4 * lane + 256 * j, v[r][j] * ss[r]);
}
template <int R, bool BASE_F32, bool OUT_F32>
__device__ __forceinline__ void rows_res(const Ctx& C, int m0, int stride, const float* gpost, float scale, int lane) {
    v4f d[R][4], b[R][4]; int mr[R]; bool ok[R]; float r1[R];
    const bf16* D = C.D(); bf16* XN = C.XN();
#pragma unroll
    for (int r = 0; r < R; ++r) { mr[r] = m0 + r * stride; ok[r] = mr[r] < M; const int mm = ok[r] ? mr[r] : m0;
#pragma unroll
        for (int j = 0; j < 4; ++j) d[r][j] = ld4_bf16(D + (size_t)mm * DM + 4 * lane + 256 * j);
        if (BASE_F32) { const float* x = xrow_ptr(C, mm);
#pragma unroll
            for (int j = 0; j < 4; ++j) b[r][j] = ld4_f32(x + 4 * lane + 256 * j);
        } else { const float inv = C.RS()[mm];
#pragma unroll
            for (int j = 0; j < 4; ++j) b[r][j] = ld4_bf16(XN + (size_t)mm * DM + 4 * lane + 256 * j) * inv;
        } }
#pragma unroll
    for (int r = 0; r < R; ++r) { float s = 0.f;
#pragma unroll
        for (int j = 0; j < 4; ++j) s += ssq4(d[r][j]);
        r1[r] = s; }
#pragma unroll
    for (int r = 0; r < R; ++r) r1[r] = rsqrtf(wave_sum(r1[r]) * (1.f / DM) + EPS) * scale;
#pragma unroll
    for (int j = 0; j < 4; ++j) { const v4f gp = ld4_f32(gpost + 4 * lane + 256 * j);
#pragma unroll
        for (int r = 0; r < R; ++r) d[r][j] = b[r][j] + d[r][j] * r1[r] * gp; }
    if (OUT_F32) { float* Y = C.out();
#pragma unroll
        for (int r = 0; r < R; ++r)
#pragma unroll
            for (int j = 0; j < 4; ++j) if (ok[r]) *(v4f*)(Y + (size_t)mr[r] * DM + 4 * lane + 256 * j) = d[r][j];
    } else { float* rs = C.RS(); float t[R];
#pragma unroll
        for (int r = 0; r < R; ++r) { float s = 0.f;
#pragma unroll
            for (int j = 0; j < 4; ++j) s += ssq4(d[r][j]);
            t[r] = s; }
#pragma unroll
        for (int r = 0; r < R; ++r) t[r] = wave_sum(t[r]) * (1.f / DM) + EPS;
#pragma unroll
        for (int r = 0; r < R; ++r) { const float rstd = rsqrtf(t[r]);
#pragma unroll
            for (int j = 0; j < 4; ++j) if (ok[r]) st4_bf16(XN + (size_t)mr[r] * DM + 4 * lane + 256 * j, d[r][j] * rstd);
            if (lane == 0 && ok[r]) rs[mr[r]] = sqrtf(t[r]); }
    }
}
__device__ __forceinline__ void row_norm512(bf16* row, const float* g, int lane) {
    const v4u w = *(const v4u*)(row + 8 * lane);
    float v[8] = {bf_lo(w.x), bf_hi(w.x), bf_lo(w.y), bf_hi(w.y), bf_lo(w.z), bf_hi(w.z), bf_lo(w.w), bf_hi(w.w)};
    float s = 0.f;
#pragma unroll
    for (int i = 0; i < 8; ++i) s += v[i] * v[i];
    const float r = rsqrtf(wave_sum(s) * (1.f / 512.f) + EPS);
    const v4f g0 = *(const v4f*)(g + 8 * lane), g1 = *(const v4f*)(g + 8 * lane + 4);
    v4u o; o.x = cvt_pk_bf16(v[0] * r * g0.x, v[1] * r * g0.y); o.y = cvt_pk_bf16(v[2] * r * g0.z, v[3] * r * g0.w);
    o.z = cvt_pk_bf16(v[4] * r * g1.x, v[5] * r * g1.y); o.w = cvt_pk_bf16(v[6] * r * g1.z, v[7] * r * g1.w);
    *(v4u*)(row + 8 * lane) = o;
}

__device__ __forceinline__ void p0_prologue(const Ctx& C, LAS unsigned char* lds, int wave, int lane, int tid) {
    LAS float* tile = (LAS float*)lds;
    const int gw = blockIdx.x * NWAVES + wave, NGW = gridDim.x * NWAVES;
    constexpr int I_GU = (DM / 64) * (DFF / 256), I_D = (DFF / 64) * (DM / 256), I_IN = (DM / 64) * (DIN / 256), I_GLU = (BWD / 64) * (BWD / 256), I_OUT = (DM / 64) * (DM / 256);
    constexpr int NITEMS = 4 * I_GU + 2 * I_D + I_IN + I_GLU + I_OUT;
    for (int it = blockIdx.x; it < NITEMS; it += gridDim.x) {
        int r = it;
        if (r < I_GU) { p0_block_item(C.in(5), C.in(4), DM, DFF, C.Wgu1(), 1, r, tile, tid); continue; } r -= I_GU;
        if (r < I_GU) { p0_block_item(C.in(6), C.in(4), DM, DFF, C.Wgu1(), 2, r, tile, tid); continue; } r -= I_GU;
        if (r < I_GU) { p0_block_item(C.in(29), C.in(28), DM, DFF, C.Wgu2(), 1, r, tile, tid); continue; } r -= I_GU;
        if (r < I_GU) { p0_block_item(C.in(30), C.in(28), DM, DFF, C.Wgu2(), 2, r, tile, tid); continue; } r -= I_GU;
        if (r < I_D) { p0_block_item(C.in(7), nullptr, DFF, DM, C.Wd1(), 0, r, tile, tid); continue; } r -= I_D;
        if (r < I_D) { p0_block_item(C.in(31), nullptr, DFF, DM, C.Wd2(), 0, r, tile, tid); continue; } r -= I_D;
        if (r < I_IN) { p0_block_item(C.in(10), C.in(9), DM, DIN, C.Win(), 0, r, tile, tid); continue; } r -= I_IN;
        if (r < I_GLU) { p0_block_item(C.in(22), nullptr, BWD, BWD, C.Wglu(), 0, r, tile, tid); continue; } r -= I_GLU;
        p0_block_item(C.in(26), nullptr, DM, DM, C.Wout(), 0, r, tile, tid);
    }
    for (int m = gw; m < M; m += 4 * NGW) rows_x0<4>(C, m, NGW, lane);
    const int gt = blockIdx.x * NTHREADS + tid, NGT = gridDim.x * NTHREADS;
    for (int idx = (tid < 8 ? blockIdx.x * 8 + tid : NG * NP); idx < NG * NP; idx += gridDim.x * 8) {
        const int g = idx / NP, p = idx % NP;
        const double lr = (double)C.in(14)[idx], li = (double)C.in(15)[idx], dt = dexp((double)C.in(16)[g]);
        double s1, c1, s8, c8; dsincos(li * dt, s1, c1); dsincos(li * dt * 128.0, s8, c8);
        const double er = dexp(lr * dt), lbr = er * c1, lbi = er * s1;
        const double e8 = dexp(lr * dt * 128.0), l8r = e8 * c8, l8i = e8 * s8;
        C.LAM()[0 * 2048 + idx] = (float)lbr; C.LAM()[1 * 2048 + idx] = (float)lbi; C.LAM()[2 * 2048 + idx] = (float)l8r; C.LAM()[3 * 2048 + idx] = (float)l8i;
        const double a = lbr - 1.0, b = lbi, den = lr * lr + li * li, cr = (a * lr + b * li) / den, ci = (b * lr - a * li) / den;
        const double p2r = lbr * lbr - lbi * lbi, p2i = 2.0 * lbr * lbi, p3r = p2r * lbr - p2i * lbi, p3i = p2r * lbi + p2i * lbr, p4r = p2r * p2r - p2i * p2i, p4i = 2.0 * p2r * p2i;
        C.LAM()[4 * 2048 + idx] = (float)p4r; C.LAM()[5 * 2048 + idx] = (float)p4i;
        const double pwr[4] = {p3r, p2r, lbr, 1.0}, pwi[4] = {p3i, p2i, lbi, 0.0};
        for (int n = 0; n < GN; ++n) {
            const double br = (double)C.in(17)[(size_t)idx * GN + n], bi = (double)C.in(18)[(size_t)idx * GN + n];
            C.BB()[((size_t)g * 128 + 2 * p) * GN + n] = f2bf((float)(cr * br - ci * bi));
            C.BB()[((size_t)g * 128 + 2 * p + 1) * GN + n] = f2bf((float)(cr * bi + ci * br));
            C.CM()[((size_t)g * GN + n) * 128 + 2 * p] = f2bf(C.in(19)[((size_t)g * GN + n) * NP + p]);
            C.CM()[((size_t)g * GN + n) * 128 + 2 * p + 1] = f2bf(-C.in(20)[((size_t)g * GN + n) * NP + p]);
        }
    }
    for (int idx = gt; idx < 2 * 4 * 128 * 128; idx += NGT) {
        const int s = idx & 127, t = (idx >> 7) & 127, h = (idx >> 14) & 3, mode = idx >> 16;
        float v;
        if (mode == 0) v = (s <= t) ? C.in(12)[((size_t)h * 128 + t) * 128 + s] : 0.f;
        else v = ((s >> 4) == (t >> 4) && (s & 15) <= (t & 15)) ? C.in(12)[((size_t)h * 128 + (t & 15)) * 128 + (s & 15)] : 0.f;
        C.Weff()[idx] = f2bf(v);
    }
}

constexpr int XU_STRIDE = 72;
constexpr int BH_STRIDE = 136;
constexpr int S5W_BYTES = 32 * XU_STRIDE * 2 + 32 * BH_STRIDE * 2;
static_assert(NWAVES * S5W_BYTES <= LDS_BYTES - 64, "s5 lds");
template <bool PASS2>
__device__ __forceinline__ void s5_tile(const Ctx& C, int T, int sb_lo, int sb_hi, LAS unsigned char* lds, int wave, int lane) {
    const bool sample = (T == NTILE - 1);
    const int r0 = T * 128;
    LAS bf16* XU = (LAS bf16*)(lds + wave * S5W_BYTES);
    LAS bf16* BH = XU + 32 * XU_STRIDE;
    const int tl = lane & 31, hh = lane >> 5, fr = lane & 15, kq = lane >> 4, xrow = lane >> 3, xpart = lane & 7;
    const float* LAM = C.LAM();
    const bf16* Zb = C.Z() + (size_t)1024 + 64 * wave;
    float sr[4], si[4], lr[4], li[4], dsk[4];
#pragma unroll
    for (int gi = 0; gi < 4; ++gi) { const int g = wave * 4 + gi; sr[gi] = 0.f; si[gi] = 0.f; lr[gi] = LAM[0 * 2048 + g * 64 + lane]; li[gi] = LAM[1 * 2048 + g * 64 + lane];
        dsk[gi] = PASS2 ? C.in(21)[16 * g + fr] : 0.f; }
    if (PASS2 && !sample) {
        const int k = T & 127, tb = T - k;
        float l8r[4], l8i[4];
#pragma unroll
        for (int gi = 0; gi < 4; ++gi) { l8r[gi] = LAM[2 * 2048 + (wave * 4 + gi) * 64 + lane]; l8i[gi] = LAM[3 * 2048 + (wave * 4 + gi) * 64 + lane]; }
        const v2f* Ep = (const v2f*)C.E() + ((size_t)tb * NG + wave * 4) * NP + lane;
        const int nb = (k + 15) >> 4, j0 = k - 16 * nb;
        for (int jb = 0; jb < nb; ++jb) {
#pragma unroll
            for (int u = 0; u < 16; ++u) {
                const int j = j0 + 16 * jb + u; const bool ok = j >= 0; const int jc = ok ? j : 0;
#pragma unroll
                for (int gi = 0; gi < 4; ++gi) { v2f e = Ep[(size_t)jc * NG * NP + gi * NP]; if (!ok) e = (v2f){0.f, 0.f};
                    const float nr = fmaf(l8r[gi], sr[gi], fmaf(-l8i[gi], si[gi], e.x)), ni = fmaf(l8r[gi], si[gi], fmaf(l8i[gi], sr[gi], e.y)); sr[gi] = nr; si[gi] = ni; }
            }
        }
    }
    v4u xn[4];
    {
        const int sb0 = sb_lo;
#pragma unroll
        for (int i = 0; i < 4; ++i) xn[i] = *(const v4u*)(Zb + (size_t)(r0 + 32 * sb0 + xrow + 8 * i) * DIN + 8 * xpart);
    }
    for (int sb = sb_lo; sb < sb_hi; ++sb) {
        const int rb0 = r0 + 32 * sb;
#pragma unroll
        for (int i = 0; i < 4; ++i) *(LAS v4u*)(XU + (xrow + 8 * i) * XU_STRIDE + 8 * xpart) = xn[i];
        if (sb + 1 < sb_hi) {
#pragma unroll
            for (int i = 0; i < 4; ++i) xn[i] = *(const v4u*)(Zb + (size_t)(rb0 + 32 + xrow + 8 * i) * DIN + 8 * xpart);
        }
        LDS_FENCE();
#pragma unroll
        for (int gi = 0; gi < 4; ++gi) {
            const int g = wave * 4 + gi;
            bfx8 bb[4];
#pragma unroll
            for (int cb = 0; cb < 4; ++cb) bb[cb] = *(const bfx8*)(C.BB() + ((size_t)(g * 128 + cb * 32 + tl)) * GN + 8 * hh);
            bfx8 cm[4];
            if (PASS2) {
#pragma unroll
                for (int ks = 0; ks < 4; ++ks) cm[ks] = *(const bfx8*)(C.CM() + ((size_t)(g * GN + fr)) * 128 + 32 * ks + 8 * kq);
            }
            float s0ar = 0.f, s0ai = 0.f, s0br = 0.f, s0bi = 0.f;
            if (sample) { const size_t o0 = ((size_t)(2 * sb) * NG + g) * NP + lane, o1 = o0 + (size_t)NG * NP;
                s0ar = C.in(2)[o0]; s0ai = C.in(3)[o0]; s0br = C.in(2)[o1]; s0bi = C.in(3)[o1]; }
            const bfx8 a = *(const LAS bfx8*)(XU + tl * XU_STRIDE + 16 * gi + 8 * hh);
#pragma unroll
            for (int cb = 0; cb < 4; ++cb) {
                v16f acc;
#pragma unroll
                for (int r = 0; r < 16; ++r) acc[r] = 0.f;
                acc = __builtin_amdgcn_mfma_f32_32x32x16_bf16(bb[cb], a, acc, 0, 0, 0);
#pragma unroll
                for (int rg = 0; rg < 4; ++rg) { v2u w; w.x = cvt_pk_c(acc[4 * rg], acc[4 * rg + 1]); w.y = cvt_pk_c(acc[4 * rg + 2], acc[4 * rg + 3]);
                    *(LAS v2u*)(BH + tl * BH_STRIDE + cb * 32 + 8 * rg + 4 * hh) = w; }
            }
            LDS_FENCE();
            {
                unsigned bu[32];
#pragma unroll
                for (int t = 0; t < 32; ++t) bu[t] = *(const LAS unsigned*)(BH + t * BH_STRIDE + 2 * lane);
                LDS_FENCE();
                float xr = sr[gi], xi = si[gi];
#pragma unroll
                for (int t = 0; t < 32; ++t) {
                    if (sample && t == 0) { xr = s0ar; xi = s0ai; }
                    if (sample && t == 16) { xr = s0br; xi = s0bi; }
                    const float nr = fmaf(lr[gi], xr, fmaf(-li[gi], xi, bf_lo(bu[t]))), ni = fmaf(lr[gi], xi, fmaf(li[gi], xr, bf_hi(bu[t])));
                    xr = nr; xi = ni;
                    if (PASS2) {
                        *(LAS unsigned*)(BH + t * BH_STRIDE + 2 * lane) = cvt_pk_nv(xr, xi);
                        if (sample && (t & 15) == 15) { const int seq = 2 * sb + (t >> 4);
                            C.out()[OFF_SRE_S + ((size_t)seq * NG + g) * NP + lane] = xr; C.out()[OFF_SIM_S + ((size_t)seq * NG + g) * NP + lane] = xi; }
                    }
                }
                sr[gi] = xr; si[gi] = xi;
            }
            LDS_FENCE();
            if (PASS2) {
#pragma unroll
                for (int rb = 0; rb < 2; ++rb) {
                    v4f acc = (v4f){0.f, 0.f, 0.f, 0.f};
#pragma unroll
                    for (int ks = 0; ks < 4; ++ks) {
                        const bfx8 sa = *(const LAS bfx8*)(BH + (16 * rb + fr) * BH_STRIDE + 32 * ks + 8 * kq);
                        acc = __builtin_amdgcn_mfma_f32_16x16x32_bf16(sa, cm[ks], acc, 0, 0, 0);
                    }
#pragma unroll
                    for (int r = 0; r < 4; ++r) {
                        LAS bf16* up = XU + (16 * rb + 4 * kq + r) * XU_STRIDE + 16 * gi + fr;
                        const float u = __uint_as_float((unsigned)(*up) << 16);
                        *up = f2bf(gelu_t(acc[r] + dsk[gi] * u));
                    }
                }
                LDS_FENCE();
            }
        }
        if (PASS2) {
#pragma unroll
            for (int i = 0; i < 4; ++i) *(v4u*)(C.YB() + (size_t)(rb0 + xrow + 8 * i) * BWD + 64 * wave + 8 * xpart) = *(const LAS v4u*)(XU + (xrow + 8 * i) * XU_STRIDE + 8 * xpart);
            LDS_FENCE();
        }
    }
#pragma unroll
    for (int gi = 0; gi < 4; ++gi) {
        const int g = wave * 4 + gi;
        if (!PASS2) { v2f* Ep = (v2f*)C.E() + ((size_t)T * NG + g) * NP + lane; *Ep = (v2f){sr[gi], si[gi]}; }
        else if (!sample && (T & 127) == 127) { const int b = T >> 7;
            C.out()[OFF_SRE_P + ((size_t)b * NG + g) * NP + lane] = sr[gi]; C.out()[OFF_SIM_P + ((size_t)b * NG + g) * NP + lane] = si[gi]; }
    }
}

__device__ __forceinline__ void gmlp_tile(const Ctx& C, int T, LAS unsigned char* lds, int wave, int lane, int tid) {
    const int mode = (T == NTILE - 1) ? 1 : 0;
    const int r0 = T * 128;
    LAS bf16* VT = (LAS bf16*)lds;
    LAS float* SSQ = (LAS float*)(lds + 128 * VT_STRIDE * 2);
    const int tb = wave & 3, dh = wave >> 2, tl = lane & 31, hh = lane >> 5;
    const int t = 32 * tb + tl;
    unsigned outp[4][2][8]; float ssq = 0.f;
    const bf16* zt = C.Z() + (size_t)(r0 + t) * DIN;
    const int row = tid >> 2, q = tid & 3;
    const bf16* vsrc = C.Z() + (size_t)(r0 + row) * DIN + 512 + q * 32;
    const bf16* Weff = C.Weff();
    v4u vraw[4];
#pragma unroll
    for (int i = 0; i < 4; ++i) vraw[i] = *(const v4u*)(vsrc + 8 * i);
#pragma unroll
    for (int h = 0; h < 4; ++h) {
        bfx8 wf[8];
        const bf16* wrow = Weff + ((size_t)(mode * 4 + h) * 128 + t) * 128 + 8 * hh;
#pragma unroll
        for (int ks = 0; ks < 8; ++ks) wf[ks] = *(const bfx8*)(wrow + 16 * ks);
        v2u uw[2][4];
#pragma unroll
        for (int dbi = 0; dbi < 2; ++dbi)
#pragma unroll
            for (int rg = 0; rg < 4; ++rg) uw[dbi][rg] = *(const v2u*)(zt + h * 128 + 32 * (2 * dh + dbi) + 8 * rg + 4 * hh);
        const float bias = C.in(13)[h * 128 + (mode ? (t & 15) : t)];
        __syncthreads();
        {
            float v[32]; float s = 0.f;
#pragma unroll
            for (int i = 0; i < 4; ++i) { const v4u w = vraw[i];
                v[8 * i + 0] = bf_lo(w.x); v[8 * i + 1] = bf_hi(w.x); v[8 * i + 2] = bf_lo(w.y); v[8 * i + 3] = bf_hi(w.y);
                v[8 * i + 4] = bf_lo(w.z); v[8 * i + 5] = bf_hi(w.z); v[8 * i + 6] = bf_lo(w.w); v[8 * i + 7] = bf_hi(w.w); }
            if (h < 3) {
#pragma unroll
                for (int i = 0; i < 4; ++i) vraw[i] = *(const v4u*)(vsrc + (h + 1) * 128 + 8 * i);
            }
#pragma unroll
            for (int i = 0; i < 32; ++i) s += v[i] * v[i];
            s += __shfl_xor(s, 1); s += __shfl_xor(s, 2);
            const float r = rsqrtf(s * (1.f / 128.f) + EPS);
            const float* gv = C.in(11) + h * 128 + q * 32;
#pragma unroll
            for (int i = 0; i < 32; ++i) { v[i] = v[i] * r * gv[i]; VT[(q * 32 + i) * VT_STRIDE + row] = f2bf(v[i]); }
            if (mode) { float* ov = C.out() + OFF_V_S + (size_t)row * AW + h * 128 + q * 32;
#pragma unroll
                for (int i = 0; i < 8; ++i) *(v4f*)(ov + 4 * i) = (v4f){v[4 * i], v[4 * i + 1], v[4 * i + 2], v[4 * i + 3]}; }
        }
        __syncthreads();
#pragma unroll
        for (int dbi = 0; dbi < 2; ++dbi) {
            const int db = 2 * dh + dbi;
            v16f acc;
#pragma unroll
            for (int r = 0; r < 16; ++r) acc[r] = 0.f;
#pragma unroll
            for (int ks = 0; ks < 8; ++ks) {
                const bfx8 va = *(const LAS bfx8*)(VT + (32 * db + tl) * VT_STRIDE + 16 * ks + 8 * hh);
                acc = __builtin_amdgcn_mfma_f32_32x32x16_bf16(va, wf[ks], acc, 0, 0, 0);
            }
#pragma unroll
            for (int rg = 0; rg < 4; ++rg) {
                const v2u u2 = uw[dbi][rg];
                const float o0 = bf_lo(u2.x) * (acc[4 * rg + 0] + bias), o1 = bf_hi(u2.x) * (acc[4 * rg + 1] + bias);
                const float o2 = bf_lo(u2.y) * (acc[4 * rg + 2] + bias), o3 = bf_hi(u2.y) * (acc[4 * rg + 3] + bias);
                ssq += (o0 * o0 + o1 * o1) + (o2 * o2 + o3 * o3);
                outp[h][dbi][2 * rg] = cvt_pk_nv(o0, o1); outp[h][dbi][2 * rg + 1] = cvt_pk_nv(o2, o3);
            }
        }
    }
    ssq += __shfl_xor(ssq, 32);
    if (hh == 0) SSQ[t * 2 + dh] = ssq;
    __syncthreads();
    const float rstd = rsqrtf((SSQ[t * 2] + SSQ[t * 2 + 1]) * (1.f / 512.f) + EPS);
    const float* gap = C.in(24);
    LAS bf16* OT = (LAS bf16*)lds;
    __syncthreads();
#pragma unroll
    for (int h = 0; h < 4; ++h)
#pragma unroll
        for (int dbi = 0; dbi < 2; ++dbi)
#pragma unroll
            for (int rg = 0; rg < 4; ++rg) {
                const int c = h * 128 + 32 * (2 * dh + dbi) + 8 * rg + 4 * hh;
                const v4f ga = *(const v4f*)(gap + c);
                const unsigned w0 = outp[h][dbi][2 * rg], w1 = outp[h][dbi][2 * rg + 1];
                v2u o; o.x = cvt_pk_nv(bf_lo(w0) * rstd * ga.x, bf_hi(w0) * rstd * ga.y); o.y = cvt_pk_nv(bf_lo(w1) * rstd * ga.z, bf_hi(w1) * rstd * ga.w);
                *(LAS v2u*)(OT + t * OT_STRIDE + c) = o;
            }
    __syncthreads();
    {
        bf16* obase = C.MIX() + (size_t)r0 * DM;
#pragma unroll 4
        for (int i = 0; i < 16; ++i) { const int row = wave * 16 + i; *(v4u*)(obase + (size_t)row * DM + 8 * lane) = *(const LAS v4u*)(OT + row * OT_STRIDE + 8 * lane); }
    }
    __syncthreads();
}

#define FTID const int ftid_ = fresh_tid()
#define TID (ftid_)
#define LANE (ftid_ & 63)
#define WAVE (__builtin_amdgcn_readfirstlane(ftid_ >> 6))
#define GSZ ((int)gridDim.x)
#define BX ((int)blockIdx.x)
#define GWV (BX * NWAVES + WAVE)
#define NGWV (GSZ * NWAVES)
constexpr size_t WS_CTL = 0, CTL_ZERO_BYTES = 16384;
constexpr int MISC_OFF = LDS_BYTES - 64;
#define XB_TMO      128
#define XB_XCNT(j)  (256  + 64 * (j))
#define XB_XSUB(j)  (1280 + 64 * (j))
#define XB_XGEN(j)  (2304 + 64 * (j))
#define XB_TOP      3328
#define XB_TOPGEN   3392
#define XCD_BAR_WORDS 3456
#define XB_SPIN_CAP (1u << 18)

__device__ __forceinline__ unsigned xb_ld(unsigned* p)              { return __hip_atomic_load(p, __ATOMIC_RELAXED, __HIP_MEMORY_SCOPE_AGENT); }
__device__ __forceinline__ unsigned xb_add(unsigned* p, unsigned v) { return __hip_atomic_fetch_add(p, v, __ATOMIC_RELAXED, __HIP_MEMORY_SCOPE_AGENT); }
__device__ __forceinline__ unsigned xb_xcc_id() { return (unsigned)__builtin_amdgcn_s_getreg((3 << 11) | 20) & 0xFu; }
#define XB_SPIN(cond, bar) do { unsigned _sp = 0; while (cond) { __builtin_amdgcn_s_sleep(1); \
    if ((++_sp & 255u) == 0u) { if (xb_ld(&(bar)[XB_TMO])) break; if (_sp > XB_SPIN_CAP) { atomicAdd(&(bar)[XB_TMO], 1u); break; } } } } while (0)

struct XcdBarrier {
    unsigned* bar; unsigned x;
    volatile LAS unsigned* st;
};

__device__ __forceinline__ XcdBarrier xcd_barrier_post(unsigned* bar, volatile LAS unsigned* st) {
    XcdBarrier b; b.bar = bar; b.x = xb_xcc_id(); b.st = st;
    if (threadIdx.x == 0) (void)xb_add(&bar[XB_XCNT(b.x)], 1u);
    return b;
}
__device__ __forceinline__ void xcd_barrier_complete(unsigned* bar, unsigned x, unsigned& nloc, unsigned& nx) {
    const unsigned G = gridDim.x * gridDim.y * gridDim.z;
    unsigned sum, cnt, mine, sp = 0u;
    for (;;) {
        sum = 0u; cnt = 0u; mine = 0u;
#pragma unroll
        for (unsigned j = 0; j < 16; ++j) { const unsigned c = xb_ld(&bar[XB_XCNT(j)]); sum += c; cnt += (c > 0u) ? 1u : 0u; mine = (j == x) ? c : mine; }
        if (sum == G) break;
        __builtin_amdgcn_s_sleep(1);
        if ((++sp & 255u) == 0u) { if (xb_ld(&bar[XB_TMO])) break; if (sp > XB_SPIN_CAP) { atomicAdd(&bar[XB_TMO], 1u); break; } }
    }
    nloc = mine > 0u ? mine : 1u; nx = cnt > 0u ? cnt : 1u;
}

__device__ __forceinline__ void xcd_barrier(const XcdBarrier& b) {
    asm volatile("s_waitcnt vmcnt(0)" ::: "memory");
    __syncthreads();
    if (threadIdx.x == 0) {
        unsigned* bar = b.bar;
        __builtin_amdgcn_s_waitcnt(0);
        unsigned nloc = b.st[0], nx = b.st[1];
        if (nloc == 0u) { xcd_barrier_complete(bar, b.x, nloc, nx); b.st[0] = nloc; b.st[1] = nx; }
        const unsigned old = xb_add(&bar[XB_XSUB(b.x)], 1u);
        const unsigned gen = old / nloc;
        if (old + 1u == (gen + 1u) * nloc) {
            __builtin_amdgcn_fence(__ATOMIC_RELEASE, "agent");
            asm volatile("s_waitcnt vmcnt(0)" ::: "memory");
            const unsigned og = xb_add(&bar[XB_TOP], 1u);
            const unsigned tg = og / nx;
            if (og + 1u == (tg + 1u) * nx) xb_add(&bar[XB_TOPGEN], 1u);
            else XB_SPIN(xb_ld(&bar[XB_TOPGEN]) == tg, bar);
            __builtin_amdgcn_fence(__ATOMIC_ACQUIRE, "agent");
            xb_add(&bar[XB_XGEN(b.x)], 1u);
            asm volatile("s_waitcnt vmcnt(0)" ::: "memory");
        } else {
            XB_SPIN(xb_ld(&bar[XB_XGEN(b.x)]) == gen, bar);
            __builtin_amdgcn_fence(__ATOMIC_ACQUIRE, "agent");
            asm volatile("s_waitcnt vmcnt(0)" ::: "memory");
        }
    }
    __syncthreads();
}

template <int MODE>
__device__ __forceinline__ void small_gemm(LAS unsigned char* lds, const bf16* A, const bf16* Bt, int N, int K, bf16* O, int ldc, int act_cols, const float* bias, const bf16* Yv, int ldy, int it0, int it1) {
    FTID; const int wave = WAVE, lane = LANE, tl = lane & 31, hh = lane >> 5;
    LAS float* red = (LAS float*)lds;
    const int nct = N / 32, nitems = 4 * nct, kw = K / 8, nks = kw / 16;
    for (int it = it0; it < it1; ++it) {
        const int item = BX + it * GSZ; if (item >= nitems) break;
        const int rt = item & 3, ct = item >> 2;
        const int hc = 32 * ct + tl;
        const int brow = (MODE == 3) ? (256 * (hc >> 7) + (hc & 127)) : hc;
        const bf16* ap = A + (size_t)(32 * rt + tl) * K + wave * kw + 8 * hh;
        const bf16* bp = Bt + (size_t)brow * K + wave * kw + 8 * hh;
        v16f acc0, acc1;
#pragma unroll
        for (int r = 0; r < 16; ++r) { acc0[r] = 0.f; acc1[r] = 0.f; }
#pragma unroll 4
        for (int ks = 0; ks < nks; ++ks) {
            const bfx8 a = *(const bfx8*)(ap + 16 * ks);
            const bfx8 b0 = *(const bfx8*)(bp + 16 * ks);
            acc0 = __builtin_amdgcn_mfma_f32_32x32x16_bf16(b0, a, acc0, 0, 0, 0);
            if (MODE == 3) { const bfx8 b1 = *(const bfx8*)(bp + (size_t)128 * K + 16 * ks); acc1 = __builtin_amdgcn_mfma_f32_32x32x16_bf16(b1, a, acc1, 0, 0, 0); }
        }
        __syncthreads();
#pragma unroll
        for (int r = 0; r < 16; ++r) { red[(wave * 16 + r) * 64 + lane] = acc0[r]; if (MODE == 3) red[8192 + (wave * 16 + r) * 64 + lane] = acc1[r]; }
        __syncthreads();
        float v0[2], v1[2];
#pragma unroll
        for (int e = 0; e < 2; ++e) { float s0 = 0.f, s1 = 0.f;
#pragma unroll
            for (int w = 0; w < 8; ++w) { s0 += red[(w * 16 + 2 * wave + e) * 64 + lane]; if (MODE == 3) s1 += red[8192 + (w * 16 + 2 * wave + e) * 64 + lane]; }
            v0[e] = s0; v1[e] = s1; }
        const int reg = 2 * wave;
        const int col = 32 * ct + (reg & 3) + 8 * (reg >> 2) + 4 * hh;
        const size_t row = (size_t)(32 * rt + tl);
        float o0 = v0[0], o1 = v0[1];
        if (MODE == 1) { if (col < act_cols) { o0 = gelu_t(o0); o1 = gelu_t(o1); } }
        if (MODE == 2) { const unsigned y = *(const unsigned*)(Yv + row * ldy + col); o0 = bf_lo(y) * pg8::sigmoid_f(o0 + bias[col]); o1 = bf_hi(y) * pg8::sigmoid_f(o1 + bias[col + 1]); }
        if (MODE == 3) { o0 = pg8::silu_f(o0) * v1[0]; o1 = pg8::silu_f(o1) * v1[1]; }
        *(unsigned*)(O + row * ldc + col) = cvt_pk_bf16(o0, o1);
    }
    __syncthreads();
}
struct Args { const float* in[33]; float* out; unsigned char* ws; };
#ifndef PROBE
#define PROBE 0
#endif
#ifndef PH_LO
#define PH_LO 0
#endif
#ifndef PH_HI
#define PH_HI 14
#endif

__global__ void __launch_bounds__(NTHREADS, 2) fwd_kernel(Args args) {
    extern __shared__ __attribute__((aligned(16))) unsigned char lds_raw[];
    cg::grid_group grid = cg::this_grid();
    LAS unsigned char* lds = (LAS unsigned char*)lds_raw;
    Ctx C;
    if (threadIdx.x < 16) ((volatile LAS unsigned*)(lds + MISC_OFF))[threadIdx.x] = 0u;
    __syncthreads();
    (void)xcd_barrier_post((unsigned*)(C.ws() + WS_CTL), (volatile LAS unsigned*)(lds + MISC_OFF));
#define XBAR() do { XcdBarrier b_; b_.bar = (unsigned*)(C.ws() + WS_CTL); b_.x = xb_xcc_id(); b_.st = (volatile LAS unsigned*)(lds + MISC_OFF); xcd_barrier(b_); } while (0)
    grid.sync();
    { FTID; p0_prologue(C, lds, WAVE, LANE, TID); }
    XBAR();
    { const int stg = (BX >> 3) & 3;
    small_gemm<3>(lds, C.XN() + (size_t)MPROMPT * DM, C.Wgu1(), DFF, DM, C.H() + (size_t)MPROMPT * DFF, DFF, 0, nullptr, nullptr, 0, 0, stg);
    { pg8::Gemm g{C.XN(), C.Wgu1(), MPROMPT, 2 * DFF, DM}; pg8::StaticOrder S; S.init(MPROMPT, 2 * DFF, GSZ, BX); pg8::EpiSwiglu E{C.H(), DFF};
      pg8::gemm_phase<pg8::EpiSwiglu, pg8::StaticOrder, true, true>(lds, g, S, E); }
    small_gemm<3>(lds, C.XN() + (size_t)MPROMPT * DM, C.Wgu1(), DFF, DM, C.H() + (size_t)MPROMPT * DFF, DFF, 0, nullptr, nullptr, 0, stg, 4); }
    XBAR();
    { const int stg = (BX >> 3) & 3;
    small_gemm<0>(lds, C.H() + (size_t)MPROMPT * DFF, C.Wd1(), DM, DFF, C.D() + (size_t)MPROMPT * DM, DM, 0, nullptr, nullptr, 0, 0, stg);
    { pg8::Gemm g{C.H(), C.Wd1(), MPROMPT, DM, DFF}; pg8::StaticOrder S; S.init(MPROMPT, DM, GSZ, BX); pg8::EpiBf16<0> E{C.D(), DM, 0, nullptr, nullptr, 0};
      pg8::gemm_phase<pg8::EpiBf16<0>, pg8::StaticOrder, true, true>(lds, g, S, E); }
    small_gemm<0>(lds, C.H() + (size_t)MPROMPT * DFF, C.Wd1(), DM, DFF, C.D() + (size_t)MPROMPT * DM, DM, 0, nullptr, nullptr, 0, stg, 4); }
    XBAR();
    { FTID; const float* gp = C.in(8); for (int m = GWV; m < M; m += RR * NGWV) rows_res<RR, true, false>(C, m, NGWV, gp, 0.5f, LANE); }
    XBAR();
    { const int stg = (BX >> 3) & 3;
    small_gemm<1>(lds, C.XN() + (size_t)MPROMPT * DM, C.Win(), DIN, DM, C.Z() + (size_t)MPROMPT * DIN, DIN, 2 * AW, nullptr, nullptr, 0, 0, stg);
    { pg8::Gemm g{C.XN(), C.Win(), MPROMPT, DIN, DM}; pg8::StaticOrder S; S.init(MPROMPT, DIN, GSZ, BX); pg8::EpiBf16<1> E{C.Z(), DIN, 2 * AW, nullptr, nullptr, 0};
      pg8::gemm_phase<pg8::EpiBf16<1>, pg8::StaticOrder, true, true>(lds, g, S, E); }
    small_gemm<1>(lds, C.XN() + (size_t)MPROMPT * DM, C.Win(), DIN, DM, C.Z() + (size_t)MPROMPT * DIN, DIN, 2 * AW, nullptr, nullptr, 0, stg, 4); }
    XBAR();
    { FTID; for (int T = BX; T < NTILE - 1; T += GSZ) {
        s5_tile<false>(C, T, 0, 4, lds, WAVE, LANE);
        __syncthreads();
        gmlp_tile(C, T, lds, WAVE, LANE, TID);
    } }
    XBAR();
    { FTID; for (int T = BX; T < NTILE - 1; T += GSZ) s5_tile<true>(C, T, 0, 4, lds, WAVE, LANE);
      if (BX >= 1 && BX <= 4) s5_tile<true>(C, NTILE - 1, BX - 1, BX, lds, WAVE, LANE);
      if (BX == 0) { __syncthreads(); gmlp_tile(C, NTILE - 1, lds, WAVE, LANE, TID); } }
    XBAR();
    { const int stg = (BX >> 3) & 3;
    small_gemm<2>(lds, C.YB() + (size_t)MPROMPT * BWD, C.Wglu(), BWD, BWD, C.MIX() + (size_t)MPROMPT * DM + AW, DM, 0, C.in(23), C.YB() + (size_t)MPROMPT * BWD, BWD, 0, stg);
    { pg8::Gemm g{C.YB(), C.Wglu(), MPROMPT, BWD, BWD}; pg8::StaticOrder S; S.init(MPROMPT, BWD, GSZ, BX); pg8::EpiBf16<2> E{C.MIX() + AW, DM, 0, C.in(23), C.YB(), BWD};
      pg8::gemm_phase<pg8::EpiBf16<2>, pg8::StaticOrder, true, true>(lds, g, S, E); }
    small_gemm<2>(lds, C.YB() + (size_t)MPROMPT * BWD, C.Wglu(), BWD, BWD, C.MIX() + (size_t)MPROMPT * DM + AW, DM, 0, C.in(23), C.YB() + (size_t)MPROMPT * BWD, BWD, stg, 4); }
    XBAR();
    { FTID; const float* gb = C.in(25); for (int m = GWV; m < M; m += NGWV) row_norm512(C.MIX() + (size_t)m * DM + AW, gb, LANE); }
    XBAR();
    { const int stg = (BX >> 3) & 3;
    small_gemm<0>(lds, C.MIX() + (size_t)MPROMPT * DM, C.Wout(), DM, DM, C.D() + (size_t)MPROMPT * DM, DM, 0, nullptr, nullptr, 0, 0, stg);
    { pg8::Gemm g{C.MIX(), C.Wout(), MPROMPT, DM, DM}; pg8::StaticOrder S; S.init(MPROMPT, DM, GSZ, BX); pg8::EpiBf16<0> E{C.D(), DM, 0, nullptr, nullptr, 0};
      pg8::gemm_phase<pg8::EpiBf16<0>, pg8::StaticOrder, true, true>(lds, g, S, E); }
    small_gemm<0>(lds, C.MIX() + (size_t)MPROMPT * DM, C.Wout(), DM, DM, C.D() + (size_t)MPROMPT * DM, DM, 0, nullptr, nullptr, 0, stg, 4); }
    XBAR();
    { FTID; const float* gp = C.in(27); for (int m = GWV; m < M; m += RR * NGWV) rows_res<RR, false, false>(C, m, NGWV, gp, 1.0f, LANE); }
    XBAR();
    { const int stg = (BX >> 3) & 3;
    small_gemm<3>(lds, C.XN() + (size_t)MPROMPT * DM, C.Wgu2(), DFF, DM, C.H() + (size_t)MPROMPT * DFF, DFF, 0, nullptr, nullptr, 0, 0, stg);
    { pg8::Gemm g{C.XN(), C.Wgu2(), MPROMPT, 2 * DFF, DM}; pg8::StaticOrder S; S.init(MPROMPT, 2 * DFF, GSZ, BX); pg8::EpiSwiglu E{C.H(), DFF};
      pg8::gemm_phase<pg8::EpiSwiglu, pg8::StaticOrder, true, true>(lds, g, S, E); }
    small_gemm<3>(lds, C.XN() + (size_t)MPROMPT * DM, C.Wgu2(), DFF, DM, C.H() + (size_t)MPROMPT * DFF, DFF, 0, nullptr, nullptr, 0, stg, 4); }
    XBAR();
    { const int stg = (BX >> 3) & 3;
    small_gemm<0>(lds, C.H() + (size_t)MPROMPT * DFF, C.Wd2(), DM, DFF, C.D() + (size_t)MPROMPT * DM, DM, 0, nullptr, nullptr, 0, 0, stg);
    { pg8::Gemm g{C.H(), C.Wd2(), MPROMPT, DM, DFF}; pg8::StaticOrder S; S.init(MPROMPT, DM, GSZ, BX); pg8::EpiBf16<0> E{C.D(), DM, 0, nullptr, nullptr, 0};
      pg8::gemm_phase<pg8::EpiBf16<0>, pg8::StaticOrder, true, true>(lds, g, S, E); }
    small_gemm<0>(lds, C.H() + (size_t)MPROMPT * DFF, C.Wd2(), DM, DFF, C.D() + (size_t)MPROMPT * DM, DM, 0, nullptr, nullptr, 0, stg, 4); }
    XBAR();
    { FTID; const float* gp = C.in(32); for (int m = GWV; m < M; m += RR * NGWV) rows_res<RR, false, true>(C, m, NGWV, gp, 0.5f, LANE); }
}

extern "C" void kernel_launch(void* const* d_in, const int* in_sizes, int n_in, void* d_out, int out_size, void* d_ws, size_t ws_size, hipStream_t stream) {
    static int grid = 0;
    if (grid == 0) {
        if (n_in != 33 || ws_size < WS_END) { fprintf(stderr, "kernel_launch: unexpected n_in %d / ws %zu\n", n_in, ws_size); grid = -1; return; }
        int dev = 0, cus = 0, per_cu = 0;
        hipGetDevice(&dev);
        hipDeviceGetAttribute(&cus, hipDeviceAttributeMultiprocessorCount, dev);
        hipFuncSetAttribute((const void*)fwd_kernel, hipFuncAttributeMaxDynamicSharedMemorySize, LDS_BYTES);
        hipOccupancyMaxActiveBlocksPerMultiprocessor(&per_cu, (const void*)fwd_kernel, NTHREADS, LDS_BYTES);
        if (per_cu < 1) { fprintf(stderr, "kernel_launch: occupancy query says %d blocks per CU\n", per_cu); per_cu = 1; }
        grid = cus * per_cu;
    }
    if (grid < 0) return;
    if (hipMemsetAsync((char*)d_ws + WS_CTL, 0, CTL_ZERO_BYTES, stream) != hipSuccess) { fprintf(stderr, "memset failed\n"); return; }
    Args a{};
    for (int i = 0; i < 33; ++i) a.in[i] = (const float*)d_in[i];
    a.out = (float*)d_out; a.ws = (unsigned char*)d_ws;
    void* params[] = {&a};
    hipError_t e = hipLaunchCooperativeKernel((const void*)fwd_kernel, dim3(grid), dim3(NTHREADS), params, LDS_BYTES, stream);
    if (e != hipSuccess) fprintf(stderr, "cooperative launch failed: %s (grid %d)\n", hipGetErrorString(e), grid);
}
```

```cpp
#include <hip/hip_runtime.h>
#include <hip/hip_cooperative_groups.h>
#include <cstdio>
#include <cstdint>
namespace cg = cooperative_groups;
__device__ __forceinline__ int fresh_tid() { int t = (int)threadIdx.x; asm volatile("" : "+v"(t)); return t; }
namespace pg8 {
#define PG8_LAS __attribute__((address_space(3)))
typedef unsigned short bf16_t;
typedef short bf16x8 __attribute__((ext_vector_type(8)));
typedef float f32x4 __attribute__((ext_vector_type(4)));
typedef unsigned u32x4 __attribute__((ext_vector_type(4)));
constexpr int BM = 256, BK = 64, HALF = 128, HTB = HALF * BK * 2  , STAGE_BYTES = 8 * HTB, NXCD = 8, WGM = 8;

__host__ __device__ __forceinline__ int lds_byte(int r, int c) { const int st = (r >> 4) * 2 + (c >> 5), rr = r & 15, cc = c & 31, ob = rr * 64 + cc * 2; return st * 1024 + (ob ^ (((ob >> 9) & 1) << 5)); }
__host__ __device__ __forceinline__ void stage_rc(int b, int& R, int& C) { const int st = b / 1024, sb = b % 1024, swz = sb ^ (((sb >> 9) & 1) << 5); R = (st >> 1) * 16 + swz / 64; C = (st & 1) * 32 + (swz % 64) / 2; }
__host__ __device__ __forceinline__ int perm32(int rho) { const int n = rho >> 4, i = rho & 15; return 8 * (i >> 2) + 4 * n + (i & 3); }

struct Unit { int pm, pn; };
struct Gemm { const bf16_t* A; const bf16_t* Bt; int M, N, K; };

struct StaticOrder {
    int nM, nN, nwg, G, c;
    __host__ __device__ void init(int M, int N, int G_, int c_) { nM = M / BM; nN = N / BM; nwg = nM * nN; G = G_; c = c_; }
    __host__ __device__ bool next(int i, Unit& u) const {
        const long L = (long)i * G + c; if (L >= nwg) return false;
        int wgid = (int)L; { const int q = nwg / NXCD, r = nwg % NXCD, xcd = wgid % NXCD, off = wgid / NXCD; wgid = (xcd < r ? xcd * (q + 1) : r * (q + 1) + (xcd - r) * q) + off; }
        const int nig = WGM * nN, gid = wgid / nig, fm = gid * WGM, gsz = (nM - fm) < WGM ? (nM - fm) : WGM;
        u.pm = fm + ((wgid % nig) % gsz); u.pn = (wgid % nig) / gsz; return true;
    }
    __device__ __forceinline__ void a_ready(const Unit&) const {}
    __device__ __forceinline__ void done(const Unit&) const {}
};

__device__ __forceinline__ unsigned cvt_pk_bf16(float lo, float hi) { unsigned r; asm volatile("v_cvt_pk_bf16_f32 %0, %1, %2" : "=v"(r) : "v"(lo), "v"(hi)); return r; }
__device__ __forceinline__ float bf_lo(unsigned w) { return __uint_as_float(w << 16); }
__device__ __forceinline__ float bf_hi(unsigned w) { return __uint_as_float(w & 0xffff0000u); }
__device__ __forceinline__ float sigmoid_f(float x) { return __builtin_amdgcn_rcpf(1.0f + __expf(-x)); }
__device__ __forceinline__ float silu_f(float x) { return x * sigmoid_f(x); }
__device__ __forceinline__ float gelu_t(float x) { const float u = 1.5957691216057308f * (x + 0.044715f * x * x * x); return x * sigmoid_f(u); }

struct EpiSwiglu {
    static constexpr bool PERM = true, AFTER_DRAIN = false;
    bf16_t* O; int ldc;
    __device__ __forceinline__ void operator()(const f32x4 (&acc)[2][2][4][2], const Unit& u, int wr, int wc, int fr, int fq) const {
        const int row0 = u.pm * BM + wr * 64 + fr; const int col0 = u.pn * HALF + wc * 32 + 8 * fq;
#pragma unroll
        for (int ai = 0; ai < 2; ++ai)
#pragma unroll
            for (int m = 0; m < 4; ++m) {
                bf16_t* rowp = O + (size_t)(row0 + ai * HALF + m * 16) * ldc + col0;
                const f32x4 g0 = acc[ai][0][m][0], g1 = acc[ai][0][m][1], u0 = acc[ai][1][m][0], u1 = acc[ai][1][m][1];
                u32x4 w;
                w.x = cvt_pk_bf16(silu_f(g0[0]) * u0[0], silu_f(g0[1]) * u0[1]); w.y = cvt_pk_bf16(silu_f(g0[2]) * u0[2], silu_f(g0[3]) * u0[3]);
                w.z = cvt_pk_bf16(silu_f(g1[0]) * u1[0], silu_f(g1[1]) * u1[1]); w.w = cvt_pk_bf16(silu_f(g1[2]) * u1[2], silu_f(g1[3]) * u1[3]);
                *(u32x4*)rowp = w;
            }
    }
};
template <int MODE> struct EpiBf16 {
    static constexpr bool PERM = true, AFTER_DRAIN = false;
    bf16_t* O; int ldc; int act_cols; const float* bias; const bf16_t* Y; int ldy;
    __device__ __forceinline__ void operator()(const f32x4 (&acc)[2][2][4][2], const Unit& u, int wr, int wc, int fr, int fq) const {
        const int row0 = u.pm * BM + wr * 64 + fr; const int col0 = u.pn * BM + wc * 32 + 8 * fq;
#pragma unroll
        for (int bj = 0; bj < 2; ++bj) {
            const int col = col0 + bj * HALF;
            f32x4 b0 = (f32x4){0.f, 0.f, 0.f, 0.f}, b1 = b0;
            if (MODE == 2) { b0 = *(const f32x4*)(bias + col); b1 = *(const f32x4*)(bias + col + 4); }
            const bool act = (MODE == 1) && (col < act_cols);
#pragma unroll
            for (int ai = 0; ai < 2; ++ai)
#pragma unroll
                for (int m = 0; m < 4; ++m) {
                    const size_t row = (size_t)(row0 + ai * HALF + m * 16);
                    f32x4 v0 = acc[ai][bj][m][0], v1 = acc[ai][bj][m][1];
                    if (MODE == 1) { if (act) {
#pragma unroll
                        for (int j = 0; j < 4; ++j) { v0[j] = gelu_t(v0[j]); v1[j] = gelu_t(v1[j]); } } }
                    if (MODE == 2) {
                        const u32x4 y = *(const u32x4*)(Y + row * ldy + col);
                        v0 = v0 + b0; v1 = v1 + b1;
                        v0[0] = bf_lo(y.x) * sigmoid_f(v0[0]); v0[1] = bf_hi(y.x) * sigmoid_f(v0[1]); v0[2] = bf_lo(y.y) * sigmoid_f(v0[2]); v0[3] = bf_hi(y.y) * sigmoid_f(v0[3]);
                        v1[0] = bf_lo(y.z) * sigmoid_f(v1[0]); v1[1] = bf_hi(y.z) * sigmoid_f(v1[1]); v1[2] = bf_lo(y.w) * sigmoid_f(v1[2]); v1[3] = bf_hi(y.w) * sigmoid_f(v1[3]);
                    }
                    u32x4 w; w.x = cvt_pk_bf16(v0[0], v0[1]); w.y = cvt_pk_bf16(v0[2], v0[3]); w.z = cvt_pk_bf16(v1[0], v1[1]); w.w = cvt_pk_bf16(v1[2], v1[3]);
                    *(u32x4*)(O + row * ldc + col) = w;
                }
        }
    }
};

struct EpiNull {
    static constexpr bool PERM = true, AFTER_DRAIN = false;
    bf16_t* O;
    __device__ __forceinline__ void operator()(const f32x4 (&acc)[2][2][4][2], const Unit& u, int wr, int wc, int fr, int fq) const {
        float s = 0.f;
#pragma unroll
        for (int ai = 0; ai < 2; ++ai)
#pragma unroll
            for (int bj = 0; bj < 2; ++bj)
#pragma unroll
                for (int m = 0; m < 4; ++m)
#pragma unroll
                    for (int n = 0; n < 2; ++n) s += (acc[ai][bj][m][n][0] + acc[ai][bj][m][n][1]) + (acc[ai][bj][m][n][2] + acc[ai][bj][m][n][3]);
        if (s == 12345.678f) O[u.pm + wr + wc + fr + fq] = 1;
    }
};
template <int P> struct EpiSwigluP {
    static constexpr bool PERM = true, AFTER_DRAIN = false;
    bf16_t* O; int ldc;
    __device__ __forceinline__ void operator()(const f32x4 (&acc)[2][2][4][2], const Unit& u, int wr, int wc, int fr, int fq) const {
        const int row0 = u.pm * BM + wr * 64 + fr; const int col0 = u.pn * HALF + wc * 32 + 8 * fq;
#pragma unroll
        for (int ai = 0; ai < 2; ++ai)
#pragma unroll
            for (int m = 0; m < 4; ++m) {
                bf16_t* rowp = O + (size_t)(row0 + ai * HALF + m * 16) * ldc + col0;
                const f32x4 g0 = acc[ai][0][m][0], g1 = acc[ai][0][m][1], u0 = acc[ai][1][m][0], u1 = acc[ai][1][m][1];
                u32x4 w;
                if (P == 1) {
                    w.x = cvt_pk_bf16(silu_f(g0[0]) * u0[0], silu_f(g0[1]) * u0[1]); w.y = cvt_pk_bf16(silu_f(g0[2]) * u0[2], silu_f(g0[3]) * u0[3]);
                    w.z = cvt_pk_bf16(silu_f(g1[0]) * u1[0], silu_f(g1[1]) * u1[1]); w.w = cvt_pk_bf16(silu_f(g1[2]) * u1[2], silu_f(g1[3]) * u1[3]);
                    if ((w.x ^ w.y ^ w.z ^ w.w) == 0x12345678u) *(u32x4*)rowp = w;
                } else {
                    w.x = cvt_pk_bf16(g0[0] + u0[0], g0[1] + u0[1]); w.y = cvt_pk_bf16(g0[2] + u0[2], g0[3] + u0[3]);
                    w.z = cvt_pk_bf16(g1[0] + u1[0], g1[1] + u1[1]); w.w = cvt_pk_bf16(g1[2] + u1[2], g1[3] + u1[3]);
                    *(u32x4*)rowp = w;
                }
            }
    }
};
template <class Epi, class Sched, bool ALIGN_EPI = false, bool SP2 = false>
__device__ __forceinline__ void gemm_phase(PG8_LAS unsigned char* lds, const Gemm g, const Sched& S, const Epi& E) {
    const int tid = fresh_tid(), wid = __builtin_amdgcn_readfirstlane(tid >> 6), lane = tid & 63, wr = wid >> 2, wc = wid & 3, fr = lane & 15, fq = lane >> 4;
    const int K = g.K, nt = K / BK;
    unsigned voffA[2], voffB[2];
#pragma unroll
    for (int i = 0; i < 2; ++i) { int R, C; stage_rc(tid * 16 + i * 8192, R, C); const int Rb = Epi::PERM ? ((R & ~31) + perm32(R & 31)) : R;
        voffA[i] = (unsigned)(R * K + C) * 2u; voffB[i] = (unsigned)(Rb * K + C) * 2u; }
    const size_t kstep = (size_t)(BK * 2);
    const size_t hstep = (size_t)HALF * K * 2;
    const size_t tstep = 2 * hstep;
    const unsigned ldsw = (unsigned)wid * 1024u;
    const int aoff = lds_byte(wr * 64 + fr, fq * 8), boff = lds_byte(wc * 32 + fr, fq * 8);
#define PG8_SA(b, h) (((b) * 2 + (h)) * HTB)
#define PG8_SB(b, h) ((4 + (b) * 2 + (h)) * HTB)
#define PG8_STAGE(bufoff, gbase, voff) do { _Pragma("unroll") for (int _i = 0; _i < 2; ++_i) \
        __builtin_amdgcn_global_load_lds((const unsigned*)((const char*)(gbase) + (voff)[_i]), (PG8_LAS unsigned*)(lds + (bufoff) + ldsw + _i * 8192), 16, 0, 0); } while (0)
#define PG8_LDA(dst, b, h) do { _Pragma("unroll") for (int m = 0; m < 4; ++m) _Pragma("unroll") for (int k = 0; k < 2; ++k) dst[m][k] = *(const PG8_LAS bf16x8*)(lds + PG8_SA(b, h) + aoff + m * 2048 + k * 1024); } while (0)
#define PG8_LDB(dst, b, h) do { _Pragma("unroll") for (int n = 0; n < 2; ++n) _Pragma("unroll") for (int k = 0; k < 2; ++k) dst[n][k] = *(const PG8_LAS bf16x8*)(lds + PG8_SB(b, h) + boff + n * 2048 + k * 1024); } while (0)
#define PG8_MMA(ai, bj, At, Bt) do { __builtin_amdgcn_s_setprio(1); _Pragma("unroll") for (int m = 0; m < 4; ++m) _Pragma("unroll") for (int n = 0; n < 2; ++n) _Pragma("unroll") for (int k = 0; k < 2; ++k) \
        acc[ai][bj][m][n] = __builtin_amdgcn_mfma_f32_16x16x32_bf16(Bt[n][k], At[m][k], acc[ai][bj][m][n], 0, 0, 0); __builtin_amdgcn_s_setprio(0); } while (0)
#define PG8_WAIT_V(n) asm volatile("s_waitcnt vmcnt(" #n ")" ::: "memory")
#define PG8_WAIT_L(n) asm volatile("s_waitcnt lgkmcnt(" #n ")" ::: "memory")
#define PG8_BAR __builtin_amdgcn_s_barrier()
#define PG8_SCHED __builtin_amdgcn_sched_barrier(0)
    Unit cur, nxt; int ui = 0;
    if (!S.next(0, cur)) return;
    f32x4 acc[2][2][4][2];
#pragma unroll
    for (int a = 0; a < 2; ++a)
#pragma unroll
        for (int b = 0; b < 2; ++b)
#pragma unroll
            for (int m = 0; m < 4; ++m)
#pragma unroll
                for (int n = 0; n < 2; ++n) acc[a][b][m][n] = (f32x4){0.f, 0.f, 0.f, 0.f};
    bf16x8 At[4][2], B0[2][2], B1[2][2];
    const char* cA = (const char*)g.A + (size_t)cur.pm * tstep; const char* cB = (const char*)g.Bt + (size_t)cur.pn * tstep;
    S.a_ready(cur);
    if constexpr (SP2) {
        PG8_STAGE(PG8_SB(0, 0), cB, voffB); PG8_STAGE(PG8_SB(0, 1), cB + hstep, voffB); PG8_STAGE(PG8_SA(0, 0), cA, voffA); PG8_STAGE(PG8_SA(0, 1), cA + hstep, voffA);
        if (wr == 1) PG8_BAR;
        PG8_WAIT_V(2); PG8_BAR;
        PG8_STAGE(PG8_SB(1, 0), cB + kstep, voffB); PG8_STAGE(PG8_SA(1, 0), cA + kstep, voffA); PG8_STAGE(PG8_SB(1, 1), cB + hstep + kstep, voffB);
        PG8_WAIT_V(6); PG8_BAR;
    } else {
        PG8_STAGE(PG8_SB(0, 0), cB, voffB); PG8_STAGE(PG8_SA(0, 0), cA, voffA); PG8_STAGE(PG8_SB(0, 1), cB + hstep, voffB); PG8_STAGE(PG8_SA(0, 1), cA + hstep, voffA);
        if (wr == 1) PG8_BAR;
        PG8_WAIT_V(4); PG8_BAR;
        PG8_STAGE(PG8_SB(1, 0), cB + kstep, voffB); PG8_STAGE(PG8_SA(1, 0), cA + kstep, voffA); PG8_STAGE(PG8_SB(1, 1), cB + hstep + kstep, voffB);
        PG8_WAIT_V(6); PG8_BAR;
    }
    for (;;) {
        const bool has_next = S.next(ui + 1, nxt);
        const char* nA = has_next ? (const char*)g.A + (size_t)nxt.pm * tstep : cA; const char* nB = has_next ? (const char*)g.Bt + (size_t)nxt.pn * tstep : cB;
        for (int t = 0; t < nt; t += 2) {
            const bool last = (t == nt - 2);
            const char* a1 = cA + (size_t)(t + 1) * kstep;
            const char* a2 = last ? nA : cA + (size_t)(t + 2) * kstep; const char* b2 = last ? nB : cB + (size_t)(t + 2) * kstep;
            const char* a3 = a2 + kstep; const char* b3 = b2 + kstep;
            if (last && has_next) S.a_ready(nxt);
            if constexpr (SP2) {
            PG8_LDB(B0, 0, 0); PG8_LDB(B1, 0, 1); PG8_SCHED; PG8_LDA(At, 0, 0); PG8_STAGE(PG8_SA(1, 1), a1 + hstep, voffA);
            PG8_WAIT_V(8); PG8_WAIT_L(0); PG8_BAR; PG8_MMA(0, 0, At, B0); PG8_MMA(0, 1, At, B1); PG8_BAR; PG8_SCHED;
            PG8_LDA(At, 0, 1); PG8_STAGE(PG8_SB(0, 0), b2, voffB); PG8_STAGE(PG8_SB(0, 1), b2 + hstep, voffB); PG8_STAGE(PG8_SA(0, 0), a2, voffA);
            PG8_WAIT_V(8); PG8_WAIT_L(0); PG8_BAR; PG8_MMA(1, 0, At, B0); PG8_MMA(1, 1, At, B1); PG8_BAR; PG8_SCHED;
            PG8_LDB(B0, 1, 0); PG8_LDB(B1, 1, 1); PG8_SCHED; PG8_LDA(At, 1, 0); PG8_STAGE(PG8_SA(0, 1), a2 + hstep, voffA);
            PG8_WAIT_V(8); PG8_WAIT_L(0); PG8_BAR; PG8_MMA(0, 0, At, B0); PG8_MMA(0, 1, At, B1); PG8_BAR; PG8_SCHED;
            PG8_LDA(At, 1, 1); PG8_STAGE(PG8_SB(1, 0), b3, voffB); PG8_STAGE(PG8_SB(1, 1), b3 + hstep, voffB); PG8_STAGE(PG8_SA(1, 0), a3, voffA);
            PG8_WAIT_V(8); PG8_WAIT_L(0); PG8_BAR; PG8_MMA(1, 0, At, B0); PG8_MMA(1, 1, At, B1); PG8_BAR; PG8_SCHED;
            } else {
            PG8_LDB(B0, 0, 0); PG8_SCHED; PG8_LDA(At, 0, 0); PG8_STAGE(PG8_SA(1, 1), a1 + hstep, voffA);
            PG8_WAIT_L(8); PG8_BAR; PG8_WAIT_L(0); PG8_MMA(0, 0, At, B0); PG8_BAR; PG8_SCHED;
            PG8_LDB(B1, 0, 1); PG8_STAGE(PG8_SB(0, 0), b2, voffB);
            PG8_BAR; PG8_WAIT_L(0); PG8_MMA(0, 1, At, B1); PG8_BAR;
            PG8_LDA(At, 0, 1); PG8_STAGE(PG8_SA(0, 0), a2, voffA);
            PG8_BAR; PG8_WAIT_L(0); PG8_MMA(1, 0, At, B0); PG8_BAR; PG8_SCHED;
            PG8_STAGE(PG8_SB(0, 1), b2 + hstep, voffB);
            PG8_WAIT_V(6); PG8_BAR; PG8_MMA(1, 1, At, B1); PG8_BAR;
            PG8_LDB(B0, 1, 0); PG8_SCHED; PG8_LDA(At, 1, 0); PG8_STAGE(PG8_SA(0, 1), a2 + hstep, voffA);
            PG8_WAIT_L(8); PG8_BAR; PG8_WAIT_L(0); PG8_MMA(0, 0, At, B0); PG8_BAR; PG8_SCHED;
            PG8_LDB(B1, 1, 1); PG8_STAGE(PG8_SB(1, 0), b3, voffB);
            PG8_BAR; PG8_WAIT_L(0); PG8_MMA(0, 1, At, B1); PG8_BAR;
            PG8_LDA(At, 1, 1); PG8_STAGE(PG8_SA(1, 0), a3, voffA);
            PG8_BAR; PG8_WAIT_L(0); PG8_MMA(1, 0, At, B0); PG8_BAR; PG8_SCHED;
            PG8_STAGE(PG8_SB(1, 1), b3 + hstep, voffB);
            PG8_WAIT_V(6); PG8_BAR; PG8_MMA(1, 1, At, B1); PG8_BAR;
            }
        }
        if constexpr (ALIGN_EPI) { if (wr == 0) PG8_BAR; }
        if constexpr (!Epi::AFTER_DRAIN) { E(acc, cur, wr, wc, fr, fq); S.done(cur); }
        if (!has_next) break;
#pragma unroll
        for (int a = 0; a < 2; ++a)
#pragma unroll
            for (int b = 0; b < 2; ++b)
#pragma unroll
                for (int m = 0; m < 4; ++m)
#pragma unroll
                    for (int n = 0; n < 2; ++n) acc[a][b][m][n] = (f32x4){0.f, 0.f, 0.f, 0.f};
        cur = nxt; cA = nA; cB = nB; ++ui;
        if constexpr (ALIGN_EPI) { if (wr == 1) PG8_BAR; }
    }
    PG8_WAIT_V(0);
    if constexpr (!ALIGN_EPI) { if (wr == 0) PG8_BAR; }
    PG8_BAR;
    if constexpr (Epi::AFTER_DRAIN) { E.fused(acc, cur, wr, wc, fr, fq, lds, wid, lane); S.done(cur); }
#undef PG8_SA
#undef PG8_SB
#undef PG8_STAGE
#undef PG8_LDA
#undef PG8_LDB
#undef PG8_MMA
#undef PG8_WAIT_V
#undef PG8_WAIT_L
#undef PG8_BAR
#undef PG8_SCHED
}
}

constexpr int DM = 1024, SEQ = 16384, NBATCH = 2, MPROMPT = NBATCH * SEQ, DEC_B = 8, DEC_S = 16;
constexpr int M = MPROMPT + DEC_B * DEC_S;
constexpr int MPAD = 33024;
constexpr int DFF = 2816, DIN = 1536, AW = 512, BWD = 512, NG = 32, NP = 64, GN = 16;
constexpr int NTILE = M / 128;
constexpr float EPS = 1e-6f;
constexpr int NWAVES = 8, NTHREADS = 512;

constexpr size_t MiB = 1u << 20;
constexpr size_t WS_WGU1 = 1 * MiB, WS_WD1 = 12 * MiB, WS_WIN = 18 * MiB, WS_WGLU = 21 * MiB, WS_WOUT = 22 * MiB, WS_WGU2 = 24 * MiB, WS_WD2 = 35 * MiB;
constexpr size_t WS_WEFF = 41 * MiB, WS_BB = 42 * MiB, WS_CM = 42 * MiB + 131072, WS_LAM = 42 * MiB + 262144, WS_RS = 42 * MiB + 524288, WS_E = 43 * MiB;
constexpr size_t WS_XN = 48 * MiB, WS_D = 113 * MiB, WS_H = 178 * MiB, WS_Z = 178 * MiB, WS_YB = 275 * MiB, WS_MIX = 356 * MiB, WS_END = 421 * MiB;
static_assert(WS_XN + (size_t)MPAD * DM * 2 <= WS_D && WS_D + (size_t)MPAD * DM * 2 <= WS_H && WS_H + (size_t)MPAD * DFF * 2 <= WS_MIX, "ws map");
static_assert(WS_Z + (size_t)MPAD * DIN * 2 <= WS_YB && WS_YB + (size_t)MPAD * BWD * 2 <= WS_H + (size_t)MPAD * DFF * 2 && WS_MIX + (size_t)MPAD * DM * 2 <= WS_END, "ws map 2");
static_assert(WS_E + (size_t)NTILE * NG * NP * 8 <= WS_XN, "ws map 3");

constexpr size_t OFF_Y = 0, OFF_SRE_P = (size_t)M * DM, OFF_SIM_P = OFF_SRE_P + NBATCH * NG * NP, OFF_SRE_S = OFF_SIM_P + NBATCH * NG * NP,
                 OFF_SIM_S = OFF_SRE_S + DEC_B * NG * NP, OFF_V_S = OFF_SIM_S + DEC_B * NG * NP;

constexpr int OT_STRIDE = 520;
constexpr int VT_STRIDE = 136;
constexpr int LDS_BYTES = 147456;
static_assert(128 * VT_STRIDE * 2 + 4096 <= LDS_BYTES - 64 && 128 * OT_STRIDE * 2 <= LDS_BYTES - 64, "lds map");

#define LAS __attribute__((address_space(3)))
typedef unsigned short bf16;
typedef float v4f __attribute__((ext_vector_type(4)));
typedef float v2f __attribute__((ext_vector_type(2)));
typedef float v16f __attribute__((ext_vector_type(16)));
typedef unsigned v4u __attribute__((ext_vector_type(4)));
typedef unsigned v2u __attribute__((ext_vector_type(2)));
typedef short bfx8 __attribute__((ext_vector_type(8)));
#define LDS_FENCE() asm volatile("s_waitcnt lgkmcnt(0)" ::: "memory")

using pg8::cvt_pk_bf16; using pg8::bf_lo; using pg8::bf_hi; using pg8::gelu_t;

__device__ __forceinline__ float wave_sum(float v) {
#pragma unroll
    for (int o = 1; o < 64; o <<= 1) v += __shfl_xor(v, o);
    return v;
}
typedef __bf16 bf16x2_t __attribute__((ext_vector_type(2)));
__device__ __forceinline__ unsigned cvt_pk_c(float lo, float hi) { const v2f v = {lo, hi}; const bf16x2_t b = __builtin_convertvector(v, bf16x2_t); return __builtin_bit_cast(unsigned, b); }
__device__ __forceinline__ unsigned cvt_pk_nv(float lo, float hi) { unsigned r; asm("v_cvt_pk_bf16_f32 %0, %1, %2" : "=v"(r) : "v"(lo), "v"(hi)); return r; }
__device__ __forceinline__ bf16 f2bf(float f) { return (bf16)(cvt_pk_nv(f, 0.f) & 0xffffu); }


__device__ __forceinline__ double dexp(double x) {
    const double y = x * (1.0 / 256.0); double t = 1.0;
#pragma unroll
    for (int i = 12; i >= 1; --i) t = 1.0 + t * y * (1.0 / (double)i);
#pragma unroll
    for (int i = 0; i < 8; ++i) t = t * t;
    return t;
}
__device__ __forceinline__ void dsincos(double x, double& s, double& c) {
    const double twopi = 6.283185307179586476925286766559;
    const double k = rint(x * (1.0 / twopi)); const double r = x - k * twopi, r2 = r * r;
    double ts = r, tc = 1.0; s = r; c = 1.0;
#pragma unroll
    for (int i = 1; i <= 15; ++i) { tc = -tc * r2 * (1.0 / (double)((2 * i - 1) * (2 * i))); ts = -ts * r2 * (1.0 / (double)((2 * i) * (2 * i + 1))); c += tc; s += ts; }
}

typedef const float* cfp_t;
typedef __attribute__((address_space(4))) cfp_t const* kin_t;
__device__ __forceinline__ const float* karg_in(int i) {
    auto k = __builtin_amdgcn_kernarg_segment_ptr();
    asm volatile("" : "+s"(k));
    return ((kin_t)k)[i];
}
struct Ctx {
    __device__ __forceinline__ const float* in(int i) const { return karg_in(i); }
    __device__ __forceinline__ float* out() const { return (float*)karg_in(33); }
    __device__ __forceinline__ unsigned char* ws() const { return (unsigned char*)karg_in(34); }
#define WSP(name, T, off) __device__ __forceinline__ T* name() const { return (T*)(ws() + (off)); }
    WSP(Wgu1, bf16, WS_WGU1) WSP(Wd1, bf16, WS_WD1) WSP(Win, bf16, WS_WIN) WSP(Wglu, bf16, WS_WGLU) WSP(Wout, bf16, WS_WOUT) WSP(Wgu2, bf16, WS_WGU2) WSP(Wd2, bf16, WS_WD2)
    WSP(Weff, bf16, WS_WEFF) WSP(BB, bf16, WS_BB) WSP(CM, bf16, WS_CM) WSP(XN, bf16, WS_XN) WSP(D, bf16, WS_D) WSP(H, bf16, WS_H) WSP(Z, bf16, WS_Z) WSP(YB, bf16, WS_YB) WSP(MIX, bf16, WS_MIX)
    WSP(LAM, float, WS_LAM) WSP(E, float, WS_E) WSP(RS, float, WS_RS)
#undef WSP
};

__device__ __forceinline__ void p0_block_item(const float* W, const float* gk, int K, int N, bf16* WT, int mode, int item, LAS float* tile, int tid) {
    const int nblk = N / 256, kb = item / nblk, nb = item % nblk, k0 = 64 * kb, n0 = 256 * nb;
    const int lr = tid >> 6, lc = 4 * (tid & 63);
    v4f v[8];
#pragma unroll
    for (int i = 0; i < 8; ++i) v[i] = *(const v4f*)(W + (size_t)(k0 + lr + 8 * i) * N + n0 + lc);
    if (gk) {
#pragma unroll
        for (int i = 0; i < 8; ++i) v[i] = v[i] * gk[k0 + lr + 8 * i];
    }
    __syncthreads();
#pragma unroll
    for (int i = 0; i < 8; ++i) { LAS float* p = tile + (lr + 8 * i) * 257 + lc; p[0] = v[i].x; p[1] = v[i].y; p[2] = v[i].z; p[3] = v[i].w; }
    __syncthreads();
    const int c = tid & 7;
#pragma unroll
    for (int j = 0; j < 4; ++j) {
        const int n = (tid >> 3) + 64 * j, ng = n0 + n;
        const int drow = (mode == 0) ? ng : (256 * (ng >> 7) + (ng & 127) + (mode == 2 ? 128 : 0));
        const LAS float* sp = tile + (8 * c) * 257 + n;
        v4u o; o.x = cvt_pk_nv(sp[0 * 257], sp[1 * 257]); o.y = cvt_pk_nv(sp[2 * 257], sp[3 * 257]); o.z = cvt_pk_nv(sp[4 * 257], sp[5 * 257]); o.w = cvt_pk_nv(sp[6 * 257], sp[7 * 257]);
        *(v4u*)(WT + (size_t)drow * K + k0 + 8 * c) = o;
    }
}
__device__ __forceinline__ const float* xrow_ptr(const Ctx& C, int row) { return row < MPROMPT ? C.in(0) + (size_t)row * DM : C.in(1) + (size_t)(row - MPROMPT) * DM; }

__device__ __forceinline__ v4f ld4_f32(const float* p) { return *(const v4f*)p; }
__device__ __forceinline__ v4f ld4_bf16(const bf16* p) { const v2u w = *(const v2u*)p; return (v4f){bf_lo(w.x), bf_hi(w.x), bf_lo(w.y), bf_hi(w.y)}; }
__device__ __forceinline__ void st4_bf16(bf16* p, v4f o) { v2u w; w.x = cvt_pk_nv(o.x, o.y); w.y = cvt_pk_nv(o.z, o.w); *(v2u*)p = w; }
__device__ __forceinline__ float ssq4(v4f v) { return (v.x * v.x + v.y * v.y) + (v.z * v.z + v.w * v.w); }
template <int R>
__device__ __forceinline__ void rows_x0(const Ctx& C, int m0, int stride, int mx, int lane) {
    v4f v[R][4]; float ss[R]; int mr[R]; bool ok[R];
#pragma unroll
    for (int r = 0; r < R; ++r) { mr[r] = (r == 4) ? mx : m0 + r * stride; ok[r] = (r == 4) ? (mx < M) : (mr[r] < MPROMPT); const float* x = xrow_ptr(C, ok[r] ? mr[r] : 0);
#pragma unroll
        for (int j = 0; j < 4; ++j) v[r][j] = ld4_f32(x + 4 * lane + 256 * j); }
    bf16* XN = C.XN();
#pragma unroll
    for (int r = 0; r < R; ++r) { float s = 0.f;
#pragma unroll
        for (int j = 0; j < 4; ++j) s += ssq4(v[r][j]);
        ss[r] = s; }
#pragma unroll
    for (int r = 0; r < R; ++r) ss[r] = rsqrtf(wave_sum(ss[r]) * (1.f / DM) + EPS);
#pragma unroll
    for (int r = 0; r < R; ++r)
#pragma unroll
        for (int j = 0; j < 4; ++j) if (ok[r]) st4_bf16(XN + (size_t)mr[r] * DM + 4 * lane + 256 * j, v[r][j] * ss[r]);
}
template <int R, bool BASE_F32, bool OUT_F32>
__device__ __forceinline__ void rows_res(const Ctx& C, int m0, int stride, int mx, const float* gpost, float scale, int lane) {
    v4f d[R][4], b[R][4]; int mr[R]; bool ok[R]; float r1[R];
    const bf16* D = C.D(); bf16* XN = C.XN();
#pragma unroll
    for (int r = 0; r < R; ++r) { mr[r] = (r == 4) ? mx : m0 + r * stride; ok[r] = (r == 4) ? (mx < M) : (mr[r] < MPROMPT); const int mm = ok[r] ? mr[r] : 0;
#pragma unroll
        for (int j = 0; j < 4; ++j) d[r][j] = ld4_bf16(D + (size_t)mm * DM + 4 * lane + 256 * j);
        if (BASE_F32) { const float* x = xrow_ptr(C, mm);
#pragma unroll
            for (int j = 0; j < 4; ++j) b[r][j] = ld4_f32(x + 4 * lane + 256 * j);
        } else { const float inv = C.RS()[mm];
#pragma unroll
            for (int j = 0; j < 4; ++j) b[r][j] = ld4_bf16(XN + (size_t)mm * DM + 4 * lane + 256 * j) * inv;
        } }
#pragma unroll
    for (int r = 0; r < R; ++r) { float s = 0.f;
#pragma unroll
        for (int j = 0; j < 4; ++j) s += ssq4(d[r][j]);
        r1[r] = s; }
#pragma unroll
    for (int r = 0; r < R; ++r) r1[r] = rsqrtf(wave_sum(r1[r]) * (1.f / DM) + EPS) * scale;
#pragma unroll
    for (int j = 0; j < 4; ++j) { const v4f gp = ld4_f32(gpost + 4 * lane + 256 * j);
#pragma unroll
        for (int r = 0; r < R; ++r) d[r][j] = b[r][j] + d[r][j] * r1[r] * gp; }
    if (OUT_F32) { float* Y = C.out();
#pragma unroll
        for (int r = 0; r < R; ++r)
#pragma unroll
            for (int j = 0; j < 4; ++j) if (ok[r]) *(v4f*)(Y + (size_t)mr[r] * DM + 4 * lane + 256 * j) = d[r][j];
    } else { float* rs = C.RS(); float t[R];
#pragma unroll
        for (int r = 0; r < R; ++r) { float s = 0.f;
#pragma unroll
            for (int j = 0; j < 4; ++j) s += ssq4(d[r][j]);
            t[r] = s; }
#pragma unroll
        for (int r = 0; r < R; ++r) t[r] = wave_sum(t[r]) * (1.f / DM) + EPS;
#pragma unroll
        for (int r = 0; r < R; ++r) { const float rstd = rsqrtf(t[r]);
#pragma unroll
            for (int j = 0; j < 4; ++j) if (ok[r]) st4_bf16(XN + (size_t)mr[r] * DM + 4 * lane + 256 * j, d[r][j] * rstd);
            if (lane == 0 && ok[r]) rs[mr[r]] = sqrtf(t[r]); }
    }
}
template <int R>
__device__ __forceinline__ void rows_norm512(bf16* base, int m0, int stride, int mx, const float* g, int lane) {
    v4u w[R]; float ss[R]; int mr[R]; bool ok[R];
#pragma unroll
    for (int r = 0; r < R; ++r) { mr[r] = (r == 4) ? mx : m0 + r * stride; ok[r] = (r == 4) ? (mx < M) : (mr[r] < MPROMPT);
        w[r] = *(const v4u*)(base + (size_t)(ok[r] ? mr[r] : 0) * DM + 8 * lane); }
    const v4f g0 = *(const v4f*)(g + 8 * lane), g1 = *(const v4f*)(g + 8 * lane + 4);
#pragma unroll
    for (int r = 0; r < R; ++r) { const v4u x = w[r];
        ss[r] = (bf_lo(x.x) * bf_lo(x.x) + bf_hi(x.x) * bf_hi(x.x)) + (bf_lo(x.y) * bf_lo(x.y) + bf_hi(x.y) * bf_hi(x.y)) + (bf_lo(x.z) * bf_lo(x.z) + bf_hi(x.z) * bf_hi(x.z)) + (bf_lo(x.w) * bf_lo(x.w) + bf_hi(x.w) * bf_hi(x.w)); }
#pragma unroll
    for (int r = 0; r < R; ++r) ss[r] = rsqrtf(wave_sum(ss[r]) * (1.f / 512.f) + EPS);
#pragma unroll
    for (int r = 0; r < R; ++r) { const v4u x = w[r]; const float q = ss[r];
        v4u o; o.x = cvt_pk_nv(bf_lo(x.x) * q * g0.x, bf_hi(x.x) * q * g0.y); o.y = cvt_pk_nv(bf_lo(x.y) * q * g0.z, bf_hi(x.y) * q * g0.w);
        o.z = cvt_pk_nv(bf_lo(x.z) * q * g1.x, bf_hi(x.z) * q * g1.y); o.w = cvt_pk_nv(bf_lo(x.w) * q * g1.z, bf_hi(x.w) * q * g1.w);
        if (ok[r]) *(v4u*)(base + (size_t)mr[r] * DM + 8 * lane) = o; }
}

__device__ __forceinline__ void p0_prologue(const Ctx& C, LAS unsigned char* lds, int wave, int lane, int tid) {
    LAS float* tile = (LAS float*)lds;
    const int gw = blockIdx.x * NWAVES + wave, NGW = gridDim.x * NWAVES;
    constexpr int I_GU = (DM / 64) * (DFF / 256), I_D = (DFF / 64) * (DM / 256), I_IN = (DM / 64) * (DIN / 256), I_GLU = (BWD / 64) * (BWD / 256), I_OUT = (DM / 64) * (DM / 256);
    constexpr int NITEMS = 4 * I_GU + 2 * I_D + I_IN + I_GLU + I_OUT;
    for (int it = blockIdx.x; it < NITEMS; it += gridDim.x) {
        int r = it;
        if (r < I_GU) { p0_block_item(C.in(5), C.in(4), DM, DFF, C.Wgu1(), 1, r, tile, tid); continue; } r -= I_GU;
        if (r < I_GU) { p0_block_item(C.in(6), C.in(4), DM, DFF, C.Wgu1(), 2, r, tile, tid); continue; } r -= I_GU;
        if (r < I_GU) { p0_block_item(C.in(29), C.in(28), DM, DFF, C.Wgu2(), 1, r, tile, tid); continue; } r -= I_GU;
        if (r < I_GU) { p0_block_item(C.in(30), C.in(28), DM, DFF, C.Wgu2(), 2, r, tile, tid); continue; } r -= I_GU;
        if (r < I_D) { p0_block_item(C.in(7), nullptr, DFF, DM, C.Wd1(), 0, r, tile, tid); continue; } r -= I_D;
        if (r < I_D) { p0_block_item(C.in(31), nullptr, DFF, DM, C.Wd2(), 0, r, tile, tid); continue; } r -= I_D;
        if (r < I_IN) { p0_block_item(C.in(10), C.in(9), DM, DIN, C.Win(), 0, r, tile, tid); continue; } r -= I_IN;
        if (r < I_GLU) { p0_block_item(C.in(22), nullptr, BWD, BWD, C.Wglu(), 0, r, tile, tid); continue; } r -= I_GLU;
        p0_block_item(C.in(26), nullptr, DM, DM, C.Wout(), 0, r, tile, tid);
    }
    { const int nit = (MPROMPT + 4 * NGW - 1) / (4 * NGW);
      for (int it = 0; it < nit - 1; ++it) rows_x0<4>(C, gw + 4 * it * NGW, NGW, M, lane);
      rows_x0<5>(C, gw + 4 * (nit - 1) * NGW, NGW, MPROMPT + gw, lane);
      for (int ms = MPROMPT + gw + NGW; ms < M; ms += NGW) rows_x0<5>(C, MPROMPT, NGW, ms, lane); }
    const int gt = blockIdx.x * NTHREADS + tid, NGT = gridDim.x * NTHREADS;
    for (int idx = (tid < 8 ? blockIdx.x * 8 + tid : NG * NP); idx < NG * NP; idx += gridDim.x * 8) {
        const int g = idx / NP, p = idx % NP;
        const double lr = (double)C.in(14)[idx], li = (double)C.in(15)[idx], dt = dexp((double)C.in(16)[g]);
        double s1, c1, s8, c8; dsincos(li * dt, s1, c1); dsincos(li * dt * 128.0, s8, c8);
        const double er = dexp(lr * dt), lbr = er * c1, lbi = er * s1;
        const double e8 = dexp(lr * dt * 128.0), l8r = e8 * c8, l8i = e8 * s8;
        C.LAM()[0 * 2048 + idx] = (float)lbr; C.LAM()[1 * 2048 + idx] = (float)lbi; C.LAM()[2 * 2048 + idx] = (float)l8r; C.LAM()[3 * 2048 + idx] = (float)l8i;
        const double a = lbr - 1.0, b = lbi, den = lr * lr + li * li, cr = (a * lr + b * li) / den, ci = (b * lr - a * li) / den;
        for (int n = 0; n < GN; ++n) {
            const double br = (double)C.in(17)[(size_t)idx * GN + n], bi = (double)C.in(18)[(size_t)idx * GN + n];
            C.BB()[((size_t)g * 128 + 2 * p) * GN + n] = f2bf((float)(cr * br - ci * bi));
            C.BB()[((size_t)g * 128 + 2 * p + 1) * GN + n] = f2bf((float)(cr * bi + ci * br));
            C.CM()[((size_t)g * GN + n) * 128 + 2 * p] = f2bf(C.in(19)[((size_t)g * GN + n) * NP + p]);
            C.CM()[((size_t)g * GN + n) * 128 + 2 * p + 1] = f2bf(-C.in(20)[((size_t)g * GN + n) * NP + p]);
        }
    }
    for (int idx = gt; idx < 2 * 4 * 128 * 128; idx += NGT) {
        const int s = idx & 127, t = (idx >> 7) & 127, h = (idx >> 14) & 3, mode = idx >> 16;
        float v;
        if (mode == 0) v = (s <= t) ? C.in(12)[((size_t)h * 128 + t) * 128 + s] : 0.f;
        else v = ((s >> 4) == (t >> 4) && (s & 15) <= (t & 15)) ? C.in(12)[((size_t)h * 128 + (t & 15)) * 128 + (s & 15)] : 0.f;
        C.Weff()[idx] = f2bf(v);
    }
}

constexpr int XU_STRIDE = 72;
constexpr int BH_STRIDE = 136;
constexpr int S5W_BYTES = 32 * XU_STRIDE * 2 + 32 * BH_STRIDE * 2;
static_assert(NWAVES * S5W_BYTES <= LDS_BYTES - 64, "s5 lds");
template <bool PASS2>
__device__ __forceinline__ void s5_tile(const Ctx& C, int T, int sb_lo, int sb_hi, LAS unsigned char* lds, int wave, int lane) {
    const bool sample = (T == NTILE - 1);
    const int r0 = T * 128;
    LAS bf16* XU = (LAS bf16*)(lds + wave * S5W_BYTES);
    LAS bf16* BH = XU + 32 * XU_STRIDE;
    const int tl = lane & 31, hh = lane >> 5, fr = lane & 15, kq = lane >> 4, xrow = lane >> 3, xpart = lane & 7;
    const float* LAM = C.LAM();
    const bf16* Zb = C.Z() + (size_t)1024 + 64 * wave;
    float sr[4], si[4], lr[4], li[4], dsk[4];
#pragma unroll
    for (int gi = 0; gi < 4; ++gi) { const int g = wave * 4 + gi; sr[gi] = 0.f; si[gi] = 0.f; lr[gi] = LAM[0 * 2048 + g * 64 + lane]; li[gi] = LAM[1 * 2048 + g * 64 + lane];
        dsk[gi] = PASS2 ? C.in(21)[16 * g + fr] : 0.f; }
    if (PASS2 && !sample) {
        const int k = T & 127, tb = T - k;
        float l8r[4], l8i[4];
#pragma unroll
        for (int gi = 0; gi < 4; ++gi) { l8r[gi] = LAM[2 * 2048 + (wave * 4 + gi) * 64 + lane]; l8i[gi] = LAM[3 * 2048 + (wave * 4 + gi) * 64 + lane]; }
        const v2f* Ep = (const v2f*)C.E() + ((size_t)tb * NG + wave * 4) * NP + lane;
        const int nb = (k + 15) >> 4, j0 = k - 16 * nb;
        for (int jb = 0; jb < nb; ++jb) {
#pragma unroll
            for (int u = 0; u < 16; ++u) {
                const int j = j0 + 16 * jb + u; const bool ok = j >= 0; const int jc = ok ? j : 0;
#pragma unroll
                for (int gi = 0; gi < 4; ++gi) { v2f e = Ep[(size_t)jc * NG * NP + gi * NP]; if (!ok) e = (v2f){0.f, 0.f};
                    const float nr = fmaf(l8r[gi], sr[gi], fmaf(-l8i[gi], si[gi], e.x)), ni = fmaf(l8r[gi], si[gi], fmaf(l8i[gi], sr[gi], e.y)); sr[gi] = nr; si[gi] = ni; }
            }
        }
    }
    v4u xn[4];
    {
        const int sb0 = sb_lo;
#pragma unroll
        for (int i = 0; i < 4; ++i) xn[i] = *(const v4u*)(Zb + (size_t)(r0 + 32 * sb0 + xrow + 8 * i) * DIN + 8 * xpart);
    }
    for (int sb = sb_lo; sb < sb_hi; ++sb) {
        const int rb0 = r0 + 32 * sb;
#pragma unroll
        for (int i = 0; i < 4; ++i) *(LAS v4u*)(XU + (xrow + 8 * i) * XU_STRIDE + 8 * xpart) = xn[i];
        if (sb + 1 < sb_hi) {
#pragma unroll
            for (int i = 0; i < 4; ++i) xn[i] = *(const v4u*)(Zb + (size_t)(rb0 + 32 + xrow + 8 * i) * DIN + 8 * xpart);
        }
        LDS_FENCE();
#pragma unroll
        for (int gi = 0; gi < 4; ++gi) {
            const int g = wave * 4 + gi;
            bfx8 bb[4];
#pragma unroll
            for (int cb = 0; cb < 4; ++cb) bb[cb] = *(const bfx8*)(C.BB() + ((size_t)(g * 128 + cb * 32 + tl)) * GN + 8 * hh);
            bfx8 cm[4];
            if (PASS2) {
#pragma unroll
                for (int ks = 0; ks < 4; ++ks) cm[ks] = *(const bfx8*)(C.CM() + ((size_t)(g * GN + fr)) * 128 + 32 * ks + 8 * kq);
            }
            float s0ar = 0.f, s0ai = 0.f, s0br = 0.f, s0bi = 0.f;
            if (sample) { const size_t o0 = ((size_t)(2 * sb) * NG + g) * NP + lane, o1 = o0 + (size_t)NG * NP;
                s0ar = C.in(2)[o0]; s0ai = C.in(3)[o0]; s0br = C.in(2)[o1]; s0bi = C.in(3)[o1]; }
            const bfx8 a = *(const LAS bfx8*)(XU + tl * XU_STRIDE + 16 * gi + 8 * hh);
#pragma unroll
            for (int cb = 0; cb < 4; ++cb) {
                v16f acc;
#pragma unroll
                for (int r = 0; r < 16; ++r) acc[r] = 0.f;
                acc = __builtin_amdgcn_mfma_f32_32x32x16_bf16(bb[cb], a, acc, 0, 0, 0);
#pragma unroll
                for (int rg = 0; rg < 4; ++rg) { v2u w; w.x = cvt_pk_c(acc[4 * rg], acc[4 * rg + 1]); w.y = cvt_pk_c(acc[4 * rg + 2], acc[4 * rg + 3]);
                    *(LAS v2u*)(BH + tl * BH_STRIDE + cb * 32 + 8 * rg + 4 * hh) = w; }
            }
            LDS_FENCE();
            {
                unsigned bu[32];
#pragma unroll
                for (int t = 0; t < 32; ++t) bu[t] = *(const LAS unsigned*)(BH + t * BH_STRIDE + 2 * lane);
                LDS_FENCE();
                float xr = sr[gi], xi = si[gi];
#pragma unroll
                for (int t = 0; t < 32; ++t) {
                    if (sample && t == 0) { xr = s0ar; xi = s0ai; }
                    if (sample && t == 16) { xr = s0br; xi = s0bi; }
                    const float nr = fmaf(lr[gi], xr, fmaf(-li[gi], xi, bf_lo(bu[t]))), ni = fmaf(lr[gi], xi, fmaf(li[gi], xr, bf_hi(bu[t])));
                    xr = nr; xi = ni;
                    if (PASS2) {
                        *(LAS unsigned*)(BH + t * BH_STRIDE + 2 * lane) = cvt_pk_nv(xr, xi);
                        if (sample && (t & 15) == 15) { const int seq = 2 * sb + (t >> 4);
                            C.out()[OFF_SRE_S + ((size_t)seq * NG + g) * NP + lane] = xr; C.out()[OFF_SIM_S + ((size_t)seq * NG + g) * NP + lane] = xi; }
                    }
                }
                sr[gi] = xr; si[gi] = xi;
            }
            LDS_FENCE();
            if (PASS2) {
#pragma unroll
                for (int rb = 0; rb < 2; ++rb) {
                    v4f acc = (v4f){0.f, 0.f, 0.f, 0.f};
#pragma unroll
                    for (int ks = 0; ks < 4; ++ks) {
                        const bfx8 sa = *(const LAS bfx8*)(BH + (16 * rb + fr) * BH_STRIDE + 32 * ks + 8 * kq);
                        acc = __builtin_amdgcn_mfma_f32_16x16x32_bf16(sa, cm[ks], acc, 0, 0, 0);
                    }
#pragma unroll
                    for (int r = 0; r < 4; ++r) {
                        LAS bf16* up = XU + (16 * rb + 4 * kq + r) * XU_STRIDE + 16 * gi + fr;
                        const float u = __uint_as_float((unsigned)(*up) << 16);
                        *up = f2bf(gelu_t(acc[r] + dsk[gi] * u));
                    }
                }
                LDS_FENCE();
            }
        }
        if (PASS2) {
#pragma unroll
            for (int i = 0; i < 4; ++i) *(v4u*)(C.YB() + (size_t)(rb0 + xrow + 8 * i) * BWD + 64 * wave + 8 * xpart) = *(const LAS v4u*)(XU + (xrow + 8 * i) * XU_STRIDE + 8 * xpart);
            LDS_FENCE();
        }
    }
#pragma unroll
    for (int gi = 0; gi < 4; ++gi) {
        const int g = wave * 4 + gi;
        if (!PASS2) { v2f* Ep = (v2f*)C.E() + ((size_t)T * NG + g) * NP + lane; *Ep = (v2f){sr[gi], si[gi]}; }
        else if (!sample && (T & 127) == 127) { const int b = T >> 7;
            C.out()[OFF_SRE_P + ((size_t)b * NG + g) * NP + lane] = sr[gi]; C.out()[OFF_SIM_P + ((size_t)b * NG + g) * NP + lane] = si[gi]; }
    }
}

__device__ __forceinline__ void gmlp_tile(const Ctx& C, int T, LAS unsigned char* lds, int wave, int lane, int tid) {
    const int mode = (T == NTILE - 1) ? 1 : 0;
    const int r0 = T * 128;
    LAS bf16* VT = (LAS bf16*)lds;
    LAS float* SSQ = (LAS float*)(lds + 128 * VT_STRIDE * 2);
    const int tb = wave & 3, dh = wave >> 2, tl = lane & 31, hh = lane >> 5;
    const int t = 32 * tb + tl;
    unsigned outp[4][2][8]; float ssq = 0.f;
    const bf16* zt = C.Z() + (size_t)(r0 + t) * DIN;
    const int row = tid >> 2, q = tid & 3;
    const bf16* vsrc = C.Z() + (size_t)(r0 + row) * DIN + 512 + q * 32;
    const bf16* Weff = C.Weff();
    v4u vraw[4];
#pragma unroll
    for (int i = 0; i < 4; ++i) vraw[i] = *(const v4u*)(vsrc + 8 * i);
#pragma unroll
    for (int h = 0; h < 4; ++h) {
        bfx8 wf[8];
        const bf16* wrow = Weff + ((size_t)(mode * 4 + h) * 128 + t) * 128 + 8 * hh;
#pragma unroll
        for (int ks = 0; ks < 8; ++ks) wf[ks] = *(const bfx8*)(wrow + 16 * ks);
        v2u uw[2][4];
#pragma unroll
        for (int dbi = 0; dbi < 2; ++dbi)
#pragma unroll
            for (int rg = 0; rg < 4; ++rg) uw[dbi][rg] = *(const v2u*)(zt + h * 128 + 32 * (2 * dh + dbi) + 8 * rg + 4 * hh);
        const float bias = C.in(13)[h * 128 + (mode ? (t & 15) : t)];
        __syncthreads();
        {
            float v[32]; float s = 0.f;
#pragma unroll
            for (int i = 0; i < 4; ++i) { const v4u w = vraw[i];
                v[8 * i + 0] = bf_lo(w.x); v[8 * i + 1] = bf_hi(w.x); v[8 * i + 2] = bf_lo(w.y); v[8 * i + 3] = bf_hi(w.y);
                v[8 * i + 4] = bf_lo(w.z); v[8 * i + 5] = bf_hi(w.z); v[8 * i + 6] = bf_lo(w.w); v[8 * i + 7] = bf_hi(w.w); }
            if (h < 3) {
#pragma unroll
                for (int i = 0; i < 4; ++i) vraw[i] = *(const v4u*)(vsrc + (h + 1) * 128 + 8 * i);
            }
#pragma unroll
            for (int i = 0; i < 32; ++i) s += v[i] * v[i];
            s += __shfl_xor(s, 1); s += __shfl_xor(s, 2);
            const float r = rsqrtf(s * (1.f / 128.f) + EPS);
            const float* gv = C.in(11) + h * 128 + q * 32;
#pragma unroll
            for (int i = 0; i < 32; ++i) { v[i] = v[i] * r * gv[i]; VT[(q * 32 + i) * VT_STRIDE + row] = f2bf(v[i]); }
            if (mode) { float* ov = C.out() + OFF_V_S + (size_t)row * AW + h * 128 + q * 32;
#pragma unroll
                for (int i = 0; i < 8; ++i) *(v4f*)(ov + 4 * i) = (v4f){v[4 * i], v[4 * i + 1], v[4 * i + 2], v[4 * i + 3]}; }
        }
        __syncthreads();
#pragma unroll
        for (int dbi = 0; dbi < 2; ++dbi) {
            const int db = 2 * dh + dbi;
            v16f acc;
#pragma unroll
            for (int r = 0; r < 16; ++r) acc[r] = 0.f;
#pragma unroll
            for (int ks = 0; ks < 8; ++ks) {
                const bfx8 va = *(const LAS bfx8*)(VT + (32 * db + tl) * VT_STRIDE + 16 * ks + 8 * hh);
                acc = __builtin_amdgcn_mfma_f32_32x32x16_bf16(va, wf[ks], acc, 0, 0, 0);
            }
#pragma unroll
            for (int rg = 0; rg < 4; ++rg) {
                const v2u u2 = uw[dbi][rg];
                const float o0 = bf_lo(u2.x) * (acc[4 * rg + 0] + bias), o1 = bf_hi(u2.x) * (acc[4 * rg + 1] + bias);
                const float o2 = bf_lo(u2.y) * (acc[4 * rg + 2] + bias), o3 = bf_hi(u2.y) * (acc[4 * rg + 3] + bias);
                ssq += (o0 * o0 + o1 * o1) + (o2 * o2 + o3 * o3);
                outp[h][dbi][2 * rg] = cvt_pk_nv(o0, o1); outp[h][dbi][2 * rg + 1] = cvt_pk_nv(o2, o3);
            }
        }
    }
    ssq += __shfl_xor(ssq, 32);
    if (hh == 0) SSQ[t * 2 + dh] = ssq;
    __syncthreads();
    const float rstd = rsqrtf((SSQ[t * 2] + SSQ[t * 2 + 1]) * (1.f / 512.f) + EPS);
    const float* gap = C.in(24);
    LAS bf16* OT = (LAS bf16*)lds;
    __syncthreads();
#pragma unroll
    for (int h = 0; h < 4; ++h)
#pragma unroll
        for (int dbi = 0; dbi < 2; ++dbi)
#pragma unroll
            for (int rg = 0; rg < 4; ++rg) {
                const int c = h * 128 + 32 * (2 * dh + dbi) + 8 * rg + 4 * hh;
                const v4f ga = *(const v4f*)(gap + c);
                const unsigned w0 = outp[h][dbi][2 * rg], w1 = outp[h][dbi][2 * rg + 1];
                v2u o; o.x = cvt_pk_nv(bf_lo(w0) * rstd * ga.x, bf_hi(w0) * rstd * ga.y); o.y = cvt_pk_nv(bf_lo(w1) * rstd * ga.z, bf_hi(w1) * rstd * ga.w);
                *(LAS v2u*)(OT + t * OT_STRIDE + c) = o;
            }
    __syncthreads();
    {
        bf16* obase = C.MIX() + (size_t)r0 * DM;
#pragma unroll 4
        for (int i = 0; i < 16; ++i) { const int row = wave * 16 + i; *(v4u*)(obase + (size_t)row * DM + 8 * lane) = *(const LAS v4u*)(OT + row * OT_STRIDE + 8 * lane); }
    }
    __syncthreads();
}

#define FTID const int ftid_ = fresh_tid()
#define TID (ftid_)
#define LANE (ftid_ & 63)
#define WAVE (__builtin_amdgcn_readfirstlane(ftid_ >> 6))
#define GSZ ((int)gridDim.x)
#define BX ((int)blockIdx.x)
#define GWV (BX * NWAVES + WAVE)
#define NGWV (GSZ * NWAVES)
constexpr size_t WS_CTL = 0, CTL_ZERO_BYTES = 16384;
constexpr int MISC_OFF = LDS_BYTES - 64;
#define XB_TMO      128
#define XB_XCNT(j)  (256  + 64 * (j))
#define XB_XSUB(j)  (1280 + 64 * (j))
#define XB_XGEN(j)  (2304 + 64 * (j))
#define XB_TOP      3328
#define XB_TOPGEN   3392
#define XCD_BAR_WORDS 3456
#define XB_SPIN_CAP (1u << 18)

__device__ __forceinline__ unsigned xb_ld(unsigned* p)              { return __hip_atomic_load(p, __ATOMIC_RELAXED, __HIP_MEMORY_SCOPE_AGENT); }
__device__ __forceinline__ unsigned xb_add(unsigned* p, unsigned v) { return __hip_atomic_fetch_add(p, v, __ATOMIC_RELAXED, __HIP_MEMORY_SCOPE_AGENT); }
__device__ __forceinline__ unsigned xb_xcc_id() { return (unsigned)__builtin_amdgcn_s_getreg((3 << 11) | 20) & 0xFu; }
#define XB_SPIN(cond, bar) do { unsigned _sp = 0; while (cond) { __builtin_amdgcn_s_sleep(1); \
    if ((++_sp & 255u) == 0u) { if (xb_ld(&(bar)[XB_TMO])) break; if (_sp > XB_SPIN_CAP) { atomicAdd(&(bar)[XB_TMO], 1u); break; } } } } while (0)

struct XcdBarrier {
    unsigned* bar; unsigned x;
    volatile LAS unsigned* st;
};

__device__ __forceinline__ XcdBarrier xcd_barrier_post(unsigned* bar, volatile LAS unsigned* st) {
    XcdBarrier b; b.bar = bar; b.x = xb_xcc_id(); b.st = st;
    if (threadIdx.x == 0) (void)xb_add(&bar[XB_XCNT(b.x)], 1u);
    return b;
}
__device__ __forceinline__ void xcd_barrier_complete(unsigned* bar, unsigned x, unsigned& nloc, unsigned& nx) {
    const unsigned G = gridDim.x * gridDim.y * gridDim.z;
    unsigned sum, cnt, mine, sp = 0u;
    for (;;) {
        sum = 0u; cnt = 0u; mine = 0u;
#pragma unroll
        for (unsigned j = 0; j < 16; ++j) { const unsigned c = xb_ld(&bar[XB_XCNT(j)]); sum += c; cnt += (c > 0u) ? 1u : 0u; mine = (j == x) ? c : mine; }
        if (sum == G) break;
        __builtin_amdgcn_s_sleep(1);
        if ((++sp & 255u) == 0u) { if (xb_ld(&bar[XB_TMO])) break; if (sp > XB_SPIN_CAP) { atomicAdd(&bar[XB_TMO], 1u); break; } }
    }
    nloc = mine > 0u ? mine : 1u; nx = cnt > 0u ? cnt : 1u;
}

__device__ __forceinline__ void xcd_barrier(const XcdBarrier& b) {
    asm volatile("s_waitcnt vmcnt(0)" ::: "memory");
    __syncthreads();
    if (threadIdx.x == 0) {
        unsigned* bar = b.bar;
        __builtin_amdgcn_s_waitcnt(0);
        unsigned nloc = b.st[0], nx = b.st[1];
        if (nloc == 0u) { xcd_barrier_complete(bar, b.x, nloc, nx); b.st[0] = nloc; b.st[1] = nx; }
        const unsigned old = xb_add(&bar[XB_XSUB(b.x)], 1u);
        const unsigned gen = old / nloc;
        if (old + 1u == (gen + 1u) * nloc) {
            __builtin_amdgcn_fence(__ATOMIC_RELEASE, "agent");
            asm volatile("s_waitcnt vmcnt(0)" ::: "memory");
            const unsigned og = xb_add(&bar[XB_TOP], 1u);
            const unsigned tg = og / nx;
            if (og + 1u == (tg + 1u) * nx) xb_add(&bar[XB_TOPGEN], 1u);
            else XB_SPIN(xb_ld(&bar[XB_TOPGEN]) == tg, bar);
            __builtin_amdgcn_fence(__ATOMIC_ACQUIRE, "agent");
            xb_add(&bar[XB_XGEN(b.x)], 1u);
            asm volatile("s_waitcnt vmcnt(0)" ::: "memory");
        } else {
            XB_SPIN(xb_ld(&bar[XB_XGEN(b.x)]) == gen, bar);
            __builtin_amdgcn_fence(__ATOMIC_ACQUIRE, "agent");
            asm volatile("s_waitcnt vmcnt(0)" ::: "memory");
        }
    }
    __syncthreads();
}

template <int MODE>
__device__ __forceinline__ void small_gemm(LAS unsigned char* lds, const bf16* A, const bf16* Bt, int N, int K, bf16* O, int ldc, int act_cols, const float* bias, const bf16* Yv, int ldy, int it0, int it1) {
    FTID; const int wave = WAVE, lane = LANE, tl = lane & 31, hh = lane >> 5;
    LAS float* red = (LAS float*)lds;
    const int nct = N / 32, nitems = 4 * nct, kw = K / 8, nks = kw / 16;
    for (int it = it0; it < it1; ++it) {
        const int item = BX + it * GSZ; if (item >= nitems) break;
        const int rt = item & 3, ct = item >> 2;
        const int hc = 32 * ct + tl;
        const int brow = (MODE == 3) ? (256 * (hc >> 7) + (hc & 127)) : hc;
        const bf16* ap = A + (size_t)(32 * rt + tl) * K + wave * kw + 8 * hh;
        const bf16* bp = Bt + (size_t)brow * K + wave * kw + 8 * hh;
        v16f acc0, acc1;
#pragma unroll
        for (int r = 0; r < 16; ++r) { acc0[r] = 0.f; acc1[r] = 0.f; }
#pragma unroll 4
        for (int ks = 0; ks < nks; ++ks) {
            const bfx8 a = *(const bfx8*)(ap + 16 * ks);
            const bfx8 b0 = *(const bfx8*)(bp + 16 * ks);
            acc0 = __builtin_amdgcn_mfma_f32_32x32x16_bf16(b0, a, acc0, 0, 0, 0);
            if (MODE == 3) { const bfx8 b1 = *(const bfx8*)(bp + (size_t)128 * K + 16 * ks); acc1 = __builtin_amdgcn_mfma_f32_32x32x16_bf16(b1, a, acc1, 0, 0, 0); }
        }
        __syncthreads();
#pragma unroll
        for (int r = 0; r < 16; ++r) { red[(wave * 16 + r) * 64 + lane] = acc0[r]; if (MODE == 3) red[8192 + (wave * 16 + r) * 64 + lane] = acc1[r]; }
        __syncthreads();
        float v0[2], v1[2];
#pragma unroll
        for (int e = 0; e < 2; ++e) { float s0 = 0.f, s1 = 0.f;
#pragma unroll
            for (int w = 0; w < 8; ++w) { s0 += red[(w * 16 + 2 * wave + e) * 64 + lane]; if (MODE == 3) s1 += red[8192 + (w * 16 + 2 * wave + e) * 64 + lane]; }
            v0[e] = s0; v1[e] = s1; }
        const int reg = 2 * wave;
        const int col = 32 * ct + (reg & 3) + 8 * (reg >> 2) + 4 * hh;
        const size_t row = (size_t)(32 * rt + tl);
        float o0 = v0[0], o1 = v0[1];
        if (MODE == 1) { if (col < act_cols) { o0 = gelu_t(o0); o1 = gelu_t(o1); } }
        if (MODE == 2) { const unsigned y = *(const unsigned*)(Yv + row * ldy + col); o0 = bf_lo(y) * pg8::sigmoid_f(o0 + bias[col]); o1 = bf_hi(y) * pg8::sigmoid_f(o1 + bias[col + 1]); }
        if (MODE == 3) { o0 = pg8::silu_f(o0) * v1[0]; o1 = pg8::silu_f(o1) * v1[1]; }
        *(unsigned*)(O + row * ldc + col) = cvt_pk_bf16(o0, o1);
    }
    __syncthreads();
}
struct Args { const float* in[33]; float* out; unsigned char* ws; };
__global__ void __launch_bounds__(NTHREADS, 2) fwd_kernel(Args args) {
    extern __shared__ __attribute__((aligned(16))) unsigned char lds_raw[];
    cg::grid_group grid = cg::this_grid();
    LAS unsigned char* lds = (LAS unsigned char*)lds_raw;
    Ctx C;
    if (threadIdx.x < 16) ((volatile LAS unsigned*)(lds + MISC_OFF))[threadIdx.x] = 0u;
    __syncthreads();
    (void)xcd_barrier_post((unsigned*)(C.ws() + WS_CTL), (volatile LAS unsigned*)(lds + MISC_OFF));
#define XBAR() do { XcdBarrier b_; b_.bar = (unsigned*)(C.ws() + WS_CTL); b_.x = xb_xcc_id(); b_.st = (volatile LAS unsigned*)(lds + MISC_OFF); xcd_barrier(b_); } while (0)
    grid.sync();
    { FTID; p0_prologue(C, lds, WAVE, LANE, TID); }
    XBAR();
    { const int stg = (BX >> 3) & 3;
    small_gemm<3>(lds, C.XN() + (size_t)MPROMPT * DM, C.Wgu1(), DFF, DM, C.H() + (size_t)MPROMPT * DFF, DFF, 0, nullptr, nullptr, 0, 0, stg);
    { pg8::Gemm g{C.XN(), C.Wgu1(), MPROMPT, 2 * DFF, DM}; pg8::StaticOrder S; S.init(MPROMPT, 2 * DFF, GSZ, BX); pg8::EpiSwiglu E{C.H(), DFF};
      pg8::gemm_phase<pg8::EpiSwiglu, pg8::StaticOrder, true, true>(lds, g, S, E); }
    small_gemm<3>(lds, C.XN() + (size_t)MPROMPT * DM, C.Wgu1(), DFF, DM, C.H() + (size_t)MPROMPT * DFF, DFF, 0, nullptr, nullptr, 0, stg, 4); }
    XBAR();
    { const int stg = (BX >> 3) & 3;
    small_gemm<0>(lds, C.H() + (size_t)MPROMPT * DFF, C.Wd1(), DM, DFF, C.D() + (size_t)MPROMPT * DM, DM, 0, nullptr, nullptr, 0, 0, stg);
    { pg8::Gemm g{C.H(), C.Wd1(), MPROMPT, DM, DFF}; pg8::StaticOrder S; S.init(MPROMPT, DM, GSZ, BX); pg8::EpiBf16<0> E{C.D(), DM, 0, nullptr, nullptr, 0};
      pg8::gemm_phase<pg8::EpiBf16<0>, pg8::StaticOrder, true, true>(lds, g, S, E); }
    small_gemm<0>(lds, C.H() + (size_t)MPROMPT * DFF, C.Wd1(), DM, DFF, C.D() + (size_t)MPROMPT * DM, DM, 0, nullptr, nullptr, 0, stg, 4); }
    XBAR();
    { FTID; const float* gp = C.in(8); { const int gw_ = GWV, ngw_ = NGWV, nit = (MPROMPT + 4 * ngw_ - 1) / (4 * ngw_);
      for (int it = 0; it < nit - 1; ++it) rows_res<4, true, false>(C, gw_ + 4 * it * ngw_, ngw_, M, gp, 0.5f, LANE);
      rows_res<5, true, false>(C, gw_ + 4 * (nit - 1) * ngw_, ngw_, MPROMPT + gw_, gp, 0.5f, LANE);
      for (int ms = MPROMPT + gw_ + ngw_; ms < M; ms += ngw_) rows_res<5, true, false>(C, MPROMPT, ngw_, ms, gp, 0.5f, LANE); } }
    XBAR();
    { const int stg = (BX >> 3) & 3;
    small_gemm<1>(lds, C.XN() + (size_t)MPROMPT * DM, C.Win(), DIN, DM, C.Z() + (size_t)MPROMPT * DIN, DIN, 2 * AW, nullptr, nullptr, 0, 0, stg);
    { pg8::Gemm g{C.XN(), C.Win(), MPROMPT, DIN, DM}; pg8::StaticOrder S; S.init(MPROMPT, DIN, GSZ, BX); pg8::EpiBf16<1> E{C.Z(), DIN, 2 * AW, nullptr, nullptr, 0};
      pg8::gemm_phase<pg8::EpiBf16<1>, pg8::StaticOrder, true, true>(lds, g, S, E); }
    small_gemm<1>(lds, C.XN() + (size_t)MPROMPT * DM, C.Win(), DIN, DM, C.Z() + (size_t)MPROMPT * DIN, DIN, 2 * AW, nullptr, nullptr, 0, stg, 4); }
    XBAR();
    { FTID; for (int T = BX; T < NTILE - 1; T += GSZ) {
        s5_tile<false>(C, T, 0, 4, lds, WAVE, LANE);
        __syncthreads();
        gmlp_tile(C, T, lds, WAVE, LANE, TID);
    } }
    XBAR();
    { FTID; for (int T = BX; T < NTILE - 1; T += GSZ) s5_tile<true>(C, T, 0, 4, lds, WAVE, LANE);
      if (BX >= 1 && BX <= 4) s5_tile<true>(C, NTILE - 1, BX - 1, BX, lds, WAVE, LANE);
      if (BX == 0) { __syncthreads(); gmlp_tile(C, NTILE - 1, lds, WAVE, LANE, TID); } }
    XBAR();
    { const int stg = (BX >> 3) & 3;
    small_gemm<2>(lds, C.YB() + (size_t)MPROMPT * BWD, C.Wglu(), BWD, BWD, C.MIX() + (size_t)MPROMPT * DM + AW, DM, 0, C.in(23), C.YB() + (size_t)MPROMPT * BWD, BWD, 0, stg);
    { pg8::Gemm g{C.YB(), C.Wglu(), MPROMPT, BWD, BWD}; pg8::StaticOrder S; S.init(MPROMPT, BWD, GSZ, BX); pg8::EpiBf16<2> E{C.MIX() + AW, DM, 0, C.in(23), C.YB(), BWD};
      pg8::gemm_phase<pg8::EpiBf16<2>, pg8::StaticOrder, true, true>(lds, g, S, E); }
    small_gemm<2>(lds, C.YB() + (size_t)MPROMPT * BWD, C.Wglu(), BWD, BWD, C.MIX() + (size_t)MPROMPT * DM + AW, DM, 0, C.in(23), C.YB() + (size_t)MPROMPT * BWD, BWD, stg, 4); }
    XBAR();
    { FTID; const float* gb = C.in(25); bf16* bb_ = C.MIX() + AW; const int gw_ = GWV, ngw_ = NGWV, nit = (MPROMPT + 4 * ngw_ - 1) / (4 * ngw_);
      for (int it = 0; it < nit - 1; ++it) rows_norm512<4>(bb_, gw_ + 4 * it * ngw_, ngw_, M, gb, LANE);
      rows_norm512<5>(bb_, gw_ + 4 * (nit - 1) * ngw_, ngw_, MPROMPT + gw_, gb, LANE);
      for (int ms = MPROMPT + gw_ + ngw_; ms < M; ms += ngw_) rows_norm512<5>(bb_, MPROMPT, ngw_, ms, gb, LANE); }
    XBAR();
    { const int stg = (BX >> 3) & 3;
    small_gemm<0>(lds, C.MIX() + (size_t)MPROMPT * DM, C.Wout(), DM, DM, C.D() + (size_t)MPROMPT * DM, DM, 0, nullptr, nullptr, 0, 0, stg);
    { pg8::Gemm g{C.MIX(), C.Wout(), MPROMPT, DM, DM}; pg8::StaticOrder S; S.init(MPROMPT, DM, GSZ, BX); pg8::EpiBf16<0> E{C.D(), DM, 0, nullptr, nullptr, 0};
      pg8::gemm_phase<pg8::EpiBf16<0>, pg8::StaticOrder, true, true>(lds, g, S, E); }
    small_gemm<0>(lds, C.MIX() + (size_t)MPROMPT * DM, C.Wout(), DM, DM, C.D() + (size_t)MPROMPT * DM, DM, 0, nullptr, nullptr, 0, stg, 4); }
    XBAR();
    { FTID; const float* gp = C.in(27); { const int gw_ = GWV, ngw_ = NGWV, nit = (MPROMPT + 4 * ngw_ - 1) / (4 * ngw_);
      for (int it = 0; it < nit - 1; ++it) rows_res<4, false, false>(C, gw_ + 4 * it * ngw_, ngw_, M, gp, 1.0f, LANE);
      rows_res<5, false, false>(C, gw_ + 4 * (nit - 1) * ngw_, ngw_, MPROMPT + gw_, gp, 1.0f, LANE);
      for (int ms = MPROMPT + gw_ + ngw_; ms < M; ms += ngw_) rows_res<5, false, false>(C, MPROMPT, ngw_, ms, gp, 1.0f, LANE); } }
    XBAR();
    { const int stg = (BX >> 3) & 3;
    small_gemm<3>(lds, C.XN() + (size_t)MPROMPT * DM, C.Wgu2(), DFF, DM, C.H() + (size_t)MPROMPT * DFF, DFF, 0, nullptr, nullptr, 0, 0, stg);
    { pg8::Gemm g{C.XN(), C.Wgu2(), MPROMPT, 2 * DFF, DM}; pg8::StaticOrder S; S.init(MPROMPT, 2 * DFF, GSZ, BX); pg8::EpiSwiglu E{C.H(), DFF};
      pg8::gemm_phase<pg8::EpiSwiglu, pg8::StaticOrder, true, true>(lds, g, S, E); }
    small_gemm<3>(lds, C.XN() + (size_t)MPROMPT * DM, C.Wgu2(), DFF, DM, C.H() + (size_t)MPROMPT * DFF, DFF, 0, nullptr, nullptr, 0, stg, 4); }
    XBAR();
    { const int stg = (BX >> 3) & 3;
    small_gemm<0>(lds, C.H() + (size_t)MPROMPT * DFF, C.Wd2(), DM, DFF, C.D() + (size_t)MPROMPT * DM, DM, 0, nullptr, nullptr, 0, 0, stg);
    { pg8::Gemm g{C.H(), C.Wd2(), MPROMPT, DM, DFF}; pg8::StaticOrder S; S.init(MPROMPT, DM, GSZ, BX); pg8::EpiBf16<0> E{C.D(), DM, 0, nullptr, nullptr, 0};
      pg8::gemm_phase<pg8::EpiBf16<0>, pg8::StaticOrder, true, true>(lds, g, S, E); }
    small_gemm<0>(lds, C.H() + (size_t)MPROMPT * DFF, C.Wd2(), DM, DFF, C.D() + (size_t)MPROMPT * DM, DM, 0, nullptr, nullptr, 0, stg, 4); }
    XBAR();
    { FTID; const float* gp = C.in(32); { const int gw_ = GWV, ngw_ = NGWV, nit = (MPROMPT + 4 * ngw_ - 1) / (4 * ngw_);
      for (int it = 0; it < nit - 1; ++it) rows_res<4, false, true>(C, gw_ + 4 * it * ngw_, ngw_, M, gp, 0.5f, LANE);
      rows_res<5, false, true>(C, gw_ + 4 * (nit - 1) * ngw_, ngw_, MPROMPT + gw_, gp, 0.5f, LANE);
      for (int ms = MPROMPT + gw_ + ngw_; ms < M; ms += ngw_) rows_res<5, false, true>(C, MPROMPT, ngw_, ms, gp, 0.5f, LANE); } }
}

extern "C" void kernel_launch(void* const* d_in, const int* in_sizes, int n_in, void* d_out, int out_size, void* d_ws, size_t ws_size, hipStream_t stream) {
    static int grid = 0;
    if (grid == 0) {
        if (n_in != 33 || ws_size < WS_END) { fprintf(stderr, "kernel_launch: unexpected n_in %d / ws %zu\n", n_in, ws_size); grid = -1; return; }
        int dev = 0, cus = 0, per_cu = 0;
        hipGetDevice(&dev);
        hipDeviceGetAttribute(&cus, hipDeviceAttributeMultiprocessorCount, dev);
        hipFuncSetAttribute((const void*)fwd_kernel, hipFuncAttributeMaxDynamicSharedMemorySize, LDS_BYTES);
        hipOccupancyMaxActiveBlocksPerMultiprocessor(&per_cu, (const void*)fwd_kernel, NTHREADS, LDS_BYTES);
        if (per_cu < 1) { fprintf(stderr, "kernel_launch: occupancy query says %d blocks per CU\n", per_cu); per_cu = 1; }
        grid = cus * per_cu;
    }
    if (grid < 0) return;
    if (hipMemsetAsync((char*)d_ws + WS_CTL, 0, CTL_ZERO_BYTES, stream) != hipSuccess) { fprintf(stderr, "memset failed\n"); return; }
    Args a{};
    for (int i = 0; i < 33; ++i) a.in[i] = (const float*)d_in[i];
    a.out = (float*)d_out; a.ws = (unsigned char*)d_ws;
    void* params[] = {&a};
    hipError_t e = hipLaunchCooperativeKernel((const void*)fwd_kernel, dim3(grid), dim3(NTHREADS), params, LDS_BYTES, stream);
    if (e != hipSuccess) fprintf(stderr, "cooperative launch failed: %s (grid %d)\n", hipGetErrorString(e), grid);
}
```

```cpp
#include <hip/hip_runtime.h>
#include <hip/hip_cooperative_groups.h>
#include <cstdio>
#include <cstdint>
namespace cg = cooperative_groups;
__device__ __forceinline__ int fresh_tid() { int t = (int)threadIdx.x; asm volatile("" : "+v"(t)); return t; }
namespace pg8 {
#define PG8_LAS __attribute__((address_space(3)))
typedef unsigned short bf16_t;
typedef short bf16x8 __attribute__((ext_vector_type(8)));
typedef float f32x4 __attribute__((ext_vector_type(4)));
typedef unsigned u32x4 __attribute__((ext_vector_type(4)));
constexpr int BM = 256, BK = 64, HALF = 128, HTB = HALF * BK * 2  , STAGE_BYTES = 8 * HTB, NXCD = 8, WGM = 8;

__host__ __device__ __forceinline__ int lds_byte(int r, int c) { const int st = (r >> 4) * 2 + (c >> 5), rr = r & 15, cc = c & 31, ob = rr * 64 + cc * 2; return st * 1024 + (ob ^ (((ob >> 9) & 1) << 5)); }
__host__ __device__ __forceinline__ void stage_rc(int b, int& R, int& C) { const int st = b / 1024, sb = b % 1024, swz = sb ^ (((sb >> 9) & 1) << 5); R = (st >> 1) * 16 + swz / 64; C = (st & 1) * 32 + (swz % 64) / 2; }
__host__ __device__ __forceinline__ int perm32(int rho) { const int n = rho >> 4, i = rho & 15; return 8 * (i >> 2) + 4 * n + (i & 3); }

struct Unit { int pm, pn; };
struct Gemm { const bf16_t* A; const bf16_t* Bt; int M, N, K; };

struct StaticOrder {
    int nM, nN, nwg, G, c;
    __host__ __device__ void init(int M, int N, int G_, int c_) { nM = M / BM; nN = N / BM; nwg = nM * nN; G = G_; c = c_; }
    __host__ __device__ bool next(int i, Unit& u) const {
        const long L = (long)i * G + c; if (L >= nwg) return false;
        int wgid = (int)L; { const int q = nwg / NXCD, r = nwg % NXCD, xcd = wgid % NXCD, off = wgid / NXCD; wgid = (xcd < r ? xcd * (q + 1) : r * (q + 1) + (xcd - r) * q) + off; }
        const int nig = WGM * nN, gid = wgid / nig, fm = gid * WGM, gsz = (nM - fm) < WGM ? (nM - fm) : WGM;
        u.pm = fm + ((wgid % nig) % gsz); u.pn = (wgid % nig) / gsz; return true;
    }
    __device__ __forceinline__ void a_ready(const Unit&) const {}
    __device__ __forceinline__ void done(const Unit&) const {}
};

__device__ __forceinline__ unsigned cvt_pk_bf16(float lo, float hi) { unsigned r; asm volatile("v_cvt_pk_bf16_f32 %0, %1, %2" : "=v"(r) : "v"(lo), "v"(hi)); return r; }
__device__ __forceinline__ float bf_lo(unsigned w) { return __uint_as_float(w << 16); }
__device__ __forceinline__ float bf_hi(unsigned w) { return __uint_as_float(w & 0xffff0000u); }
__device__ __forceinline__ float sigmoid_f(float x) { return __builtin_amdgcn_rcpf(1.0f + __expf(-x)); }
__device__ __forceinline__ float silu_f(float x) { return x * sigmoid_f(x); }
__device__ __forceinline__ float gelu_t(float x) { const float u = 1.5957691216057308f * (x + 0.044715f * x * x * x); return x * sigmoid_f(u); }

struct EpiSwiglu {
    static constexpr bool PERM = true, AFTER_DRAIN = false;
    bf16_t* O; int ldc;
    __device__ __forceinline__ void operator()(const f32x4 (&acc)[2][2][4][2], const Unit& u, int wr, int wc, int fr, int fq) const {
        const int row0 = u.pm * BM + wr * 64 + fr; const int col0 = u.pn * HALF + wc * 32 + 8 * fq;
#pragma unroll
        for (int ai = 0; ai < 2; ++ai)
#pragma unroll
            for (int m = 0; m < 4; ++m) {
                bf16_t* rowp = O + (size_t)(row0 + ai * HALF + m * 16) * ldc + col0;
                const f32x4 g0 = acc[ai][0][m][0], g1 = acc[ai][0][m][1], u0 = acc[ai][1][m][0], u1 = acc[ai][1][m][1];
                u32x4 w;
                w.x = cvt_pk_bf16(silu_f(g0[0]) * u0[0], silu_f(g0[1]) * u0[1]); w.y = cvt_pk_bf16(silu_f(g0[2]) * u0[2], silu_f(g0[3]) * u0[3]);
                w.z = cvt_pk_bf16(silu_f(g1[0]) * u1[0], silu_f(g1[1]) * u1[1]); w.w = cvt_pk_bf16(silu_f(g1[2]) * u1[2], silu_f(g1[3]) * u1[3]);
                *(u32x4*)rowp = w;
            }
    }
};
template <int MODE> struct EpiBf16 {
    static constexpr bool PERM = true, AFTER_DRAIN = false;
    bf16_t* O; int ldc; int act_cols; const float* bias; const bf16_t* Y; int ldy;
    __device__ __forceinline__ void operator()(const f32x4 (&acc)[2][2][4][2], const Unit& u, int wr, int wc, int fr, int fq) const {
        const int row0 = u.pm * BM + wr * 64 + fr; const int col0 = u.pn * BM + wc * 32 + 8 * fq;
#pragma unroll
        for (int bj = 0; bj < 2; ++bj) {
            const int col = col0 + bj * HALF;
            f32x4 b0 = (f32x4){0.f, 0.f, 0.f, 0.f}, b1 = b0;
            if (MODE == 2) { b0 = *(const f32x4*)(bias + col); b1 = *(const f32x4*)(bias + col + 4); }
            const bool act = (MODE == 1) && (col < act_cols);
#pragma unroll
            for (int ai = 0; ai < 2; ++ai)
#pragma unroll
                for (int m = 0; m < 4; ++m) {
                    const size_t row = (size_t)(row0 + ai * HALF + m * 16);
                    f32x4 v0 = acc[ai][bj][m][0], v1 = acc[ai][bj][m][1];
                    if (MODE == 1) { if (act) {
#pragma unroll
                        for (int j = 0; j < 4; ++j) { v0[j] = gelu_t(v0[j]); v1[j] = gelu_t(v1[j]); } } }
                    if (MODE == 2) {
                        const u32x4 y = *(const u32x4*)(Y + row * ldy + col);
                        v0 = v0 + b0; v1 = v1 + b1;
                        v0[0] = bf_lo(y.x) * sigmoid_f(v0[0]); v0[1] = bf_hi(y.x) * sigmoid_f(v0[1]); v0[2] = bf_lo(y.y) * sigmoid_f(v0[2]); v0[3] = bf_hi(y.y) * sigmoid_f(v0[3]);
                        v1[0] = bf_lo(y.z) * sigmoid_f(v1[0]); v1[1] = bf_hi(y.z) * sigmoid_f(v1[1]); v1[2] = bf_lo(y.w) * sigmoid_f(v1[2]); v1[3] = bf_hi(y.w) * sigmoid_f(v1[3]);
                    }
                    u32x4 w; w.x = cvt_pk_bf16(v0[0], v0[1]); w.y = cvt_pk_bf16(v0[2], v0[3]); w.z = cvt_pk_bf16(v1[0], v1[1]); w.w = cvt_pk_bf16(v1[2], v1[3]);
                    *(u32x4*)(O + row * ldc + col) = w;
                }
        }
    }
};

struct EpiNull {
    static constexpr bool PERM = true, AFTER_DRAIN = false;
    bf16_t* O;
    __device__ __forceinline__ void operator()(const f32x4 (&acc)[2][2][4][2], const Unit& u, int wr, int wc, int fr, int fq) const {
        float s = 0.f;
#pragma unroll
        for (int ai = 0; ai < 2; ++ai)
#pragma unroll
            for (int bj = 0; bj < 2; ++bj)
#pragma unroll
                for (int m = 0; m < 4; ++m)
#pragma unroll
                    for (int n = 0; n < 2; ++n) s += (acc[ai][bj][m][n][0] + acc[ai][bj][m][n][1]) + (acc[ai][bj][m][n][2] + acc[ai][bj][m][n][3]);
        if (s == 12345.678f) O[u.pm + wr + wc + fr + fq] = 1;
    }
};
template <int P> struct EpiSwigluP {
    static constexpr bool PERM = true, AFTER_DRAIN = false;
    bf16_t* O; int ldc;
    __device__ __forceinline__ void operator()(const f32x4 (&acc)[2][2][4][2], const Unit& u, int wr, int wc, int fr, int fq) const {
        const int row0 = u.pm * BM + wr * 64 + fr; const int col0 = u.pn * HALF + wc * 32 + 8 * fq;
#pragma unroll
        for (int ai = 0; ai < 2; ++ai)
#pragma unroll
            for (int m = 0; m < 4; ++m) {
                bf16_t* rowp = O + (size_t)(row0 + ai * HALF + m * 16) * ldc + col0;
                const f32x4 g0 = acc[ai][0][m][0], g1 = acc[ai][0][m][1], u0 = acc[ai][1][m][0], u1 = acc[ai][1][m][1];
                u32x4 w;
                if (P == 1) {
                    w.x = cvt_pk_bf16(silu_f(g0[0]) * u0[0], silu_f(g0[1]) * u0[1]); w.y = cvt_pk_bf16(silu_f(g0[2]) * u0[2], silu_f(g0[3]) * u0[3]);
                    w.z = cvt_pk_bf16(silu_f(g1[0]) * u1[0], silu_f(g1[1]) * u1[1]); w.w = cvt_pk_bf16(silu_f(g1[2]) * u1[2], silu_f(g1[3]) * u1[3]);
                    if ((w.x ^ w.y ^ w.z ^ w.w) == 0x12345678u) *(u32x4*)rowp = w;
                } else {
                    w.x = cvt_pk_bf16(g0[0] + u0[0], g0[1] + u0[1]); w.y = cvt_pk_bf16(g0[2] + u0[2], g0[3] + u0[3]);
                    w.z = cvt_pk_bf16(g1[0] + u1[0], g1[1] + u1[1]); w.w = cvt_pk_bf16(g1[2] + u1[2], g1[3] + u1[3]);
                    *(u32x4*)rowp = w;
                }
            }
    }
};
template <class Epi, class Sched, bool ALIGN_EPI = false, bool SP2 = false>
__device__ __forceinline__ void gemm_phase(PG8_LAS unsigned char* lds, const Gemm g, const Sched& S, const Epi& E) {
    const int tid = fresh_tid(), wid = __builtin_amdgcn_readfirstlane(tid >> 6), lane = tid & 63, wr = wid >> 2, wc = wid & 3, fr = lane & 15, fq = lane >> 4;
    const int K = g.K, nt = K / BK;
    unsigned voffA[2], voffB[2];
#pragma unroll
    for (int i = 0; i < 2; ++i) { int R, C; stage_rc(tid * 16 + i * 8192, R, C); const int Rb = Epi::PERM ? ((R & ~31) + perm32(R & 31)) : R;
        voffA[i] = (unsigned)(R * K + C) * 2u; voffB[i] = (unsigned)(Rb * K + C) * 2u; }
    const size_t kstep = (size_t)(BK * 2);
    const size_t hstep = (size_t)HALF * K * 2;
    const size_t tstep = 2 * hstep;
    const unsigned ldsw = (unsigned)wid * 1024u;
    const int aoff = lds_byte(wr * 64 + fr, fq * 8), boff = lds_byte(wc * 32 + fr, fq * 8);
#define PG8_SA(b, h) (((b) * 2 + (h)) * HTB)
#define PG8_SB(b, h) ((4 + (b) * 2 + (h)) * HTB)
#define PG8_STAGE(bufoff, gbase, voff) do { _Pragma("unroll") for (int _i = 0; _i < 2; ++_i) \
        __builtin_amdgcn_global_load_lds((const unsigned*)((const char*)(gbase) + (voff)[_i]), (PG8_LAS unsigned*)(lds + (bufoff) + ldsw + _i * 8192), 16, 0, 0); } while (0)
#define PG8_LDA(dst, b, h) do { _Pragma("unroll") for (int m = 0; m < 4; ++m) _Pragma("unroll") for (int k = 0; k < 2; ++k) dst[m][k] = *(const PG8_LAS bf16x8*)(lds + PG8_SA(b, h) + aoff + m * 2048 + k * 1024); } while (0)
#define PG8_LDB(dst, b, h) do { _Pragma("unroll") for (int n = 0; n < 2; ++n) _Pragma("unroll") for (int k = 0; k < 2; ++k) dst[n][k] = *(const PG8_LAS bf16x8*)(lds + PG8_SB(b, h) + boff + n * 2048 + k * 1024); } while (0)
#define PG8_MMA(ai, bj, At, Bt) do { __builtin_amdgcn_s_setprio(1); _Pragma("unroll") for (int m = 0; m < 4; ++m) _Pragma("unroll") for (int n = 0; n < 2; ++n) _Pragma("unroll") for (int k = 0; k < 2; ++k) \
        acc[ai][bj][m][n] = __builtin_amdgcn_mfma_f32_16x16x32_bf16(Bt[n][k], At[m][k], acc[ai][bj][m][n], 0, 0, 0); __builtin_amdgcn_s_setprio(0); } while (0)
#define PG8_WAIT_V(n) asm volatile("s_waitcnt vmcnt(" #n ")" ::: "memory")
#define PG8_WAIT_L(n) asm volatile("s_waitcnt lgkmcnt(" #n ")" ::: "memory")
#define PG8_BAR __builtin_amdgcn_s_barrier()
#define PG8_SCHED __builtin_amdgcn_sched_barrier(0)
    Unit cur, nxt; int ui = 0;
    if (!S.next(0, cur)) return;
    f32x4 acc[2][2][4][2];
#pragma unroll
    for (int a = 0; a < 2; ++a)
#pragma unroll
        for (int b = 0; b < 2; ++b)
#pragma unroll
            for (int m = 0; m < 4; ++m)
#pragma unroll
                for (int n = 0; n < 2; ++n) acc[a][b][m][n] = (f32x4){0.f, 0.f, 0.f, 0.f};
    bf16x8 At[4][2], B0[2][2], B1[2][2];
    const char* cA = (const char*)g.A + (size_t)cur.pm * tstep; const char* cB = (const char*)g.Bt + (size_t)cur.pn * tstep;
    S.a_ready(cur);
    if constexpr (SP2) {
        PG8_STAGE(PG8_SB(0, 0), cB, voffB); PG8_STAGE(PG8_SB(0, 1), cB + hstep, voffB); PG8_STAGE(PG8_SA(0, 0), cA, voffA); PG8_STAGE(PG8_SA(0, 1), cA + hstep, voffA);
        if (wr == 1) PG8_BAR;
        PG8_WAIT_V(2); PG8_BAR;
        PG8_STAGE(PG8_SB(1, 0), cB + kstep, voffB); PG8_STAGE(PG8_SA(1, 0), cA + kstep, voffA); PG8_STAGE(PG8_SB(1, 1), cB + hstep + kstep, voffB);
        PG8_WAIT_V(6); PG8_BAR;
    } else {
        PG8_STAGE(PG8_SB(0, 0), cB, voffB); PG8_STAGE(PG8_SA(0, 0), cA, voffA); PG8_STAGE(PG8_SB(0, 1), cB + hstep, voffB); PG8_STAGE(PG8_SA(0, 1), cA + hstep, voffA);
        if (wr == 1) PG8_BAR;
        PG8_WAIT_V(4); PG8_BAR;
        PG8_STAGE(PG8_SB(1, 0), cB + kstep, voffB); PG8_STAGE(PG8_SA(1, 0), cA + kstep, voffA); PG8_STAGE(PG8_SB(1, 1), cB + hstep + kstep, voffB);
        PG8_WAIT_V(6); PG8_BAR;
    }
    for (;;) {
        const bool has_next = S.next(ui + 1, nxt);
        const char* nA = has_next ? (const char*)g.A + (size_t)nxt.pm * tstep : cA; const char* nB = has_next ? (const char*)g.Bt + (size_t)nxt.pn * tstep : cB;
        for (int t = 0; t < nt; t += 2) {
            const bool last = (t == nt - 2);
            const char* a1 = cA + (size_t)(t + 1) * kstep;
            const char* a2 = last ? nA : cA + (size_t)(t + 2) * kstep; const char* b2 = last ? nB : cB + (size_t)(t + 2) * kstep;
            const char* a3 = a2 + kstep; const char* b3 = b2 + kstep;
            if (last && has_next) S.a_ready(nxt);
            if constexpr (SP2) {
            PG8_LDB(B0, 0, 0); PG8_LDB(B1, 0, 1); PG8_SCHED; PG8_LDA(At, 0, 0); PG8_STAGE(PG8_SA(1, 1), a1 + hstep, voffA);
            PG8_WAIT_V(8); PG8_WAIT_L(0); PG8_BAR; PG8_MMA(0, 0, At, B0); PG8_MMA(0, 1, At, B1); PG8_BAR; PG8_SCHED;
            PG8_LDA(At, 0, 1); PG8_STAGE(PG8_SB(0, 0), b2, voffB); PG8_STAGE(PG8_SB(0, 1), b2 + hstep, voffB); PG8_STAGE(PG8_SA(0, 0), a2, voffA);
            PG8_WAIT_V(8); PG8_WAIT_L(0); PG8_BAR; PG8_MMA(1, 0, At, B0); PG8_MMA(1, 1, At, B1); PG8_BAR; PG8_SCHED;
            PG8_LDB(B0, 1, 0); PG8_LDB(B1, 1, 1); PG8_SCHED; PG8_LDA(At, 1, 0); PG8_STAGE(PG8_SA(0, 1), a2 + hstep, voffA);
            PG8_WAIT_V(8); PG8_WAIT_L(0); PG8_BAR; PG8_MMA(0, 0, At, B0); PG8_MMA(0, 1, At, B1); PG8_BAR; PG8_SCHED;
            PG8_LDA(At, 1, 1); PG8_STAGE(PG8_SB(1, 0), b3, voffB); PG8_STAGE(PG8_SB(1, 1), b3 + hstep, voffB); PG8_STAGE(PG8_SA(1, 0), a3, voffA);
            PG8_WAIT_V(8); PG8_WAIT_L(0); PG8_BAR; PG8_MMA(1, 0, At, B0); PG8_MMA(1, 1, At, B1); PG8_BAR; PG8_SCHED;
            } else {
            PG8_LDB(B0, 0, 0); PG8_SCHED; PG8_LDA(At, 0, 0); PG8_STAGE(PG8_SA(1, 1), a1 + hstep, voffA);
            PG8_WAIT_L(8); PG8_BAR; PG8_WAIT_L(0); PG8_MMA(0, 0, At, B0); PG8_BAR; PG8_SCHED;
            PG8_LDB(B1, 0, 1); PG8_STAGE(PG8_SB(0, 0), b2, voffB);
            PG8_BAR; PG8_WAIT_L(0); PG8_MMA(0, 1, At, B1); PG8_BAR;
            PG8_LDA(At, 0, 1); PG8_STAGE(PG8_SA(0, 0), a2, voffA);
            PG8_BAR; PG8_WAIT_L(0); PG8_MMA(1, 0, At, B0); PG8_BAR; PG8_SCHED;
            PG8_STAGE(PG8_SB(0, 1), b2 + hstep, voffB);
            PG8_WAIT_V(6); PG8_BAR; PG8_MMA(1, 1, At, B1); PG8_BAR;
            PG8_LDB(B0, 1, 0); PG8_SCHED; PG8_LDA(At, 1, 0); PG8_STAGE(PG8_SA(0, 1), a2 + hstep, voffA);
            PG8_WAIT_L(8); PG8_BAR; PG8_WAIT_L(0); PG8_MMA(0, 0, At, B0); PG8_BAR; PG8_SCHED;
            PG8_LDB(B1, 1, 1); PG8_STAGE(PG8_SB(1, 0), b3, voffB);
            PG8_BAR; PG8_WAIT_L(0); PG8_MMA(0, 1, At, B1); PG8_BAR;
            PG8_LDA(At, 1, 1); PG8_STAGE(PG8_SA(1, 0), a3, voffA);
            PG8_BAR; PG8_WAIT_L(0); PG8_MMA(1, 0, At, B0); PG8_BAR; PG8_SCHED;
            PG8_STAGE(PG8_SB(1, 1), b3 + hstep, voffB);
            PG8_WAIT_V(6); PG8_BAR; PG8_MMA(1, 1, At, B1); PG8_BAR;
            }
        }
        if constexpr (ALIGN_EPI) { if (wr == 0) PG8_BAR; }
        if constexpr (!Epi::AFTER_DRAIN) { E(acc, cur, wr, wc, fr, fq); S.done(cur); }
        if (!has_next) break;
#pragma unroll
        for (int a = 0; a < 2; ++a)
#pragma unroll
            for (int b = 0; b < 2; ++b)
#pragma unroll
                for (int m = 0; m < 4; ++m)
#pragma unroll
                    for (int n = 0; n < 2; ++n) acc[a][b][m][n] = (f32x4){0.f, 0.f, 0.f, 0.f};
        cur = nxt; cA = nA; cB = nB; ++ui;
        if constexpr (ALIGN_EPI) { if (wr == 1) PG8_BAR; }
    }
    PG8_WAIT_V(0);
    if constexpr (!ALIGN_EPI) { if (wr == 0) PG8_BAR; }
    PG8_BAR;
    if constexpr (Epi::AFTER_DRAIN) { E.fused(acc, cur, wr, wc, fr, fq, lds, wid, lane); S.done(cur); }
#undef PG8_SA
#undef PG8_SB
#undef PG8_STAGE
#undef PG8_LDA
#undef PG8_LDB
#undef PG8_MMA
#undef PG8_WAIT_V
#undef PG8_WAIT_L
#undef PG8_BAR
#undef PG8_SCHED
}
}

constexpr int DM = 1024, SEQ = 16384, NBATCH = 2, MPROMPT = NBATCH * SEQ, DEC_B = 8, DEC_S = 16;
constexpr int M = MPROMPT + DEC_B * DEC_S;
constexpr int MPAD = 33024;
constexpr int DFF = 2816, DIN = 1536, AW = 512, BWD = 512, NG = 32, NP = 64, GN = 16;
constexpr int NTILE = M / 128;
constexpr float EPS = 1e-6f;
constexpr int NWAVES = 8, NTHREADS = 512;

constexpr size_t MiB = 1u << 20;
constexpr size_t WS_WGU1 = 1 * MiB, WS_WD1 = 12 * MiB, WS_WIN = 18 * MiB, WS_WGLU = 21 * MiB, WS_WOUT = 22 * MiB, WS_WGU2 = 24 * MiB, WS_WD2 = 35 * MiB;
constexpr size_t WS_WEFF = 41 * MiB, WS_BB = 42 * MiB, WS_CM = 42 * MiB + 131072, WS_LAM = 42 * MiB + 262144, WS_RS = 42 * MiB + 524288, WS_E = 43 * MiB;
constexpr size_t WS_XN = 48 * MiB, WS_D = 113 * MiB, WS_H = 178 * MiB, WS_Z = 178 * MiB, WS_YB = 275 * MiB, WS_MIX = 356 * MiB, WS_END = 421 * MiB;
static_assert(WS_XN + (size_t)MPAD * DM * 2 <= WS_D && WS_D + (size_t)MPAD * DM * 2 <= WS_H && WS_H + (size_t)MPAD * DFF * 2 <= WS_MIX, "ws map");
static_assert(WS_Z + (size_t)MPAD * DIN * 2 <= WS_YB && WS_YB + (size_t)MPAD * BWD * 2 <= WS_H + (size_t)MPAD * DFF * 2 && WS_MIX + (size_t)MPAD * DM * 2 <= WS_END, "ws map 2");
static_assert(WS_E + (size_t)NTILE * NG * NP * 8 <= WS_XN, "ws map 3");

constexpr size_t OFF_Y = 0, OFF_SRE_P = (size_t)M * DM, OFF_SIM_P = OFF_SRE_P + NBATCH * NG * NP, OFF_SRE_S = OFF_SIM_P + NBATCH * NG * NP,
                 OFF_SIM_S = OFF_SRE_S + DEC_B * NG * NP, OFF_V_S = OFF_SIM_S + DEC_B * NG * NP;

constexpr int OT_STRIDE = 520;
constexpr int VT_STRIDE = 136;
constexpr int LDS_BYTES = 147456;
static_assert(128 * VT_STRIDE * 2 + 4096 <= LDS_BYTES - 64 && 128 * OT_STRIDE * 2 <= LDS_BYTES - 64, "lds map");

#define LAS __attribute__((address_space(3)))
typedef unsigned short bf16;
typedef float v4f __attribute__((ext_vector_type(4)));
typedef float v2f __attribute__((ext_vector_type(2)));
typedef float v16f __attribute__((ext_vector_type(16)));
typedef unsigned v4u __attribute__((ext_vector_type(4)));
typedef unsigned v2u __attribute__((ext_vector_type(2)));
typedef short bfx8 __attribute__((ext_vector_type(8)));
#define LDS_FENCE() asm volatile("s_waitcnt lgkmcnt(0)" ::: "memory")

using pg8::cvt_pk_bf16; using pg8::bf_lo; using pg8::bf_hi; using pg8::gelu_t;

__device__ __forceinline__ float wave_sum(float v) {
#pragma unroll
    for (int o = 1; o < 64; o <<= 1) v += __shfl_xor(v, o);
    return v;
}
typedef __bf16 bf16x2_t __attribute__((ext_vector_type(2)));
__device__ __forceinline__ unsigned cvt_pk_c(float lo, float hi) { const v2f v = {lo, hi}; const bf16x2_t b = __builtin_convertvector(v, bf16x2_t); return __builtin_bit_cast(unsigned, b); }
__device__ __forceinline__ unsigned cvt_pk_nv(float lo, float hi) { unsigned r; asm("v_cvt_pk_bf16_f32 %0, %1, %2" : "=v"(r) : "v"(lo), "v"(hi)); return r; }
__device__ __forceinline__ bf16 f2bf(float f) { return (bf16)(cvt_pk_nv(f, 0.f) & 0xffffu); }


__device__ __forceinline__ double dexp(double x) {
    const double y = x * (1.0 / 256.0); double t = 1.0;
#pragma unroll
    for (int i = 12; i >= 1; --i) t = 1.0 + t * y * (1.0 / (double)i);
#pragma unroll
    for (int i = 0; i < 8; ++i) t = t * t;
    return t;
}
__device__ __forceinline__ void dsincos(double x, double& s, double& c) {
    const double twopi = 6.283185307179586476925286766559;
    const double k = rint(x * (1.0 / twopi)); const double r = x - k * twopi, r2 = r * r;
    double ts = r, tc = 1.0; s = r; c = 1.0;
#pragma unroll
    for (int i = 1; i <= 15; ++i) { tc = -tc * r2 * (1.0 / (double)((2 * i - 1) * (2 * i))); ts = -ts * r2 * (1.0 / (double)((2 * i) * (2 * i + 1))); c += tc; s += ts; }
}

typedef const float* cfp_t;
typedef __attribute__((address_space(4))) cfp_t const* kin_t;
__device__ __forceinline__ const float* karg_in(int i) {
    auto k = __builtin_amdgcn_kernarg_segment_ptr();
    asm volatile("" : "+s"(k));
    return ((kin_t)k)[i];
}
struct Ctx {
    __device__ __forceinline__ const float* in(int i) const { return karg_in(i); }
    __device__ __forceinline__ float* out() const { return (float*)karg_in(33); }
    __device__ __forceinline__ unsigned char* ws() const { return (unsigned char*)karg_in(34); }
#define WSP(name, T, off) __device__ __forceinline__ T* name() const { return (T*)(ws() + (off)); }
    WSP(Wgu1, bf16, WS_WGU1) WSP(Wd1, bf16, WS_WD1) WSP(Win, bf16, WS_WIN) WSP(Wglu, bf16, WS_WGLU) WSP(Wout, bf16, WS_WOUT) WSP(Wgu2, bf16, WS_WGU2) WSP(Wd2, bf16, WS_WD2)
    WSP(Weff, bf16, WS_WEFF) WSP(BB, bf16, WS_BB) WSP(CM, bf16, WS_CM) WSP(XN, bf16, WS_XN) WSP(D, bf16, WS_D) WSP(H, bf16, WS_H) WSP(Z, bf16, WS_Z) WSP(YB, bf16, WS_YB) WSP(MIX, bf16, WS_MIX)
    WSP(LAM, float, WS_LAM) WSP(E, float, WS_E) WSP(RS, float, WS_RS)
#undef WSP
};

__device__ __forceinline__ void p0_block_item(const float* W, const float* gk, int K, int N, bf16* WT, int mode, int item, LAS float* tile, int tid) {
    const int nblk = N / 256, kb = item / nblk, nb = item % nblk, k0 = 64 * kb, n0 = 256 * nb;
    const int lr = tid >> 6, lc = 4 * (tid & 63);
    v4f v[8];
#pragma unroll
    for (int i = 0; i < 8; ++i) v[i] = *(const v4f*)(W + (size_t)(k0 + lr + 8 * i) * N + n0 + lc);
    if (gk) {
#pragma unroll
        for (int i = 0; i < 8; ++i) v[i] = v[i] * gk[k0 + lr + 8 * i];
    }
    __syncthreads();
#pragma unroll
    for (int i = 0; i < 8; ++i) { LAS float* p = tile + (lr + 8 * i) * 257 + lc; p[0] = v[i].x; p[1] = v[i].y; p[2] = v[i].z; p[3] = v[i].w; }
    __syncthreads();
    const int c = tid & 7;
#pragma unroll
    for (int j = 0; j < 4; ++j) {
        const int n = (tid >> 3) + 64 * j, ng = n0 + n;
        const int drow = (mode == 0) ? ng : (256 * (ng >> 7) + (ng & 127) + (mode == 2 ? 128 : 0));
        const LAS float* sp = tile + (8 * c) * 257 + n;
        v4u o; o.x = cvt_pk_nv(sp[0 * 257], sp[1 * 257]); o.y = cvt_pk_nv(sp[2 * 257], sp[3 * 257]); o.z = cvt_pk_nv(sp[4 * 257], sp[5 * 257]); o.w = cvt_pk_nv(sp[6 * 257], sp[7 * 257]);
        *(v4u*)(WT + (size_t)drow * K + k0 + 8 * c) = o;
    }
}
__device__ __forceinline__ const float* xrow_ptr(const Ctx& C, int row) { return row < MPROMPT ? C.in(0) + (size_t)row * DM : C.in(1) + (size_t)(row - MPROMPT) * DM; }

__device__ __forceinline__ v4f ld4_f32(const float* p) { return *(const v4f*)p; }
__device__ __forceinline__ v4f ld4_bf16(const bf16* p) { const v2u w = *(const v2u*)p; return (v4f){bf_lo(w.x), bf_hi(w.x), bf_lo(w.y), bf_hi(w.y)}; }
__device__ __forceinline__ void st4_bf16(bf16* p, v4f o) { v2u w; w.x = cvt_pk_nv(o.x, o.y); w.y = cvt_pk_nv(o.z, o.w); *(v2u*)p = w; }
__device__ __forceinline__ float ssq4(v4f v) { return (v.x * v.x + v.y * v.y) + (v.z * v.z + v.w * v.w); }
template <int R>
__device__ __forceinline__ void rows_x0(const Ctx& C, int m0, int stride, int mx, int lane) {
    v4f v[R][4]; float ss[R]; int mr[R]; bool ok[R];
#pragma unroll
    for (int r = 0; r < R; ++r) { mr[r] = (r == 4) ? mx : m0 + r * stride; ok[r] = (r == 4) ? (mx < M) : (mr[r] < MPROMPT); const float* x = xrow_ptr(C, ok[r] ? mr[r] : 0);
#pragma unroll
        for (int j = 0; j < 4; ++j) v[r][j] = ld4_f32(x + 4 * lane + 256 * j); }
    bf16* XN = C.XN();
#pragma unroll
    for (int r = 0; r < R; ++r) { float s = 0.f;
#pragma unroll
        for (int j = 0; j < 4; ++j) s += ssq4(v[r][j]);
        ss[r] = s; }
#pragma unroll
    for (int r = 0; r < R; ++r) ss[r] = rsqrtf(wave_sum(ss[r]) * (1.f / DM) + EPS);
#pragma unroll
    for (int r = 0; r < R; ++r)
#pragma unroll
        for (int j = 0; j < 4; ++j) if (ok[r]) st4_bf16(XN + (size_t)mr[r] * DM + 4 * lane + 256 * j, v[r][j] * ss[r]);
}
template <int R, bool BASE_F32, bool OUT_F32>
__device__ __forceinline__ void rows_res(const Ctx& C, int m0, int stride, int mx, const float* gpost, float scale, int lane) {
    v4f d[R][4], b[R][4]; int mr[R]; bool ok[R]; float r1[R];
    const bf16* D = C.D(); bf16* XN = C.XN();
#pragma unroll
    for (int r = 0; r < R; ++r) { mr[r] = (r == 4) ? mx : m0 + r * stride; ok[r] = (r == 4) ? (mx < M) : (mr[r] < MPROMPT); const int mm = ok[r] ? mr[r] : 0;
#pragma unroll
        for (int j = 0; j < 4; ++j) d[r][j] = ld4_bf16(D + (size_t)mm * DM + 4 * lane + 256 * j);
        if (BASE_F32) { const float* x = xrow_ptr(C, mm);
#pragma unroll
            for (int j = 0; j < 4; ++j) b[r][j] = ld4_f32(x + 4 * lane + 256 * j);
        } else { const float inv = C.RS()[mm];
#pragma unroll
            for (int j = 0; j < 4; ++j) b[r][j] = ld4_bf16(XN + (size_t)mm * DM + 4 * lane + 256 * j) * inv;
        } }
#pragma unroll
    for (int r = 0; r < R; ++r) { float s = 0.f;
#pragma unroll
        for (int j = 0; j < 4; ++j) s += ssq4(d[r][j]);
        r1[r] = s; }
#pragma unroll
    for (int r = 0; r < R; ++r) r1[r] = rsqrtf(wave_sum(r1[r]) * (1.f / DM) + EPS) * scale;
#pragma unroll
    for (int j = 0; j < 4; ++j) { const v4f gp = ld4_f32(gpost + 4 * lane + 256 * j);
#pragma unroll
        for (int r = 0; r < R; ++r) d[r][j] = b[r][j] + d[r][j] * r1[r] * gp; }
    if (OUT_F32) { float* Y = C.out();
#pragma unroll
        for (int r = 0; r < R; ++r)
#pragma unroll
            for (int j = 0; j < 4; ++j) if (ok[r]) *(v4f*)(Y + (size_t)mr[r] * DM + 4 * lane + 256 * j) = d[r][j];
    } else { float* rs = C.RS(); float t[R];
#pragma unroll
        for (int r = 0; r < R; ++r) { float s = 0.f;
#pragma unroll
            for (int j = 0; j < 4; ++j) s += ssq4(d[r][j]);
            t[r] = s; }
#pragma unroll
        for (int r = 0; r < R; ++r) t[r] = wave_sum(t[r]) * (1.f / DM) + EPS;
#pragma unroll
        for (int r = 0; r < R; ++r) { const float rstd = rsqrtf(t[r]);
#pragma unroll
            for (int j = 0; j < 4; ++j) if (ok[r]) st4_bf16(XN + (size_t)mr[r] * DM + 4 * lane + 256 * j, d[r][j] * rstd);
            if (lane == 0 && ok[r]) rs[mr[r]] = sqrtf(t[r]); }
    }
}
template <int R>
__device__ __forceinline__ void rows_norm512(bf16* base, int m0, int stride, int mx, const float* g, int lane) {
    v4u w[R]; float ss[R]; int mr[R]; bool ok[R];
#pragma unroll
    for (int r = 0; r < R; ++r) { mr[r] = (r == 4) ? mx : m0 + r * stride; ok[r] = (r == 4) ? (mx < M) : (mr[r] < MPROMPT);
        w[r] = *(const v4u*)(base + (size_t)(ok[r] ? mr[r] : 0) * DM + 8 * lane); }
    const v4f g0 = *(const v4f*)(g + 8 * lane), g1 = *(const v4f*)(g + 8 * lane + 4);
#pragma unroll
    for (int r = 0; r < R; ++r) { const v4u x = w[r];
        ss[r] = (bf_lo(x.x) * bf_lo(x.x) + bf_hi(x.x) * bf_hi(x.x)) + (bf_lo(x.y) * bf_lo(x.y) + bf_hi(x.y) * bf_hi(x.y)) + (bf_lo(x.z) * bf_lo(x.z) + bf_hi(x.z) * bf_hi(x.z)) + (bf_lo(x.w) * bf_lo(x.w) + bf_hi(x.w) * bf_hi(x.w)); }
#pragma unroll
    for (int r = 0; r < R; ++r) ss[r] = rsqrtf(wave_sum(ss[r]) * (1.f / 512.f) + EPS);
#pragma unroll
    for (int r = 0; r < R; ++r) { const v4u x = w[r]; const float q = ss[r];
        v4u o; o.x = cvt_pk_nv(bf_lo(x.x) * q * g0.x, bf_hi(x.x) * q * g0.y); o.y = cvt_pk_nv(bf_lo(x.y) * q * g0.z, bf_hi(x.y) * q * g0.w);
        o.z = cvt_pk_nv(bf_lo(x.z) * q * g1.x, bf_hi(x.z) * q * g1.y); o.w = cvt_pk_nv(bf_lo(x.w) * q * g1.z, bf_hi(x.w) * q * g1.w);
        if (ok[r]) *(v4u*)(base + (size_t)mr[r] * DM + 8 * lane) = o; }
}

__device__ __forceinline__ void p0_prologue(const Ctx& C, LAS unsigned char* lds, int wave, int lane, int tid) {
    LAS float* tile = (LAS float*)lds;
    const int gw = blockIdx.x * NWAVES + wave, NGW = gridDim.x * NWAVES;
    constexpr int I_GU = (DM / 64) * (DFF / 256), I_D = (DFF / 64) * (DM / 256), I_IN = (DM / 64) * (DIN / 256), I_GLU = (BWD / 64) * (BWD / 256), I_OUT = (DM / 64) * (DM / 256);
    constexpr int NITEMS = 4 * I_GU + 2 * I_D + I_IN + I_GLU + I_OUT;
    for (int it = blockIdx.x; it < NITEMS; it += gridDim.x) {
        int r = it;
        if (r < I_GU) { p0_block_item(C.in(5), C.in(4), DM, DFF, C.Wgu1(), 1, r, tile, tid); continue; } r -= I_GU;
        if (r < I_GU) { p0_block_item(C.in(6), C.in(4), DM, DFF, C.Wgu1(), 2, r, tile, tid); continue; } r -= I_GU;
        if (r < I_GU) { p0_block_item(C.in(29), C.in(28), DM, DFF, C.Wgu2(), 1, r, tile, tid); continue; } r -= I_GU;
        if (r < I_GU) { p0_block_item(C.in(30), C.in(28), DM, DFF, C.Wgu2(), 2, r, tile, tid); continue; } r -= I_GU;
        if (r < I_D) { p0_block_item(C.in(7), nullptr, DFF, DM, C.Wd1(), 0, r, tile, tid); continue; } r -= I_D;
        if (r < I_D) { p0_block_item(C.in(31), nullptr, DFF, DM, C.Wd2(), 0, r, tile, tid); continue; } r -= I_D;
        if (r < I_IN) { p0_block_item(C.in(10), C.in(9), DM, DIN, C.Win(), 0, r, tile, tid); continue; } r -= I_IN;
        if (r < I_GLU) { p0_block_item(C.in(22), nullptr, BWD, BWD, C.Wglu(), 0, r, tile, tid); continue; } r -= I_GLU;
        p0_block_item(C.in(26), nullptr, DM, DM, C.Wout(), 0, r, tile, tid);
    }
    { const int nit = (MPROMPT + 4 * NGW - 1) / (4 * NGW);
      for (int it = 0; it < nit - 1; ++it) rows_x0<4>(C, gw + 4 * it * NGW, NGW, M, lane);
      rows_x0<5>(C, gw + 4 * (nit - 1) * NGW, NGW, MPROMPT + gw, lane);
      for (int ms = MPROMPT + gw + NGW; ms < M; ms += NGW) rows_x0<5>(C, MPROMPT, NGW, ms, lane); }
    const int gt = blockIdx.x * NTHREADS + tid, NGT = gridDim.x * NTHREADS;
    for (int idx = (tid < 8 ? blockIdx.x * 8 + tid : NG * NP); idx < NG * NP; idx += gridDim.x * 8) {
        const int g = idx / NP, p = idx % NP;
        const double lr = (double)C.in(14)[idx], li = (double)C.in(15)[idx], dt = dexp((double)C.in(16)[g]);
        double s1, c1, s8, c8; dsincos(li * dt, s1, c1); dsincos(li * dt * 128.0, s8, c8);
        const double er = dexp(lr * dt), lbr = er * c1, lbi = er * s1;
        const double e8 = dexp(lr * dt * 128.0), l8r = e8 * c8, l8i = e8 * s8;
        C.LAM()[0 * 2048 + idx] = (float)lbr; C.LAM()[1 * 2048 + idx] = (float)lbi; C.LAM()[2 * 2048 + idx] = (float)l8r; C.LAM()[3 * 2048 + idx] = (float)l8i;
        const double a = lbr - 1.0, b = lbi, den = lr * lr + li * li, cr = (a * lr + b * li) / den, ci = (b * lr - a * li) / den;
        for (int n = 0; n < GN; ++n) {
            const double br = (double)C.in(17)[(size_t)idx * GN + n], bi = (double)C.in(18)[(size_t)idx * GN + n];
            C.BB()[((size_t)g * 128 + 2 * p) * GN + n] = f2bf((float)(cr * br - ci * bi));
            C.BB()[((size_t)g * 128 + 2 * p + 1) * GN + n] = f2bf((float)(cr * bi + ci * br));
            C.CM()[((size_t)g * GN + n) * 128 + 2 * p] = f2bf(C.in(19)[((size_t)g * GN + n) * NP + p]);
            C.CM()[((size_t)g * GN + n) * 128 + 2 * p + 1] = f2bf(-C.in(20)[((size_t)g * GN + n) * NP + p]);
        }
    }
    for (int idx = gt; idx < 2 * 4 * 128 * 128; idx += NGT) {
        const int s = idx & 127, t = (idx >> 7) & 127, h = (idx >> 14) & 3, mode = idx >> 16;
        float v;
        if (mode == 0) v = (s <= t) ? C.in(12)[((size_t)h * 128 + t) * 128 + s] : 0.f;
        else v = ((s >> 4) == (t >> 4) && (s & 15) <= (t & 15)) ? C.in(12)[((size_t)h * 128 + (t & 15)) * 128 + (s & 15)] : 0.f;
        C.Weff()[idx] = f2bf(v);
    }
}

constexpr int XU_STRIDE = 72;
constexpr int BH_STRIDE = 136;
constexpr int S5W_BYTES = 32 * XU_STRIDE * 2 + 32 * BH_STRIDE * 2;
static_assert(NWAVES * S5W_BYTES <= LDS_BYTES - 64, "s5 lds");
template <bool PASS2>
__device__ __forceinline__ void s5_tile(const Ctx& C, int T, int sb_lo, int sb_hi, LAS unsigned char* lds, int wave, int lane) {
    const bool sample = (T == NTILE - 1);
    const int r0 = T * 128;
    LAS bf16* XU = (LAS bf16*)(lds + wave * S5W_BYTES);
    LAS bf16* BH = XU + 32 * XU_STRIDE;
    const int tl = lane & 31, hh = lane >> 5, fr = lane & 15, kq = lane >> 4, xrow = lane >> 3, xpart = lane & 7;
    const float* LAM = C.LAM();
    const bf16* Zb = C.Z() + (size_t)1024 + 64 * wave;
    float sr[4], si[4], lr[4], li[4], dsk[4];
#pragma unroll
    for (int gi = 0; gi < 4; ++gi) { const int g = wave * 4 + gi; sr[gi] = 0.f; si[gi] = 0.f; lr[gi] = LAM[0 * 2048 + g * 64 + lane]; li[gi] = LAM[1 * 2048 + g * 64 + lane];
        dsk[gi] = PASS2 ? C.in(21)[16 * g + fr] : 0.f; }
    if (PASS2 && !sample) {
        const int k = T & 127, tb = T - k;
        float l8r[4], l8i[4];
#pragma unroll
        for (int gi = 0; gi < 4; ++gi) { l8r[gi] = LAM[2 * 2048 + (wave * 4 + gi) * 64 + lane]; l8i[gi] = LAM[3 * 2048 + (wave * 4 + gi) * 64 + lane]; }
        const v2f* Ep = (const v2f*)C.E() + ((size_t)tb * NG + wave * 4) * NP + lane;
        const int nb = (k + 15) >> 4, j0 = k - 16 * nb;
        for (int jb = 0; jb < nb; ++jb) {
#pragma unroll
            for (int u = 0; u < 16; ++u) {
                const int j = j0 + 16 * jb + u; const bool ok = j >= 0; const int jc = ok ? j : 0;
#pragma unroll
                for (int gi = 0; gi < 4; ++gi) { v2f e = Ep[(size_t)jc * NG * NP + gi * NP]; if (!ok) e = (v2f){0.f, 0.f};
                    const float nr = fmaf(l8r[gi], sr[gi], fmaf(-l8i[gi], si[gi], e.x)), ni = fmaf(l8r[gi], si[gi], fmaf(l8i[gi], sr[gi], e.y)); sr[gi] = nr; si[gi] = ni; }
            }
        }
    }
    v4u xn[4];
    {
        const int sb0 = sb_lo;
#pragma unroll
        for (int i = 0; i < 4; ++i) xn[i] = *(const v4u*)(Zb + (size_t)(r0 + 32 * sb0 + xrow + 8 * i) * DIN + 8 * xpart);
    }
    for (int sb = sb_lo; sb < sb_hi; ++sb) {
        const int rb0 = r0 + 32 * sb;
#pragma unroll
        for (int i = 0; i < 4; ++i) *(LAS v4u*)(XU + (xrow + 8 * i) * XU_STRIDE + 8 * xpart) = xn[i];
        if (sb + 1 < sb_hi) {
#pragma unroll
            for (int i = 0; i < 4; ++i) xn[i] = *(const v4u*)(Zb + (size_t)(rb0 + 32 + xrow + 8 * i) * DIN + 8 * xpart);
        }
        LDS_FENCE();
#pragma unroll
        for (int gi = 0; gi < 4; ++gi) {
            const int g = wave * 4 + gi;
            bfx8 bb[4];
#pragma unroll
            for (int cb = 0; cb < 4; ++cb) bb[cb] = *(const bfx8*)(C.BB() + ((size_t)(g * 128 + cb * 32 + tl)) * GN + 8 * hh);
            bfx8 cm[4];
            if (PASS2) {
#pragma unroll
                for (int ks = 0; ks < 4; ++ks) cm[ks] = *(const bfx8*)(C.CM() + ((size_t)(g * GN + fr)) * 128 + 32 * ks + 8 * kq);
            }
            float s0ar = 0.f, s0ai = 0.f, s0br = 0.f, s0bi = 0.f;
            if (sample) { const size_t o0 = ((size_t)(2 * sb) * NG + g) * NP + lane, o1 = o0 + (size_t)NG * NP;
                s0ar = C.in(2)[o0]; s0ai = C.in(3)[o0]; s0br = C.in(2)[o1]; s0bi = C.in(3)[o1]; }
            const bfx8 a = *(const LAS bfx8*)(XU + tl * XU_STRIDE + 16 * gi + 8 * hh);
#pragma unroll
            for (int cb = 0; cb < 4; ++cb) {
                v16f acc;
#pragma unroll
                for (int r = 0; r < 16; ++r) acc[r] = 0.f;
                acc = __builtin_amdgcn_mfma_f32_32x32x16_bf16(bb[cb], a, acc, 0, 0, 0);
#pragma unroll
                for (int rg = 0; rg < 4; ++rg) { v2u w; w.x = cvt_pk_c(acc[4 * rg], acc[4 * rg + 1]); w.y = cvt_pk_c(acc[4 * rg + 2], acc[4 * rg + 3]);
                    *(LAS v2u*)(BH + tl * BH_STRIDE + cb * 32 + 8 * rg + 4 * hh) = w; }
            }
            LDS_FENCE();
            {
                unsigned bu[32];
#pragma unroll
                for (int t = 0; t < 32; ++t) bu[t] = *(const LAS unsigned*)(BH + t * BH_STRIDE + 2 * lane);
                LDS_FENCE();
                float xr = sr[gi], xi = si[gi];
#pragma unroll
                for (int t = 0; t < 32; ++t) {
                    if (sample && t == 0) { xr = s0ar; xi = s0ai; }
                    if (sample && t == 16) { xr = s0br; xi = s0bi; }
                    const float nr = fmaf(lr[gi], xr, fmaf(-li[gi], xi, bf_lo(bu[t]))), ni = fmaf(lr[gi], xi, fmaf(li[gi], xr, bf_hi(bu[t])));
                    xr = nr; xi = ni;
                    if (PASS2) {
                        *(LAS unsigned*)(BH + t * BH_STRIDE + 2 * lane) = cvt_pk_nv(xr, xi);
                        if (sample && (t & 15) == 15) { const int seq = 2 * sb + (t >> 4);
                            C.out()[OFF_SRE_S + ((size_t)seq * NG + g) * NP + lane] = xr; C.out()[OFF_SIM_S + ((size_t)seq * NG + g) * NP + lane] = xi; }
                    }
                }
                sr[gi] = xr; si[gi] = xi;
            }
            LDS_FENCE();
            if (PASS2) {
#pragma unroll
                for (int rb = 0; rb < 2; ++rb) {
                    v4f acc = (v4f){0.f, 0.f, 0.f, 0.f};
#pragma unroll
                    for (int ks = 0; ks < 4; ++ks) {
                        const bfx8 sa = *(const LAS bfx8*)(BH + (16 * rb + fr) * BH_STRIDE + 32 * ks + 8 * kq);
                        acc = __builtin_amdgcn_mfma_f32_16x16x32_bf16(sa, cm[ks], acc, 0, 0, 0);
                    }
#pragma unroll
                    for (int r = 0; r < 4; ++r) {
                        LAS bf16* up = XU + (16 * rb + 4 * kq + r) * XU_STRIDE + 16 * gi + fr;
                        const float u = __uint_as_float((unsigned)(*up) << 16);
                        *up = f2bf(gelu_t(acc[r] + dsk[gi] * u));
                    }
                }
                LDS_FENCE();
            }
        }
        if (PASS2) {
#pragma unroll
            for (int i = 0; i < 4; ++i) *(v4u*)(C.YB() + (size_t)(rb0 + xrow + 8 * i) * BWD + 64 * wave + 8 * xpart) = *(const LAS v4u*)(XU + (xrow + 8 * i) * XU_STRIDE + 8 * xpart);
            LDS_FENCE();
        }
    }
#pragma unroll
    for (int gi = 0; gi < 4; ++gi) {
        const int g = wave * 4 + gi;
        if (!PASS2) { v2f* Ep = (v2f*)C.E() + ((size_t)T * NG + g) * NP + lane; *Ep = (v2f){sr[gi], si[gi]}; }
        else if (!sample && (T & 127) == 127) { const int b = T >> 7;
            C.out()[OFF_SRE_P + ((size_t)b * NG + g) * NP + lane] = sr[gi]; C.out()[OFF_SIM_P + ((size_t)b * NG + g) * NP + lane] = si[gi]; }
    }
}

__device__ __forceinline__ void gmlp_tile(const Ctx& C, int T, LAS unsigned char* lds, int wave, int lane, int tid) {
    const int mode = (T == NTILE - 1) ? 1 : 0;
    const int r0 = T * 128;
    LAS bf16* VT = (LAS bf16*)lds;
    LAS float* SSQ = (LAS float*)(lds + 128 * VT_STRIDE * 2);
    const int tb = wave & 3, dh = wave >> 2, tl = lane & 31, hh = lane >> 5;
    const int t = 32 * tb + tl;
    unsigned outp[4][2][8]; float ssq = 0.f;
    const bf16* zt = C.Z() + (size_t)(r0 + t) * DIN;
    const int row = tid >> 2, q = tid & 3;
    const bf16* vsrc = C.Z() + (size_t)(r0 + row) * DIN + 512 + q * 32;
    const bf16* Weff = C.Weff();
    v4u vraw[4];
#pragma unroll
    for (int i = 0; i < 4; ++i) vraw[i] = *(const v4u*)(vsrc + 8 * i);
#pragma unroll
    for (int h = 0; h < 4; ++h) {
        bfx8 wf[8];
        const bf16* wrow = Weff + ((size_t)(mode * 4 + h) * 128 + t) * 128 + 8 * hh;
#pragma unroll
        for (int ks = 0; ks < 8; ++ks) wf[ks] = *(const bfx8*)(wrow + 16 * ks);
        v2u uw[2][4];
#pragma unroll
        for (int dbi = 0; dbi < 2; ++dbi)
#pragma unroll
            for (int rg = 0; rg < 4; ++rg) uw[dbi][rg] = *(const v2u*)(zt + h * 128 + 32 * (2 * dh + dbi) + 8 * rg + 4 * hh);
        const float bias = C.in(13)[h * 128 + (mode ? (t & 15) : t)];
        __syncthreads();
        {
            float v[32]; float s = 0.f;
#pragma unroll
            for (int i = 0; i < 4; ++i) { const v4u w = vraw[i];
                v[8 * i + 0] = bf_lo(w.x); v[8 * i + 1] = bf_hi(w.x); v[8 * i + 2] = bf_lo(w.y); v[8 * i + 3] = bf_hi(w.y);
                v[8 * i + 4] = bf_lo(w.z); v[8 * i + 5] = bf_hi(w.z); v[8 * i + 6] = bf_lo(w.w); v[8 * i + 7] = bf_hi(w.w); }
            if (h < 3) {
#pragma unroll
                for (int i = 0; i < 4; ++i) vraw[i] = *(const v4u*)(vsrc + (h + 1) * 128 + 8 * i);
            }
#pragma unroll
            for (int i = 0; i < 32; ++i) s += v[i] * v[i];
            s += __shfl_xor(s, 1); s += __shfl_xor(s, 2);
            const float r = rsqrtf(s * (1.f / 128.f) + EPS);
            const float* gv = C.in(11) + h * 128 + q * 32;
#pragma unroll
            for (int i = 0; i < 32; ++i) { v[i] = v[i] * r * gv[i]; VT[(q * 32 + i) * VT_STRIDE + row] = f2bf(v[i]); }
            if (mode) { float* ov = C.out() + OFF_V_S + (size_t)row * AW + h * 128 + q * 32;
#pragma unroll
                for (int i = 0; i < 8; ++i) *(v4f*)(ov + 4 * i) = (v4f){v[4 * i], v[4 * i + 1], v[4 * i + 2], v[4 * i + 3]}; }
        }
        __syncthreads();
#pragma unroll
        for (int dbi = 0; dbi < 2; ++dbi) {
            const int db = 2 * dh + dbi;
            v16f acc;
#pragma unroll
            for (int r = 0; r < 16; ++r) acc[r] = 0.f;
#pragma unroll
            for (int ks = 0; ks < 8; ++ks) {
                const bfx8 va = *(const LAS bfx8*)(VT + (32 * db + tl) * VT_STRIDE + 16 * ks + 8 * hh);
                acc = __builtin_amdgcn_mfma_f32_32x32x16_bf16(va, wf[ks], acc, 0, 0, 0);
            }
#pragma unroll
            for (int rg = 0; rg < 4; ++rg) {
                const v2u u2 = uw[dbi][rg];
                const float o0 = bf_lo(u2.x) * (acc[4 * rg + 0] + bias), o1 = bf_hi(u2.x) * (acc[4 * rg + 1] + bias);
                const float o2 = bf_lo(u2.y) * (acc[4 * rg + 2] + bias), o3 = bf_hi(u2.y) * (acc[4 * rg + 3] + bias);
                ssq += (o0 * o0 + o1 * o1) + (o2 * o2 + o3 * o3);
                outp[h][dbi][2 * rg] = cvt_pk_nv(o0, o1); outp[h][dbi][2 * rg + 1] = cvt_pk_nv(o2, o3);
            }
        }
    }
    ssq += __shfl_xor(ssq, 32);
    if (hh == 0) SSQ[t * 2 + dh] = ssq;
    __syncthreads();
    const float rstd = rsqrtf((SSQ[t * 2] + SSQ[t * 2 + 1]) * (1.f / 512.f) + EPS);
    const float* gap = C.in(24);
    LAS bf16* OT = (LAS bf16*)lds;
    __syncthreads();
#pragma unroll
    for (int h = 0; h < 4; ++h)
#pragma unroll
        for (int dbi = 0; dbi < 2; ++dbi)
#pragma unroll
            for (int rg = 0; rg < 4; ++rg) {
                const int c = h * 128 + 32 * (2 * dh + dbi) + 8 * rg + 4 * hh;
                const v4f ga = *(const v4f*)(gap + c);
                const unsigned w0 = outp[h][dbi][2 * rg], w1 = outp[h][dbi][2 * rg + 1];
                v2u o; o.x = cvt_pk_nv(bf_lo(w0) * rstd * ga.x, bf_hi(w0) * rstd * ga.y); o.y = cvt_pk_nv(bf_lo(w1) * rstd * ga.z, bf_hi(w1) * rstd * ga.w);
                *(LAS v2u*)(OT + t * OT_STRIDE + c) = o;
            }
    __syncthreads();
    {
        bf16* obase = C.MIX() + (size_t)r0 * DM;
#pragma unroll 4
        for (int i = 0; i < 16; ++i) { const int row = wave * 16 + i; *(v4u*)(obase + (size_t)row * DM + 8 * lane) = *(const LAS v4u*)(OT + row * OT_STRIDE + 8 * lane); }
    }
    __syncthreads();
}

#define FTID const int ftid_ = fresh_tid()
#define TID (ftid_)
#define LANE (ftid_ & 63)
#define WAVE (__builtin_amdgcn_readfirstlane(ftid_ >> 6))
#define GSZ ((int)gridDim.x)
#define BX ((int)blockIdx.x)
#define GWV (BX * NWAVES + WAVE)
#define NGWV (GSZ * NWAVES)
constexpr size_t WS_CTL = 0, CTL_ZERO_BYTES = 16384;
constexpr int MISC_OFF = LDS_BYTES - 64;
#define XB_TMO      128
#define XB_XCNT(j)  (256  + 64 * (j))
#define XB_XSUB(j)  (1280 + 64 * (j))
#define XB_XGEN(j)  (2304 + 64 * (j))
#define XB_TOP      3328
#define XB_TOPGEN   3392
#define XCD_BAR_WORDS 3456
#define XB_SPIN_CAP (1u << 18)

__device__ __forceinline__ unsigned xb_ld(unsigned* p)              { return __hip_atomic_load(p, __ATOMIC_RELAXED, __HIP_MEMORY_SCOPE_AGENT); }
__device__ __forceinline__ unsigned xb_add(unsigned* p, unsigned v) { return __hip_atomic_fetch_add(p, v, __ATOMIC_RELAXED, __HIP_MEMORY_SCOPE_AGENT); }
__device__ __forceinline__ unsigned xb_xcc_id() { return (unsigned)__builtin_amdgcn_s_getreg((3 << 11) | 20) & 0xFu; }
#define XB_SPIN(cond, bar) do { unsigned _sp = 0; while (cond) { __builtin_amdgcn_s_sleep(1); \
    if ((++_sp & 255u) == 0u) { if (xb_ld(&(bar)[XB_TMO])) break; if (_sp > XB_SPIN_CAP) { atomicAdd(&(bar)[XB_TMO], 1u); break; } } } } while (0)

struct XcdBarrier {
    unsigned* bar; unsigned x;
    volatile LAS unsigned* st;
};

__device__ __forceinline__ XcdBarrier xcd_barrier_post(unsigned* bar, volatile LAS unsigned* st) {
    XcdBarrier b; b.bar = bar; b.x = xb_xcc_id(); b.st = st;
    if (threadIdx.x == 0) (void)xb_add(&bar[XB_XCNT(b.x)], 1u);
    return b;
}
__device__ __forceinline__ void xcd_barrier_complete(unsigned* bar, unsigned x, unsigned& nloc, unsigned& nx) {
    const unsigned G = gridDim.x * gridDim.y * gridDim.z;
    unsigned sum, cnt, mine, sp = 0u;
    for (;;) {
        sum = 0u; cnt = 0u; mine = 0u;
#pragma unroll
        for (unsigned j = 0; j < 16; ++j) { const unsigned c = xb_ld(&bar[XB_XCNT(j)]); sum += c; cnt += (c > 0u) ? 1u : 0u; mine = (j == x) ? c : mine; }
        if (sum == G) break;
        __builtin_amdgcn_s_sleep(1);
        if ((++sp & 255u) == 0u) { if (xb_ld(&bar[XB_TMO])) break; if (sp > XB_SPIN_CAP) { atomicAdd(&bar[XB_TMO], 1u); break; } }
    }
    nloc = mine > 0u ? mine : 1u; nx = cnt > 0u ? cnt : 1u;
}

__device__ __forceinline__ void xcd_barrier(const XcdBarrier& b) {
    asm volatile("s_waitcnt vmcnt(0)" ::: "memory");
    __syncthreads();
    if (threadIdx.x == 0) {
        unsigned* bar = b.bar;
        __builtin_amdgcn_s_waitcnt(0);
        unsigned nloc = b.st[0], nx = b.st[1];
        if (nloc == 0u) { xcd_barrier_complete(bar, b.x, nloc, nx); b.st[0] = nloc; b.st[1] = nx; }
        const unsigned old = xb_add(&bar[XB_XSUB(b.x)], 1u);
        const unsigned gen = old / nloc;
        if (old + 1u == (gen + 1u) * nloc) {
            __builtin_amdgcn_fence(__ATOMIC_RELEASE, "agent");
            asm volatile("s_waitcnt vmcnt(0)" ::: "memory");
            const unsigned og = xb_add(&bar[XB_TOP], 1u);
            const unsigned tg = og / nx;
            if (og + 1u == (tg + 1u) * nx) xb_add(&bar[XB_TOPGEN], 1u);
            else XB_SPIN(xb_ld(&bar[XB_TOPGEN]) == tg, bar);
            __builtin_amdgcn_fence(__ATOMIC_ACQUIRE, "agent");
            xb_add(&bar[XB_XGEN(b.x)], 1u);
            asm volatile("s_waitcnt vmcnt(0)" ::: "memory");
        } else {
            XB_SPIN(xb_ld(&bar[XB_XGEN(b.x)]) == gen, bar);
            __builtin_amdgcn_fence(__ATOMIC_ACQUIRE, "agent");
            asm volatile("s_waitcnt vmcnt(0)" ::: "memory");
        }
    }
    __syncthreads();
}

template <int MODE>
__device__ __forceinline__ void small_gemm(LAS unsigned char* lds, const bf16* A, const bf16* Bt, int N, int K, bf16* O, int ldc, int act_cols, const float* bias, const bf16* Yv, int ldy, int it0, int it1) {
    FTID; const int wave = WAVE, lane = LANE, tl = lane & 31, hh = lane >> 5;
    LAS float* red = (LAS float*)lds;
    const int nct = N / 32, nitems = 4 * nct, kw = K / 8, nks = kw / 16;
    for (int it = it0; it < it1; ++it) {
        const int item = BX + it * GSZ; if (item >= nitems) break;
        const int rt = item & 3, ct = item >> 2;
        const int hc = 32 * ct + tl;
        const int brow = (MODE == 3) ? (256 * (hc >> 7) + (hc & 127)) : hc;
        const bf16* ap = A + (size_t)(32 * rt + tl) * K + wave * kw + 8 * hh;
        const bf16* bp = Bt + (size_t)brow * K + wave * kw + 8 * hh;
        v16f acc0, acc1;
#pragma unroll
        for (int r = 0; r < 16; ++r) { acc0[r] = 0.f; acc1[r] = 0.f; }
#pragma unroll 4
        for (int ks = 0; ks < nks; ++ks) {
            const bfx8 a = *(const bfx8*)(ap + 16 * ks);
            const bfx8 b0 = *(const bfx8*)(bp + 16 * ks);
            acc0 = __builtin_amdgcn_mfma_f32_32x32x16_bf16(b0, a, acc0, 0, 0, 0);
            if (MODE == 3) { const bfx8 b1 = *(const bfx8*)(bp + (size_t)128 * K + 16 * ks); acc1 = __builtin_amdgcn_mfma_f32_32x32x16_bf16(b1, a, acc1, 0, 0, 0); }
        }
        __syncthreads();
#pragma unroll
        for (int r = 0; r < 16; ++r) { red[(wave * 16 + r) * 64 + lane] = acc0[r]; if (MODE == 3) red[8192 + (wave * 16 + r) * 64 + lane] = acc1[r]; }
        __syncthreads();
        float v0[2], v1[2];
#pragma unroll
        for (int e = 0; e < 2; ++e) { float s0 = 0.f, s1 = 0.f;
#pragma unroll
            for (int w = 0; w < 8; ++w) { s0 += red[(w * 16 + 2 * wave + e) * 64 + lane]; if (MODE == 3) s1 += red[8192 + (w * 16 + 2 * wave + e) * 64 + lane]; }
            v0[e] = s0; v1[e] = s1; }
        const int reg = 2 * wave;
        const int col = 32 * ct + (reg & 3) + 8 * (reg >> 2) + 4 * hh;
        const size_t row = (size_t)(32 * rt + tl);
        float o0 = v0[0], o1 = v0[1];
        if (MODE == 1) { if (col < act_cols) { o0 = gelu_t(o0); o1 = gelu_t(o1); } }
        if (MODE == 2) { const unsigned y = *(const unsigned*)(Yv + row * ldy + col); o0 = bf_lo(y) * pg8::sigmoid_f(o0 + bias[col]); o1 = bf_hi(y) * pg8::sigmoid_f(o1 + bias[col + 1]); }
        if (MODE == 3) { o0 = pg8::silu_f(o0) * v1[0]; o1 = pg8::silu_f(o1) * v1[1]; }
        *(unsigned*)(O + row * ldc + col) = cvt_pk_bf16(o0, o1);
    }
    __syncthreads();
}
struct Args { const float* in[33]; float* out; unsigned char* ws; };
__global__ void __launch_bounds__(NTHREADS, 2) fwd_kernel(Args args) {
    extern __shared__ __attribute__((aligned(16))) unsigned char lds_raw[];
    cg::grid_group grid = cg::this_grid();
    LAS unsigned char* lds = (LAS unsigned char*)lds_raw;
    Ctx C;
    if (threadIdx.x < 16) ((volatile LAS unsigned*)(lds + MISC_OFF))[threadIdx.x] = 0u;
    __syncthreads();
    (void)xcd_barrier_post((unsigned*)(C.ws() + WS_CTL), (volatile LAS unsigned*)(lds + MISC_OFF));
#define XBAR() do { XcdBarrier b_; b_.bar = (unsigned*)(C.ws() + WS_CTL); b_.x = xb_xcc_id(); b_.st = (volatile LAS unsigned*)(lds + MISC_OFF); xcd_barrier(b_); } while (0)
    grid.sync();
    { FTID; p0_prologue(C, lds, WAVE, LANE, TID); }
    XBAR();
    { const int stg = (BX >> 3) & 3;
    small_gemm<3>(lds, C.XN() + (size_t)MPROMPT * DM, C.Wgu1(), DFF, DM, C.H() + (size_t)MPROMPT * DFF, DFF, 0, nullptr, nullptr, 0, 0, stg);
    { pg8::Gemm g{C.XN(), C.Wgu1(), MPROMPT, 2 * DFF, DM}; pg8::StaticOrder S; S.init(MPROMPT, 2 * DFF, GSZ, BX); pg8::EpiSwiglu E{C.H(), DFF};
      pg8::gemm_phase<pg8::EpiSwiglu, pg8::StaticOrder, true, true>(lds, g, S, E); }
    small_gemm<3>(lds, C.XN() + (size_t)MPROMPT * DM, C.Wgu1(), DFF, DM, C.H() + (size_t)MPROMPT * DFF, DFF, 0, nullptr, nullptr, 0, stg, 4); }
    XBAR();
    { const int stg = (BX >> 3) & 3;
    small_gemm<0>(lds, C.H() + (size_t)MPROMPT * DFF, C.Wd1(), DM, DFF, C.D() + (size_t)MPROMPT * DM, DM, 0, nullptr, nullptr, 0, 0, stg);
    { pg8::Gemm g{C.H(), C.Wd1(), MPROMPT, DM, DFF}; pg8::StaticOrder S; S.init(MPROMPT, DM, GSZ, BX); pg8::EpiBf16<0> E{C.D(), DM, 0, nullptr, nullptr, 0};
      pg8::gemm_phase<pg8::EpiBf16<0>, pg8::StaticOrder, true, true>(lds, g, S, E); }
    small_gemm<0>(lds, C.H() + (size_t)MPROMPT * DFF, C.Wd1(), DM, DFF, C.D() + (size_t)MPROMPT * DM, DM, 0, nullptr, nullptr, 0, stg, 4); }
    XBAR();
    { FTID; const float* gp = C.in(8); { const int gw_ = GWV, ngw_ = NGWV, nit = (MPROMPT + 4 * ngw_ - 1) / (4 * ngw_);
      for (int it = 0; it < nit - 1; ++it) rows_res<4, true, false>(C, gw_ + 4 * it * ngw_, ngw_, M, gp, 0.5f, LANE);
      rows_res<5, true, false>(C, gw_ + 4 * (nit - 1) * ngw_, ngw_, MPROMPT + gw_, gp, 0.5f, LANE);
      for (int ms = MPROMPT + gw_ + ngw_; ms < M; ms += ngw_) rows_res<5, true, false>(C, MPROMPT, ngw_, ms, gp, 0.5f, LANE); } }
    XBAR();
    { const int stg = (BX >> 3) & 3;
    small_gemm<1>(lds, C.XN() + (size_t)MPROMPT * DM, C.Win(), DIN, DM, C.Z() + (size_t)MPROMPT * DIN, DIN, 2 * AW, nullptr, nullptr, 0, 0, stg);
    { pg8::Gemm g{C.XN(), C.Win(), MPROMPT, DIN, DM}; pg8::StaticOrder S; S.init(MPROMPT, DIN, GSZ, BX); pg8::EpiBf16<1> E{C.Z(), DIN, 2 * AW, nullptr, nullptr, 0};
      pg8::gemm_phase<pg8::EpiBf16<1>, pg8::StaticOrder, true, true>(lds, g, S, E); }
    small_gemm<1>(lds, C.XN() + (size_t)MPROMPT * DM, C.Win(), DIN, DM, C.Z() + (size_t)MPROMPT * DIN, DIN, 2 * AW, nullptr, nullptr, 0, stg, 4); }
    XBAR();
    { FTID; for (int T = BX; T < NTILE - 1; T += GSZ) {
        s5_tile<false>(C, T, 0, 4, lds, WAVE, LANE);
        __syncthreads();
        gmlp_tile(C, T, lds, WAVE, LANE, TID);
    } }
    XBAR();
    { FTID; const bool swap0 = GSZ > 128;
      for (int T = BX; T < NTILE - 1; T += GSZ) { if (swap0 && T == 0) continue; s5_tile<true>(C, T, 0, 4, lds, WAVE, LANE); }
      if (swap0 && BX == 128) s5_tile<true>(C, 0, 0, 4, lds, WAVE, LANE);
      if (BX >= 1 && BX <= 4) s5_tile<true>(C, NTILE - 1, BX - 1, BX, lds, WAVE, LANE);
      if (BX == 0) { __syncthreads(); gmlp_tile(C, NTILE - 1, lds, WAVE, LANE, TID); } }
    XBAR();
    { const int stg = (BX >> 3) & 3;
    small_gemm<2>(lds, C.YB() + (size_t)MPROMPT * BWD, C.Wglu(), BWD, BWD, C.MIX() + (size_t)MPROMPT * DM + AW, DM, 0, C.in(23), C.YB() + (size_t)MPROMPT * BWD, BWD, 0, stg);
    { pg8::Gemm g{C.YB(), C.Wglu(), MPROMPT, BWD, BWD}; pg8::StaticOrder S; S.init(MPROMPT, BWD, GSZ, BX); pg8::EpiBf16<2> E{C.MIX() + AW, DM, 0, C.in(23), C.YB(), BWD};
      pg8::gemm_phase<pg8::EpiBf16<2>, pg8::StaticOrder, true, true>(lds, g, S, E); }
    small_gemm<2>(lds, C.YB() + (size_t)MPROMPT * BWD, C.Wglu(), BWD, BWD, C.MIX() + (size_t)MPROMPT * DM + AW, DM, 0, C.in(23), C.YB() + (size_t)MPROMPT * BWD, BWD, stg, 4); }
    XBAR();
    { FTID; const float* gb = C.in(25); bf16* bb_ = C.MIX() + AW; const int gw_ = GWV, ngw_ = NGWV, nit = (MPROMPT + 4 * ngw_ - 1) / (4 * ngw_);
      for (int it = 0; it < nit - 1; ++it) rows_norm512<4>(bb_, gw_ + 4 * it * ngw_, ngw_, M, gb, LANE);
      rows_norm512<5>(bb_, gw_ + 4 * (nit - 1) * ngw_, ngw_, MPROMPT + gw_, gb, LANE);
      for (int ms = MPROMPT + gw_ + ngw_; ms < M; ms += ngw_) rows_norm512<5>(bb_, MPROMPT, ngw_, ms, gb, LANE); }
    XBAR();
    { const int stg = (BX >> 3) & 3;
    small_gemm<0>(lds, C.MIX() + (size_t)MPROMPT * DM, C.Wout(), DM, DM, C.D() + (size_t)MPROMPT * DM, DM, 0, nullptr, nullptr, 0, 0, stg);
    { pg8::Gemm g{C.MIX(), C.Wout(), MPROMPT, DM, DM}; pg8::StaticOrder S; S.init(MPROMPT, DM, GSZ, BX); pg8::EpiBf16<0> E{C.D(), DM, 0, nullptr, nullptr, 0};
      pg8::gemm_phase<pg8::EpiBf16<0>, pg8::StaticOrder, true, true>(lds, g, S, E); }
    small_gemm<0>(lds, C.MIX() + (size_t)MPROMPT * DM, C.Wout(), DM, DM, C.D() + (size_t)MPROMPT * DM, DM, 0, nullptr, nullptr, 0, stg, 4); }
    XBAR();
    { FTID; const float* gp = C.in(27); { const int gw_ = GWV, ngw_ = NGWV, nit = (MPROMPT + 4 * ngw_ - 1) / (4 * ngw_);
      for (int it = 0; it < nit - 1; ++it) rows_res<4, false, false>(C, gw_ + 4 * it * ngw_, ngw_, M, gp, 1.0f, LANE);
      rows_res<5, false, false>(C, gw_ + 4 * (nit - 1) * ngw_, ngw_, MPROMPT + gw_, gp, 1.0f, LANE);
      for (int ms = MPROMPT + gw_ + ngw_; ms < M; ms += ngw_) rows_res<5, false, false>(C, MPROMPT, ngw_, ms, gp, 1.0f, LANE); } }
    XBAR();
    { const int stg = (BX >> 3) & 3;
    small_gemm<3>(lds, C.XN() + (size_t)MPROMPT * DM, C.Wgu2(), DFF, DM, C.H() + (size_t)MPROMPT * DFF, DFF, 0, nullptr, nullptr, 0, 0, stg);
    { pg8::Gemm g{C.XN(), C.Wgu2(), MPROMPT, 2 * DFF, DM}; pg8::StaticOrder S; S.init(MPROMPT, 2 * DFF, GSZ, BX); pg8::EpiSwiglu E{C.H(), DFF};
      pg8::gemm_phase<pg8::EpiSwiglu, pg8::StaticOrder, true, true>(lds, g, S, E); }
    small_gemm<3>(lds, C.XN() + (size_t)MPROMPT * DM, C.Wgu2(), DFF, DM, C.H() + (size_t)MPROMPT * DFF, DFF, 0, nullptr, nullptr, 0, stg, 4); }
    XBAR();
    { const int stg = (BX >> 3) & 3;
    small_gemm<0>(lds, C.H() + (size_t)MPROMPT * DFF, C.Wd2(), DM, DFF, C.D() + (size_t)MPROMPT * DM, DM, 0, nullptr, nullptr, 0, 0, stg);
    { pg8::Gemm g{C.H(), C.Wd2(), MPROMPT, DM, DFF}; pg8::StaticOrder S; S.init(MPROMPT, DM, GSZ, BX); pg8::EpiBf16<0> E{C.D(), DM, 0, nullptr, nullptr, 0};
      pg8::gemm_phase<pg8::EpiBf16<0>, pg8::StaticOrder, true, true>(lds, g, S, E); }
    small_gemm<0>(lds, C.H() + (size_t)MPROMPT * DFF, C.Wd2(), DM, DFF, C.D() + (size_t)MPROMPT * DM, DM, 0, nullptr, nullptr, 0, stg, 4); }
    XBAR();
    { FTID; const float* gp = C.in(32); { const int gw_ = GWV, ngw_ = NGWV, nit = (MPROMPT + 4 * ngw_ - 1) / (4 * ngw_);
      for (int it = 0; it < nit - 1; ++it) rows_res<4, false, true>(C, gw_ + 4 * it * ngw_, ngw_, M, gp, 0.5f, LANE);
      rows_res<5, false, true>(C, gw_ + 4 * (nit - 1) * ngw_, ngw_, MPROMPT + gw_, gp, 0.5f, LANE);
      for (int ms = MPROMPT + gw_ + ngw_; ms < M; ms += ngw_) rows_res<5, false, true>(C, MPROMPT, ngw_, ms, gp, 0.5f, LANE); } }
}

extern "C" void kernel_launch(void* const* d_in, const int* in_sizes, int n_in, void* d_out, int out_size, void* d_ws, size_t ws_size, hipStream_t stream) {
    static int grid = 0;
    if (grid == 0) {
        if (n_in != 33 || ws_size < WS_END) { fprintf(stderr, "kernel_launch: unexpected n_in %d / ws %zu\n", n_in, ws_size); grid = -1; return; }
        int dev = 0, cus = 0, per_cu = 0;
        hipGetDevice(&dev);
        hipDeviceGetAttribute(&cus, hipDeviceAttributeMultiprocessorCount, dev);
        hipFuncSetAttribute((const void*)fwd_kernel, hipFuncAttributeMaxDynamicSharedMemorySize, LDS_BYTES);
        hipOccupancyMaxActiveBlocksPerMultiprocessor(&per_cu, (const void*)fwd_kernel, NTHREADS, LDS_BYTES);
        if (per_cu < 1) { fprintf(stderr, "kernel_launch: occupancy query says %d blocks per CU\n", per_cu); per_cu = 1; }
        grid = cus * per_cu;
    }
    if (grid < 0) return;
    if (hipMemsetAsync((char*)d_ws + WS_CTL, 0, CTL_ZERO_BYTES, stream) != hipSuccess) { fprintf(stderr, "memset failed\n"); return; }
    Args a{};
    for (int i = 0; i < 33; ++i) a.in[i] = (const float*)d_in[i];
    a.out = (float*)d_out; a.ws = (unsigned char*)d_ws;
    void* params[] = {&a};
    hipError_t e = hipLaunchCooperativeKernel((const void*)fwd_kernel, dim3(grid), dim3(NTHREADS), params, LDS_BYTES, stream);
    if (e != hipSuccess) fprintf(stderr, "cooperative launch failed: %s (grid %d)\n", hipGetErrorString(e), grid);
}
```

```cpp
#include <hip/hip_runtime.h>
#include <hip/hip_cooperative_groups.h>
#include <cstdio>
#include <cstdint>
namespace cg = cooperative_groups;
__device__ __forceinline__ int fresh_tid() { int t = (int)threadIdx.x; asm volatile("" : "+v"(t)); return t; }
namespace pg8 {
#define PG8_LAS __attribute__((address_space(3)))
typedef unsigned short bf16_t;
typedef short bf16x8 __attribute__((ext_vector_type(8)));
typedef float f32x4 __attribute__((ext_vector_type(4)));
typedef unsigned u32x4 __attribute__((ext_vector_type(4)));
constexpr int BM = 256, BK = 64, HALF = 128, HTB = HALF * BK * 2  , STAGE_BYTES = 8 * HTB, NXCD = 8, WGM = 8;

__host__ __device__ __forceinline__ int lds_byte(int r, int c) { const int st = (r >> 4) * 2 + (c >> 5), rr = r & 15, cc = c & 31, ob = rr * 64 + cc * 2; return st * 1024 + (ob ^ (((ob >> 9) & 1) << 5)); }
__host__ __device__ __forceinline__ void stage_rc(int b, int& R, int& C) { const int st = b / 1024, sb = b % 1024, swz = sb ^ (((sb >> 9) & 1) << 5); R = (st >> 1) * 16 + swz / 64; C = (st & 1) * 32 + (swz % 64) / 2; }
__host__ __device__ __forceinline__ int perm32(int rho) { const int n = rho >> 4, i = rho & 15; return 8 * (i >> 2) + 4 * n + (i & 3); }

struct Unit { int pm, pn; };
struct Gemm { const bf16_t* A; const bf16_t* Bt; int M, N, K; };

struct StaticOrder {
    int nM, nN, nwg, G, c;
    __host__ __device__ void init(int M, int N, int G_, int c_) { nM = M / BM; nN = N / BM; nwg = nM * nN; G = G_; c = c_; }
    __host__ __device__ bool next(int i, Unit& u) const {
        const long L = (long)i * G + c; if (L >= nwg) return false;
        int wgid = (int)L; { const int q = nwg / NXCD, r = nwg % NXCD, xcd = wgid % NXCD, off = wgid / NXCD; wgid = (xcd < r ? xcd * (q + 1) : r * (q + 1) + (xcd - r) * q) + off; }
        const int nig = WGM * nN, gid = wgid / nig, fm = gid * WGM, gsz = (nM - fm) < WGM ? (nM - fm) : WGM;
        u.pm = fm + ((wgid % nig) % gsz); u.pn = (wgid % nig) / gsz; return true;
    }
    __device__ __forceinline__ void a_ready(const Unit&) const {}
    __device__ __forceinline__ void done(const Unit&) const {}
};

__device__ __forceinline__ unsigned cvt_pk_bf16(float lo, float hi) { unsigned r; asm volatile("v_cvt_pk_bf16_f32 %0, %1, %2" : "=v"(r) : "v"(lo), "v"(hi)); return r; }
__device__ __forceinline__ float bf_lo(unsigned w) { return __uint_as_float(w << 16); }
__device__ __forceinline__ float bf_hi(unsigned w) { return __uint_as_float(w & 0xffff0000u); }
__device__ __forceinline__ float sigmoid_f(float x) { return __builtin_amdgcn_rcpf(1.0f + __expf(-x)); }
__device__ __forceinline__ float silu_f(float x) { return x * sigmoid_f(x); }
__device__ __forceinline__ float gelu_t(float x) { const float u = 1.5957691216057308f * (x + 0.044715f * x * x * x); return x * sigmoid_f(u); }

struct EpiSwiglu {
    static constexpr bool PERM = true, AFTER_DRAIN = false;
    bf16_t* O; int ldc;
    __device__ __forceinline__ void operator()(const f32x4 (&acc)[2][2][4][2], const Unit& u, int wr, int wc, int fr, int fq) const {
        const int row0 = u.pm * BM + wr * 64 + fr; const int col0 = u.pn * HALF + wc * 32 + 8 * fq;
#pragma unroll
        for (int ai = 0; ai < 2; ++ai)
#pragma unroll
            for (int m = 0; m < 4; ++m) {
                bf16_t* rowp = O + (size_t)(row0 + ai * HALF + m * 16) * ldc + col0;
                const f32x4 g0 = acc[ai][0][m][0], g1 = acc[ai][0][m][1], u0 = acc[ai][1][m][0], u1 = acc[ai][1][m][1];
                u32x4 w;
                w.x = cvt_pk_bf16(silu_f(g0[0]) * u0[0], silu_f(g0[1]) * u0[1]); w.y = cvt_pk_bf16(silu_f(g0[2]) * u0[2], silu_f(g0[3]) * u0[3]);
                w.z = cvt_pk_bf16(silu_f(g1[0]) * u1[0], silu_f(g1[1]) * u1[1]); w.w = cvt_pk_bf16(silu_f(g1[2]) * u1[2], silu_f(g1[3]) * u1[3]);
                *(u32x4*)rowp = w;
            }
    }
};
template <int MODE> struct EpiBf16 {
    static constexpr bool PERM = true, AFTER_DRAIN = false;
    bf16_t* O; int ldc; int act_cols; const float* bias; const bf16_t* Y; int ldy;
    __device__ __forceinline__ void operator()(const f32x4 (&acc)[2][2][4][2], const Unit& u, int wr, int wc, int fr, int fq) const {
        const int row0 = u.pm * BM + wr * 64 + fr; const int col0 = u.pn * BM + wc * 32 + 8 * fq;
#pragma unroll
        for (int bj = 0; bj < 2; ++bj) {
            const int col = col0 + bj * HALF;
            f32x4 b0 = (f32x4){0.f, 0.f, 0.f, 0.f}, b1 = b0;
            if (MODE == 2) { b0 = *(const f32x4*)(bias + col); b1 = *(const f32x4*)(bias + col + 4); }
            const bool act = (MODE == 1) && (col < act_cols);
#pragma unroll
            for (int ai = 0; ai < 2; ++ai)
#pragma unroll
                for (int m = 0; m < 4; ++m) {
                    const size_t row = (size_t)(row0 + ai * HALF + m * 16);
                    f32x4 v0 = acc[ai][bj][m][0], v1 = acc[ai][bj][m][1];
                    if (MODE == 1) { if (act) {
#pragma unroll
                        for (int j = 0; j < 4; ++j) { v0[j] = gelu_t(v0[j]); v1[j] = gelu_t(v1[j]); } } }
                    if (MODE == 2) {
                        const u32x4 y = *(const u32x4*)(Y + row * ldy + col);
                        v0 = v0 + b0; v1 = v1 + b1;
                        v0[0] = bf_lo(y.x) * sigmoid_f(v0[0]); v0[1] = bf_hi(y.x) * sigmoid_f(v0[1]); v0[2] = bf_lo(y.y) * sigmoid_f(v0[2]); v0[3] = bf_hi(y.y) * sigmoid_f(v0[3]);
                        v1[0] = bf_lo(y.z) * sigmoid_f(v1[0]); v1[1] = bf_hi(y.z) * sigmoid_f(v1[1]); v1[2] = bf_lo(y.w) * sigmoid_f(v1[2]); v1[3] = bf_hi(y.w) * sigmoid_f(v1[3]);
                    }
                    u32x4 w; w.x = cvt_pk_bf16(v0[0], v0[1]); w.y = cvt_pk_bf16(v0[2], v0[3]); w.z = cvt_pk_bf16(v1[0], v1[1]); w.w = cvt_pk_bf16(v1[2], v1[3]);
                    *(u32x4*)(O + row * ldc + col) = w;
                }
        }
    }
};

struct EpiNull {
    static constexpr bool PERM = true, AFTER_DRAIN = false;
    bf16_t* O;
    __device__ __forceinline__ void operator()(const f32x4 (&acc)[2][2][4][2], const Unit& u, int wr, int wc, int fr, int fq) const {
        float s = 0.f;
#pragma unroll
        for (int ai = 0; ai < 2; ++ai)
#pragma unroll
            for (int bj = 0; bj < 2; ++bj)
#pragma unroll
                for (int m = 0; m < 4; ++m)
#pragma unroll
                    for (int n = 0; n < 2; ++n) s += (acc[ai][bj][m][n][0] + acc[ai][bj][m][n][1]) + (acc[ai][bj][m][n][2] + acc[ai][bj][m][n][3]);
        if (s == 12345.678f) O[u.pm + wr + wc + fr + fq] = 1;
    }
};
template <int P> struct EpiSwigluP {
    static constexpr bool PERM = true, AFTER_DRAIN = false;
    bf16_t* O; int ldc;
    __device__ __forceinline__ void operator()(const f32x4 (&acc)[2][2][4][2], const Unit& u, int wr, int wc, int fr, int fq) const {
        const int row0 = u.pm * BM + wr * 64 + fr; const int col0 = u.pn * HALF + wc * 32 + 8 * fq;
#pragma unroll
        for (int ai = 0; ai < 2; ++ai)
#pragma unroll
            for (int m = 0; m < 4; ++m) {
                bf16_t* rowp = O + (size_t)(row0 + ai * HALF + m * 16) * ldc + col0;
                const f32x4 g0 = acc[ai][0][m][0], g1 = acc[ai][0][m][1], u0 = acc[ai][1][m][0], u1 = acc[ai][1][m][1];
                u32x4 w;
                if (P == 1) {
                    w.x = cvt_pk_bf16(silu_f(g0[0]) * u0[0], silu_f(g0[1]) * u0[1]); w.y = cvt_pk_bf16(silu_f(g0[2]) * u0[2], silu_f(g0[3]) * u0[3]);
                    w.z = cvt_pk_bf16(silu_f(g1[0]) * u1[0], silu_f(g1[1]) * u1[1]); w.w = cvt_pk_bf16(silu_f(g1[2]) * u1[2], silu_f(g1[3]) * u1[3]);
                    if ((w.x ^ w.y ^ w.z ^ w.w) == 0x12345678u) *(u32x4*)rowp = w;
                } else {
                    w.x = cvt_pk_bf16(g0[0] + u0[0], g0[1] + u0[1]); w.y = cvt_pk_bf16(g0[2] + u0[2], g0[3] + u0[3]);
                    w.z = cvt_pk_bf16(g1[0] + u1[0], g1[1] + u1[1]); w.w = cvt_pk_bf16(g1[2] + u1[2], g1[3] + u1[3]);
                    *(u32x4*)rowp = w;
                }
            }
    }
};
template <class Epi, class Sched, bool ALIGN_EPI = false, bool SP2 = false>
__device__ __forceinline__ void gemm_phase(PG8_LAS unsigned char* lds, const Gemm g, const Sched& S, const Epi& E) {
    const int tid = fresh_tid(), wid = __builtin_amdgcn_readfirstlane(tid >> 6), lane = tid & 63, wr = wid >> 2, wc = wid & 3, fr = lane & 15, fq = lane >> 4;
    const int K = g.K, nt = K / BK;
    unsigned voffA[2], voffB[2];
#pragma unroll
    for (int i = 0; i < 2; ++i) { int R, C; stage_rc(tid * 16 + i * 8192, R, C); const int Rb = Epi::PERM ? ((R & ~31) + perm32(R & 31)) : R;
        voffA[i] = (unsigned)(R * K + C) * 2u; voffB[i] = (unsigned)(Rb * K + C) * 2u; }
    const size_t kstep = (size_t)(BK * 2);
    const size_t hstep = (size_t)HALF * K * 2;
    const size_t tstep = 2 * hstep;
    const unsigned ldsw = (unsigned)wid * 1024u;
    const int aoff = lds_byte(wr * 64 + fr, fq * 8), boff = lds_byte(wc * 32 + fr, fq * 8);
#define PG8_SA(b, h) (((b) * 2 + (h)) * HTB)
#define PG8_SB(b, h) ((4 + (b) * 2 + (h)) * HTB)
#define PG8_STAGE(bufoff, gbase, voff) do { _Pragma("unroll") for (int _i = 0; _i < 2; ++_i) \
        __builtin_amdgcn_global_load_lds((const unsigned*)((const char*)(gbase) + (voff)[_i]), (PG8_LAS unsigned*)(lds + (bufoff) + ldsw + _i * 8192), 16, 0, 0); } while (0)
#define PG8_LDA(dst, b, h) do { _Pragma("unroll") for (int m = 0; m < 4; ++m) _Pragma("unroll") for (int k = 0; k < 2; ++k) dst[m][k] = *(const PG8_LAS bf16x8*)(lds + PG8_SA(b, h) + aoff + m * 2048 + k * 1024); } while (0)
#define PG8_LDB(dst, b, h) do { _Pragma("unroll") for (int n = 0; n < 2; ++n) _Pragma("unroll") for (int k = 0; k < 2; ++k) dst[n][k] = *(const PG8_LAS bf16x8*)(lds + PG8_SB(b, h) + boff + n * 2048 + k * 1024); } while (0)
#define PG8_MMA(ai, bj, At, Bt) do { __builtin_amdgcn_s_setprio(1); _Pragma("unroll") for (int m = 0; m < 4; ++m) _Pragma("unroll") for (int n = 0; n < 2; ++n) _Pragma("unroll") for (int k = 0; k < 2; ++k) \
        acc[ai][bj][m][n] = __builtin_amdgcn_mfma_f32_16x16x32_bf16(Bt[n][k], At[m][k], acc[ai][bj][m][n], 0, 0, 0); __builtin_amdgcn_s_setprio(0); } while (0)
#define PG8_WAIT_V(n) asm volatile("s_waitcnt vmcnt(" #n ")" ::: "memory")
#define PG8_WAIT_L(n) asm volatile("s_waitcnt lgkmcnt(" #n ")" ::: "memory")
#define PG8_BAR __builtin_amdgcn_s_barrier()
#define PG8_SCHED __builtin_amdgcn_sched_barrier(0)
    Unit cur, nxt; int ui = 0;
    if (!S.next(0, cur)) return;
    f32x4 acc[2][2][4][2];
#pragma unroll
    for (int a = 0; a < 2; ++a)
#pragma unroll
        for (int b = 0; b < 2; ++b)
#pragma unroll
            for (int m = 0; m < 4; ++m)
#pragma unroll
                for (int n = 0; n < 2; ++n) acc[a][b][m][n] = (f32x4){0.f, 0.f, 0.f, 0.f};
    bf16x8 At[4][2], B0[2][2], B1[2][2];
    const char* cA = (const char*)g.A + (size_t)cur.pm * tstep; const char* cB = (const char*)g.Bt + (size_t)cur.pn * tstep;
    S.a_ready(cur);
    if constexpr (SP2) {
        PG8_STAGE(PG8_SB(0, 0), cB, voffB); PG8_STAGE(PG8_SB(0, 1), cB + hstep, voffB); PG8_STAGE(PG8_SA(0, 0), cA, voffA); PG8_STAGE(PG8_SA(0, 1), cA + hstep, voffA);
        if (wr == 1) PG8_BAR;
        PG8_WAIT_V(2); PG8_BAR;
        PG8_STAGE(PG8_SB(1, 0), cB + kstep, voffB); PG8_STAGE(PG8_SA(1, 0), cA + kstep, voffA); PG8_STAGE(PG8_SB(1, 1), cB + hstep + kstep, voffB);
        PG8_WAIT_V(6); PG8_BAR;
    } else {
        PG8_STAGE(PG8_SB(0, 0), cB, voffB); PG8_STAGE(PG8_SA(0, 0), cA, voffA); PG8_STAGE(PG8_SB(0, 1), cB + hstep, voffB); PG8_STAGE(PG8_SA(0, 1), cA + hstep, voffA);
        if (wr == 1) PG8_BAR;
        PG8_WAIT_V(4); PG8_BAR;
        PG8_STAGE(PG8_SB(1, 0), cB + kstep, voffB); PG8_STAGE(PG8_SA(1, 0), cA + kstep, voffA); PG8_STAGE(PG8_SB(1, 1), cB + hstep + kstep, voffB);
        PG8_WAIT_V(6); PG8_BAR;
    }
    for (;;) {
        const bool has_next = S.next(ui + 1, nxt);
        const char* nA = has_next ? (const char*)g.A + (size_t)nxt.pm * tstep : cA; const char* nB = has_next ? (const char*)g.Bt + (size_t)nxt.pn * tstep : cB;
        for (int t = 0; t < nt; t += 2) {
            const bool last = (t == nt - 2);
            const char* a1 = cA + (size_t)(t + 1) * kstep;
            const char* a2 = last ? nA : cA + (size_t)(t + 2) * kstep; const char* b2 = last ? nB : cB + (size_t)(t + 2) * kstep;
            const char* a3 = a2 + kstep; const char* b3 = b2 + kstep;
            if (last && has_next) S.a_ready(nxt);
            if constexpr (SP2) {
            PG8_LDB(B0, 0, 0); PG8_LDB(B1, 0, 1); PG8_SCHED; PG8_LDA(At, 0, 0); PG8_STAGE(PG8_SA(1, 1), a1 + hstep, voffA);
            PG8_WAIT_V(8); PG8_WAIT_L(0); PG8_BAR; PG8_MMA(0, 0, At, B0); PG8_MMA(0, 1, At, B1); PG8_BAR; PG8_SCHED;
            PG8_LDA(At, 0, 1); PG8_STAGE(PG8_SB(0, 0), b2, voffB); PG8_STAGE(PG8_SB(0, 1), b2 + hstep, voffB); PG8_STAGE(PG8_SA(0, 0), a2, voffA);
            PG8_WAIT_V(8); PG8_WAIT_L(0); PG8_BAR; PG8_MMA(1, 0, At, B0); PG8_MMA(1, 1, At, B1); PG8_BAR; PG8_SCHED;
            PG8_LDB(B0, 1, 0); PG8_LDB(B1, 1, 1); PG8_SCHED; PG8_LDA(At, 1, 0); PG8_STAGE(PG8_SA(0, 1), a2 + hstep, voffA);
            PG8_WAIT_V(8); PG8_WAIT_L(0); PG8_BAR; PG8_MMA(0, 0, At, B0); PG8_MMA(0, 1, At, B1); PG8_BAR; PG8_SCHED;
            PG8_LDA(At, 1, 1); PG8_STAGE(PG8_SB(1, 0), b3, voffB); PG8_STAGE(PG8_SB(1, 1), b3 + hstep, voffB); PG8_STAGE(PG8_SA(1, 0), a3, voffA);
            PG8_WAIT_V(8); PG8_WAIT_L(0); PG8_BAR; PG8_MMA(1, 0, At, B0); PG8_MMA(1, 1, At, B1); PG8_BAR; PG8_SCHED;
            } else {
            PG8_LDB(B0, 0, 0); PG8_SCHED; PG8_LDA(At, 0, 0); PG8_STAGE(PG8_SA(1, 1), a1 + hstep, voffA);
            PG8_WAIT_L(8); PG8_BAR; PG8_WAIT_L(0); PG8_MMA(0, 0, At, B0); PG8_BAR; PG8_SCHED;
            PG8_LDB(B1, 0, 1); PG8_STAGE(PG8_SB(0, 0), b2, voffB);
            PG8_BAR; PG8_WAIT_L(0); PG8_MMA(0, 1, At, B1); PG8_BAR;
            PG8_LDA(At, 0, 1); PG8_STAGE(PG8_SA(0, 0), a2, voffA);
            PG8_BAR; PG8_WAIT_L(0); PG8_MMA(1, 0, At, B0); PG8_BAR; PG8_SCHED;
            PG8_STAGE(PG8_SB(0, 1), b2 + hstep, voffB);
            PG8_WAIT_V(6); PG8_BAR; PG8_MMA(1, 1, At, B1); PG8_BAR;
            PG8_LDB(B0, 1, 0); PG8_SCHED; PG8_LDA(At, 1, 0); PG8_STAGE(PG8_SA(0, 1), a2 + hstep, voffA);
            PG8_WAIT_L(8); PG8_BAR; PG8_WAIT_L(0); PG8_MMA(0, 0, At, B0); PG8_BAR; PG8_SCHED;
            PG8_LDB(B1, 1, 1); PG8_STAGE(PG8_SB(1, 0), b3, voffB);
            PG8_BAR; PG8_WAIT_L(0); PG8_MMA(0, 1, At, B1); PG8_BAR;
            PG8_LDA(At, 1, 1); PG8_STAGE(PG8_SA(1, 0), a3, voffA);
            PG8_BAR; PG8_WAIT_L(0); PG8_MMA(1, 0, At, B0); PG8_BAR; PG8_SCHED;
            PG8_STAGE(PG8_SB(1, 1), b3 + hstep, voffB);
            PG8_WAIT_V(6); PG8_BAR; PG8_MMA(1, 1, At, B1); PG8_BAR;
            }
        }
        if constexpr (ALIGN_EPI) { if (wr == 0) PG8_BAR; }
        if constexpr (!Epi::AFTER_DRAIN) { E(acc, cur, wr, wc, fr, fq); S.done(cur); }
        if (!has_next) break;
#pragma unroll
        for (int a = 0; a < 2; ++a)
#pragma unroll
            for (int b = 0; b < 2; ++b)
#pragma unroll
                for (int m = 0; m < 4; ++m)
#pragma unroll
                    for (int n = 0; n < 2; ++n) acc[a][b][m][n] = (f32x4){0.f, 0.f, 0.f, 0.f};
        cur = nxt; cA = nA; cB = nB; ++ui;
        if constexpr (ALIGN_EPI) { if (wr == 1) PG8_BAR; }
    }
    PG8_WAIT_V(0);
    if constexpr (!ALIGN_EPI) { if (wr == 0) PG8_BAR; }
    PG8_BAR;
    if constexpr (Epi::AFTER_DRAIN) { E.fused(acc, cur, wr, wc, fr, fq, lds, wid, lane); S.done(cur); }
#undef PG8_SA
#undef PG8_SB
#undef PG8_STAGE
#undef PG8_LDA
#undef PG8_LDB
#undef PG8_MMA
#undef PG8_WAIT_V
#undef PG8_WAIT_L
#undef PG8_BAR
#undef PG8_SCHED
}
}

constexpr int DM = 1024, SEQ = 16384, NBATCH = 2, MPROMPT = NBATCH * SEQ, DEC_B = 8, DEC_S = 16;
constexpr int M = MPROMPT + DEC_B * DEC_S;
constexpr int MPAD = 33024;
constexpr int DFF = 2816, DIN = 1536, AW = 512, BWD = 512, NG = 32, NP = 64, GN = 16;
constexpr int NTILE = M / 128;
constexpr float EPS = 1e-6f;
constexpr int NWAVES = 8, NTHREADS = 512;

constexpr size_t MiB = 1u << 20;
constexpr size_t WS_WGU1 = 1 * MiB, WS_WD1 = 12 * MiB, WS_WIN = 18 * MiB, WS_WGLU = 21 * MiB, WS_WOUT = 22 * MiB, WS_WGU2 = 24 * MiB, WS_WD2 = 35 * MiB;
constexpr size_t WS_WEFF = 41 * MiB, WS_BB = 42 * MiB, WS_CM = 42 * MiB + 131072, WS_LAM = 42 * MiB + 262144, WS_RS = 42 * MiB + 524288, WS_E = 43 * MiB;
constexpr size_t WS_XN = 48 * MiB, WS_D = 113 * MiB, WS_H = 178 * MiB, WS_Z = 178 * MiB, WS_YB = 275 * MiB, WS_MIX = 356 * MiB, WS_END = 421 * MiB;
static_assert(WS_XN + (size_t)MPAD * DM * 2 <= WS_D && WS_D + (size_t)MPAD * DM * 2 <= WS_H && WS_H + (size_t)MPAD * DFF * 2 <= WS_MIX, "ws map");
static_assert(WS_Z + (size_t)MPAD * DIN * 2 <= WS_YB && WS_YB + (size_t)MPAD * BWD * 2 <= WS_H + (size_t)MPAD * DFF * 2 && WS_MIX + (size_t)MPAD * DM * 2 <= WS_END, "ws map 2");
static_assert(WS_E + (size_t)NTILE * NG * NP * 8 <= WS_XN, "ws map 3");

constexpr size_t OFF_Y = 0, OFF_SRE_P = (size_t)M * DM, OFF_SIM_P = OFF_SRE_P + NBATCH * NG * NP, OFF_SRE_S = OFF_SIM_P + NBATCH * NG * NP,
                 OFF_SIM_S = OFF_SRE_S + DEC_B * NG * NP, OFF_V_S = OFF_SIM_S + DEC_B * NG * NP;

constexpr int OT_STRIDE = 520;
constexpr int VT_STRIDE = 136;
constexpr int LDS_BYTES = 147456;
static_assert(128 * VT_STRIDE * 2 + 4096 <= LDS_BYTES - 64 && 128 * OT_STRIDE * 2 <= LDS_BYTES - 64, "lds map");

#define LAS __attribute__((address_space(3)))
typedef unsigned short bf16;
typedef float v4f __attribute__((ext_vector_type(4)));
typedef float v2f __attribute__((ext_vector_type(2)));
typedef float v16f __attribute__((ext_vector_type(16)));
typedef unsigned v4u __attribute__((ext_vector_type(4)));
typedef unsigned v2u __attribute__((ext_vector_type(2)));
typedef short bfx8 __attribute__((ext_vector_type(8)));
#define LDS_FENCE() asm volatile("s_waitcnt lgkmcnt(0)" ::: "memory")

using pg8::cvt_pk_bf16; using pg8::bf_lo; using pg8::bf_hi; using pg8::gelu_t;

__device__ __forceinline__ float wave_sum(float v) {
#pragma unroll
    for (int o = 1; o < 64; o <<= 1) v += __shfl_xor(v, o);
    return v;
}
typedef __bf16 bf16x2_t __attribute__((ext_vector_type(2)));
__device__ __forceinline__ unsigned cvt_pk_c(float lo, float hi) { const v2f v = {lo, hi}; const bf16x2_t b = __builtin_convertvector(v, bf16x2_t); return __builtin_bit_cast(unsigned, b); }
__device__ __forceinline__ unsigned cvt_pk_nv(float lo, float hi) { unsigned r; asm("v_cvt_pk_bf16_f32 %0, %1, %2" : "=v"(r) : "v"(lo), "v"(hi)); return r; }
__device__ __forceinline__ bf16 f2bf(float f) { return (bf16)(cvt_pk_nv(f, 0.f) & 0xffffu); }


__device__ __forceinline__ double dexp(double x) {
    const double y = x * (1.0 / 256.0); double t = 1.0;
#pragma unroll
    for (int i = 12; i >= 1; --i) t = 1.0 + t * y * (1.0 / (double)i);
#pragma unroll
    for (int i = 0; i < 8; ++i) t = t * t;
    return t;
}
__device__ __forceinline__ void dsincos(double x, double& s, double& c) {
    const double twopi = 6.283185307179586476925286766559;
    const double k = rint(x * (1.0 / twopi)); const double r = x - k * twopi, r2 = r * r;
    double ts = r, tc = 1.0; s = r; c = 1.0;
#pragma unroll
    for (int i = 1; i <= 15; ++i) { tc = -tc * r2 * (1.0 / (double)((2 * i - 1) * (2 * i))); ts = -ts * r2 * (1.0 / (double)((2 * i) * (2 * i + 1))); c += tc; s += ts; }
}

typedef const float* cfp_t;
typedef __attribute__((address_space(4))) cfp_t const* kin_t;
__device__ __forceinline__ const float* karg_in(int i) {
    auto k = __builtin_amdgcn_kernarg_segment_ptr();
    asm volatile("" : "+s"(k));
    return ((kin_t)k)[i];
}
struct Ctx {
    __device__ __forceinline__ const float* in(int i) const { return karg_in(i); }
    __device__ __forceinline__ float* out() const { return (float*)karg_in(33); }
    __device__ __forceinline__ unsigned char* ws() const { return (unsigned char*)karg_in(34); }
#define WSP(name, T, off) __device__ __forceinline__ T* name() const { return (T*)(ws() + (off)); }
    WSP(Wgu1, bf16, WS_WGU1) WSP(Wd1, bf16, WS_WD1) WSP(Win, bf16, WS_WIN) WSP(Wglu, bf16, WS_WGLU) WSP(Wout, bf16, WS_WOUT) WSP(Wgu2, bf16, WS_WGU2) WSP(Wd2, bf16, WS_WD2)
    WSP(Weff, bf16, WS_WEFF) WSP(BB, bf16, WS_BB) WSP(CM, bf16, WS_CM) WSP(XN, bf16, WS_XN) WSP(D, bf16, WS_D) WSP(H, bf16, WS_H) WSP(Z, bf16, WS_Z) WSP(YB, bf16, WS_YB) WSP(MIX, bf16, WS_MIX)
    WSP(LAM, float, WS_LAM) WSP(E, float, WS_E) WSP(RS, float, WS_RS)
#undef WSP
};

__device__ __forceinline__ void p0_block_item(const float* W, const float* gk, int K, int N, bf16* WT, int mode, int item, LAS float* tile, int tid) {
    const int nblk = N / 256, kb = item / nblk, nb = item % nblk, k0 = 64 * kb, n0 = 256 * nb;
    const int lr = tid >> 6, lc = 4 * (tid & 63);
    v4f v[8];
#pragma unroll
    for (int i = 0; i < 8; ++i) v[i] = *(const v4f*)(W + (size_t)(k0 + lr + 8 * i) * N + n0 + lc);
    if (gk) {
#pragma unroll
        for (int i = 0; i < 8; ++i) v[i] = v[i] * gk[k0 + lr + 8 * i];
    }
    __syncthreads();
#pragma unroll
    for (int i = 0; i < 8; ++i) { LAS float* p = tile + (lr + 8 * i) * 257 + lc; p[0] = v[i].x; p[1] = v[i].y; p[2] = v[i].z; p[3] = v[i].w; }
    __syncthreads();
    const int c = tid & 7;
#pragma unroll
    for (int j = 0; j < 4; ++j) {
        const int n = (tid >> 3) + 64 * j, ng = n0 + n;
        const int drow = (mode == 0) ? ng : (256 * (ng >> 7) + (ng & 127) + (mode == 2 ? 128 : 0));
        const LAS float* sp = tile + (8 * c) * 257 + n;
        v4u o; o.x = cvt_pk_nv(sp[0 * 257], sp[1 * 257]); o.y = cvt_pk_nv(sp[2 * 257], sp[3 * 257]); o.z = cvt_pk_nv(sp[4 * 257], sp[5 * 257]); o.w = cvt_pk_nv(sp[6 * 257], sp[7 * 257]);
        *(v4u*)(WT + (size_t)drow * K + k0 + 8 * c) = o;
    }
}
__device__ __forceinline__ const float* xrow_ptr(const Ctx& C, int row) { return row < MPROMPT ? C.in(0) + (size_t)row * DM : C.in(1) + (size_t)(row - MPROMPT) * DM; }

__device__ __forceinline__ v4f ld4_f32(const float* p) { return *(const v4f*)p; }
__device__ __forceinline__ v4f ld4_bf16(const bf16* p) { const v2u w = *(const v2u*)p; return (v4f){bf_lo(w.x), bf_hi(w.x), bf_lo(w.y), bf_hi(w.y)}; }
__device__ __forceinline__ void st4_bf16(bf16* p, v4f o) { v2u w; w.x = cvt_pk_nv(o.x, o.y); w.y = cvt_pk_nv(o.z, o.w); *(v2u*)p = w; }
__device__ __forceinline__ float ssq4(v4f v) { return (v.x * v.x + v.y * v.y) + (v.z * v.z + v.w * v.w); }
template <int R>
__device__ __forceinline__ void rows_x0(const Ctx& C, int m0, int stride, int mx, int lane) {
    v4f v[R][4]; float ss[R]; int mr[R]; bool ok[R];
#pragma unroll
    for (int r = 0; r < R; ++r) { mr[r] = (r == 4) ? mx : m0 + r * stride; ok[r] = (r == 4) ? (mx < M) : (mr[r] < MPROMPT); const float* x = xrow_ptr(C, ok[r] ? mr[r] : 0);
#pragma unroll
        for (int j = 0; j < 4; ++j) v[r][j] = ld4_f32(x + 4 * lane + 256 * j); }
    bf16* XN = C.XN();
#pragma unroll
    for (int r = 0; r < R; ++r) { float s = 0.f;
#pragma unroll
        for (int j = 0; j < 4; ++j) s += ssq4(v[r][j]);
        ss[r] = s; }
    float* rs = C.RS();
#pragma unroll
    for (int r = 0; r < R; ++r) ss[r] = wave_sum(ss[r]) * (1.f / DM) + EPS;
#pragma unroll
    for (int r = 0; r < R; ++r) { const float rstd = rsqrtf(ss[r]);
#pragma unroll
        for (int j = 0; j < 4; ++j) if (ok[r]) st4_bf16(XN + (size_t)mr[r] * DM + 4 * lane + 256 * j, v[r][j] * rstd);
        if (lane == 0 && ok[r]) rs[mr[r]] = sqrtf(ss[r]); }
}
template <int R, bool BASE_F32, bool OUT_F32>
__device__ __forceinline__ void rows_res(const Ctx& C, int m0, int stride, int mx, const float* gpost, float scale, int lane) {
    v4f d[R][4], b[R][4]; int mr[R]; bool ok[R]; float r1[R];
    const bf16* D = C.D(); bf16* XN = C.XN();
#pragma unroll
    for (int r = 0; r < R; ++r) { mr[r] = (r == 4) ? mx : m0 + r * stride; ok[r] = (r == 4) ? (mx < M) : (mr[r] < MPROMPT); const int mm = ok[r] ? mr[r] : 0;
#pragma unroll
        for (int j = 0; j < 4; ++j) d[r][j] = ld4_bf16(D + (size_t)mm * DM + 4 * lane + 256 * j);
        if (BASE_F32) { const float* x = xrow_ptr(C, mm);
#pragma unroll
            for (int j = 0; j < 4; ++j) b[r][j] = ld4_f32(x + 4 * lane + 256 * j);
        } else { const float inv = C.RS()[mm];
#pragma unroll
            for (int j = 0; j < 4; ++j) b[r][j] = ld4_bf16(XN + (size_t)mm * DM + 4 * lane + 256 * j) * inv;
        } }
#pragma unroll
    for (int r = 0; r < R; ++r) { float s = 0.f;
#pragma unroll
        for (int j = 0; j < 4; ++j) s += ssq4(d[r][j]);
        r1[r] = s; }
#pragma unroll
    for (int r = 0; r < R; ++r) r1[r] = rsqrtf(wave_sum(r1[r]) * (1.f / DM) + EPS) * scale;
#pragma unroll
    for (int j = 0; j < 4; ++j) { const v4f gp = ld4_f32(gpost + 4 * lane + 256 * j);
#pragma unroll
        for (int r = 0; r < R; ++r) d[r][j] = b[r][j] + d[r][j] * r1[r] * gp; }
    if (OUT_F32) { float* Y = C.out();
#pragma unroll
        for (int r = 0; r < R; ++r)
#pragma unroll
            for (int j = 0; j < 4; ++j) if (ok[r]) *(v4f*)(Y + (size_t)mr[r] * DM + 4 * lane + 256 * j) = d[r][j];
    } else { float* rs = C.RS(); float t[R];
#pragma unroll
        for (int r = 0; r < R; ++r) { float s = 0.f;
#pragma unroll
            for (int j = 0; j < 4; ++j) s += ssq4(d[r][j]);
            t[r] = s; }
#pragma unroll
        for (int r = 0; r < R; ++r) t[r] = wave_sum(t[r]) * (1.f / DM) + EPS;
#pragma unroll
        for (int r = 0; r < R; ++r) { const float rstd = rsqrtf(t[r]);
#pragma unroll
            for (int j = 0; j < 4; ++j) if (ok[r]) st4_bf16(XN + (size_t)mr[r] * DM + 4 * lane + 256 * j, d[r][j] * rstd);
            if (lane == 0 && ok[r]) rs[mr[r]] = sqrtf(t[r]); }
    }
}
template <int R>
__device__ __forceinline__ void rows_norm512(bf16* base, int m0, int stride, int mx, const float* g, int lane) {
    v4u w[R]; float ss[R]; int mr[R]; bool ok[R];
#pragma unroll
    for (int r = 0; r < R; ++r) { mr[r] = (r == 4) ? mx : m0 + r * stride; ok[r] = (r == 4) ? (mx < M) : (mr[r] < MPROMPT);
        w[r] = *(const v4u*)(base + (size_t)(ok[r] ? mr[r] : 0) * DM + 8 * lane); }
    const v4f g0 = *(const v4f*)(g + 8 * lane), g1 = *(const v4f*)(g + 8 * lane + 4);
#pragma unroll
    for (int r = 0; r < R; ++r) { const v4u x = w[r];
        ss[r] = (bf_lo(x.x) * bf_lo(x.x) + bf_hi(x.x) * bf_hi(x.x)) + (bf_lo(x.y) * bf_lo(x.y) + bf_hi(x.y) * bf_hi(x.y)) + (bf_lo(x.z) * bf_lo(x.z) + bf_hi(x.z) * bf_hi(x.z)) + (bf_lo(x.w) * bf_lo(x.w) + bf_hi(x.w) * bf_hi(x.w)); }
#pragma unroll
    for (int r = 0; r < R; ++r) ss[r] = rsqrtf(wave_sum(ss[r]) * (1.f / 512.f) + EPS);
#pragma unroll
    for (int r = 0; r < R; ++r) { const v4u x = w[r]; const float q = ss[r];
        v4u o; o.x = cvt_pk_nv(bf_lo(x.x) * q * g0.x, bf_hi(x.x) * q * g0.y); o.y = cvt_pk_nv(bf_lo(x.y) * q * g0.z, bf_hi(x.y) * q * g0.w);
        o.z = cvt_pk_nv(bf_lo(x.z) * q * g1.x, bf_hi(x.z) * q * g1.y); o.w = cvt_pk_nv(bf_lo(x.w) * q * g1.z, bf_hi(x.w) * q * g1.w);
        if (ok[r]) *(v4u*)(base + (size_t)mr[r] * DM + 8 * lane) = o; }
}

__device__ __forceinline__ void p0_prologue(const Ctx& C, LAS unsigned char* lds, int wave, int lane, int tid) {
    LAS float* tile = (LAS float*)lds;
    const int gw = blockIdx.x * NWAVES + wave, NGW = gridDim.x * NWAVES;
    constexpr int I_GU = (DM / 64) * (DFF / 256), I_D = (DFF / 64) * (DM / 256), I_IN = (DM / 64) * (DIN / 256), I_GLU = (BWD / 64) * (BWD / 256), I_OUT = (DM / 64) * (DM / 256);
    constexpr int NITEMS = 4 * I_GU + 2 * I_D + I_IN + I_GLU + I_OUT;
    for (int it = blockIdx.x; it < NITEMS; it += gridDim.x) {
        int r = it;
        if (r < I_GU) { p0_block_item(C.in(5), C.in(4), DM, DFF, C.Wgu1(), 1, r, tile, tid); continue; } r -= I_GU;
        if (r < I_GU) { p0_block_item(C.in(6), C.in(4), DM, DFF, C.Wgu1(), 2, r, tile, tid); continue; } r -= I_GU;
        if (r < I_GU) { p0_block_item(C.in(29), C.in(28), DM, DFF, C.Wgu2(), 1, r, tile, tid); continue; } r -= I_GU;
        if (r < I_GU) { p0_block_item(C.in(30), C.in(28), DM, DFF, C.Wgu2(), 2, r, tile, tid); continue; } r -= I_GU;
        if (r < I_D) { p0_block_item(C.in(7), nullptr, DFF, DM, C.Wd1(), 0, r, tile, tid); continue; } r -= I_D;
        if (r < I_D) { p0_block_item(C.in(31), nullptr, DFF, DM, C.Wd2(), 0, r, tile, tid); continue; } r -= I_D;
        if (r < I_IN) { p0_block_item(C.in(10), C.in(9), DM, DIN, C.Win(), 0, r, tile, tid); continue; } r -= I_IN;
        if (r < I_GLU) { p0_block_item(C.in(22), nullptr, BWD, BWD, C.Wglu(), 0, r, tile, tid); continue; } r -= I_GLU;
        p0_block_item(C.in(26), nullptr, DM, DM, C.Wout(), 0, r, tile, tid);
    }
    { const int nit = (MPROMPT + 4 * NGW - 1) / (4 * NGW);
      for (int it = 0; it < nit - 1; ++it) rows_x0<4>(C, gw + 4 * it * NGW, NGW, M, lane);
      rows_x0<5>(C, gw + 4 * (nit - 1) * NGW, NGW, MPROMPT + gw, lane);
      for (int ms = MPROMPT + gw + NGW; ms < M; ms += NGW) rows_x0<5>(C, MPROMPT, NGW, ms, lane); }
    const int gt = blockIdx.x * NTHREADS + tid, NGT = gridDim.x * NTHREADS;
    for (int idx = (tid < 8 ? blockIdx.x * 8 + tid : NG * NP); idx < NG * NP; idx += gridDim.x * 8) {
        const int g = idx / NP, p = idx % NP;
        const double lr = (double)C.in(14)[idx], li = (double)C.in(15)[idx], dt = dexp((double)C.in(16)[g]);
        double s1, c1, s8, c8; dsincos(li * dt, s1, c1); dsincos(li * dt * 128.0, s8, c8);
        const double er = dexp(lr * dt), lbr = er * c1, lbi = er * s1;
        const double e8 = dexp(lr * dt * 128.0), l8r = e8 * c8, l8i = e8 * s8;
        C.LAM()[0 * 2048 + idx] = (float)lbr; C.LAM()[1 * 2048 + idx] = (float)lbi; C.LAM()[2 * 2048 + idx] = (float)l8r; C.LAM()[3 * 2048 + idx] = (float)l8i;
        const double a = lbr - 1.0, b = lbi, den = lr * lr + li * li, cr = (a * lr + b * li) / den, ci = (b * lr - a * li) / den;
        for (int n = 0; n < GN; ++n) {
            const double br = (double)C.in(17)[(size_t)idx * GN + n], bi = (double)C.in(18)[(size_t)idx * GN + n];
            C.BB()[((size_t)g * 128 + 2 * p) * GN + n] = f2bf((float)(cr * br - ci * bi));
            C.BB()[((size_t)g * 128 + 2 * p + 1) * GN + n] = f2bf((float)(cr * bi + ci * br));
            C.CM()[((size_t)g * GN + n) * 128 + 2 * p] = f2bf(C.in(19)[((size_t)g * GN + n) * NP + p]);
            C.CM()[((size_t)g * GN + n) * 128 + 2 * p + 1] = f2bf(-C.in(20)[((size_t)g * GN + n) * NP + p]);
        }
    }
    for (int idx = gt; idx < 2 * 4 * 128 * 128; idx += NGT) {
        const int s = idx & 127, t = (idx >> 7) & 127, h = (idx >> 14) & 3, mode = idx >> 16;
        float v;
        if (mode == 0) v = (s <= t) ? C.in(12)[((size_t)h * 128 + t) * 128 + s] : 0.f;
        else v = ((s >> 4) == (t >> 4) && (s & 15) <= (t & 15)) ? C.in(12)[((size_t)h * 128 + (t & 15)) * 128 + (s & 15)] : 0.f;
        C.Weff()[idx] = f2bf(v);
    }
}

constexpr int XU_STRIDE = 72;
constexpr int BH_STRIDE = 136;
constexpr int S5W_BYTES = 32 * XU_STRIDE * 2 + 32 * BH_STRIDE * 2;
static_assert(NWAVES * S5W_BYTES <= LDS_BYTES - 64, "s5 lds");
template <bool PASS2>
__device__ __forceinline__ void s5_tile(const Ctx& C, int T, int sb_lo, int sb_hi, LAS unsigned char* lds, int wave, int lane) {
    const bool sample = (T == NTILE - 1);
    const int r0 = T * 128;
    LAS bf16* XU = (LAS bf16*)(lds + wave * S5W_BYTES);
    LAS bf16* BH = XU + 32 * XU_STRIDE;
    const int tl = lane & 31, hh = lane >> 5, fr = lane & 15, kq = lane >> 4, xrow = lane >> 3, xpart = lane & 7;
    const float* LAM = C.LAM();
    const bf16* Zb = C.Z() + (size_t)1024 + 64 * wave;
    float sr[4], si[4], lr[4], li[4], dsk[4];
#pragma unroll
    for (int gi = 0; gi < 4; ++gi) { const int g = wave * 4 + gi; sr[gi] = 0.f; si[gi] = 0.f; lr[gi] = LAM[0 * 2048 + g * 64 + lane]; li[gi] = LAM[1 * 2048 + g * 64 + lane];
        dsk[gi] = PASS2 ? C.in(21)[16 * g + fr] : 0.f; }
    if (PASS2 && !sample) {
        const int k = T & 127, tb = T - k;
        float l8r[4], l8i[4];
#pragma unroll
        for (int gi = 0; gi < 4; ++gi) { l8r[gi] = LAM[2 * 2048 + (wave * 4 + gi) * 64 + lane]; l8i[gi] = LAM[3 * 2048 + (wave * 4 + gi) * 64 + lane]; }
        const v2f* Ep = (const v2f*)C.E() + ((size_t)tb * NG + wave * 4) * NP + lane;
        const int nb = (k + 15) >> 4, j0 = k - 16 * nb;
        for (int jb = 0; jb < nb; ++jb) {
#pragma unroll
            for (int u = 0; u < 16; ++u) {
                const int j = j0 + 16 * jb + u; const bool ok = j >= 0; const int jc = ok ? j : 0;
#pragma unroll
                for (int gi = 0; gi < 4; ++gi) { v2f e = Ep[(size_t)jc * NG * NP + gi * NP]; if (!ok) e = (v2f){0.f, 0.f};
                    const float nr = fmaf(l8r[gi], sr[gi], fmaf(-l8i[gi], si[gi], e.x)), ni = fmaf(l8r[gi], si[gi], fmaf(l8i[gi], sr[gi], e.y)); sr[gi] = nr; si[gi] = ni; }
            }
        }
    }
    v4u xn[4];
    {
        const int sb0 = sb_lo;
#pragma unroll
        for (int i = 0; i < 4; ++i) xn[i] = *(const v4u*)(Zb + (size_t)(r0 + 32 * sb0 + xrow + 8 * i) * DIN + 8 * xpart);
    }
    for (int sb = sb_lo; sb < sb_hi; ++sb) {
        const int rb0 = r0 + 32 * sb;
#pragma unroll
        for (int i = 0; i < 4; ++i) *(LAS v4u*)(XU + (xrow + 8 * i) * XU_STRIDE + 8 * xpart) = xn[i];
        if (sb + 1 < sb_hi) {
#pragma unroll
            for (int i = 0; i < 4; ++i) xn[i] = *(const v4u*)(Zb + (size_t)(rb0 + 32 + xrow + 8 * i) * DIN + 8 * xpart);
        }
        LDS_FENCE();
#pragma unroll
        for (int gi = 0; gi < 4; ++gi) {
            const int g = wave * 4 + gi;
            bfx8 bb[4];
#pragma unroll
            for (int cb = 0; cb < 4; ++cb) bb[cb] = *(const bfx8*)(C.BB() + ((size_t)(g * 128 + cb * 32 + tl)) * GN + 8 * hh);
            bfx8 cm[4];
            if (PASS2) {
#pragma unroll
                for (int ks = 0; ks < 4; ++ks) cm[ks] = *(const bfx8*)(C.CM() + ((size_t)(g * GN + fr)) * 128 + 32 * ks + 8 * kq);
            }
            float s0ar = 0.f, s0ai = 0.f, s0br = 0.f, s0bi = 0.f;
            if (sample) { const size_t o0 = ((size_t)(2 * sb) * NG + g) * NP + lane, o1 = o0 + (size_t)NG * NP;
                s0ar = C.in(2)[o0]; s0ai = C.in(3)[o0]; s0br = C.in(2)[o1]; s0bi = C.in(3)[o1]; }
            const bfx8 a = *(const LAS bfx8*)(XU + tl * XU_STRIDE + 16 * gi + 8 * hh);
#pragma unroll
            for (int cb = 0; cb < 4; ++cb) {
                v16f acc;
#pragma unroll
                for (int r = 0; r < 16; ++r) acc[r] = 0.f;
                acc = __builtin_amdgcn_mfma_f32_32x32x16_bf16(bb[cb], a, acc, 0, 0, 0);
#pragma unroll
                for (int rg = 0; rg < 4; ++rg) { v2u w; w.x = cvt_pk_c(acc[4 * rg], acc[4 * rg + 1]); w.y = cvt_pk_c(acc[4 * rg + 2], acc[4 * rg + 3]);
                    *(LAS v2u*)(BH + tl * BH_STRIDE + cb * 32 + 8 * rg + 4 * hh) = w; }
            }
            LDS_FENCE();
            {
                unsigned bu[32];
#pragma unroll
                for (int t = 0; t < 32; ++t) bu[t] = *(const LAS unsigned*)(BH + t * BH_STRIDE + 2 * lane);
                LDS_FENCE();
                float xr = sr[gi], xi = si[gi];
#pragma unroll
                for (int t = 0; t < 32; ++t) {
                    if (sample && t == 0) { xr = s0ar; xi = s0ai; }
                    if (sample && t == 16) { xr = s0br; xi = s0bi; }
                    const float nr = fmaf(lr[gi], xr, fmaf(-li[gi], xi, bf_lo(bu[t]))), ni = fmaf(lr[gi], xi, fmaf(li[gi], xr, bf_hi(bu[t])));
                    xr = nr; xi = ni;
                    if (PASS2) {
                        *(LAS unsigned*)(BH + t * BH_STRIDE + 2 * lane) = cvt_pk_nv(xr, xi);
                        if (sample && (t & 15) == 15) { const int seq = 2 * sb + (t >> 4);
                            C.out()[OFF_SRE_S + ((size_t)seq * NG + g) * NP + lane] = xr; C.out()[OFF_SIM_S + ((size_t)seq * NG + g) * NP + lane] = xi; }
                    }
                }
                sr[gi] = xr; si[gi] = xi;
            }
            LDS_FENCE();
            if (PASS2) {
#pragma unroll
                for (int rb = 0; rb < 2; ++rb) {
                    v4f acc = (v4f){0.f, 0.f, 0.f, 0.f};
#pragma unroll
                    for (int ks = 0; ks < 4; ++ks) {
                        const bfx8 sa = *(const LAS bfx8*)(BH + (16 * rb + fr) * BH_STRIDE + 32 * ks + 8 * kq);
                        acc = __builtin_amdgcn_mfma_f32_16x16x32_bf16(sa, cm[ks], acc, 0, 0, 0);
                    }
#pragma unroll
                    for (int r = 0; r < 4; ++r) {
                        LAS bf16* up = XU + (16 * rb + 4 * kq + r) * XU_STRIDE + 16 * gi + fr;
                        const float u = __uint_as_float((unsigned)(*up) << 16);
                        *up = f2bf(gelu_t(acc[r] + dsk[gi] * u));
                    }
                }
                LDS_FENCE();
            }
        }
        if (PASS2) {
#pragma unroll
            for (int i = 0; i < 4; ++i) *(v4u*)(C.YB() + (size_t)(rb0 + xrow + 8 * i) * BWD + 64 * wave + 8 * xpart) = *(const LAS v4u*)(XU + (xrow + 8 * i) * XU_STRIDE + 8 * xpart);
            LDS_FENCE();
        }
    }
#pragma unroll
    for (int gi = 0; gi < 4; ++gi) {
        const int g = wave * 4 + gi;
        if (!PASS2) { v2f* Ep = (v2f*)C.E() + ((size_t)T * NG + g) * NP + lane; *Ep = (v2f){sr[gi], si[gi]}; }
        else if (!sample && (T & 127) == 127) { const int b = T >> 7;
            C.out()[OFF_SRE_P + ((size_t)b * NG + g) * NP + lane] = sr[gi]; C.out()[OFF_SIM_P + ((size_t)b * NG + g) * NP + lane] = si[gi]; }
    }
}

__device__ __forceinline__ void gmlp_tile(const Ctx& C, int T, LAS unsigned char* lds, int wave, int lane, int tid) {
    const int mode = (T == NTILE - 1) ? 1 : 0;
    const int r0 = T * 128;
    LAS bf16* VT = (LAS bf16*)lds;
    LAS float* SSQ = (LAS float*)(lds + 128 * VT_STRIDE * 2);
    const int tb = wave & 3, dh = wave >> 2, tl = lane & 31, hh = lane >> 5;
    const int t = 32 * tb + tl;
    unsigned outp[4][2][8]; float ssq = 0.f;
    const bf16* zt = C.Z() + (size_t)(r0 + t) * DIN;
    const int row = tid >> 2, q = tid & 3;
    const bf16* vsrc = C.Z() + (size_t)(r0 + row) * DIN + 512 + q * 32;
    const bf16* Weff = C.Weff();
    v4u vraw[4];
#pragma unroll
    for (int i = 0; i < 4; ++i) vraw[i] = *(const v4u*)(vsrc + 8 * i);
#pragma unroll
    for (int h = 0; h < 4; ++h) {
        bfx8 wf[8];
        const bf16* wrow = Weff + ((size_t)(mode * 4 + h) * 128 + t) * 128 + 8 * hh;
#pragma unroll
        for (int ks = 0; ks < 8; ++ks) wf[ks] = *(const bfx8*)(wrow + 16 * ks);
        v2u uw[2][4];
#pragma unroll
        for (int dbi = 0; dbi < 2; ++dbi)
#pragma unroll
            for (int rg = 0; rg < 4; ++rg) uw[dbi][rg] = *(const v2u*)(zt + h * 128 + 32 * (2 * dh + dbi) + 8 * rg + 4 * hh);
        const float bias = C.in(13)[h * 128 + (mode ? (t & 15) : t)];
        __syncthreads();
        {
            float v[32]; float s = 0.f;
#pragma unroll
            for (int i = 0; i < 4; ++i) { const v4u w = vraw[i];
                v[8 * i + 0] = bf_lo(w.x); v[8 * i + 1] = bf_hi(w.x); v[8 * i + 2] = bf_lo(w.y); v[8 * i + 3] = bf_hi(w.y);
                v[8 * i + 4] = bf_lo(w.z); v[8 * i + 5] = bf_hi(w.z); v[8 * i + 6] = bf_lo(w.w); v[8 * i + 7] = bf_hi(w.w); }
            if (h < 3) {
#pragma unroll
                for (int i = 0; i < 4; ++i) vraw[i] = *(const v4u*)(vsrc + (h + 1) * 128 + 8 * i);
            }
#pragma unroll
            for (int i = 0; i < 32; ++i) s += v[i] * v[i];
            s += __shfl_xor(s, 1); s += __shfl_xor(s, 2);
            const float r = rsqrtf(s * (1.f / 128.f) + EPS);
            const float* gv = C.in(11) + h * 128 + q * 32;
#pragma unroll
            for (int i = 0; i < 32; ++i) { v[i] = v[i] * r * gv[i]; VT[(q * 32 + i) * VT_STRIDE + row] = f2bf(v[i]); }
            if (mode) { float* ov = C.out() + OFF_V_S + (size_t)row * AW + h * 128 + q * 32;
#pragma unroll
                for (int i = 0; i < 8; ++i) *(v4f*)(ov + 4 * i) = (v4f){v[4 * i], v[4 * i + 1], v[4 * i + 2], v[4 * i + 3]}; }
        }
        __syncthreads();
#pragma unroll
        for (int dbi = 0; dbi < 2; ++dbi) {
            const int db = 2 * dh + dbi;
            v16f acc;
#pragma unroll
            for (int r = 0; r < 16; ++r) acc[r] = 0.f;
#pragma unroll
            for (int ks = 0; ks < 8; ++ks) {
                const bfx8 va = *(const LAS bfx8*)(VT + (32 * db + tl) * VT_STRIDE + 16 * ks + 8 * hh);
                acc = __builtin_amdgcn_mfma_f32_32x32x16_bf16(va, wf[ks], acc, 0, 0, 0);
            }
#pragma unroll
            for (int rg = 0; rg < 4; ++rg) {
                const v2u u2 = uw[dbi][rg];
                const float o0 = bf_lo(u2.x) * (acc[4 * rg + 0] + bias), o1 = bf_hi(u2.x) * (acc[4 * rg + 1] + bias);
                const float o2 = bf_lo(u2.y) * (acc[4 * rg + 2] + bias), o3 = bf_hi(u2.y) * (acc[4 * rg + 3] + bias);
                ssq += (o0 * o0 + o1 * o1) + (o2 * o2 + o3 * o3);
                outp[h][dbi][2 * rg] = cvt_pk_nv(o0, o1); outp[h][dbi][2 * rg + 1] = cvt_pk_nv(o2, o3);
            }
        }
    }
    ssq += __shfl_xor(ssq, 32);
    if (hh == 0) SSQ[t * 2 + dh] = ssq;
    __syncthreads();
    const float rstd = rsqrtf((SSQ[t * 2] + SSQ[t * 2 + 1]) * (1.f / 512.f) + EPS);
    const float* gap = C.in(24);
    LAS bf16* OT = (LAS bf16*)lds;
    __syncthreads();
#pragma unroll
    for (int h = 0; h < 4; ++h)
#pragma unroll
        for (int dbi = 0; dbi < 2; ++dbi)
#pragma unroll
            for (int rg = 0; rg < 4; ++rg) {
                const int c = h * 128 + 32 * (2 * dh + dbi) + 8 * rg + 4 * hh;
                const v4f ga = *(const v4f*)(gap + c);
                const unsigned w0 = outp[h][dbi][2 * rg], w1 = outp[h][dbi][2 * rg + 1];
                v2u o; o.x = cvt_pk_nv(bf_lo(w0) * rstd * ga.x, bf_hi(w0) * rstd * ga.y); o.y = cvt_pk_nv(bf_lo(w1) * rstd * ga.z, bf_hi(w1) * rstd * ga.w);
                *(LAS v2u*)(OT + t * OT_STRIDE + c) = o;
            }
    __syncthreads();
    {
        bf16* obase = C.MIX() + (size_t)r0 * DM;
#pragma unroll 4
        for (int i = 0; i < 16; ++i) { const int row = wave * 16 + i; *(v4u*)(obase + (size_t)row * DM + 8 * lane) = *(const LAS v4u*)(OT + row * OT_STRIDE + 8 * lane); }
    }
    __syncthreads();
}

#define FTID const int ftid_ = fresh_tid()
#define TID (ftid_)
#define LANE (ftid_ & 63)
#define WAVE (__builtin_amdgcn_readfirstlane(ftid_ >> 6))
#define GSZ ((int)gridDim.x)
#define BX ((int)blockIdx.x)
#define GWV (BX * NWAVES + WAVE)
#define NGWV (GSZ * NWAVES)
constexpr size_t WS_CTL = 0, CTL_ZERO_BYTES = 16384;
constexpr int MISC_OFF = LDS_BYTES - 64;
#define XB_TMO      128
#define XB_XCNT(j)  (256  + 64 * (j))
#define XB_XSUB(j)  (1280 + 64 * (j))
#define XB_XGEN(j)  (2304 + 64 * (j))
#define XB_TOP      3328
#define XB_TOPGEN   3392
#define XCD_BAR_WORDS 3456
#define XB_SPIN_CAP (1u << 18)

__device__ __forceinline__ unsigned xb_ld(unsigned* p)              { return __hip_atomic_load(p, __ATOMIC_RELAXED, __HIP_MEMORY_SCOPE_AGENT); }
__device__ __forceinline__ unsigned xb_add(unsigned* p, unsigned v) { return __hip_atomic_fetch_add(p, v, __ATOMIC_RELAXED, __HIP_MEMORY_SCOPE_AGENT); }
__device__ __forceinline__ unsigned xb_xcc_id() { return (unsigned)__builtin_amdgcn_s_getreg((3 << 11) | 20) & 0xFu; }
#define XB_SPIN(cond, bar) do { unsigned _sp = 0; while (cond) { __builtin_amdgcn_s_sleep(1); \
    if ((++_sp & 255u) == 0u) { if (xb_ld(&(bar)[XB_TMO])) break; if (_sp > XB_SPIN_CAP) { atomicAdd(&(bar)[XB_TMO], 1u); break; } } } } while (0)

struct XcdBarrier {
    unsigned* bar; unsigned x;
    volatile LAS unsigned* st;
};

__device__ __forceinline__ XcdBarrier xcd_barrier_post(unsigned* bar, volatile LAS unsigned* st) {
    XcdBarrier b; b.bar = bar; b.x = xb_xcc_id(); b.st = st;
    if (threadIdx.x == 0) (void)xb_add(&bar[XB_XCNT(b.x)], 1u);
    return b;
}
__device__ __forceinline__ void xcd_barrier_complete(unsigned* bar, unsigned x, unsigned& nloc, unsigned& nx) {
    const unsigned G = gridDim.x * gridDim.y * gridDim.z;
    unsigned sum, cnt, mine, sp = 0u;
    for (;;) {
        sum = 0u; cnt = 0u; mine = 0u;
#pragma unroll
        for (unsigned j = 0; j < 16; ++j) { const unsigned c = xb_ld(&bar[XB_XCNT(j)]); sum += c; cnt += (c > 0u) ? 1u : 0u; mine = (j == x) ? c : mine; }
        if (sum == G) break;
        __builtin_amdgcn_s_sleep(1);
        if ((++sp & 255u) == 0u) { if (xb_ld(&bar[XB_TMO])) break; if (sp > XB_SPIN_CAP) { atomicAdd(&bar[XB_TMO], 1u); break; } }
    }
    nloc = mine > 0u ? mine : 1u; nx = cnt > 0u ? cnt : 1u;
}

__device__ __forceinline__ void xcd_barrier(const XcdBarrier& b) {
    asm volatile("s_waitcnt vmcnt(0)" ::: "memory");
    __syncthreads();
    if (threadIdx.x == 0) {
        unsigned* bar = b.bar;
        __builtin_amdgcn_s_waitcnt(0);
        unsigned nloc = b.st[0], nx = b.st[1];
        if (nloc == 0u) { xcd_barrier_complete(bar, b.x, nloc, nx); b.st[0] = nloc; b.st[1] = nx; }
        const unsigned old = xb_add(&bar[XB_XSUB(b.x)], 1u);
        const unsigned gen = old / nloc;
        if (old + 1u == (gen + 1u) * nloc) {
            __builtin_amdgcn_fence(__ATOMIC_RELEASE, "agent");
            asm volatile("s_waitcnt vmcnt(0)" ::: "memory");
            const unsigned og = xb_add(&bar[XB_TOP], 1u);
            const unsigned tg = og / nx;
            if (og + 1u == (tg + 1u) * nx) xb_add(&bar[XB_TOPGEN], 1u);
            else XB_SPIN(xb_ld(&bar[XB_TOPGEN]) == tg, bar);
            __builtin_amdgcn_fence(__ATOMIC_ACQUIRE, "agent");
            xb_add(&bar[XB_XGEN(b.x)], 1u);
            asm volatile("s_waitcnt vmcnt(0)" ::: "memory");
        } else {
            XB_SPIN(xb_ld(&bar[XB_XGEN(b.x)]) == gen, bar);
            __builtin_amdgcn_fence(__ATOMIC_ACQUIRE, "agent");
            asm volatile("s_waitcnt vmcnt(0)" ::: "memory");
        }
    }
    __syncthreads();
}

template <int MODE>
__device__ __forceinline__ void small_gemm(LAS unsigned char* lds, const bf16* A, const bf16* Bt, int N, int K, bf16* O, int ldc, int act_cols, const float* bias, const bf16* Yv, int ldy, int it0, int it1) {
    FTID; const int wave = WAVE, lane = LANE, tl = lane & 31, hh = lane >> 5;
    LAS float* red = (LAS float*)lds;
    const int nct = N / 32, nitems = 4 * nct, kw = K / 8, nks = kw / 16;
    for (int it = it0; it < it1; ++it) {
        const int item = BX + it * GSZ; if (item >= nitems) break;
        const int rt = item & 3, ct = item >> 2;
        const int hc = 32 * ct + tl;
        const int brow = (MODE == 3) ? (256 * (hc >> 7) + (hc & 127)) : hc;
        const bf16* ap = A + (size_t)(32 * rt + tl) * K + wave * kw + 8 * hh;
        const bf16* bp = Bt + (size_t)brow * K + wave * kw + 8 * hh;
        v16f acc0, acc1;
#pragma unroll
        for (int r = 0; r < 16; ++r) { acc0[r] = 0.f; acc1[r] = 0.f; }
#pragma unroll 4
        for (int ks = 0; ks < nks; ++ks) {
            const bfx8 a = *(const bfx8*)(ap + 16 * ks);
            const bfx8 b0 = *(const bfx8*)(bp + 16 * ks);
            acc0 = __builtin_amdgcn_mfma_f32_32x32x16_bf16(b0, a, acc0, 0, 0, 0);
            if (MODE == 3) { const bfx8 b1 = *(const bfx8*)(bp + (size_t)128 * K + 16 * ks); acc1 = __builtin_amdgcn_mfma_f32_32x32x16_bf16(b1, a, acc1, 0, 0, 0); }
        }
        __syncthreads();
#pragma unroll
        for (int r = 0; r < 16; ++r) { red[(wave * 16 + r) * 64 + lane] = acc0[r]; if (MODE == 3) red[8192 + (wave * 16 + r) * 64 + lane] = acc1[r]; }
        __syncthreads();
        float v0[2], v1[2];
#pragma unroll
        for (int e = 0; e < 2; ++e) { float s0 = 0.f, s1 = 0.f;
#pragma unroll
            for (int w = 0; w < 8; ++w) { s0 += red[(w * 16 + 2 * wave + e) * 64 + lane]; if (MODE == 3) s1 += red[8192 + (w * 16 + 2 * wave + e) * 64 + lane]; }
            v0[e] = s0; v1[e] = s1; }
        const int reg = 2 * wave;
        const int col = 32 * ct + (reg & 3) + 8 * (reg >> 2) + 4 * hh;
        const size_t row = (size_t)(32 * rt + tl);
        float o0 = v0[0], o1 = v0[1];
        if (MODE == 1) { if (col < act_cols) { o0 = gelu_t(o0); o1 = gelu_t(o1); } }
        if (MODE == 2) { const unsigned y = *(const unsigned*)(Yv + row * ldy + col); o0 = bf_lo(y) * pg8::sigmoid_f(o0 + bias[col]); o1 = bf_hi(y) * pg8::sigmoid_f(o1 + bias[col + 1]); }
        if (MODE == 3) { o0 = pg8::silu_f(o0) * v1[0]; o1 = pg8::silu_f(o1) * v1[1]; }
        *(unsigned*)(O + row * ldc + col) = cvt_pk_bf16(o0, o1);
    }
    __syncthreads();
}
struct Args { const float* in[33]; float* out; unsigned char* ws; };
__global__ void __launch_bounds__(NTHREADS, 2) fwd_kernel(Args args) {
    extern __shared__ __attribute__((aligned(16))) unsigned char lds_raw[];
    cg::grid_group grid = cg::this_grid();
    LAS unsigned char* lds = (LAS unsigned char*)lds_raw;
    Ctx C;
    if (threadIdx.x < 16) ((volatile LAS unsigned*)(lds + MISC_OFF))[threadIdx.x] = 0u;
    __syncthreads();
    (void)xcd_barrier_post((unsigned*)(C.ws() + WS_CTL), (volatile LAS unsigned*)(lds + MISC_OFF));
#define XBAR() do { XcdBarrier b_; b_.bar = (unsigned*)(C.ws() + WS_CTL); b_.x = xb_xcc_id(); b_.st = (volatile LAS unsigned*)(lds + MISC_OFF); xcd_barrier(b_); } while (0)
    grid.sync();
    { FTID; p0_prologue(C, lds, WAVE, LANE, TID); }
    XBAR();
    { const int stg = (BX >> 3) & 3;
    small_gemm<3>(lds, C.XN() + (size_t)MPROMPT * DM, C.Wgu1(), DFF, DM, C.H() + (size_t)MPROMPT * DFF, DFF, 0, nullptr, nullptr, 0, 0, stg);
    { pg8::Gemm g{C.XN(), C.Wgu1(), MPROMPT, 2 * DFF, DM}; pg8::StaticOrder S; S.init(MPROMPT, 2 * DFF, GSZ, BX); pg8::EpiSwiglu E{C.H(), DFF};
      pg8::gemm_phase<pg8::EpiSwiglu, pg8::StaticOrder, true, true>(lds, g, S, E); }
    small_gemm<3>(lds, C.XN() + (size_t)MPROMPT * DM, C.Wgu1(), DFF, DM, C.H() + (size_t)MPROMPT * DFF, DFF, 0, nullptr, nullptr, 0, stg, 4); }
    XBAR();
    { const int stg = (BX >> 3) & 3;
    small_gemm<0>(lds, C.H() + (size_t)MPROMPT * DFF, C.Wd1(), DM, DFF, C.D() + (size_t)MPROMPT * DM, DM, 0, nullptr, nullptr, 0, 0, stg);
    { pg8::Gemm g{C.H(), C.Wd1(), MPROMPT, DM, DFF}; pg8::StaticOrder S; S.init(MPROMPT, DM, GSZ, BX); pg8::EpiBf16<0> E{C.D(), DM, 0, nullptr, nullptr, 0};
      pg8::gemm_phase<pg8::EpiBf16<0>, pg8::StaticOrder, true, true>(lds, g, S, E); }
    small_gemm<0>(lds, C.H() + (size_t)MPROMPT * DFF, C.Wd1(), DM, DFF, C.D() + (size_t)MPROMPT * DM, DM, 0, nullptr, nullptr, 0, stg, 4); }
    XBAR();
    { FTID; const float* gp = C.in(8); { const int gw_ = GWV, ngw_ = NGWV, nit = (MPROMPT + 4 * ngw_ - 1) / (4 * ngw_);
      for (int it = 0; it < nit - 1; ++it) rows_res<4, false, false>(C, gw_ + 4 * it * ngw_, ngw_, M, gp, 0.5f, LANE);
      rows_res<5, false, false>(C, gw_ + 4 * (nit - 1) * ngw_, ngw_, MPROMPT + gw_, gp, 0.5f, LANE);
      for (int ms = MPROMPT + gw_ + ngw_; ms < M; ms += ngw_) rows_res<5, false, false>(C, MPROMPT, ngw_, ms, gp, 0.5f, LANE); } }
    XBAR();
    { const int stg = (BX >> 3) & 3;
    small_gemm<1>(lds, C.XN() + (size_t)MPROMPT * DM, C.Win(), DIN, DM, C.Z() + (size_t)MPROMPT * DIN, DIN, 2 * AW, nullptr, nullptr, 0, 0, stg);
    { pg8::Gemm g{C.XN(), C.Win(), MPROMPT, DIN, DM}; pg8::StaticOrder S; S.init(MPROMPT, DIN, GSZ, BX); pg8::EpiBf16<1> E{C.Z(), DIN, 2 * AW, nullptr, nullptr, 0};
      pg8::gemm_phase<pg8::EpiBf16<1>, pg8::StaticOrder, true, true>(lds, g, S, E); }
    small_gemm<1>(lds, C.XN() + (size_t)MPROMPT * DM, C.Win(), DIN, DM, C.Z() + (size_t)MPROMPT * DIN, DIN, 2 * AW, nullptr, nullptr, 0, stg, 4); }
    XBAR();
    { FTID; for (int T = BX; T < NTILE - 1; T += GSZ) {
        s5_tile<false>(C, T, 0, 4, lds, WAVE, LANE);
        __syncthreads();
        gmlp_tile(C, T, lds, WAVE, LANE, TID);
    } }
    XBAR();
    { FTID; const bool swap0 = GSZ > 128;
      for (int T = BX; T < NTILE - 1; T += GSZ) { if (swap0 && T == 0) continue; s5_tile<true>(C, T, 0, 4, lds, WAVE, LANE); }
      if (swap0 && BX == 128) s5_tile<true>(C, 0, 0, 4, lds, WAVE, LANE);
      if (BX >= 1 && BX <= 4) s5_tile<true>(C, NTILE - 1, BX - 1, BX, lds, WAVE, LANE);
      if (BX == 0) { __syncthreads(); gmlp_tile(C, NTILE - 1, lds, WAVE, LANE, TID); } }
    XBAR();
    { const int stg = (BX >> 3) & 3;
    small_gemm<2>(lds, C.YB() + (size_t)MPROMPT * BWD, C.Wglu(), BWD, BWD, C.MIX() + (size_t)MPROMPT * DM + AW, DM, 0, C.in(23), C.YB() + (size_t)MPROMPT * BWD, BWD, 0, stg);
    { pg8::Gemm g{C.YB(), C.Wglu(), MPROMPT, BWD, BWD}; pg8::StaticOrder S; S.init(MPROMPT, BWD, GSZ, BX); pg8::EpiBf16<2> E{C.MIX() + AW, DM, 0, C.in(23), C.YB(), BWD};
      pg8::gemm_phase<pg8::EpiBf16<2>, pg8::StaticOrder, true, true>(lds, g, S, E); }
    small_gemm<2>(lds, C.YB() + (size_t)MPROMPT * BWD, C.Wglu(), BWD, BWD, C.MIX() + (size_t)MPROMPT * DM + AW, DM, 0, C.in(23), C.YB() + (size_t)MPROMPT * BWD, BWD, stg, 4); }
    XBAR();
    { FTID; const float* gb = C.in(25); bf16* bb_ = C.MIX() + AW; const int gw_ = GWV, ngw_ = NGWV, nit = (MPROMPT + 4 * ngw_ - 1) / (4 * ngw_);
      for (int it = 0; it < nit - 1; ++it) rows_norm512<4>(bb_, gw_ + 4 * it * ngw_, ngw_, M, gb, LANE);
      rows_norm512<5>(bb_, gw_ + 4 * (nit - 1) * ngw_, ngw_, MPROMPT + gw_, gb, LANE);
      for (int ms = MPROMPT + gw_ + ngw_; ms < M; ms += ngw_) rows_norm512<5>(bb_, MPROMPT, ngw_, ms, gb, LANE); }
    XBAR();
    { const int stg = (BX >> 3) & 3;
    small_gemm<0>(lds, C.MIX() + (size_t)MPROMPT * DM, C.Wout(), DM, DM, C.D() + (size_t)MPROMPT * DM, DM, 0, nullptr, nullptr, 0, 0, stg);
    { pg8::Gemm g{C.MIX(), C.Wout(), MPROMPT, DM, DM}; pg8::StaticOrder S; S.init(MPROMPT, DM, GSZ, BX); pg8::EpiBf16<0> E{C.D(), DM, 0, nullptr, nullptr, 0};
      pg8::gemm_phase<pg8::EpiBf16<0>, pg8::StaticOrder, true, true>(lds, g, S, E); }
    small_gemm<0>(lds, C.MIX() + (size_t)MPROMPT * DM, C.Wout(), DM, DM, C.D() + (size_t)MPROMPT * DM, DM, 0, nullptr, nullptr, 0, stg, 4); }
    XBAR();
    { FTID; const float* gp = C.in(27); { const int gw_ = GWV, ngw_ = NGWV, nit = (MPROMPT + 4 * ngw_ - 1) / (4 * ngw_);
      for (int it = 0; it < nit - 1; ++it) rows_res<4, false, false>(C, gw_ + 4 * it * ngw_, ngw_, M, gp, 1.0f, LANE);
      rows_res<5, false, false>(C, gw_ + 4 * (nit - 1) * ngw_, ngw_, MPROMPT + gw_, gp, 1.0f, LANE);
      for (int ms = MPROMPT + gw_ + ngw_; ms < M; ms += ngw_) rows_res<5, false, false>(C, MPROMPT, ngw_, ms, gp, 1.0f, LANE); } }
    XBAR();
    { const int stg = (BX >> 3) & 3;
    small_gemm<3>(lds, C.XN() + (size_t)MPROMPT * DM, C.Wgu2(), DFF, DM, C.H() + (size_t)MPROMPT * DFF, DFF, 0, nullptr, nullptr, 0, 0, stg);
    { pg8::Gemm g{C.XN(), C.Wgu2(), MPROMPT, 2 * DFF, DM}; pg8::StaticOrder S; S.init(MPROMPT, 2 * DFF, GSZ, BX); pg8::EpiSwiglu E{C.H(), DFF};
      pg8::gemm_phase<pg8::EpiSwiglu, pg8::StaticOrder, true, true>(lds, g, S, E); }
    small_gemm<3>(lds, C.XN() + (size_t)MPROMPT * DM, C.Wgu2(), DFF, DM, C.H() + (size_t)MPROMPT * DFF, DFF, 0, nullptr, nullptr, 0, stg, 4); }
    XBAR();
    { const int stg = (BX >> 3) & 3;
    small_gemm<0>(lds, C.H() + (size_t)MPROMPT * DFF, C.Wd2(), DM, DFF, C.D() + (size_t)MPROMPT * DM, DM, 0, nullptr, nullptr, 0, 0, stg);
    { pg8::Gemm g{C.H(), C.Wd2(), MPROMPT, DM, DFF}; pg8::StaticOrder S; S.init(MPROMPT, DM, GSZ, BX); pg8::EpiBf16<0> E{C.D(), DM, 0, nullptr, nullptr, 0};
      pg8::gemm_phase<pg8::EpiBf16<0>, pg8::StaticOrder, true, true>(lds, g, S, E); }
    small_gemm<0>(lds, C.H() + (size_t)MPROMPT * DFF, C.Wd2(), DM, DFF, C.D() + (size_t)MPROMPT * DM, DM, 0, nullptr, nullptr, 0, stg, 4); }
    XBAR();
    { FTID; const float* gp = C.in(32); { const int gw_ = GWV, ngw_ = NGWV, nit = (MPROMPT + 4 * ngw_ - 1) / (4 * ngw_);
      for (int it = 0; it < nit - 1; ++it) rows_res<4, false, true>(C, gw_ + 4 * it * ngw_, ngw_, M, gp, 0.5f, LANE);
      rows_res<5, false, true>(C, gw_ + 4 * (nit - 1) * ngw_, ngw_, MPROMPT + gw_, gp, 0.5f, LANE);
      for (int ms = MPROMPT + gw_ + ngw_; ms < M; ms += ngw_) rows_res<5, false, true>(C, MPROMPT, ngw_, ms, gp, 0.5f, LANE); } }
}

extern "C" void kernel_launch(void* const* d_in, const int* in_sizes, int n_in, void* d_out, int out_size, void* d_ws, size_t ws_size, hipStream_t stream) {
    static int grid = 0;
    if (grid == 0) {
        if (n_in != 33 || ws_size < WS_END) { fprintf(stderr, "kernel_launch: unexpected n_in %d / ws %zu\n", n_in, ws_size); grid = -1; return; }
        int dev = 0, cus = 0, per_cu = 0;
        hipGetDevice(&dev);
        hipDeviceGetAttribute(&cus, hipDeviceAttributeMultiprocessorCount, dev);
        hipFuncSetAttribute((const void*)fwd_kernel, hipFuncAttributeMaxDynamicSharedMemorySize, LDS_BYTES);
        hipOccupancyMaxActiveBlocksPerMultiprocessor(&per_cu, (const void*)fwd_kernel, NTHREADS, LDS_BYTES);
        if (per_cu < 1) { fprintf(stderr, "kernel_launch: occupancy query says %d blocks per CU\n", per_cu); per_cu = 1; }
        grid = cus * per_cu;
    }
    if (grid < 0) return;
    if (hipMemsetAsync((char*)d_ws + WS_CTL, 0, CTL_ZERO_BYTES, stream) != hipSuccess) { fprintf(stderr, "memset failed\n"); return; }
    Args a{};
    for (int i = 0; i < 33; ++i) a.in[i] = (const float*)d_in[i];
    a.out = (float*)d_out; a.ws = (unsigned char*)d_ws;
    void* params[] = {&a};
    hipError_t e = hipLaunchCooperativeKernel((const void*)fwd_kernel, dim3(grid), dim3(NTHREADS), params, LDS_BYTES, stream);
    if (e != hipSuccess) fprintf(stderr, "cooperative launch failed: %s (grid %d)\n", hipGetErrorString(e), grid);
}
```

```cpp
#include <hip/hip_runtime.h>
#include <hip/hip_cooperative_groups.h>
#include <cstdio>
#include <cstdint>
namespace cg = cooperative_groups;
__device__ __forceinline__ int fresh_tid() { int t = (int)threadIdx.x; asm volatile("" : "+v"(t)); return t; }
namespace pg8 {
#define PG8_LAS __attribute__((address_space(3)))
typedef unsigned short bf16_t;
typedef short bf16x8 __attribute__((ext_vector_type(8)));
typedef float f32x4 __attribute__((ext_vector_type(4)));
typedef unsigned u32x4 __attribute__((ext_vector_type(4)));
constexpr int BM = 256, BK = 64, HALF = 128, HTB = HALF * BK * 2  , STAGE_BYTES = 8 * HTB, NXCD = 8, WGM = 8;

__host__ __device__ __forceinline__ int lds_byte(int r, int c) { const int st = (r >> 4) * 2 + (c >> 5), rr = r & 15, cc = c & 31, ob = rr * 64 + cc * 2; return st * 1024 + (ob ^ (((ob >> 9) & 1) << 5)); }
__host__ __device__ __forceinline__ void stage_rc(int b, int& R, int& C) { const int st = b / 1024, sb = b % 1024, swz = sb ^ (((sb >> 9) & 1) << 5); R = (st >> 1) * 16 + swz / 64; C = (st & 1) * 32 + (swz % 64) / 2; }
__host__ __device__ __forceinline__ int perm32(int rho) { const int n = rho >> 4, i = rho & 15; return 8 * (i >> 2) + 4 * n + (i & 3); }

struct Unit { int pm, pn; };
struct Gemm { const bf16_t* A; const bf16_t* Bt; int M, N, K; };

struct StaticOrder {
    int nM, nN, nwg, G, c;
    __host__ __device__ void init(int M, int N, int G_, int c_) { nM = M / BM; nN = N / BM; nwg = nM * nN; G = G_; c = c_; }
    __host__ __device__ bool next(int i, Unit& u) const {
        const long L = (long)i * G + c; if (L >= nwg) return false;
        int wgid = (int)L; { const int q = nwg / NXCD, r = nwg % NXCD, xcd = wgid % NXCD, off = wgid / NXCD; wgid = (xcd < r ? xcd * (q + 1) : r * (q + 1) + (xcd - r) * q) + off; }
        const int nig = WGM * nN, gid = wgid / nig, fm = gid * WGM, gsz = (nM - fm) < WGM ? (nM - fm) : WGM;
        u.pm = fm + ((wgid % nig) % gsz); u.pn = (wgid % nig) / gsz; return true;
    }
    __device__ __forceinline__ void a_ready(const Unit&) const {}
    __device__ __forceinline__ void done(const Unit&) const {}
};

__device__ __forceinline__ unsigned cvt_pk_bf16(float lo, float hi) { unsigned r; asm volatile("v_cvt_pk_bf16_f32 %0, %1, %2" : "=v"(r) : "v"(lo), "v"(hi)); return r; }
__device__ __forceinline__ float bf_lo(unsigned w) { return __uint_as_float(w << 16); }
__device__ __forceinline__ float bf_hi(unsigned w) { return __uint_as_float(w & 0xffff0000u); }
__device__ __forceinline__ float sigmoid_f(float x) { return __builtin_amdgcn_rcpf(1.0f + __expf(-x)); }
__device__ __forceinline__ float silu_f(float x) { return x * sigmoid_f(x); }
__device__ __forceinline__ float gelu_t(float x) { const float u = 1.5957691216057308f * (x + 0.044715f * x * x * x); return x * sigmoid_f(u); }

struct EpiSwiglu {
    static constexpr bool PERM = true, AFTER_DRAIN = false;
    bf16_t* O; int ldc;
    __device__ __forceinline__ void operator()(const f32x4 (&acc)[2][2][4][2], const Unit& u, int wr, int wc, int fr, int fq) const {
        const int row0 = u.pm * BM + wr * 64 + fr; const int col0 = u.pn * HALF + wc * 32 + 8 * fq;
#pragma unroll
        for (int ai = 0; ai < 2; ++ai)
#pragma unroll
            for (int m = 0; m < 4; ++m) {
                bf16_t* rowp = O + (size_t)(row0 + ai * HALF + m * 16) * ldc + col0;
                const f32x4 g0 = acc[ai][0][m][0], g1 = acc[ai][0][m][1], u0 = acc[ai][1][m][0], u1 = acc[ai][1][m][1];
                u32x4 w;
                w.x = cvt_pk_bf16(silu_f(g0[0]) * u0[0], silu_f(g0[1]) * u0[1]); w.y = cvt_pk_bf16(silu_f(g0[2]) * u0[2], silu_f(g0[3]) * u0[3]);
                w.z = cvt_pk_bf16(silu_f(g1[0]) * u1[0], silu_f(g1[1]) * u1[1]); w.w = cvt_pk_bf16(silu_f(g1[2]) * u1[2], silu_f(g1[3]) * u1[3]);
                *(u32x4*)rowp = w;
            }
    }
};
template <int MODE> struct EpiBf16 {
    static constexpr bool PERM = true, AFTER_DRAIN = false;
    bf16_t* O; int ldc; int act_cols; const float* bias; const bf16_t* Y; int ldy;
    __device__ __forceinline__ void operator()(const f32x4 (&acc)[2][2][4][2], const Unit& u, int wr, int wc, int fr, int fq) const {
        const int row0 = u.pm * BM + wr * 64 + fr; const int col0 = u.pn * BM + wc * 32 + 8 * fq;
#pragma unroll
        for (int bj = 0; bj < 2; ++bj) {
            const int col = col0 + bj * HALF;
            f32x4 b0 = (f32x4){0.f, 0.f, 0.f, 0.f}, b1 = b0;
            if (MODE == 2) { b0 = *(const f32x4*)(bias + col); b1 = *(const f32x4*)(bias + col + 4); }
            const bool act = (MODE == 1) && (col < act_cols);
#pragma unroll
            for (int ai = 0; ai < 2; ++ai)
#pragma unroll
                for (int m = 0; m < 4; ++m) {
                    const size_t row = (size_t)(row0 + ai * HALF + m * 16);
                    f32x4 v0 = acc[ai][bj][m][0], v1 = acc[ai][bj][m][1];
                    if (MODE == 1) { if (act) {
#pragma unroll
                        for (int j = 0; j < 4; ++j) { v0[j] = gelu_t(v0[j]); v1[j] = gelu_t(v1[j]); } } }
                    if (MODE == 2) {
                        const u32x4 y = *(const u32x4*)(Y + row * ldy + col);
                        v0 = v0 + b0; v1 = v1 + b1;
                        v0[0] = bf_lo(y.x) * sigmoid_f(v0[0]); v0[1] = bf_hi(y.x) * sigmoid_f(v0[1]); v0[2] = bf_lo(y.y) * sigmoid_f(v0[2]); v0[3] = bf_hi(y.y) * sigmoid_f(v0[3]);
                        v1[0] = bf_lo(y.z) * sigmoid_f(v1[0]); v1[1] = bf_hi(y.z) * sigmoid_f(v1[1]); v1[2] = bf_lo(y.w) * sigmoid_f(v1[2]); v1[3] = bf_hi(y.w) * sigmoid_f(v1[3]);
                    }
                    u32x4 w; w.x = cvt_pk_bf16(v0[0], v0[1]); w.y = cvt_pk_bf16(v0[2], v0[3]); w.z = cvt_pk_bf16(v1[0], v1[1]); w.w = cvt_pk_bf16(v1[2], v1[3]);
                    *(u32x4*)(O + row * ldc + col) = w;
                }
        }
    }
};

template <class Epi, class Sched, bool ALIGN_EPI = false, bool SP2 = false>
__device__ __forceinline__ void gemm_phase(PG8_LAS unsigned char* lds, const Gemm g, const Sched& S, const Epi& E) {
    const int tid = fresh_tid(), wid = __builtin_amdgcn_readfirstlane(tid >> 6), lane = tid & 63, wr = wid >> 2, wc = wid & 3, fr = lane & 15, fq = lane >> 4;
    const int K = g.K, nt = K / BK;
    unsigned voffA[2], voffB[2];
#pragma unroll
    for (int i = 0; i < 2; ++i) { int R, C; stage_rc(tid * 16 + i * 8192, R, C); const int Rb = Epi::PERM ? ((R & ~31) + perm32(R & 31)) : R;
        voffA[i] = (unsigned)(R * K + C) * 2u; voffB[i] = (unsigned)(Rb * K + C) * 2u; }
    const size_t kstep = (size_t)(BK * 2);
    const size_t hstep = (size_t)HALF * K * 2;
    const size_t tstep = 2 * hstep;
    const unsigned ldsw = (unsigned)wid * 1024u;
    const int aoff = lds_byte(wr * 64 + fr, fq * 8), boff = lds_byte(wc * 32 + fr, fq * 8);
#define PG8_SA(b, h) (((b) * 2 + (h)) * HTB)
#define PG8_SB(b, h) ((4 + (b) * 2 + (h)) * HTB)
#define PG8_STAGE(bufoff, gbase, voff) do { _Pragma("unroll") for (int _i = 0; _i < 2; ++_i) \
        __builtin_amdgcn_global_load_lds((const unsigned*)((const char*)(gbase) + (voff)[_i]), (PG8_LAS unsigned*)(lds + (bufoff) + ldsw + _i * 8192), 16, 0, 0); } while (0)
#define PG8_LDA(dst, b, h) do { _Pragma("unroll") for (int m = 0; m < 4; ++m) _Pragma("unroll") for (int k = 0; k < 2; ++k) dst[m][k] = *(const PG8_LAS bf16x8*)(lds + PG8_SA(b, h) + aoff + m * 2048 + k * 1024); } while (0)
#define PG8_LDB(dst, b, h) do { _Pragma("unroll") for (int n = 0; n < 2; ++n) _Pragma("unroll") for (int k = 0; k < 2; ++k) dst[n][k] = *(const PG8_LAS bf16x8*)(lds + PG8_SB(b, h) + boff + n * 2048 + k * 1024); } while (0)
#define PG8_MMA(ai, bj, At, Bt) do { __builtin_amdgcn_s_setprio(1); _Pragma("unroll") for (int m = 0; m < 4; ++m) _Pragma("unroll") for (int n = 0; n < 2; ++n) _Pragma("unroll") for (int k = 0; k < 2; ++k) \
        acc[ai][bj][m][n] = __builtin_amdgcn_mfma_f32_16x16x32_bf16(Bt[n][k], At[m][k], acc[ai][bj][m][n], 0, 0, 0); __builtin_amdgcn_s_setprio(0); } while (0)
#define PG8_WAIT_V(n) asm volatile("s_waitcnt vmcnt(" #n ")" ::: "memory")
#define PG8_WAIT_L(n) asm volatile("s_waitcnt lgkmcnt(" #n ")" ::: "memory")
#define PG8_BAR __builtin_amdgcn_s_barrier()
#define PG8_SCHED __builtin_amdgcn_sched_barrier(0)
    Unit cur, nxt; int ui = 0;
    if (!S.next(0, cur)) return;
    f32x4 acc[2][2][4][2];
#pragma unroll
    for (int a = 0; a < 2; ++a)
#pragma unroll
        for (int b = 0; b < 2; ++b)
#pragma unroll
            for (int m = 0; m < 4; ++m)
#pragma unroll
                for (int n = 0; n < 2; ++n) acc[a][b][m][n] = (f32x4){0.f, 0.f, 0.f, 0.f};
    bf16x8 At[4][2], B0[2][2], B1[2][2];
    const char* cA = (const char*)g.A + (size_t)cur.pm * tstep; const char* cB = (const char*)g.Bt + (size_t)cur.pn * tstep;
    S.a_ready(cur);
    if constexpr (SP2) {
        PG8_STAGE(PG8_SB(0, 0), cB, voffB); PG8_STAGE(PG8_SB(0, 1), cB + hstep, voffB); PG8_STAGE(PG8_SA(0, 0), cA, voffA); PG8_STAGE(PG8_SA(0, 1), cA + hstep, voffA);
        if (wr == 1) PG8_BAR;
        PG8_WAIT_V(2); PG8_BAR;
        PG8_STAGE(PG8_SB(1, 0), cB + kstep, voffB); PG8_STAGE(PG8_SA(1, 0), cA + kstep, voffA); PG8_STAGE(PG8_SB(1, 1), cB + hstep + kstep, voffB);
        PG8_WAIT_V(6); PG8_BAR;
    } else {
        PG8_STAGE(PG8_SB(0, 0), cB, voffB); PG8_STAGE(PG8_SA(0, 0), cA, voffA); PG8_STAGE(PG8_SB(0, 1), cB + hstep, voffB); PG8_STAGE(PG8_SA(0, 1), cA + hstep, voffA);
        if (wr == 1) PG8_BAR;
        PG8_WAIT_V(4); PG8_BAR;
        PG8_STAGE(PG8_SB(1, 0), cB + kstep, voffB); PG8_STAGE(PG8_SA(1, 0), cA + kstep, voffA); PG8_STAGE(PG8_SB(1, 1), cB + hstep + kstep, voffB);
        PG8_WAIT_V(6); PG8_BAR;
    }
    for (;;) {
        const bool has_next = S.next(ui + 1, nxt);
        const char* nA = has_next ? (const char*)g.A + (size_t)nxt.pm * tstep : cA; const char* nB = has_next ? (const char*)g.Bt + (size_t)nxt.pn * tstep : cB;
        for (int t = 0; t < nt; t += 2) {
            const bool last = (t == nt - 2);
            const char* a1 = cA + (size_t)(t + 1) * kstep;
            const char* a2 = last ? nA : cA + (size_t)(t + 2) * kstep; const char* b2 = last ? nB : cB + (size_t)(t + 2) * kstep;
            const char* a3 = a2 + kstep; const char* b3 = b2 + kstep;
            if (last && has_next) S.a_ready(nxt);
            if constexpr (SP2) {
            PG8_LDB(B0, 0, 0); PG8_LDB(B1, 0, 1); PG8_SCHED; PG8_LDA(At, 0, 0); PG8_STAGE(PG8_SA(1, 1), a1 + hstep, voffA);
            PG8_WAIT_V(8); PG8_WAIT_L(0); PG8_BAR; PG8_MMA(0, 0, At, B0); PG8_MMA(0, 1, At, B1); PG8_BAR; PG8_SCHED;
            PG8_LDA(At, 0, 1); PG8_STAGE(PG8_SB(0, 0), b2, voffB); PG8_STAGE(PG8_SB(0, 1), b2 + hstep, voffB); PG8_STAGE(PG8_SA(0, 0), a2, voffA);
            PG8_WAIT_V(8); PG8_WAIT_L(0); PG8_BAR; PG8_MMA(1, 0, At, B0); PG8_MMA(1, 1, At, B1); PG8_BAR; PG8_SCHED;
            PG8_LDB(B0, 1, 0); PG8_LDB(B1, 1, 1); PG8_SCHED; PG8_LDA(At, 1, 0); PG8_STAGE(PG8_SA(0, 1), a2 + hstep, voffA);
            PG8_WAIT_V(8); PG8_WAIT_L(0); PG8_BAR; PG8_MMA(0, 0, At, B0); PG8_MMA(0, 1, At, B1); PG8_BAR; PG8_SCHED;
            PG8_LDA(At, 1, 1); PG8_STAGE(PG8_SB(1, 0), b3, voffB); PG8_STAGE(PG8_SB(1, 1), b3 + hstep, voffB); PG8_STAGE(PG8_SA(1, 0), a3, voffA);
            PG8_WAIT_V(8); PG8_WAIT_L(0); PG8_BAR; PG8_MMA(1, 0, At, B0); PG8_MMA(1, 1, At, B1); PG8_BAR; PG8_SCHED;
            } else {
            PG8_LDB(B0, 0, 0); PG8_SCHED; PG8_LDA(At, 0, 0); PG8_STAGE(PG8_SA(1, 1), a1 + hstep, voffA);
            PG8_WAIT_L(8); PG8_BAR; PG8_WAIT_L(0); PG8_MMA(0, 0, At, B0); PG8_BAR; PG8_SCHED;
            PG8_LDB(B1, 0, 1); PG8_STAGE(PG8_SB(0, 0), b2, voffB);
            PG8_BAR; PG8_WAIT_L(0); PG8_MMA(0, 1, At, B1); PG8_BAR;
            PG8_LDA(At, 0, 1); PG8_STAGE(PG8_SA(0, 0), a2, voffA);
            PG8_BAR; PG8_WAIT_L(0); PG8_MMA(1, 0, At, B0); PG8_BAR; PG8_SCHED;
            PG8_STAGE(PG8_SB(0, 1), b2 + hstep, voffB);
            PG8_WAIT_V(6); PG8_BAR; PG8_MMA(1, 1, At, B1); PG8_BAR;
            PG8_LDB(B0, 1, 0); PG8_SCHED; PG8_LDA(At, 1, 0); PG8_STAGE(PG8_SA(0, 1), a2 + hstep, voffA);
            PG8_WAIT_L(8); PG8_BAR; PG8_WAIT_L(0); PG8_MMA(0, 0, At, B0); PG8_BAR; PG8_SCHED;
            PG8_LDB(B1, 1, 1); PG8_STAGE(PG8_SB(1, 0), b3, voffB);
            PG8_BAR; PG8_WAIT_L(0); PG8_MMA(0, 1, At, B1); PG8_BAR;
            PG8_LDA(At, 1, 1); PG8_STAGE(PG8_SA(1, 0), a3, voffA);
            PG8_BAR; PG8_WAIT_L(0); PG8_MMA(1, 0, At, B0); PG8_BAR; PG8_SCHED;
            PG8_STAGE(PG8_SB(1, 1), b3 + hstep, voffB);
            PG8_WAIT_V(6); PG8_BAR; PG8_MMA(1, 1, At, B1); PG8_BAR;
            }
        }
        if constexpr (ALIGN_EPI) { if (wr == 0) PG8_BAR; }
        if constexpr (!Epi::AFTER_DRAIN) { E(acc, cur, wr, wc, fr, fq); S.done(cur); }
        if (!has_next) break;
#pragma unroll
        for (int a = 0; a < 2; ++a)
#pragma unroll
            for (int b = 0; b < 2; ++b)
#pragma unroll
                for (int m = 0; m < 4; ++m)
#pragma unroll
                    for (int n = 0; n < 2; ++n) acc[a][b][m][n] = (f32x4){0.f, 0.f, 0.f, 0.f};
        cur = nxt; cA = nA; cB = nB; ++ui;
        if constexpr (ALIGN_EPI) { if (wr == 1) PG8_BAR; }
    }
    PG8_WAIT_V(0);
    if constexpr (!ALIGN_EPI) { if (wr == 0) PG8_BAR; }
    PG8_BAR;
    if constexpr (Epi::AFTER_DRAIN) { E.fused(acc, cur, wr, wc, fr, fq, lds, wid, lane); S.done(cur); }
#undef PG8_SA
#undef PG8_SB
#undef PG8_STAGE
#undef PG8_LDA
#undef PG8_LDB
#undef PG8_MMA
#undef PG8_WAIT_V
#undef PG8_WAIT_L
#undef PG8_BAR
#undef PG8_SCHED
}
}

constexpr int DM = 1024, SEQ = 16384, NBATCH = 2, MPROMPT = NBATCH * SEQ, DEC_B = 8, DEC_S = 16;
constexpr int M = MPROMPT + DEC_B * DEC_S;
constexpr int MPAD = 33024;
constexpr int DFF = 2816, DIN = 1536, AW = 512, BWD = 512, NG = 32, NP = 64, GN = 16;
constexpr int NTILE = M / 128;
constexpr float EPS = 1e-6f;
constexpr int NWAVES = 8, NTHREADS = 512;

constexpr size_t MiB = 1u << 20;
constexpr size_t WS_WGU1 = 1 * MiB, WS_WD1 = 12 * MiB, WS_WIN = 18 * MiB, WS_WGLU = 21 * MiB, WS_WOUT = 22 * MiB, WS_WGU2 = 24 * MiB, WS_WD2 = 35 * MiB;
constexpr size_t WS_WEFF = 41 * MiB, WS_BB = 42 * MiB, WS_CM = 42 * MiB + 131072, WS_LAM = 42 * MiB + 262144, WS_RS = 42 * MiB + 524288, WS_E = 43 * MiB;
constexpr size_t WS_XN = 48 * MiB, WS_D = 113 * MiB, WS_H = 178 * MiB, WS_Z = 178 * MiB, WS_YB = 275 * MiB, WS_MIX = 356 * MiB, WS_END = 421 * MiB;
static_assert(WS_XN + (size_t)MPAD * DM * 2 <= WS_D && WS_D + (size_t)MPAD * DM * 2 <= WS_H && WS_H + (size_t)MPAD * DFF * 2 <= WS_MIX, "ws map");
static_assert(WS_Z + (size_t)MPAD * DIN * 2 <= WS_YB && WS_YB + (size_t)MPAD * BWD * 2 <= WS_H + (size_t)MPAD * DFF * 2 && WS_MIX + (size_t)MPAD * DM * 2 <= WS_END, "ws map 2");
static_assert(WS_E + (size_t)NTILE * NG * NP * 8 <= WS_XN, "ws map 3");

constexpr size_t OFF_Y = 0, OFF_SRE_P = (size_t)M * DM, OFF_SIM_P = OFF_SRE_P + NBATCH * NG * NP, OFF_SRE_S = OFF_SIM_P + NBATCH * NG * NP,
                 OFF_SIM_S = OFF_SRE_S + DEC_B * NG * NP, OFF_V_S = OFF_SIM_S + DEC_B * NG * NP;

constexpr int OT_STRIDE = 520;
constexpr int VT_STRIDE = 136;
constexpr int LDS_BYTES = 147456;
static_assert(128 * VT_STRIDE * 2 + 4096 <= LDS_BYTES - 64 && 128 * OT_STRIDE * 2 <= LDS_BYTES - 64, "lds map");

#define LAS __attribute__((address_space(3)))
typedef unsigned short bf16;
typedef float v4f __attribute__((ext_vector_type(4)));
typedef float v2f __attribute__((ext_vector_type(2)));
typedef float v16f __attribute__((ext_vector_type(16)));
typedef unsigned v4u __attribute__((ext_vector_type(4)));
typedef unsigned v2u __attribute__((ext_vector_type(2)));
typedef short bfx8 __attribute__((ext_vector_type(8)));
#define LDS_FENCE() asm volatile("s_waitcnt lgkmcnt(0)" ::: "memory")

using pg8::cvt_pk_bf16; using pg8::bf_lo; using pg8::bf_hi; using pg8::gelu_t;

__device__ __forceinline__ float wave_sum(float v) {
#pragma unroll
    for (int o = 1; o < 64; o <<= 1) v += __shfl_xor(v, o);
    return v;
}
typedef __bf16 bf16x2_t __attribute__((ext_vector_type(2)));
__device__ __forceinline__ unsigned cvt_pk_c(float lo, float hi) { const v2f v = {lo, hi}; const bf16x2_t b = __builtin_convertvector(v, bf16x2_t); return __builtin_bit_cast(unsigned, b); }
__device__ __forceinline__ unsigned cvt_pk_nv(float lo, float hi) { unsigned r; asm("v_cvt_pk_bf16_f32 %0, %1, %2" : "=v"(r) : "v"(lo), "v"(hi)); return r; }
__device__ __forceinline__ bf16 f2bf(float f) { return (bf16)(cvt_pk_nv(f, 0.f) & 0xffffu); }


__device__ __forceinline__ double dexp(double x) {
    const double y = x * (1.0 / 256.0); double t = 1.0;
#pragma unroll
    for (int i = 12; i >= 1; --i) t = 1.0 + t * y * (1.0 / (double)i);
#pragma unroll
    for (int i = 0; i < 8; ++i) t = t * t;
    return t;
}
__device__ __forceinline__ void dsincos(double x, double& s, double& c) {
    const double twopi = 6.283185307179586476925286766559;
    const double k = rint(x * (1.0 / twopi)); const double r = x - k * twopi, r2 = r * r;
    double ts = r, tc = 1.0; s = r; c = 1.0;
#pragma unroll
    for (int i = 1; i <= 15; ++i) { tc = -tc * r2 * (1.0 / (double)((2 * i - 1) * (2 * i))); ts = -ts * r2 * (1.0 / (double)((2 * i) * (2 * i + 1))); c += tc; s += ts; }
}

typedef const float* cfp_t;
typedef __attribute__((address_space(4))) cfp_t const* kin_t;
__device__ __forceinline__ const float* karg_in(int i) {
    auto k = __builtin_amdgcn_kernarg_segment_ptr();
    asm volatile("" : "+s"(k));
    return ((kin_t)k)[i];
}
struct Ctx {
    __device__ __forceinline__ const float* in(int i) const { return karg_in(i); }
    __device__ __forceinline__ float* out() const { return (float*)karg_in(33); }
    __device__ __forceinline__ unsigned char* ws() const { return (unsigned char*)karg_in(34); }
#define WSP(name, T, off) __device__ __forceinline__ T* name() const { return (T*)(ws() + (off)); }
    WSP(Wgu1, bf16, WS_WGU1) WSP(Wd1, bf16, WS_WD1) WSP(Win, bf16, WS_WIN) WSP(Wglu, bf16, WS_WGLU) WSP(Wout, bf16, WS_WOUT) WSP(Wgu2, bf16, WS_WGU2) WSP(Wd2, bf16, WS_WD2)
    WSP(Weff, bf16, WS_WEFF) WSP(BB, bf16, WS_BB) WSP(CM, bf16, WS_CM) WSP(XN, bf16, WS_XN) WSP(D, bf16, WS_D) WSP(H, bf16, WS_H) WSP(Z, bf16, WS_Z) WSP(YB, bf16, WS_YB) WSP(MIX, bf16, WS_MIX)
    WSP(LAM, float, WS_LAM) WSP(E, float, WS_E) WSP(RS, float, WS_RS)
#undef WSP
};

__device__ __forceinline__ void p0_block_item(const float* W, const float* gk, int K, int N, bf16* WT, int mode, int item, LAS float* tile, int tid) {
    const int nblk = N / 256, kb = item / nblk, nb = item % nblk, k0 = 64 * kb, n0 = 256 * nb;
    const int lr = tid >> 6, lc = 4 * (tid & 63);
    v4f v[8];
#pragma unroll
    for (int i = 0; i < 8; ++i) v[i] = *(const v4f*)(W + (size_t)(k0 + lr + 8 * i) * N + n0 + lc);
    if (gk) {
#pragma unroll
        for (int i = 0; i < 8; ++i) v[i] = v[i] * gk[k0 + lr + 8 * i];
    }
    __syncthreads();
#pragma unroll
    for (int i = 0; i < 8; ++i) { LAS float* p = tile + (lr + 8 * i) * 257 + lc; p[0] = v[i].x; p[1] = v[i].y; p[2] = v[i].z; p[3] = v[i].w; }
    __syncthreads();
    const int c = tid & 7;
#pragma unroll
    for (int j = 0; j < 4; ++j) {
        const int n = (tid >> 3) + 64 * j, ng = n0 + n;
        const int drow = (mode == 0) ? ng : (256 * (ng >> 7) + (ng & 127) + (mode == 2 ? 128 : 0));
        const LAS float* sp = tile + (8 * c) * 257 + n;
        v4u o; o.x = cvt_pk_nv(sp[0 * 257], sp[1 * 257]); o.y = cvt_pk_nv(sp[2 * 257], sp[3 * 257]); o.z = cvt_pk_nv(sp[4 * 257], sp[5 * 257]); o.w = cvt_pk_nv(sp[6 * 257], sp[7 * 257]);
        *(v4u*)(WT + (size_t)drow * K + k0 + 8 * c) = o;
    }
}
__device__ __forceinline__ const float* xrow_ptr(const Ctx& C, int row) { return row < MPROMPT ? C.in(0) + (size_t)row * DM : C.in(1) + (size_t)(row - MPROMPT) * DM; }

__device__ __forceinline__ v4f ld4_f32(const float* p) { return *(const v4f*)p; }
__device__ __forceinline__ v4f ld4_bf16(const bf16* p) { const v2u w = *(const v2u*)p; return (v4f){bf_lo(w.x), bf_hi(w.x), bf_lo(w.y), bf_hi(w.y)}; }
__device__ __forceinline__ void st4_bf16(bf16* p, v4f o) { v2u w; w.x = cvt_pk_nv(o.x, o.y); w.y = cvt_pk_nv(o.z, o.w); *(v2u*)p = w; }
__device__ __forceinline__ float ssq4(v4f v) { return (v.x * v.x + v.y * v.y) + (v.z * v.z + v.w * v.w); }
template <int R>
__device__ __forceinline__ void rows_x0(const Ctx& C, int m0, int stride, int mx, int lane) {
    v4f v[R][4]; float ss[R]; int mr[R]; bool ok[R];
#pragma unroll
    for (int r = 0; r < R; ++r) { mr[r] = (r == 4) ? mx : m0 + r * stride; ok[r] = (r == 4) ? (mx < M) : (mr[r] < MPROMPT); const float* x = xrow_ptr(C, ok[r] ? mr[r] : 0);
#pragma unroll
        for (int j = 0; j < 4; ++j) v[r][j] = ld4_f32(x + 4 * lane + 256 * j); }
    bf16* XN = C.XN();
#pragma unroll
    for (int r = 0; r < R; ++r) { float s = 0.f;
#pragma unroll
        for (int j = 0; j < 4; ++j) s += ssq4(v[r][j]);
        ss[r] = s; }
    float* rs = C.RS();
#pragma unroll
    for (int r = 0; r < R; ++r) ss[r] = wave_sum(ss[r]) * (1.f / DM) + EPS;
#pragma unroll
    for (int r = 0; r < R; ++r) { const float rstd = rsqrtf(ss[r]);
#pragma unroll
        for (int j = 0; j < 4; ++j) if (ok[r]) st4_bf16(XN + (size_t)mr[r] * DM + 4 * lane + 256 * j, v[r][j] * rstd);
        if (lane == 0 && ok[r]) rs[mr[r]] = sqrtf(ss[r]); }
}
template <int R, bool BASE_F32, bool OUT_F32>
__device__ __forceinline__ void rows_res(const Ctx& C, int m0, int stride, int mx, const float* gpost, float scale, int lane) {
    v4f d[R][4], b[R][4]; int mr[R]; bool ok[R]; float r1[R];
    const bf16* D = C.D(); bf16* XN = C.XN();
#pragma unroll
    for (int r = 0; r < R; ++r) { mr[r] = (r == 4) ? mx : m0 + r * stride; ok[r] = (r == 4) ? (mx < M) : (mr[r] < MPROMPT); const int mm = ok[r] ? mr[r] : 0;
#pragma unroll
        for (int j = 0; j < 4; ++j) d[r][j] = ld4_bf16(D + (size_t)mm * DM + 4 * lane + 256 * j);
        if (BASE_F32) { const float* x = xrow_ptr(C, mm);
#pragma unroll
            for (int j = 0; j < 4; ++j) b[r][j] = ld4_f32(x + 4 * lane + 256 * j);
        } else { const float inv = C.RS()[mm];
#pragma unroll
            for (int j = 0; j < 4; ++j) b[r][j] = ld4_bf16(XN + (size_t)mm * DM + 4 * lane + 256 * j) * inv;
        } }
#pragma unroll
    for (int r = 0; r < R; ++r) { float s = 0.f;
#pragma unroll
        for (int j = 0; j < 4; ++j) s += ssq4(d[r][j]);
        r1[r] = s; }
#pragma unroll
    for (int r = 0; r < R; ++r) r1[r] = rsqrtf(wave_sum(r1[r]) * (1.f / DM) + EPS) * scale;
#pragma unroll
    for (int j = 0; j < 4; ++j) { const v4f gp = ld4_f32(gpost + 4 * lane + 256 * j);
#pragma unroll
        for (int r = 0; r < R; ++r) d[r][j] = b[r][j] + d[r][j] * r1[r] * gp; }
    if (OUT_F32) { float* Y = C.out();
#pragma unroll
        for (int r = 0; r < R; ++r)
#pragma unroll
            for (int j = 0; j < 4; ++j) if (ok[r]) *(v4f*)(Y + (size_t)mr[r] * DM + 4 * lane + 256 * j) = d[r][j];
    } else { float* rs = C.RS(); float t[R];
#pragma unroll
        for (int r = 0; r < R; ++r) { float s = 0.f;
#pragma unroll
            for (int j = 0; j < 4; ++j) s += ssq4(d[r][j]);
            t[r] = s; }
#pragma unroll
        for (int r = 0; r < R; ++r) t[r] = wave_sum(t[r]) * (1.f / DM) + EPS;
#pragma unroll
        for (int r = 0; r < R; ++r) { const float rstd = rsqrtf(t[r]);
#pragma unroll
            for (int j = 0; j < 4; ++j) if (ok[r]) st4_bf16(XN + (size_t)mr[r] * DM + 4 * lane + 256 * j, d[r][j] * rstd);
            if (lane == 0 && ok[r]) rs[mr[r]] = sqrtf(t[r]); }
    }
}
template <int R>
__device__ __forceinline__ void rows_norm512(bf16* base, int m0, int stride, int mx, const float* g, int lane) {
    v4u w[R]; float ss[R]; int mr[R]; bool ok[R];
#pragma unroll
    for (int r = 0; r < R; ++r) { mr[r] = (r == 4) ? mx : m0 + r * stride; ok[r] = (r == 4) ? (mx < M) : (mr[r] < MPROMPT);
        w[r] = *(const v4u*)(base + (size_t)(ok[r] ? mr[r] : 0) * DM + 8 * lane); }
    const v4f g0 = *(const v4f*)(g + 8 * lane), g1 = *(const v4f*)(g + 8 * lane + 4);
#pragma unroll
    for (int r = 0; r < R; ++r) { const v4u x = w[r];
        ss[r] = (bf_lo(x.x) * bf_lo(x.x) + bf_hi(x.x) * bf_hi(x.x)) + (bf_lo(x.y) * bf_lo(x.y) + bf_hi(x.y) * bf_hi(x.y)) + (bf_lo(x.z) * bf_lo(x.z) + bf_hi(x.z) * bf_hi(x.z)) + (bf_lo(x.w) * bf_lo(x.w) + bf_hi(x.w) * bf_hi(x.w)); }
#pragma unroll
    for (int r = 0; r < R; ++r) ss[r] = rsqrtf(wave_sum(ss[r]) * (1.f / 512.f) + EPS);
#pragma unroll
    for (int r = 0; r < R; ++r) { const v4u x = w[r]; const float q = ss[r];
        v4u o; o.x = cvt_pk_nv(bf_lo(x.x) * q * g0.x, bf_hi(x.x) * q * g0.y); o.y = cvt_pk_nv(bf_lo(x.y) * q * g0.z, bf_hi(x.y) * q * g0.w);
        o.z = cvt_pk_nv(bf_lo(x.z) * q * g1.x, bf_hi(x.z) * q * g1.y); o.w = cvt_pk_nv(bf_lo(x.w) * q * g1.z, bf_hi(x.w) * q * g1.w);
        if (ok[r]) *(v4u*)(base + (size_t)mr[r] * DM + 8 * lane) = o; }
}

__device__ __forceinline__ void p0_prologue(const Ctx& C, LAS unsigned char* lds, int wave, int lane, int tid) {
    LAS float* tile = (LAS float*)lds;
    const int gw = blockIdx.x * NWAVES + wave, NGW = gridDim.x * NWAVES;
    constexpr int I_GU = (DM / 64) * (DFF / 256), I_D = (DFF / 64) * (DM / 256), I_IN = (DM / 64) * (DIN / 256), I_GLU = (BWD / 64) * (BWD / 256), I_OUT = (DM / 64) * (DM / 256);
    constexpr int NITEMS = 4 * I_GU + 2 * I_D + I_IN + I_GLU + I_OUT;
    for (int it = blockIdx.x; it < NITEMS; it += gridDim.x) {
        int r = it;
        if (r < I_GU) { p0_block_item(C.in(5), C.in(4), DM, DFF, C.Wgu1(), 1, r, tile, tid); continue; } r -= I_GU;
        if (r < I_GU) { p0_block_item(C.in(6), C.in(4), DM, DFF, C.Wgu1(), 2, r, tile, tid); continue; } r -= I_GU;
        if (r < I_GU) { p0_block_item(C.in(29), C.in(28), DM, DFF, C.Wgu2(), 1, r, tile, tid); continue; } r -= I_GU;
        if (r < I_GU) { p0_block_item(C.in(30), C.in(28), DM, DFF, C.Wgu2(), 2, r, tile, tid); continue; } r -= I_GU;
        if (r < I_D) { p0_block_item(C.in(7), nullptr, DFF, DM, C.Wd1(), 0, r, tile, tid); continue; } r -= I_D;
        if (r < I_D) { p0_block_item(C.in(31), nullptr, DFF, DM, C.Wd2(), 0, r, tile, tid); continue; } r -= I_D;
        if (r < I_IN) { p0_block_item(C.in(10), C.in(9), DM, DIN, C.Win(), 0, r, tile, tid); continue; } r -= I_IN;
        if (r < I_GLU) { p0_block_item(C.in(22), nullptr, BWD, BWD, C.Wglu(), 0, r, tile, tid); continue; } r -= I_GLU;
        p0_block_item(C.in(26), nullptr, DM, DM, C.Wout(), 0, r, tile, tid);
    }
    { const int nit = (MPROMPT + 4 * NGW - 1) / (4 * NGW);
      for (int it = 0; it < nit - 1; ++it) rows_x0<4>(C, gw + 4 * it * NGW, NGW, M, lane);
      rows_x0<5>(C, gw + 4 * (nit - 1) * NGW, NGW, MPROMPT + gw, lane);
      for (int ms = MPROMPT + gw + NGW; ms < M; ms += NGW) rows_x0<5>(C, MPROMPT, NGW, ms, lane); }
    const int gt = blockIdx.x * NTHREADS + tid, NGT = gridDim.x * NTHREADS;
    for (int idx = (tid < 8 ? blockIdx.x * 8 + tid : NG * NP); idx < NG * NP; idx += gridDim.x * 8) {
        const int g = idx / NP, p = idx % NP;
        const double lr = (double)C.in(14)[idx], li = (double)C.in(15)[idx], dt = dexp((double)C.in(16)[g]);
        double s1, c1, s8, c8; dsincos(li * dt, s1, c1); dsincos(li * dt * 128.0, s8, c8);
        const double er = dexp(lr * dt), lbr = er * c1, lbi = er * s1;
        const double e8 = dexp(lr * dt * 128.0), l8r = e8 * c8, l8i = e8 * s8;
        C.LAM()[0 * 2048 + idx] = (float)lbr; C.LAM()[1 * 2048 + idx] = (float)lbi; C.LAM()[2 * 2048 + idx] = (float)l8r; C.LAM()[3 * 2048 + idx] = (float)l8i;
        const double a = lbr - 1.0, b = lbi, den = lr * lr + li * li, cr = (a * lr + b * li) / den, ci = (b * lr - a * li) / den;
        for (int n = 0; n < GN; ++n) {
            const double br = (double)C.in(17)[(size_t)idx * GN + n], bi = (double)C.in(18)[(size_t)idx * GN + n];
            C.BB()[((size_t)g * 128 + 2 * p) * GN + n] = f2bf((float)(cr * br - ci * bi));
            C.BB()[((size_t)g * 128 + 2 * p + 1) * GN + n] = f2bf((float)(cr * bi + ci * br));
            C.CM()[((size_t)g * GN + n) * 128 + 2 * p] = f2bf(C.in(19)[((size_t)g * GN + n) * NP + p]);
            C.CM()[((size_t)g * GN + n) * 128 + 2 * p + 1] = f2bf(-C.in(20)[((size_t)g * GN + n) * NP + p]);
        }
    }
    for (int idx = gt; idx < 2 * 4 * 128 * 128; idx += NGT) {
        const int s = idx & 127, t = (idx >> 7) & 127, h = (idx >> 14) & 3, mode = idx >> 16;
        float v;
        if (mode == 0) v = (s <= t) ? C.in(12)[((size_t)h * 128 + t) * 128 + s] : 0.f;
        else v = ((s >> 4) == (t >> 4) && (s & 15) <= (t & 15)) ? C.in(12)[((size_t)h * 128 + (t & 15)) * 128 + (s & 15)] : 0.f;
        C.Weff()[idx] = f2bf(v);
    }
}

constexpr int XU_STRIDE = 72;
constexpr int BH_STRIDE = 136;
constexpr int S5W_BYTES = 32 * XU_STRIDE * 2 + 32 * BH_STRIDE * 2;
static_assert(NWAVES * S5W_BYTES <= LDS_BYTES - 64, "s5 lds");
template <bool PASS2>
__device__ __forceinline__ void s5_tile(const Ctx& C, int T, int sb_lo, int sb_hi, LAS unsigned char* lds, int wave, int lane) {
    const bool sample = (T == NTILE - 1);
    const int r0 = T * 128;
    LAS bf16* XU = (LAS bf16*)(lds + wave * S5W_BYTES);
    LAS bf16* BH = XU + 32 * XU_STRIDE;
    const int tl = lane & 31, hh = lane >> 5, fr = lane & 15, kq = lane >> 4, xrow = lane >> 3, xpart = lane & 7;
    const float* LAM = C.LAM();
    const bf16* Zb = C.Z() + (size_t)1024 + 64 * wave;
    float sr[4], si[4], lr[4], li[4], dsk[4];
#pragma unroll
    for (int gi = 0; gi < 4; ++gi) { const int g = wave * 4 + gi; sr[gi] = 0.f; si[gi] = 0.f; lr[gi] = LAM[0 * 2048 + g * 64 + lane]; li[gi] = LAM[1 * 2048 + g * 64 + lane];
        dsk[gi] = PASS2 ? C.in(21)[16 * g + fr] : 0.f; }
    if (PASS2 && !sample) {
        const int k = T & 127, tb = T - k;
        float l8r[4], l8i[4];
#pragma unroll
        for (int gi = 0; gi < 4; ++gi) { l8r[gi] = LAM[2 * 2048 + (wave * 4 + gi) * 64 + lane]; l8i[gi] = LAM[3 * 2048 + (wave * 4 + gi) * 64 + lane]; }
        const v2f* Ep = (const v2f*)C.E() + ((size_t)tb * NG + wave * 4) * NP + lane;
        const int nb = (k + 15) >> 4, j0 = k - 16 * nb;
        for (int jb = 0; jb < nb; ++jb) {
#pragma unroll
            for (int u = 0; u < 16; ++u) {
                const int j = j0 + 16 * jb + u; const bool ok = j >= 0; const int jc = ok ? j : 0;
#pragma unroll
                for (int gi = 0; gi < 4; ++gi) { v2f e = Ep[(size_t)jc * NG * NP + gi * NP]; if (!ok) e = (v2f){0.f, 0.f};
                    const float nr = fmaf(l8r[gi], sr[gi], fmaf(-l8i[gi], si[gi], e.x)), ni = fmaf(l8r[gi], si[gi], fmaf(l8i[gi], sr[gi], e.y)); sr[gi] = nr; si[gi] = ni; }
            }
        }
    }
    v4u xn[4];
    {
        const int sb0 = sb_lo;
#pragma unroll
        for (int i = 0; i < 4; ++i) xn[i] = *(const v4u*)(Zb + (size_t)(r0 + 32 * sb0 + xrow + 8 * i) * DIN + 8 * xpart);
    }
    for (int sb = sb_lo; sb < sb_hi; ++sb) {
        const int rb0 = r0 + 32 * sb;
#pragma unroll
        for (int i = 0; i < 4; ++i) *(LAS v4u*)(XU + (xrow + 8 * i) * XU_STRIDE + 8 * xpart) = xn[i];
        if (sb + 1 < sb_hi) {
#pragma unroll
            for (int i = 0; i < 4; ++i) xn[i] = *(const v4u*)(Zb + (size_t)(rb0 + 32 + xrow + 8 * i) * DIN + 8 * xpart);
        }
        LDS_FENCE();
#pragma unroll
        for (int gi = 0; gi < 4; ++gi) {
            const int g = wave * 4 + gi;
            bfx8 bb[4];
#pragma unroll
            for (int cb = 0; cb < 4; ++cb) bb[cb] = *(const bfx8*)(C.BB() + ((size_t)(g * 128 + cb * 32 + tl)) * GN + 8 * hh);
            bfx8 cm[4];
            if (PASS2) {
#pragma unroll
                for (int ks = 0; ks < 4; ++ks) cm[ks] = *(const bfx8*)(C.CM() + ((size_t)(g * GN + fr)) * 128 + 32 * ks + 8 * kq);
            }
            float s0ar = 0.f, s0ai = 0.f, s0br = 0.f, s0bi = 0.f;
            if (sample) { const size_t o0 = ((size_t)(2 * sb) * NG + g) * NP + lane, o1 = o0 + (size_t)NG * NP;
                s0ar = C.in(2)[o0]; s0ai = C.in(3)[o0]; s0br = C.in(2)[o1]; s0bi = C.in(3)[o1]; }
            const bfx8 a = *(const LAS bfx8*)(XU + tl * XU_STRIDE + 16 * gi + 8 * hh);
#pragma unroll
            for (int cb = 0; cb < 4; ++cb) {
                v16f acc;
#pragma unroll
                for (int r = 0; r < 16; ++r) acc[r] = 0.f;
                acc = __builtin_amdgcn_mfma_f32_32x32x16_bf16(bb[cb], a, acc, 0, 0, 0);
#pragma unroll
                for (int rg = 0; rg < 4; ++rg) { v2u w; w.x = cvt_pk_c(acc[4 * rg], acc[4 * rg + 1]); w.y = cvt_pk_c(acc[4 * rg + 2], acc[4 * rg + 3]);
                    *(LAS v2u*)(BH + tl * BH_STRIDE + cb * 32 + 8 * rg + 4 * hh) = w; }
            }
            LDS_FENCE();
            {
                unsigned bu[32];
#pragma unroll
                for (int t = 0; t < 32; ++t) bu[t] = *(const LAS unsigned*)(BH + t * BH_STRIDE + 2 * lane);
                LDS_FENCE();
                float xr = sr[gi], xi = si[gi];
#pragma unroll
                for (int t = 0; t < 32; ++t) {
                    if (sample && t == 0) { xr = s0ar; xi = s0ai; }
                    if (sample && t == 16) { xr = s0br; xi = s0bi; }
                    const float nr = fmaf(lr[gi], xr, fmaf(-li[gi], xi, bf_lo(bu[t]))), ni = fmaf(lr[gi], xi, fmaf(li[gi], xr, bf_hi(bu[t])));
                    xr = nr; xi = ni;
                    if (PASS2) {
                        *(LAS unsigned*)(BH + t * BH_STRIDE + 2 * lane) = cvt_pk_nv(xr, xi);
                        if (sample && (t & 15) == 15) { const int seq = 2 * sb + (t >> 4);
                            C.out()[OFF_SRE_S + ((size_t)seq * NG + g) * NP + lane] = xr; C.out()[OFF_SIM_S + ((size_t)seq * NG + g) * NP + lane] = xi; }
                    }
                }
                sr[gi] = xr; si[gi] = xi;
            }
            LDS_FENCE();
            if (PASS2) {
#pragma unroll
                for (int rb = 0; rb < 2; ++rb) {
                    v4f acc = (v4f){0.f, 0.f, 0.f, 0.f};
#pragma unroll
                    for (int ks = 0; ks < 4; ++ks) {
                        const bfx8 sa = *(const LAS bfx8*)(BH + (16 * rb + fr) * BH_STRIDE + 32 * ks + 8 * kq);
                        acc = __builtin_amdgcn_mfma_f32_16x16x32_bf16(sa, cm[ks], acc, 0, 0, 0);
                    }
#pragma unroll
                    for (int r = 0; r < 4; ++r) {
                        LAS bf16* up = XU + (16 * rb + 4 * kq + r) * XU_STRIDE + 16 * gi + fr;
                        const float u = __uint_as_float((unsigned)(*up) << 16);
                        *up = f2bf(gelu_t(acc[r] + dsk[gi] * u));
                    }
                }
                LDS_FENCE();
            }
        }
        if (PASS2) {
#pragma unroll
            for (int i = 0; i < 4; ++i) *(v4u*)(C.YB() + (size_t)(rb0 + xrow + 8 * i) * BWD + 64 * wave + 8 * xpart) = *(const LAS v4u*)(XU + (xrow + 8 * i) * XU_STRIDE + 8 * xpart);
            LDS_FENCE();
        }
    }
#pragma unroll
    for (int gi = 0; gi < 4; ++gi) {
        const int g = wave * 4 + gi;
        if (!PASS2) { v2f* Ep = (v2f*)C.E() + ((size_t)T * NG + g) * NP + lane; *Ep = (v2f){sr[gi], si[gi]}; }
        else if (!sample && (T & 127) == 127) { const int b = T >> 7;
            C.out()[OFF_SRE_P + ((size_t)b * NG + g) * NP + lane] = sr[gi]; C.out()[OFF_SIM_P + ((size_t)b * NG + g) * NP + lane] = si[gi]; }
    }
}

__device__ __forceinline__ void gmlp_tile(const Ctx& C, int T, LAS unsigned char* lds, int wave, int lane, int tid) {
    const int mode = (T == NTILE - 1) ? 1 : 0;
    const int r0 = T * 128;
    LAS bf16* VT = (LAS bf16*)lds;
    LAS float* SSQ = (LAS float*)(lds + 128 * VT_STRIDE * 2);
    const int tb = wave & 3, dh = wave >> 2, tl = lane & 31, hh = lane >> 5;
    const int t = 32 * tb + tl;
    unsigned outp[4][2][8]; float ssq = 0.f;
    const bf16* zt = C.Z() + (size_t)(r0 + t) * DIN;
    const int row = tid >> 2, q = tid & 3;
    const bf16* vsrc = C.Z() + (size_t)(r0 + row) * DIN + 512 + q * 32;
    const bf16* Weff = C.Weff();
    v4u vraw[4];
#pragma unroll
    for (int i = 0; i < 4; ++i) vraw[i] = *(const v4u*)(vsrc + 8 * i);
#pragma unroll
    for (int h = 0; h < 4; ++h) {
        bfx8 wf[8];
        const bf16* wrow = Weff + ((size_t)(mode * 4 + h) * 128 + t) * 128 + 8 * hh;
#pragma unroll
        for (int ks = 0; ks < 8; ++ks) wf[ks] = *(const bfx8*)(wrow + 16 * ks);
        v2u uw[2][4];
#pragma unroll
        for (int dbi = 0; dbi < 2; ++dbi)
#pragma unroll
            for (int rg = 0; rg < 4; ++rg) uw[dbi][rg] = *(const v2u*)(zt + h * 128 + 32 * (2 * dh + dbi) + 8 * rg + 4 * hh);
        const float bias = C.in(13)[h * 128 + (mode ? (t & 15) : t)];
        __syncthreads();
        {
            float v[32]; float s = 0.f;
#pragma unroll
            for (int i = 0; i < 4; ++i) { const v4u w = vraw[i];
                v[8 * i + 0] = bf_lo(w.x); v[8 * i + 1] = bf_hi(w.x); v[8 * i + 2] = bf_lo(w.y); v[8 * i + 3] = bf_hi(w.y);
                v[8 * i + 4] = bf_lo(w.z); v[8 * i + 5] = bf_hi(w.z); v[8 * i + 6] = bf_lo(w.w); v[8 * i + 7] = bf_hi(w.w); }
            if (h < 3) {
#pragma unroll
                for (int i = 0; i < 4; ++i) vraw[i] = *(const v4u*)(vsrc + (h + 1) * 128 + 8 * i);
            }
#pragma unroll
            for (int i = 0; i < 32; ++i) s += v[i] * v[i];
            s += __shfl_xor(s, 1); s += __shfl_xor(s, 2);
            const float r = rsqrtf(s * (1.f / 128.f) + EPS);
            const float* gv = C.in(11) + h * 128 + q * 32;
#pragma unroll
            for (int i = 0; i < 32; ++i) { v[i] = v[i] * r * gv[i]; VT[(q * 32 + i) * VT_STRIDE + row] = f2bf(v[i]); }
            if (mode) { float* ov = C.out() + OFF_V_S + (size_t)row * AW + h * 128 + q * 32;
#pragma unroll
                for (int i = 0; i < 8; ++i) *(v4f*)(ov + 4 * i) = (v4f){v[4 * i], v[4 * i + 1], v[4 * i + 2], v[4 * i + 3]}; }
        }
        __syncthreads();
#pragma unroll
        for (int dbi = 0; dbi < 2; ++dbi) {
            const int db = 2 * dh + dbi;
            v16f acc;
#pragma unroll
            for (int r = 0; r < 16; ++r) acc[r] = 0.f;
#pragma unroll
            for (int ks = 0; ks < 8; ++ks) {
                const bfx8 va = *(const LAS bfx8*)(VT + (32 * db + tl) * VT_STRIDE + 16 * ks + 8 * hh);
                acc = __builtin_amdgcn_mfma_f32_32x32x16_bf16(va, wf[ks], acc, 0, 0, 0);
            }
#pragma unroll
            for (int rg = 0; rg < 4; ++rg) {
                const v2u u2 = uw[dbi][rg];
                const float o0 = bf_lo(u2.x) * (acc[4 * rg + 0] + bias), o1 = bf_hi(u2.x) * (acc[4 * rg + 1] + bias);
                const float o2 = bf_lo(u2.y) * (acc[4 * rg + 2] + bias), o3 = bf_hi(u2.y) * (acc[4 * rg + 3] + bias);
                ssq += (o0 * o0 + o1 * o1) + (o2 * o2 + o3 * o3);
                outp[h][dbi][2 * rg] = cvt_pk_nv(o0, o1); outp[h][dbi][2 * rg + 1] = cvt_pk_nv(o2, o3);
            }
        }
    }
    ssq += __shfl_xor(ssq, 32);
    if (hh == 0) SSQ[t * 2 + dh] = ssq;
    __syncthreads();
    const float rstd = rsqrtf((SSQ[t * 2] + SSQ[t * 2 + 1]) * (1.f / 512.f) + EPS);
    const float* gap = C.in(24);
    LAS bf16* OT = (LAS bf16*)lds;
    __syncthreads();
#pragma unroll
    for (int h = 0; h < 4; ++h)
#pragma unroll
        for (int dbi = 0; dbi < 2; ++dbi)
#pragma unroll
            for (int rg = 0; rg < 4; ++rg) {
                const int c = h * 128 + 32 * (2 * dh + dbi) + 8 * rg + 4 * hh;
                const v4f ga = *(const v4f*)(gap + c);
                const unsigned w0 = outp[h][dbi][2 * rg], w1 = outp[h][dbi][2 * rg + 1];
                v2u o; o.x = cvt_pk_nv(bf_lo(w0) * rstd * ga.x, bf_hi(w0) * rstd * ga.y); o.y = cvt_pk_nv(bf_lo(w1) * rstd * ga.z, bf_hi(w1) * rstd * ga.w);
                *(LAS v2u*)(OT + t * OT_STRIDE + c) = o;
            }
    __syncthreads();
    {
        bf16* obase = C.MIX() + (size_t)r0 * DM;
#pragma unroll 4
        for (int i = 0; i < 16; ++i) { const int row = wave * 16 + i; *(v4u*)(obase + (size_t)row * DM + 8 * lane) = *(const LAS v4u*)(OT + row * OT_STRIDE + 8 * lane); }
    }
    __syncthreads();
}

#define FTID const int ftid_ = fresh_tid()
#define TID (ftid_)
#define LANE (ftid_ & 63)
#define WAVE (__builtin_amdgcn_readfirstlane(ftid_ >> 6))
#define GSZ ((int)gridDim.x)
#define BX ((int)blockIdx.x)
#define GWV (BX * NWAVES + WAVE)
#define NGWV (GSZ * NWAVES)
constexpr size_t WS_CTL = 0, CTL_ZERO_BYTES = 16384;
constexpr int MISC_OFF = LDS_BYTES - 64;
#define XB_TMO      128
#define XB_XCNT(j)  (256  + 64 * (j))
#define XB_XSUB(j)  (1280 + 64 * (j))
#define XB_XGEN(j)  (2304 + 64 * (j))
#define XB_TOP      3328
#define XB_TOPGEN   3392
#define XCD_BAR_WORDS 3456
#define XB_SPIN_CAP (1u << 18)

__device__ __forceinline__ unsigned xb_ld(unsigned* p)              { return __hip_atomic_load(p, __ATOMIC_RELAXED, __HIP_MEMORY_SCOPE_AGENT); }
__device__ __forceinline__ unsigned xb_add(unsigned* p, unsigned v) { return __hip_atomic_fetch_add(p, v, __ATOMIC_RELAXED, __HIP_MEMORY_SCOPE_AGENT); }
__device__ __forceinline__ unsigned xb_xcc_id() { return (unsigned)__builtin_amdgcn_s_getreg((3 << 11) | 20) & 0xFu; }
#define XB_SPIN(cond, bar) do { unsigned _sp = 0; while (cond) { __builtin_amdgcn_s_sleep(1); \
    if ((++_sp & 255u) == 0u) { if (xb_ld(&(bar)[XB_TMO])) break; if (_sp > XB_SPIN_CAP) { atomicAdd(&(bar)[XB_TMO], 1u); break; } } } } while (0)

struct XcdBarrier {
    unsigned* bar; unsigned x;
    volatile LAS unsigned* st;
};

__device__ __forceinline__ XcdBarrier xcd_barrier_post(unsigned* bar, volatile LAS unsigned* st) {
    XcdBarrier b; b.bar = bar; b.x = xb_xcc_id(); b.st = st;
    if (threadIdx.x == 0) (void)xb_add(&bar[XB_XCNT(b.x)], 1u);
    return b;
}
__device__ __forceinline__ void xcd_barrier_complete(unsigned* bar, unsigned x, unsigned& nloc, unsigned& nx) {
    const unsigned G = gridDim.x * gridDim.y * gridDim.z;
    unsigned sum, cnt, mine, sp = 0u;
    for (;;) {
        sum = 0u; cnt = 0u; mine = 0u;
#pragma unroll
        for (unsigned j = 0; j < 16; ++j) { const unsigned c = xb_ld(&bar[XB_XCNT(j)]); sum += c; cnt += (c > 0u) ? 1u : 0u; mine = (j == x) ? c : mine; }
        if (sum == G) break;
        __builtin_amdgcn_s_sleep(1);
        if ((++sp & 255u) == 0u) { if (xb_ld(&bar[XB_TMO])) break; if (sp > XB_SPIN_CAP) { atomicAdd(&bar[XB_TMO], 1u); break; } }
    }
    nloc = mine > 0u ? mine : 1u; nx = cnt > 0u ? cnt : 1u;
}

__device__ __forceinline__ void xcd_barrier(const XcdBarrier& b) {
    asm volatile("s_waitcnt vmcnt(0)" ::: "memory");
    __syncthreads();
    if (threadIdx.x == 0) {
        unsigned* bar = b.bar;
        __builtin_amdgcn_s_waitcnt(0);
        unsigned nloc = b.st[0], nx = b.st[1];
        if (nloc == 0u) { xcd_barrier_complete(bar, b.x, nloc, nx); b.st[0] = nloc; b.st[1] = nx; }
        const unsigned old = xb_add(&bar[XB_XSUB(b.x)], 1u);
        const unsigned gen = old / nloc;
        if (old + 1u == (gen + 1u) * nloc) {
            __builtin_amdgcn_fence(__ATOMIC_RELEASE, "agent");
            asm volatile("s_waitcnt vmcnt(0)" ::: "memory");
            const unsigned og = xb_add(&bar[XB_TOP], 1u);
            const unsigned tg = og / nx;
            if (og + 1u == (tg + 1u) * nx) xb_add(&bar[XB_TOPGEN], 1u);
            else XB_SPIN(xb_ld(&bar[XB_TOPGEN]) == tg, bar);
            __builtin_amdgcn_fence(__ATOMIC_ACQUIRE, "agent");
            xb_add(&bar[XB_XGEN(b.x)], 1u);
            asm volatile("s_waitcnt vmcnt(0)" ::: "memory");
        } else {
            XB_SPIN(xb_ld(&bar[XB_XGEN(b.x)]) == gen, bar);
            __builtin_amdgcn_fence(__ATOMIC_ACQUIRE, "agent");
            asm volatile("s_waitcnt vmcnt(0)" ::: "memory");
        }
    }
    __syncthreads();
}

template <int MODE>
__device__ __forceinline__ void small_gemm(LAS unsigned char* lds, const bf16* A, const bf16* Bt, int N, int K, bf16* O, int ldc, int act_cols, const float* bias, const bf16* Yv, int ldy, int it0, int it1) {
    FTID; const int wave = WAVE, lane = LANE, tl = lane & 31, hh = lane >> 5;
    LAS float* red = (LAS float*)lds;
    const int nct = N / 32, nitems = 4 * nct, kw = K / 8, nks = kw / 16;
    for (int it = it0; it < it1; ++it) {
        const int item = BX + it * GSZ; if (item >= nitems) break;
        const int rt = item & 3, ct = item >> 2;
        const int hc = 32 * ct + tl;
        const int brow = (MODE == 3) ? (256 * (hc >> 7) + (hc & 127)) : hc;
        const bf16* ap = A + (size_t)(32 * rt + tl) * K + wave * kw + 8 * hh;
        const bf16* bp = Bt + (size_t)brow * K + wave * kw + 8 * hh;
        v16f acc0, acc1;
#pragma unroll
        for (int r = 0; r < 16; ++r) { acc0[r] = 0.f; acc1[r] = 0.f; }
#pragma unroll 4
        for (int ks = 0; ks < nks; ++ks) {
            const bfx8 a = *(const bfx8*)(ap + 16 * ks);
            const bfx8 b0 = *(const bfx8*)(bp + 16 * ks);
            acc0 = __builtin_amdgcn_mfma_f32_32x32x16_bf16(b0, a, acc0, 0, 0, 0);
            if (MODE == 3) { const bfx8 b1 = *(const bfx8*)(bp + (size_t)128 * K + 16 * ks); acc1 = __builtin_amdgcn_mfma_f32_32x32x16_bf16(b1, a, acc1, 0, 0, 0); }
        }
        __syncthreads();
#pragma unroll
        for (int r = 0; r < 16; ++r) { red[(wave * 16 + r) * 64 + lane] = acc0[r]; if (MODE == 3) red[8192 + (wave * 16 + r) * 64 + lane] = acc1[r]; }
        __syncthreads();
        float v0[2], v1[2];
#pragma unroll
        for (int e = 0; e < 2; ++e) { float s0 = 0.f, s1 = 0.f;
#pragma unroll
            for (int w = 0; w < 8; ++w) { s0 += red[(w * 16 + 2 * wave + e) * 64 + lane]; if (MODE == 3) s1 += red[8192 + (w * 16 + 2 * wave + e) * 64 + lane]; }
            v0[e] = s0; v1[e] = s1; }
        const int reg = 2 * wave;
        const int col = 32 * ct + (reg & 3) + 8 * (reg >> 2) + 4 * hh;
        const size_t row = (size_t)(32 * rt + tl);
        float o0 = v0[0], o1 = v0[1];
        if (MODE == 1) { if (col < act_cols) { o0 = gelu_t(o0); o1 = gelu_t(o1); } }
        if (MODE == 2) { const unsigned y = *(const unsigned*)(Yv + row * ldy + col); o0 = bf_lo(y) * pg8::sigmoid_f(o0 + bias[col]); o1 = bf_hi(y) * pg8::sigmoid_f(o1 + bias[col + 1]); }
        if (MODE == 3) { o0 = pg8::silu_f(o0) * v1[0]; o1 = pg8::silu_f(o1) * v1[1]; }
        *(unsigned*)(O + row * ldc + col) = cvt_pk_bf16(o0, o1);
    }
    __syncthreads();
}
struct Args { const float* in[33]; float* out; unsigned char* ws; };
__global__ void __launch_bounds__(NTHREADS, 2) fwd_kernel(Args args) {
    extern __shared__ __attribute__((aligned(16))) unsigned char lds_raw[];
    cg::grid_group grid = cg::this_grid();
    LAS unsigned char* lds = (LAS unsigned char*)lds_raw;
    Ctx C;
    if (threadIdx.x < 16) ((volatile LAS unsigned*)(lds + MISC_OFF))[threadIdx.x] = 0u;
    __syncthreads();
    (void)xcd_barrier_post((unsigned*)(C.ws() + WS_CTL), (volatile LAS unsigned*)(lds + MISC_OFF));
#define XBAR() do { XcdBarrier b_; b_.bar = (unsigned*)(C.ws() + WS_CTL); b_.x = xb_xcc_id(); b_.st = (volatile LAS unsigned*)(lds + MISC_OFF); xcd_barrier(b_); } while (0)
    grid.sync();
    { FTID; p0_prologue(C, lds, WAVE, LANE, TID); }
    XBAR();
    { const int stg = (BX >> 3) & 3;
    small_gemm<3>(lds, C.XN() + (size_t)MPROMPT * DM, C.Wgu1(), DFF, DM, C.H() + (size_t)MPROMPT * DFF, DFF, 0, nullptr, nullptr, 0, 0, stg);
    { pg8::Gemm g{C.XN(), C.Wgu1(), MPROMPT, 2 * DFF, DM}; pg8::StaticOrder S; S.init(MPROMPT, 2 * DFF, GSZ, BX); pg8::EpiSwiglu E{C.H(), DFF};
      pg8::gemm_phase<pg8::EpiSwiglu, pg8::StaticOrder, true, true>(lds, g, S, E); }
    small_gemm<3>(lds, C.XN() + (size_t)MPROMPT * DM, C.Wgu1(), DFF, DM, C.H() + (size_t)MPROMPT * DFF, DFF, 0, nullptr, nullptr, 0, stg, 4); }
    XBAR();
    { const int stg = (BX >> 3) & 3;
    small_gemm<0>(lds, C.H() + (size_t)MPROMPT * DFF, C.Wd1(), DM, DFF, C.D() + (size_t)MPROMPT * DM, DM, 0, nullptr, nullptr, 0, 0, stg);
    { pg8::Gemm g{C.H(), C.Wd1(), MPROMPT, DM, DFF}; pg8::StaticOrder S; S.init(MPROMPT, DM, GSZ, BX); pg8::EpiBf16<0> E{C.D(), DM, 0, nullptr, nullptr, 0};
      pg8::gemm_phase<pg8::EpiBf16<0>, pg8::StaticOrder, true, true>(lds, g, S, E); }
    small_gemm<0>(lds, C.H() + (size_t)MPROMPT * DFF, C.Wd1(), DM, DFF, C.D() + (size_t)MPROMPT * DM, DM, 0, nullptr, nullptr, 0, stg, 4); }
    XBAR();
    { FTID; const float* gp = C.in(8); { const int gw_ = GWV, ngw_ = NGWV, nit = (MPROMPT + 4 * ngw_ - 1) / (4 * ngw_);
      for (int it = 0; it < nit - 1; ++it) rows_res<4, false, false>(C, gw_ + 4 * it * ngw_, ngw_, M, gp, 0.5f, LANE);
      rows_res<5, false, false>(C, gw_ + 4 * (nit - 1) * ngw_, ngw_, MPROMPT + gw_, gp, 0.5f, LANE);
      for (int ms = MPROMPT + gw_ + ngw_; ms < M; ms += ngw_) rows_res<5, false, false>(C, MPROMPT, ngw_, ms, gp, 0.5f, LANE); } }
    XBAR();
    { const int stg = (BX >> 3) & 3;
    small_gemm<1>(lds, C.XN() + (size_t)MPROMPT * DM, C.Win(), DIN, DM, C.Z() + (size_t)MPROMPT * DIN, DIN, 2 * AW, nullptr, nullptr, 0, 0, stg);
    { pg8::Gemm g{C.XN(), C.Win(), MPROMPT, DIN, DM}; pg8::StaticOrder S; S.init(MPROMPT, DIN, GSZ, BX); pg8::EpiBf16<1> E{C.Z(), DIN, 2 * AW, nullptr, nullptr, 0};
      pg8::gemm_phase<pg8::EpiBf16<1>, pg8::StaticOrder, true, true>(lds, g, S, E); }
    small_gemm<1>(lds, C.XN() + (size_t)MPROMPT * DM, C.Win(), DIN, DM, C.Z() + (size_t)MPROMPT * DIN, DIN, 2 * AW, nullptr, nullptr, 0, stg, 4); }
    XBAR();
    { FTID; for (int T = BX; T < NTILE - 1; T += GSZ) {
        s5_tile<false>(C, T, 0, 4, lds, WAVE, LANE);
        __syncthreads();
        gmlp_tile(C, T, lds, WAVE, LANE, TID);
    } }
    XBAR();
    { FTID; const bool swap0 = GSZ > 128;
      for (int T = BX; T < NTILE - 1; T += GSZ) { if (swap0 && T == 0) continue; s5_tile<true>(C, T, 0, 4, lds, WAVE, LANE); }
      if (swap0 && BX == 128) s5_tile<true>(C, 0, 0, 4, lds, WAVE, LANE);
      if (BX >= 1 && BX <= 4) s5_tile<true>(C, NTILE - 1, BX - 1, BX, lds, WAVE, LANE);
      if (BX == 0) { __syncthreads(); gmlp_tile(C, NTILE - 1, lds, WAVE, LANE, TID); } }
    XBAR();
    { const int stg = (BX >> 3) & 3;
    small_gemm<2>(lds, C.YB() + (size_t)MPROMPT * BWD, C.Wglu(), BWD, BWD, C.MIX() + (size_t)MPROMPT * DM + AW, DM, 0, C.in(23), C.YB() + (size_t)MPROMPT * BWD, BWD, 0, stg);
    { pg8::Gemm g{C.YB(), C.Wglu(), MPROMPT, BWD, BWD}; pg8::StaticOrder S; S.init(MPROMPT, BWD, GSZ, BX); pg8::EpiBf16<2> E{C.MIX() + AW, DM, 0, C.in(23), C.YB(), BWD};
      pg8::gemm_phase<pg8::EpiBf16<2>, pg8::StaticOrder, true, true>(lds, g, S, E); }
    small_gemm<2>(lds, C.YB() + (size_t)MPROMPT * BWD, C.Wglu(), BWD, BWD, C.MIX() + (size_t)MPROMPT * DM + AW, DM, 0, C.in(23), C.YB() + (size_t)MPROMPT * BWD, BWD, stg, 4); }
    XBAR();
    { FTID; const float* gb = C.in(25); bf16* bb_ = C.MIX() + AW; const int gw_ = GWV, ngw_ = NGWV, nit = (MPROMPT + 4 * ngw_ - 1) / (4 * ngw_);
      for (int it = 0; it < nit - 1; ++it) rows_norm512<4>(bb_, gw_ + 4 * it * ngw_, ngw_, M, gb, LANE);
      rows_norm512<5>(bb_, gw_ + 4 * (nit - 1) * ngw_, ngw_, MPROMPT + gw_, gb, LANE);
      for (int ms = MPROMPT + gw_ + ngw_; ms < M; ms += ngw_) rows_norm512<5>(bb_, MPROMPT, ngw_, ms, gb, LANE); }
    XBAR();
    { const int stg = (BX >> 3) & 3;
    small_gemm<0>(lds, C.MIX() + (size_t)MPROMPT * DM, C.Wout(), DM, DM, C.D() + (size_t)MPROMPT * DM, DM, 0, nullptr, nullptr, 0, 0, stg);
    { pg8::Gemm g{C.MIX(), C.Wout(), MPROMPT, DM, DM}; pg8::StaticOrder S; S.init(MPROMPT, DM, GSZ, BX); pg8::EpiBf16<0> E{C.D(), DM, 0, nullptr, nullptr, 0};
      pg8::gemm_phase<pg8::EpiBf16<0>, pg8::StaticOrder, true, true>(lds, g, S, E); }
    small_gemm<0>(lds, C.MIX() + (size_t)MPROMPT * DM, C.Wout(), DM, DM, C.D() + (size_t)MPROMPT * DM, DM, 0, nullptr, nullptr, 0, stg, 4); }
    XBAR();
    { FTID; const float* gp = C.in(27); { const int gw_ = GWV, ngw_ = NGWV, nit = (MPROMPT + 4 * ngw_ - 1) / (4 * ngw_);
      for (int it = 0; it < nit - 1; ++it) rows_res<4, false, false>(C, gw_ + 4 * it * ngw_, ngw_, M, gp, 1.0f, LANE);
      rows_res<5, false, false>(C, gw_ + 4 * (nit - 1) * ngw_, ngw_, MPROMPT + gw_, gp, 1.0f, LANE);
      for (int ms = MPROMPT + gw_ + ngw_; ms < M; ms += ngw_) rows_res<5, false, false>(C, MPROMPT, ngw_, ms, gp, 1.0f, LANE); } }
    XBAR();
    { const int stg = (BX >> 3) & 3;
    small_gemm<3>(lds, C.XN() + (size_t)MPROMPT * DM, C.Wgu2(), DFF, DM, C.H() + (size_t)MPROMPT * DFF, DFF, 0, nullptr, nullptr, 0, 0, stg);
    { pg8::Gemm g{C.XN(), C.Wgu2(), MPROMPT, 2 * DFF, DM}; pg8::StaticOrder S; S.init(MPROMPT, 2 * DFF, GSZ, BX); pg8::EpiSwiglu E{C.H(), DFF};
      pg8::gemm_phase<pg8::EpiSwiglu, pg8::StaticOrder, true, true>(lds, g, S, E); }
    small_gemm<3>(lds, C.XN() + (size_t)MPROMPT * DM, C.Wgu2(), DFF, DM, C.H() + (size_t)MPROMPT * DFF, DFF, 0, nullptr, nullptr, 0, stg, 4); }
    XBAR();
    { const int stg = (BX >> 3) & 3;
    small_gemm<0>(lds, C.H() + (size_t)MPROMPT * DFF, C.Wd2(), DM, DFF, C.D() + (size_t)MPROMPT * DM, DM, 0, nullptr, nullptr, 0, 0, stg);
    { pg8::Gemm g{C.H(), C.Wd2(), MPROMPT, DM, DFF}; pg8::StaticOrder S; S.init(MPROMPT, DM, GSZ, BX); pg8::EpiBf16<0> E{C.D(), DM, 0, nullptr, nullptr, 0};
      pg8::gemm_phase<pg8::EpiBf16<0>, pg8::StaticOrder, true, true>(lds, g, S, E); }
    small_gemm<0>(lds, C.H() + (size_t)MPROMPT * DFF, C.Wd2(), DM, DFF, C.D() + (size_t)MPROMPT * DM, DM, 0, nullptr, nullptr, 0, stg, 4); }
    XBAR();
    { FTID; const float* gp = C.in(32); { const int gw_ = GWV, ngw_ = NGWV, nit = (MPROMPT + 4 * ngw_ - 1) / (4 * ngw_);
      for (int it = 0; it < nit - 1; ++it) rows_res<4, false, true>(C, gw_ + 4 * it * ngw_, ngw_, M, gp, 0.5f, LANE);
      rows_res<5, false, true>(C, gw_ + 4 * (nit - 1) * ngw_, ngw_, MPROMPT + gw_, gp, 0.5f, LANE);
      for (int ms = MPROMPT + gw_ + ngw_; ms < M; ms += ngw_) rows_res<5, false, true>(C, MPROMPT, ngw_, ms, gp, 0.5f, LANE); } }
}

extern "C" void kernel_launch(void* const* d_in, const int* in_sizes, int n_in, void* d_out, int out_size, void* d_ws, size_t ws_size, hipStream_t stream) {
    static int grid = 0;
    if (grid == 0) {
        if (n_in != 33 || ws_size < WS_END) { fprintf(stderr, "kernel_launch: unexpected n_in %d / ws %zu\n", n_in, ws_size); grid = -1; return; }
        int dev = 0, cus = 0, per_cu = 0;
        hipGetDevice(&dev);
        hipDeviceGetAttribute(&cus, hipDeviceAttributeMultiprocessorCount, dev);
        hipFuncSetAttribute((const void*)fwd_kernel, hipFuncAttributeMaxDynamicSharedMemorySize, LDS_BYTES);
        hipOccupancyMaxActiveBlocksPerMultiprocessor(&per_cu, (const void*)fwd_kernel, NTHREADS, LDS_BYTES);
        if (per_cu < 1) { fprintf(stderr, "kernel_launch: occupancy query says %d blocks per CU\n", per_cu); per_cu = 1; }
        grid = cus * per_cu;
    }
    if (grid < 0) return;
    if (hipMemsetAsync((char*)d_ws + WS_CTL, 0, CTL_ZERO_BYTES, stream) != hipSuccess) { fprintf(stderr, "memset failed\n"); return; }
    Args a{};
    for (int i = 0; i < 33; ++i) a.in[i] = (const float*)d_in[i];
    a.out = (float*)d_out; a.ws = (unsigned char*)d_ws;
    void* params[] = {&a};
    hipError_t e = hipLaunchCooperativeKernel((const void*)fwd_kernel, dim3(grid), dim3(NTHREADS), params, LDS_BYTES, stream);
    if (e != hipSuccess) fprintf(stderr, "cooperative launch failed: %s (grid %d)\n", hipGetErrorString(e), grid);
}
```

```cpp
#include <hip/hip_runtime.h>
#include <hip/hip_cooperative_groups.h>
#include <cstdio>
#include <cstdint>
namespace cg = cooperative_groups;
__device__ __forceinline__ int fresh_tid() { int t = (int)threadIdx.x; asm volatile("" : "+v"(t)); return t; }
namespace pg8 {
#define PG8_LAS __attribute__((address_space(3)))
typedef unsigned short bf16_t;
typedef short bf16x8 __attribute__((ext_vector_type(8)));
typedef float f32x4 __attribute__((ext_vector_type(4)));
typedef unsigned u32x4 __attribute__((ext_vector_type(4)));
constexpr int BM = 256, BK = 64, HALF = 128, HTB = HALF * BK * 2  , STAGE_BYTES = 8 * HTB, NXCD = 8, WGM = 8;

__host__ __device__ __forceinline__ int lds_byte(int r, int c) { const int st = (r >> 4) * 2 + (c >> 5), rr = r & 15, cc = c & 31, ob = rr * 64 + cc * 2; return st * 1024 + (ob ^ (((ob >> 9) & 1) << 5)); }
__host__ __device__ __forceinline__ void stage_rc(int b, int& R, int& C) { const int st = b / 1024, sb = b % 1024, swz = sb ^ (((sb >> 9) & 1) << 5); R = (st >> 1) * 16 + swz / 64; C = (st & 1) * 32 + (swz % 64) / 2; }
__host__ __device__ __forceinline__ int perm32(int rho) { const int n = rho >> 4, i = rho & 15; return 8 * (i >> 2) + 4 * n + (i & 3); }

struct Unit { int pm, pn; };
struct Gemm { const bf16_t* A; const bf16_t* Bt; int M, N, K; };

struct StaticOrder {
    int nM, nN, nwg, G, c;
    __host__ __device__ void init(int M, int N, int G_, int c_) { nM = M / BM; nN = N / BM; nwg = nM * nN; G = G_; c = c_; }
    __host__ __device__ bool next(int i, Unit& u) const {
        const long L = (long)i * G + c; if (L >= nwg) return false;
        int wgid = (int)L; { const int q = nwg / NXCD, r = nwg % NXCD, xcd = wgid % NXCD, off = wgid / NXCD; wgid = (xcd < r ? xcd * (q + 1) : r * (q + 1) + (xcd - r) * q) + off; }
        const int nig = WGM * nN, gid = wgid / nig, fm = gid * WGM, gsz = (nM - fm) < WGM ? (nM - fm) : WGM;
        u.pm = fm + ((wgid % nig) % gsz); u.pn = (wgid % nig) / gsz; return true;
    }
    __device__ __forceinline__ void a_ready(const Unit&) const {}
    __device__ __forceinline__ void done(const Unit&) const {}
};

__device__ __forceinline__ unsigned cvt_pk_bf16(float lo, float hi) { unsigned r; asm volatile("v_cvt_pk_bf16_f32 %0, %1, %2" : "=v"(r) : "v"(lo), "v"(hi)); return r; }
__device__ __forceinline__ float bf_lo(unsigned w) { return __uint_as_float(w << 16); }
__device__ __forceinline__ float bf_hi(unsigned w) { return __uint_as_float(w & 0xffff0000u); }
__device__ __forceinline__ float sigmoid_f(float x) { return __builtin_amdgcn_rcpf(1.0f + __expf(-x)); }
__device__ __forceinline__ float silu_f(float x) { return x * sigmoid_f(x); }
__device__ __forceinline__ float gelu_t(float x) { const float u = 1.5957691216057308f * (x + 0.044715f * x * x * x); return x * sigmoid_f(u); }

struct EpiSwiglu {
    static constexpr bool PERM = true, AFTER_DRAIN = false;
    bf16_t* O; int ldc;
    __device__ __forceinline__ void operator()(const f32x4 (&acc)[2][2][4][2], const Unit& u, int wr, int wc, int fr, int fq) const {
        const int row0 = u.pm * BM + wr * 64 + fr; const int col0 = u.pn * HALF + wc * 32 + 8 * fq;
#pragma unroll
        for (int ai = 0; ai < 2; ++ai)
#pragma unroll
            for (int m = 0; m < 4; ++m) {
                bf16_t* rowp = O + (size_t)(row0 + ai * HALF + m * 16) * ldc + col0;
                const f32x4 g0 = acc[ai][0][m][0], g1 = acc[ai][0][m][1], u0 = acc[ai][1][m][0], u1 = acc[ai][1][m][1];
                u32x4 w;
                w.x = cvt_pk_bf16(silu_f(g0[0]) * u0[0], silu_f(g0[1]) * u0[1]); w.y = cvt_pk_bf16(silu_f(g0[2]) * u0[2], silu_f(g0[3]) * u0[3]);
                w.z = cvt_pk_bf16(silu_f(g1[0]) * u1[0], silu_f(g1[1]) * u1[1]); w.w = cvt_pk_bf16(silu_f(g1[2]) * u1[2], silu_f(g1[3]) * u1[3]);
                *(u32x4*)rowp = w;
            }
    }
};
template <int MODE> struct EpiBf16 {
    static constexpr bool PERM = true, AFTER_DRAIN = false;
    bf16_t* O; int ldc; int act_cols; const float* bias; const bf16_t* Y; int ldy;
    __device__ __forceinline__ void operator()(const f32x4 (&acc)[2][2][4][2], const Unit& u, int wr, int wc, int fr, int fq) const {
        const int row0 = u.pm * BM + wr * 64 + fr; const int col0 = u.pn * BM + wc * 32 + 8 * fq;
#pragma unroll
        for (int bj = 0; bj < 2; ++bj) {
            const int col = col0 + bj * HALF;
            f32x4 b0 = (f32x4){0.f, 0.f, 0.f, 0.f}, b1 = b0;
            if (MODE == 2) { b0 = *(const f32x4*)(bias + col); b1 = *(const f32x4*)(bias + col + 4); }
            const bool act = (MODE == 1) && (col < act_cols);
#pragma unroll
            for (int ai = 0; ai < 2; ++ai)
#pragma unroll
                for (int m = 0; m < 4; ++m) {
                    const size_t row = (size_t)(row0 + ai * HALF + m * 16);
                    f32x4 v0 = acc[ai][bj][m][0], v1 = acc[ai][bj][m][1];
                    if (MODE == 1) { if (act) {
#pragma unroll
                        for (int j = 0; j < 4; ++j) { v0[j] = gelu_t(v0[j]); v1[j] = gelu_t(v1[j]); } } }
                    if (MODE == 2) {
                        const u32x4 y = *(const u32x4*)(Y + row * ldy + col);
                        v0 = v0 + b0; v1 = v1 + b1;
                        v0[0] = bf_lo(y.x) * sigmoid_f(v0[0]); v0[1] = bf_hi(y.x) * sigmoid_f(v0[1]); v0[2] = bf_lo(y.y) * sigmoid_f(v0[2]); v0[3] = bf_hi(y.y) * sigmoid_f(v0[3]);
                        v1[0] = bf_lo(y.z) * sigmoid_f(v1[0]); v1[1] = bf_hi(y.z) * sigmoid_f(v1[1]); v1[2] = bf_lo(y.w) * sigmoid_f(v1[2]); v1[3] = bf_hi(y.w) * sigmoid_f(v1[3]);
                    }
                    u32x4 w; w.x = cvt_pk_bf16(v0[0], v0[1]); w.y = cvt_pk_bf16(v0[2], v0[3]); w.z = cvt_pk_bf16(v1[0], v1[1]); w.w = cvt_pk_bf16(v1[2], v1[3]);
                    *(u32x4*)(O + row * ldc + col) = w;
                }
        }
    }
};

template <class Epi, class Sched, bool ALIGN_EPI = false, bool SP2 = false>
__device__ __forceinline__ void gemm_phase(PG8_LAS unsigned char* lds, const Gemm g, const Sched& S, const Epi& E) {
    const int tid = fresh_tid(), wid = __builtin_amdgcn_readfirstlane(tid >> 6), lane = tid & 63, wr = wid >> 2, wc = wid & 3, fr = lane & 15, fq = lane >> 4;
    const int K = g.K, nt = K / BK;
    unsigned voffA[2], voffB[2];
#pragma unroll
    for (int i = 0; i < 2; ++i) { int R, C; stage_rc(tid * 16 + i * 8192, R, C); const int Rb = Epi::PERM ? ((R & ~31) + perm32(R & 31)) : R;
        voffA[i] = (unsigned)(R * K + C) * 2u; voffB[i] = (unsigned)(Rb * K + C) * 2u; }
    const size_t kstep = (size_t)(BK * 2);
    const size_t hstep = (size_t)HALF * K * 2;
    const size_t tstep = 2 * hstep;
    const unsigned ldsw = (unsigned)wid * 1024u;
    const int aoff = lds_byte(wr * 64 + fr, fq * 8), boff = lds_byte(wc * 32 + fr, fq * 8);
#define PG8_SA(b, h) (((b) * 2 + (h)) * HTB)
#define PG8_SB(b, h) ((4 + (b) * 2 + (h)) * HTB)
#define PG8_STAGE(bufoff, gbase, voff) do { _Pragma("unroll") for (int _i = 0; _i < 2; ++_i) \
        __builtin_amdgcn_global_load_lds((const unsigned*)((const char*)(gbase) + (voff)[_i]), (PG8_LAS unsigned*)(lds + (bufoff) + ldsw + _i * 8192), 16, 0, 0); } while (0)
#define PG8_LDA(dst, b, h) do { _Pragma("unroll") for (int m = 0; m < 4; ++m) _Pragma("unroll") for (int k = 0; k < 2; ++k) dst[m][k] = *(const PG8_LAS bf16x8*)(lds + PG8_SA(b, h) + aoff + m * 2048 + k * 1024); } while (0)
#define PG8_LDB(dst, b, h) do { _Pragma("unroll") for (int n = 0; n < 2; ++n) _Pragma("unroll") for (int k = 0; k < 2; ++k) dst[n][k] = *(const PG8_LAS bf16x8*)(lds + PG8_SB(b, h) + boff + n * 2048 + k * 1024); } while (0)
#define PG8_MMA(ai, bj, At, Bt) do { __builtin_amdgcn_s_setprio(1); _Pragma("unroll") for (int m = 0; m < 4; ++m) _Pragma("unroll") for (int n = 0; n < 2; ++n) _Pragma("unroll") for (int k = 0; k < 2; ++k) \
        acc[ai][bj][m][n] = __builtin_amdgcn_mfma_f32_16x16x32_bf16(Bt[n][k], At[m][k], acc[ai][bj][m][n], 0, 0, 0); __builtin_amdgcn_s_setprio(0); } while (0)
#define PG8_WAIT_V(n) asm volatile("s_waitcnt vmcnt(" #n ")" ::: "memory")
#define PG8_WAIT_L(n) asm volatile("s_waitcnt lgkmcnt(" #n ")" ::: "memory")
#define PG8_BAR __builtin_amdgcn_s_barrier()
#define PG8_SCHED __builtin_amdgcn_sched_barrier(0)
    Unit cur, nxt; int ui = 0;
    if (!S.next(0, cur)) return;
    f32x4 acc[2][2][4][2];
#pragma unroll
    for (int a = 0; a < 2; ++a)
#pragma unroll
        for (int b = 0; b < 2; ++b)
#pragma unroll
            for (int m = 0; m < 4; ++m)
#pragma unroll
                for (int n = 0; n < 2; ++n) acc[a][b][m][n] = (f32x4){0.f, 0.f, 0.f, 0.f};
    bf16x8 At[4][2], B0[2][2], B1[2][2];
    const char* cA = (const char*)g.A + (size_t)cur.pm * tstep; const char* cB = (const char*)g.Bt + (size_t)cur.pn * tstep;
    S.a_ready(cur);
    if constexpr (SP2) {
        PG8_STAGE(PG8_SB(0, 0), cB, voffB); PG8_STAGE(PG8_SB(0, 1), cB + hstep, voffB); PG8_STAGE(PG8_SA(0, 0), cA, voffA); PG8_STAGE(PG8_SA(0, 1), cA + hstep, voffA);
        if (wr == 1) PG8_BAR;
        PG8_WAIT_V(2); PG8_BAR;
        PG8_STAGE(PG8_SB(1, 0), cB + kstep, voffB); PG8_STAGE(PG8_SA(1, 0), cA + kstep, voffA); PG8_STAGE(PG8_SB(1, 1), cB + hstep + kstep, voffB);
        PG8_WAIT_V(6); PG8_BAR;
    } else {
        PG8_STAGE(PG8_SB(0, 0), cB, voffB); PG8_STAGE(PG8_SA(0, 0), cA, voffA); PG8_STAGE(PG8_SB(0, 1), cB + hstep, voffB); PG8_STAGE(PG8_SA(0, 1), cA + hstep, voffA);
        if (wr == 1) PG8_BAR;
        PG8_WAIT_V(4); PG8_BAR;
        PG8_STAGE(PG8_SB(1, 0), cB + kstep, voffB); PG8_STAGE(PG8_SA(1, 0), cA + kstep, voffA); PG8_STAGE(PG8_SB(1, 1), cB + hstep + kstep, voffB);
        PG8_WAIT_V(6); PG8_BAR;
    }
    for (;;) {
        const bool has_next = S.next(ui + 1, nxt);
        const char* nA = has_next ? (const char*)g.A + (size_t)nxt.pm * tstep : cA; const char* nB = has_next ? (const char*)g.Bt + (size_t)nxt.pn * tstep : cB;
        for (int t = 0; t < nt; t += 2) {
            const bool last = (t == nt - 2);
            const char* a1 = cA + (size_t)(t + 1) * kstep;
            const char* a2 = last ? nA : cA + (size_t)(t + 2) * kstep; const char* b2 = last ? nB : cB + (size_t)(t + 2) * kstep;
            const char* a3 = a2 + kstep; const char* b3 = b2 + kstep;
            if (last && has_next) S.a_ready(nxt);
            if constexpr (SP2) {
            PG8_LDB(B0, 0, 0); PG8_LDB(B1, 0, 1); PG8_SCHED; PG8_LDA(At, 0, 0); PG8_STAGE(PG8_SA(1, 1), a1 + hstep, voffA);
            PG8_WAIT_V(8); PG8_WAIT_L(0); PG8_BAR; PG8_MMA(0, 0, At, B0); PG8_MMA(0, 1, At, B1); PG8_BAR; PG8_SCHED;
            PG8_LDA(At, 0, 1); PG8_STAGE(PG8_SB(0, 0), b2, voffB); PG8_STAGE(PG8_SB(0, 1), b2 + hstep, voffB); PG8_STAGE(PG8_SA(0, 0), a2, voffA);
            PG8_WAIT_V(8); PG8_WAIT_L(0); PG8_BAR; PG8_MMA(1, 0, At, B0); PG8_MMA(1, 1, At, B1); PG8_BAR; PG8_SCHED;
            PG8_LDB(B0, 1, 0); PG8_LDB(B1, 1, 1); PG8_SCHED; PG8_LDA(At, 1, 0); PG8_STAGE(PG8_SA(0, 1), a2 + hstep, voffA);
            PG8_WAIT_V(8); PG8_WAIT_L(0); PG8_BAR; PG8_MMA(0, 0, At, B0); PG8_MMA(0, 1, At, B1); PG8_BAR; PG8_SCHED;
            PG8_LDA(At, 1, 1); PG8_STAGE(PG8_SB(1, 0), b3, voffB); PG8_STAGE(PG8_SB(1, 1), b3 + hstep, voffB); PG8_STAGE(PG8_SA(1, 0), a3, voffA);
            PG8_WAIT_V(8); PG8_WAIT_L(0); PG8_BAR; PG8_MMA(1, 0, At, B0); PG8_MMA(1, 1, At, B1); PG8_BAR; PG8_SCHED;
            } else {
            PG8_LDB(B0, 0, 0); PG8_SCHED; PG8_LDA(At, 0, 0); PG8_STAGE(PG8_SA(1, 1), a1 + hstep, voffA);
            PG8_WAIT_L(8); PG8_BAR; PG8_WAIT_L(0); PG8_MMA(0, 0, At, B0); PG8_BAR; PG8_SCHED;
            PG8_LDB(B1, 0, 1); PG8_STAGE(PG8_SB(0, 0), b2, voffB);
            PG8_BAR; PG8_WAIT_L(0); PG8_MMA(0, 1, At, B1); PG8_BAR;
            PG8_LDA(At, 0, 1); PG8_STAGE(PG8_SA(0, 0), a2, voffA);
            PG8_BAR; PG8_WAIT_L(0); PG8_MMA(1, 0, At, B0); PG8_BAR; PG8_SCHED;
            PG8_STAGE(PG8_SB(0, 1), b2 + hstep, voffB);
            PG8_WAIT_V(6); PG8_BAR; PG8_MMA(1, 1, At, B1); PG8_BAR;
            PG8_LDB(B0, 1, 0); PG8_SCHED; PG8_LDA(At, 1, 0); PG8_STAGE(PG8_SA(0, 1), a2 + hstep, voffA);
            PG8_WAIT_L(8); PG8_BAR; PG8_WAIT_L(0); PG8_MMA(0, 0, At, B0); PG8_BAR; PG8_SCHED;
            PG8_LDB(B1, 1, 1); PG8_STAGE(PG8_SB(1, 0), b3, voffB);
            PG8_BAR; PG8_WAIT_L(0); PG8_MMA(0, 1, At, B1); PG8_BAR;
            PG8_LDA(At, 1, 1); PG8_STAGE(PG8_SA(1, 0), a3, voffA);
            PG8_BAR; PG8_WAIT_L(0); PG8_MMA(1, 0, At, B0); PG8_BAR; PG8_SCHED;
            PG8_STAGE(PG8_SB(1, 1), b3 + hstep, voffB);
            PG8_WAIT_V(6); PG8_BAR; PG8_MMA(1, 1, At, B1); PG8_BAR;
            }
        }
        if constexpr (ALIGN_EPI) { if (wr == 0) PG8_BAR; }
        if constexpr (!Epi::AFTER_DRAIN) { E(acc, cur, wr, wc, fr, fq); S.done(cur); }
        if (!has_next) break;
#pragma unroll
        for (int a = 0; a < 2; ++a)
#pragma unroll
            for (int b = 0; b < 2; ++b)
#pragma unroll
                for (int m = 0; m < 4; ++m)
#pragma unroll
                    for (int n = 0; n < 2; ++n) acc[a][b][m][n] = (f32x4){0.f, 0.f, 0.f, 0.f};
        cur = nxt; cA = nA; cB = nB; ++ui;
        if constexpr (ALIGN_EPI) { if (wr == 1) PG8_BAR; }
    }
    PG8_WAIT_V(0);
    if constexpr (!ALIGN_EPI) { if (wr == 0) PG8_BAR; }
    PG8_BAR;
    if constexpr (Epi::AFTER_DRAIN) { E.fused(acc, cur, wr, wc, fr, fq, lds, wid, lane); S.done(cur); }
#undef PG8_SA
#undef PG8_SB
#undef PG8_STAGE
#undef PG8_LDA
#undef PG8_LDB
#undef PG8_MMA
#undef PG8_WAIT_V
#undef PG8_WAIT_L
#undef PG8_BAR
#undef PG8_SCHED
}
}

constexpr int DM = 1024, SEQ = 16384, NBATCH = 2, MPROMPT = NBATCH * SEQ, DEC_B = 8, DEC_S = 16;
constexpr int M = MPROMPT + DEC_B * DEC_S;
constexpr int MPAD = 33024;
constexpr int DFF = 2816, DIN = 1536, AW = 512, BWD = 512, NG = 32, NP = 64, GN = 16;
constexpr int NTILE = M / 128;
constexpr float EPS = 1e-6f;
constexpr int NWAVES = 8, NTHREADS = 512;

constexpr size_t MiB = 1u << 20;
constexpr size_t WS_WGU1 = 1 * MiB, WS_WD1 = 12 * MiB, WS_WIN = 18 * MiB, WS_WGLU = 21 * MiB, WS_WOUT = 22 * MiB, WS_WGU2 = 24 * MiB, WS_WD2 = 35 * MiB;
constexpr size_t WS_WEFF = 41 * MiB, WS_BB = 42 * MiB, WS_CM = 42 * MiB + 131072, WS_LAM = 42 * MiB + 262144, WS_RS = 42 * MiB + 524288, WS_E = 43 * MiB;
constexpr size_t WS_XN = 48 * MiB, WS_D = 113 * MiB, WS_H = 178 * MiB, WS_Z = 178 * MiB, WS_YB = 275 * MiB, WS_MIX = 356 * MiB, WS_END = 421 * MiB;
static_assert(WS_XN + (size_t)MPAD * DM * 2 <= WS_D && WS_D + (size_t)MPAD * DM * 2 <= WS_H && WS_H + (size_t)MPAD * DFF * 2 <= WS_MIX, "ws map");
static_assert(WS_Z + (size_t)MPAD * DIN * 2 <= WS_YB && WS_YB + (size_t)MPAD * BWD * 2 <= WS_H + (size_t)MPAD * DFF * 2 && WS_MIX + (size_t)MPAD * DM * 2 <= WS_END, "ws map 2");
static_assert(WS_E + (size_t)NTILE * NG * NP * 8 <= WS_XN, "ws map 3");

constexpr size_t OFF_Y = 0, OFF_SRE_P = (size_t)M * DM, OFF_SIM_P = OFF_SRE_P + NBATCH * NG * NP, OFF_SRE_S = OFF_SIM_P + NBATCH * NG * NP,
                 OFF_SIM_S = OFF_SRE_S + DEC_B * NG * NP, OFF_V_S = OFF_SIM_S + DEC_B * NG * NP;

constexpr int OT_STRIDE = 520;
constexpr int VT_STRIDE = 136;
constexpr int LDS_BYTES = 147456;
static_assert(128 * VT_STRIDE * 2 + 4096 <= LDS_BYTES - 64 && 128 * OT_STRIDE * 2 <= LDS_BYTES - 64, "lds map");

#define LAS __attribute__((address_space(3)))
typedef unsigned short bf16;
typedef float v4f __attribute__((ext_vector_type(4)));
typedef float v2f __attribute__((ext_vector_type(2)));
typedef float v16f __attribute__((ext_vector_type(16)));
typedef unsigned v4u __attribute__((ext_vector_type(4)));
typedef unsigned v2u __attribute__((ext_vector_type(2)));
typedef short bfx8 __attribute__((ext_vector_type(8)));
#define LDS_FENCE() asm volatile("s_waitcnt lgkmcnt(0)" ::: "memory")

using pg8::cvt_pk_bf16; using pg8::bf_lo; using pg8::bf_hi; using pg8::gelu_t;

__device__ __forceinline__ float wave_sum(float v) {
#pragma unroll
    for (int o = 1; o < 64; o <<= 1) v += __shfl_xor(v, o);
    return v;
}
typedef __bf16 bf16x2_t __attribute__((ext_vector_type(2)));
__device__ __forceinline__ unsigned cvt_pk_c(float lo, float hi) { const v2f v = {lo, hi}; const bf16x2_t b = __builtin_convertvector(v, bf16x2_t); return __builtin_bit_cast(unsigned, b); }
__device__ __forceinline__ unsigned cvt_pk_nv(float lo, float hi) { unsigned r; asm("v_cvt_pk_bf16_f32 %0, %1, %2" : "=v"(r) : "v"(lo), "v"(hi)); return r; }
__device__ __forceinline__ bf16 f2bf(float f) { return (bf16)(cvt_pk_nv(f, 0.f) & 0xffffu); }


__device__ __forceinline__ double dexp(double x) {
    const double y = x * (1.0 / 256.0); double t = 1.0;
#pragma unroll
    for (int i = 12; i >= 1; --i) t = 1.0 + t * y * (1.0 / (double)i);
#pragma unroll
    for (int i = 0; i < 8; ++i) t = t * t;
    return t;
}
__device__ __forceinline__ void dsincos(double x, double& s, double& c) {
    const double twopi = 6.283185307179586476925286766559;
    const double k = rint(x * (1.0 / twopi)); const double r = x - k * twopi, r2 = r * r;
    double ts = r, tc = 1.0; s = r; c = 1.0;
#pragma unroll
    for (int i = 1; i <= 15; ++i) { tc = -tc * r2 * (1.0 / (double)((2 * i - 1) * (2 * i))); ts = -ts * r2 * (1.0 / (double)((2 * i) * (2 * i + 1))); c += tc; s += ts; }
}

typedef const float* cfp_t;
typedef __attribute__((address_space(4))) cfp_t const* kin_t;
__device__ __forceinline__ const float* karg_in(int i) {
    auto k = __builtin_amdgcn_kernarg_segment_ptr();
    asm volatile("" : "+s"(k));
    return ((kin_t)k)[i];
}
struct Ctx {
    __device__ __forceinline__ const float* in(int i) const { return karg_in(i); }
    __device__ __forceinline__ float* out() const { return (float*)karg_in(33); }
    __device__ __forceinline__ unsigned char* ws() const { return (unsigned char*)karg_in(34); }
#define WSP(name, T, off) __device__ __forceinline__ T* name() const { return (T*)(ws() + (off)); }
    WSP(Wgu1, bf16, WS_WGU1) WSP(Wd1, bf16, WS_WD1) WSP(Win, bf16, WS_WIN) WSP(Wglu, bf16, WS_WGLU) WSP(Wout, bf16, WS_WOUT) WSP(Wgu2, bf16, WS_WGU2) WSP(Wd2, bf16, WS_WD2)
    WSP(Weff, bf16, WS_WEFF) WSP(BB, bf16, WS_BB) WSP(CM, bf16, WS_CM) WSP(XN, bf16, WS_XN) WSP(D, bf16, WS_D) WSP(H, bf16, WS_H) WSP(Z, bf16, WS_Z) WSP(YB, bf16, WS_YB) WSP(MIX, bf16, WS_MIX)
    WSP(LAM, float, WS_LAM) WSP(E, float, WS_E) WSP(RS, float, WS_RS)
#undef WSP
};

__device__ __forceinline__ void p0_block_item(const float* W, const float* gk, int K, int N, bf16* WT, int mode, int item, LAS float* tile, int tid) {
    const int nblk = N / 256, kb = item / nblk, nb = item % nblk, k0 = 64 * kb, n0 = 256 * nb;
    const int lr = tid >> 6, lc = 4 * (tid & 63);
    v4f v[8];
#pragma unroll
    for (int i = 0; i < 8; ++i) v[i] = *(const v4f*)(W + (size_t)(k0 + lr + 8 * i) * N + n0 + lc);
    if (gk) {
#pragma unroll
        for (int i = 0; i < 8; ++i) v[i] = v[i] * gk[k0 + lr + 8 * i];
    }
    __syncthreads();
#pragma unroll
    for (int i = 0; i < 8; ++i) { LAS float* p = tile + (lr + 8 * i) * 257 + lc; p[0] = v[i].x; p[1] = v[i].y; p[2] = v[i].z; p[3] = v[i].w; }
    __syncthreads();
    const int c = tid & 7;
#pragma unroll
    for (int j = 0; j < 4; ++j) {
        const int n = (tid >> 3) + 64 * j, ng = n0 + n;
        const int drow = (mode == 0) ? ng : (256 * (ng >> 7) + (ng & 127) + (mode == 2 ? 128 : 0));
        const LAS float* sp = tile + (8 * c) * 257 + n;
        v4u o; o.x = cvt_pk_nv(sp[0 * 257], sp[1 * 257]); o.y = cvt_pk_nv(sp[2 * 257], sp[3 * 257]); o.z = cvt_pk_nv(sp[4 * 257], sp[5 * 257]); o.w = cvt_pk_nv(sp[6 * 257], sp[7 * 257]);
        *(v4u*)(WT + (size_t)drow * K + k0 + 8 * c) = o;
    }
}
__device__ __forceinline__ const float* xrow_ptr(const Ctx& C, int row) { return row < MPROMPT ? C.in(0) + (size_t)row * DM : C.in(1) + (size_t)(row - MPROMPT) * DM; }

__device__ __forceinline__ v4f ld4_f32(const float* p) { return *(const v4f*)p; }
__device__ __forceinline__ v4f ld4_bf16(const bf16* p) { const v2u w = *(const v2u*)p; return (v4f){bf_lo(w.x), bf_hi(w.x), bf_lo(w.y), bf_hi(w.y)}; }
__device__ __forceinline__ void st4_bf16(bf16* p, v4f o) { v2u w; w.x = cvt_pk_nv(o.x, o.y); w.y = cvt_pk_nv(o.z, o.w); *(v2u*)p = w; }
__device__ __forceinline__ float ssq4(v4f v) { return (v.x * v.x + v.y * v.y) + (v.z * v.z + v.w * v.w); }
template <int R>
__device__ __forceinline__ void rows_x0(const Ctx& C, int m0, int stride, int mx, int lane) {
    v4f v[R][4]; float ss[R]; int mr[R]; bool ok[R];
#pragma unroll
    for (int r = 0; r < R; ++r) { mr[r] = (r == 4) ? mx : m0 + r * stride; ok[r] = (r == 4) ? (mx < M) : (mr[r] < MPROMPT); const float* x = xrow_ptr(C, ok[r] ? mr[r] : 0);
#pragma unroll
        for (int j = 0; j < 4; ++j) v[r][j] = ld4_f32(x + 4 * lane + 256 * j); }
    bf16* XN = C.XN();
#pragma unroll
    for (int r = 0; r < R; ++r) { float s = 0.f;
#pragma unroll
        for (int j = 0; j < 4; ++j) s += ssq4(v[r][j]);
        ss[r] = s; }
    float* rs = C.RS();
#pragma unroll
    for (int r = 0; r < R; ++r) ss[r] = wave_sum(ss[r]) * (1.f / DM) + EPS;
#pragma unroll
    for (int r = 0; r < R; ++r) { const float rstd = rsqrtf(ss[r]);
#pragma unroll
        for (int j = 0; j < 4; ++j) if (ok[r]) st4_bf16(XN + (size_t)mr[r] * DM + 4 * lane + 256 * j, v[r][j] * rstd);
        if (lane == 0 && ok[r]) rs[mr[r]] = sqrtf(ss[r]); }
}
template <int R, bool BASE_F32, bool OUT_F32>
__device__ __forceinline__ void rows_res(const Ctx& C, int m0, int stride, int mx, const float* gpost, float scale, int lane) {
    v4f d[R][4], b[R][4]; int mr[R]; bool ok[R]; float r1[R];
    const bf16* D = C.D(); bf16* XN = C.XN();
#pragma unroll
    for (int r = 0; r < R; ++r) { mr[r] = (r == 4) ? mx : m0 + r * stride; ok[r] = (r == 4) ? (mx < M) : (mr[r] < MPROMPT); const int mm = ok[r] ? mr[r] : 0;
#pragma unroll
        for (int j = 0; j < 4; ++j) d[r][j] = ld4_bf16(D + (size_t)mm * DM + 4 * lane + 256 * j);
        if (BASE_F32) { const float* x = xrow_ptr(C, mm);
#pragma unroll
            for (int j = 0; j < 4; ++j) b[r][j] = ld4_f32(x + 4 * lane + 256 * j);
        } else { const float inv = C.RS()[mm];
#pragma unroll
            for (int j = 0; j < 4; ++j) b[r][j] = ld4_bf16(XN + (size_t)mm * DM + 4 * lane + 256 * j) * inv;
        } }
#pragma unroll
    for (int r = 0; r < R; ++r) { float s = 0.f;
#pragma unroll
        for (int j = 0; j < 4; ++j) s += ssq4(d[r][j]);
        r1[r] = s; }
#pragma unroll
    for (int r = 0; r < R; ++r) r1[r] = rsqrtf(wave_sum(r1[r]) * (1.f / DM) + EPS) * scale;
#pragma unroll
    for (int j = 0; j < 4; ++j) { const v4f gp = ld4_f32(gpost + 4 * lane + 256 * j);
#pragma unroll
        for (int r = 0; r < R; ++r) d[r][j] = b[r][j] + d[r][j] * r1[r] * gp; }
    if (OUT_F32) { float* Y = C.out();
#pragma unroll
        for (int r = 0; r < R; ++r)
#pragma unroll
            for (int j = 0; j < 4; ++j) if (ok[r]) *(v4f*)(Y + (size_t)mr[r] * DM + 4 * lane + 256 * j) = d[r][j];
    } else { float* rs = C.RS(); float t[R];
#pragma unroll
        for (int r = 0; r < R; ++r) { float s = 0.f;
#pragma unroll
            for (int j = 0; j < 4; ++j) s += ssq4(d[r][j]);
            t[r] = s; }
#pragma unroll
        for (int r = 0; r < R; ++r) t[r] = wave_sum(t[r]) * (1.f / DM) + EPS;
#pragma unroll
        for (int r = 0; r < R; ++r) { const float rstd = rsqrtf(t[r]);
#pragma unroll
            for (int j = 0; j < 4; ++j) if (ok[r]) st4_bf16(XN + (size_t)mr[r] * DM + 4 * lane + 256 * j, d[r][j] * rstd);
            if (lane == 0 && ok[r]) rs[mr[r]] = sqrtf(t[r]); }
    }
}
template <int R>
__device__ __forceinline__ void rows_norm512(bf16* base, int m0, int stride, int mx, const float* g, int lane) {
    v4u w[R]; float ss[R]; int mr[R]; bool ok[R];
#pragma unroll
    for (int r = 0; r < R; ++r) { mr[r] = (r == 4) ? mx : m0 + r * stride; ok[r] = (r == 4) ? (mx < M) : (mr[r] < MPROMPT);
        w[r] = *(const v4u*)(base + (size_t)(ok[r] ? mr[r] : 0) * DM + 8 * lane); }
    const v4f g0 = *(const v4f*)(g + 8 * lane), g1 = *(const v4f*)(g + 8 * lane + 4);
#pragma unroll
    for (int r = 0; r < R; ++r) { const v4u x = w[r];
        ss[r] = (bf_lo(x.x) * bf_lo(x.x) + bf_hi(x.x) * bf_hi(x.x)) + (bf_lo(x.y) * bf_lo(x.y) + bf_hi(x.y) * bf_hi(x.y)) + (bf_lo(x.z) * bf_lo(x.z) + bf_hi(x.z) * bf_hi(x.z)) + (bf_lo(x.w) * bf_lo(x.w) + bf_hi(x.w) * bf_hi(x.w)); }
#pragma unroll
    for (int r = 0; r < R; ++r) ss[r] = rsqrtf(wave_sum(ss[r]) * (1.f / 512.f) + EPS);
#pragma unroll
    for (int r = 0; r < R; ++r) { const v4u x = w[r]; const float q = ss[r];
        v4u o; o.x = cvt_pk_nv(bf_lo(x.x) * q * g0.x, bf_hi(x.x) * q * g0.y); o.y = cvt_pk_nv(bf_lo(x.y) * q * g0.z, bf_hi(x.y) * q * g0.w);
        o.z = cvt_pk_nv(bf_lo(x.z) * q * g1.x, bf_hi(x.z) * q * g1.y); o.w = cvt_pk_nv(bf_lo(x.w) * q * g1.z, bf_hi(x.w) * q * g1.w);
        if (ok[r]) *(v4u*)(base + (size_t)mr[r] * DM + 8 * lane) = o; }
}

__device__ __forceinline__ void p0_prologue(const Ctx& C, LAS unsigned char* lds, int wave, int lane, int tid) {
    LAS float* tile = (LAS float*)lds;
    const int gw = blockIdx.x * NWAVES + wave, NGW = gridDim.x * NWAVES;
    constexpr int I_GU = (DM / 64) * (DFF / 256), I_D = (DFF / 64) * (DM / 256), I_IN = (DM / 64) * (DIN / 256), I_GLU = (BWD / 64) * (BWD / 256), I_OUT = (DM / 64) * (DM / 256);
    constexpr int NITEMS = 4 * I_GU + 2 * I_D + I_IN + I_GLU + I_OUT;
    for (int it = blockIdx.x; it < NITEMS; it += gridDim.x) {
        int r = it;
        if (r < I_GU) { p0_block_item(C.in(5), C.in(4), DM, DFF, C.Wgu1(), 1, r, tile, tid); continue; } r -= I_GU;
        if (r < I_GU) { p0_block_item(C.in(6), C.in(4), DM, DFF, C.Wgu1(), 2, r, tile, tid); continue; } r -= I_GU;
        if (r < I_GU) { p0_block_item(C.in(29), C.in(28), DM, DFF, C.Wgu2(), 1, r, tile, tid); continue; } r -= I_GU;
        if (r < I_GU) { p0_block_item(C.in(30), C.in(28), DM, DFF, C.Wgu2(), 2, r, tile, tid); continue; } r -= I_GU;
        if (r < I_D) { p0_block_item(C.in(7), nullptr, DFF, DM, C.Wd1(), 0, r, tile, tid); continue; } r -= I_D;
        if (r < I_D) { p0_block_item(C.in(31), nullptr, DFF, DM, C.Wd2(), 0, r, tile, tid); continue; } r -= I_D;
        if (r < I_IN) { p0_block_item(C.in(10), C.in(9), DM, DIN, C.Win(), 0, r, tile, tid); continue; } r -= I_IN;
        if (r < I_GLU) { p0_block_item(C.in(22), nullptr, BWD, BWD, C.Wglu(), 0, r, tile, tid); continue; } r -= I_GLU;
        p0_block_item(C.in(26), nullptr, DM, DM, C.Wout(), 0, r, tile, tid);
    }
    { const int nit = (MPROMPT + 4 * NGW - 1) / (4 * NGW);
      for (int it = 0; it < nit - 1; ++it) rows_x0<4>(C, gw + 4 * it * NGW, NGW, M, lane);
      rows_x0<5>(C, gw + 4 * (nit - 1) * NGW, NGW, MPROMPT + gw, lane);
      for (int ms = MPROMPT + gw + NGW; ms < M; ms += NGW) rows_x0<5>(C, MPROMPT, NGW, ms, lane); }
    const int gt = blockIdx.x * NTHREADS + tid, NGT = gridDim.x * NTHREADS;
    for (int idx = (tid < 8 ? blockIdx.x * 8 + tid : NG * NP); idx < NG * NP; idx += gridDim.x * 8) {
        const int g = idx / NP, p = idx % NP;
        const double lr = (double)C.in(14)[idx], li = (double)C.in(15)[idx], dt = dexp((double)C.in(16)[g]);
        double s1, c1, s8, c8; dsincos(li * dt, s1, c1); dsincos(li * dt * 128.0, s8, c8);
        const double er = dexp(lr * dt), lbr = er * c1, lbi = er * s1;
        const double e8 = dexp(lr * dt * 128.0), l8r = e8 * c8, l8i = e8 * s8;
        C.LAM()[0 * 2048 + idx] = (float)lbr; C.LAM()[1 * 2048 + idx] = (float)lbi; C.LAM()[2 * 2048 + idx] = (float)l8r; C.LAM()[3 * 2048 + idx] = (float)l8i;
        const double a = lbr - 1.0, b = lbi, den = lr * lr + li * li, cr = (a * lr + b * li) / den, ci = (b * lr - a * li) / den;
        for (int n = 0; n < GN; ++n) {
            const double br = (double)C.in(17)[(size_t)idx * GN + n], bi = (double)C.in(18)[(size_t)idx * GN + n];
            C.BB()[((size_t)g * 128 + 2 * p) * GN + n] = f2bf((float)(cr * br - ci * bi));
            C.BB()[((size_t)g * 128 + 2 * p + 1) * GN + n] = f2bf((float)(cr * bi + ci * br));
            C.CM()[((size_t)g * GN + n) * 128 + 2 * p] = f2bf(C.in(19)[((size_t)g * GN + n) * NP + p]);
            C.CM()[((size_t)g * GN + n) * 128 + 2 * p + 1] = f2bf(-C.in(20)[((size_t)g * GN + n) * NP + p]);
        }
    }
    for (int idx = gt; idx < 2 * 4 * 128 * 128; idx += NGT) {
        const int s = idx & 127, t = (idx >> 7) & 127, h = (idx >> 14) & 3, mode = idx >> 16;
        float v;
        if (mode == 0) v = (s <= t) ? C.in(12)[((size_t)h * 128 + t) * 128 + s] : 0.f;
        else v = ((s >> 4) == (t >> 4) && (s & 15) <= (t & 15)) ? C.in(12)[((size_t)h * 128 + (t & 15)) * 128 + (s & 15)] : 0.f;
        C.Weff()[idx] = f2bf(v);
    }
}

constexpr int XU_STRIDE = 72;
constexpr int BH_STRIDE = 136;
constexpr int S5W_BYTES = 32 * XU_STRIDE * 2 + 32 * BH_STRIDE * 2;
static_assert(NWAVES * S5W_BYTES <= LDS_BYTES - 64, "s5 lds");
template <bool PASS2>
__device__ __forceinline__ void s5_tile(const Ctx& C, int T, int sb_lo, int sb_hi, LAS unsigned char* lds, int wave, int lane) {
    const bool sample = (T == NTILE - 1);
    const int r0 = T * 128;
    LAS bf16* XU = (LAS bf16*)(lds + wave * S5W_BYTES);
    LAS bf16* BH = XU + 32 * XU_STRIDE;
    const int tl = lane & 31, hh = lane >> 5, fr = lane & 15, kq = lane >> 4, xrow = lane >> 3, xpart = lane & 7;
    const float* LAM = C.LAM();
    const bf16* Zb = C.Z() + (size_t)1024 + 64 * wave;
    float sr[4], si[4], lr[4], li[4], dsk[4];
#pragma unroll
    for (int gi = 0; gi < 4; ++gi) { const int g = wave * 4 + gi; sr[gi] = 0.f; si[gi] = 0.f; lr[gi] = LAM[0 * 2048 + g * 64 + lane]; li[gi] = LAM[1 * 2048 + g * 64 + lane];
        dsk[gi] = PASS2 ? C.in(21)[16 * g + fr] : 0.f; }
    if (PASS2 && !sample) {
        const int k = T & 127, tb = T - k;
        float l8r[4], l8i[4];
#pragma unroll
        for (int gi = 0; gi < 4; ++gi) { l8r[gi] = LAM[2 * 2048 + (wave * 4 + gi) * 64 + lane]; l8i[gi] = LAM[3 * 2048 + (wave * 4 + gi) * 64 + lane]; }
        const v2f* Ep = (const v2f*)C.E() + ((size_t)tb * NG + wave * 4) * NP + lane;
        const int nb = (k + 15) >> 4, j0 = k - 16 * nb;
        for (int jb = 0; jb < nb; ++jb) {
#pragma unroll
            for (int u = 0; u < 16; ++u) {
                const int j = j0 + 16 * jb + u; const bool ok = j >= 0; const int jc = ok ? j : 0;
#pragma unroll
                for (int gi = 0; gi < 4; ++gi) { v2f e = Ep[(size_t)jc * NG * NP + gi * NP]; if (!ok) e = (v2f){0.f, 0.f};
                    const float nr = fmaf(l8r[gi], sr[gi], fmaf(-l8i[gi], si[gi], e.x)), ni = fmaf(l8r[gi], si[gi], fmaf(l8i[gi], sr[gi], e.y)); sr[gi] = nr; si[gi] = ni; }
            }
        }
    }
    v4u xn[4];
    {
        const int sb0 = sb_lo;
#pragma unroll
        for (int i = 0; i < 4; ++i) xn[i] = *(const v4u*)(Zb + (size_t)(r0 + 32 * sb0 + xrow + 8 * i) * DIN + 8 * xpart);
    }
    const bf16* BBt = C.BB(); const bf16* CMt = C.CM();
    bfx8 bbn[4], cmn[4];
#pragma unroll
    for (int cb = 0; cb < 4; ++cb) bbn[cb] = *(const bfx8*)(BBt + ((size_t)(wave * 4 * 128 + cb * 32 + tl)) * GN + 8 * hh);
    if (PASS2) {
#pragma unroll
        for (int ks = 0; ks < 4; ++ks) cmn[ks] = *(const bfx8*)(CMt + ((size_t)(wave * 4 * GN + fr)) * 128 + 32 * ks + 8 * kq);
    }
    for (int sb = sb_lo; sb < sb_hi; ++sb) {
        const int rb0 = r0 + 32 * sb;
#pragma unroll
        for (int i = 0; i < 4; ++i) *(LAS v4u*)(XU + (xrow + 8 * i) * XU_STRIDE + 8 * xpart) = xn[i];
        if (sb + 1 < sb_hi) {
#pragma unroll
            for (int i = 0; i < 4; ++i) xn[i] = *(const v4u*)(Zb + (size_t)(rb0 + 32 + xrow + 8 * i) * DIN + 8 * xpart);
        }
        LDS_FENCE();
#pragma unroll
        for (int gi = 0; gi < 4; ++gi) {
            const int g = wave * 4 + gi, gnx = wave * 4 + ((gi + 1) & 3);
            bfx8 bb[4], cm[4];
#pragma unroll
            for (int cb = 0; cb < 4; ++cb) { bb[cb] = bbn[cb]; bbn[cb] = *(const bfx8*)(BBt + ((size_t)(gnx * 128 + cb * 32 + tl)) * GN + 8 * hh); }
            if (PASS2) {
#pragma unroll
                for (int ks = 0; ks < 4; ++ks) { cm[ks] = cmn[ks]; cmn[ks] = *(const bfx8*)(CMt + ((size_t)(gnx * GN + fr)) * 128 + 32 * ks + 8 * kq); }
            }
            float s0ar = 0.f, s0ai = 0.f, s0br = 0.f, s0bi = 0.f;
            if (sample) { const size_t o0 = ((size_t)(2 * sb) * NG + g) * NP + lane, o1 = o0 + (size_t)NG * NP;
                s0ar = C.in(2)[o0]; s0ai = C.in(3)[o0]; s0br = C.in(2)[o1]; s0bi = C.in(3)[o1]; }
            const bfx8 a = *(const LAS bfx8*)(XU + tl * XU_STRIDE + 16 * gi + 8 * hh);
#pragma unroll
            for (int cb = 0; cb < 4; ++cb) {
                v16f acc;
#pragma unroll
                for (int r = 0; r < 16; ++r) acc[r] = 0.f;
                acc = __builtin_amdgcn_mfma_f32_32x32x16_bf16(bb[cb], a, acc, 0, 0, 0);
#pragma unroll
                for (int rg = 0; rg < 4; ++rg) { v2u w; w.x = cvt_pk_c(acc[4 * rg], acc[4 * rg + 1]); w.y = cvt_pk_c(acc[4 * rg + 2], acc[4 * rg + 3]);
                    *(LAS v2u*)(BH + tl * BH_STRIDE + cb * 32 + 8 * rg + 4 * hh) = w; }
            }
            LDS_FENCE();
            {
                unsigned bu[32];
#pragma unroll
                for (int t = 0; t < 32; ++t) bu[t] = *(const LAS unsigned*)(BH + t * BH_STRIDE + 2 * lane);
                LDS_FENCE();
                float xr = sr[gi], xi = si[gi];
#pragma unroll
                for (int t = 0; t < 32; ++t) {
                    if (sample && t == 0) { xr = s0ar; xi = s0ai; }
                    if (sample && t == 16) { xr = s0br; xi = s0bi; }
                    const float nr = fmaf(lr[gi], xr, fmaf(-li[gi], xi, bf_lo(bu[t]))), ni = fmaf(lr[gi], xi, fmaf(li[gi], xr, bf_hi(bu[t])));
                    xr = nr; xi = ni;
                    if (PASS2) {
                        *(LAS unsigned*)(BH + t * BH_STRIDE + 2 * lane) = cvt_pk_nv(xr, xi);
                        if (sample && (t & 15) == 15) { const int seq = 2 * sb + (t >> 4);
                            C.out()[OFF_SRE_S + ((size_t)seq * NG + g) * NP + lane] = xr; C.out()[OFF_SIM_S + ((size_t)seq * NG + g) * NP + lane] = xi; }
                    }
                }
                sr[gi] = xr; si[gi] = xi;
            }
            LDS_FENCE();
            if (PASS2) {
#pragma unroll
                for (int rb = 0; rb < 2; ++rb) {
                    v4f acc = (v4f){0.f, 0.f, 0.f, 0.f};
#pragma unroll
                    for (int ks = 0; ks < 4; ++ks) {
                        const bfx8 sa = *(const LAS bfx8*)(BH + (16 * rb + fr) * BH_STRIDE + 32 * ks + 8 * kq);
                        acc = __builtin_amdgcn_mfma_f32_16x16x32_bf16(sa, cm[ks], acc, 0, 0, 0);
                    }
#pragma unroll
                    for (int r = 0; r < 4; ++r) {
                        LAS bf16* up = XU + (16 * rb + 4 * kq + r) * XU_STRIDE + 16 * gi + fr;
                        const float u = __uint_as_float((unsigned)(*up) << 16);
                        *up = f2bf(gelu_t(acc[r] + dsk[gi] * u));
                    }
                }
                LDS_FENCE();
            }
        }
        if (PASS2) {
#pragma unroll
            for (int i = 0; i < 4; ++i) *(v4u*)(C.YB() + (size_t)(rb0 + xrow + 8 * i) * BWD + 64 * wave + 8 * xpart) = *(const LAS v4u*)(XU + (xrow + 8 * i) * XU_STRIDE + 8 * xpart);
            LDS_FENCE();
        }
    }
#pragma unroll
    for (int gi = 0; gi < 4; ++gi) {
        const int g = wave * 4 + gi;
        if (!PASS2) { v2f* Ep = (v2f*)C.E() + ((size_t)T * NG + g) * NP + lane; *Ep = (v2f){sr[gi], si[gi]}; }
        else if (!sample && (T & 127) == 127) { const int b = T >> 7;
            C.out()[OFF_SRE_P + ((size_t)b * NG + g) * NP + lane] = sr[gi]; C.out()[OFF_SIM_P + ((size_t)b * NG + g) * NP + lane] = si[gi]; }
    }
}

__device__ __forceinline__ void gmlp_tile(const Ctx& C, int T, LAS unsigned char* lds, int wave, int lane, int tid) {
    const int mode = (T == NTILE - 1) ? 1 : 0;
    const int r0 = T * 128;
    LAS bf16* VT = (LAS bf16*)lds;
    LAS float* SSQ = (LAS float*)(lds + 128 * VT_STRIDE * 2);
    const int tb = wave & 3, dh = wave >> 2, tl = lane & 31, hh = lane >> 5;
    const int t = 32 * tb + tl;
    unsigned outp[4][2][8]; float ssq = 0.f;
    const bf16* zt = C.Z() + (size_t)(r0 + t) * DIN;
    const int row = tid >> 2, q = tid & 3;
    const bf16* vsrc = C.Z() + (size_t)(r0 + row) * DIN + 512 + q * 32;
    const bf16* Weff = C.Weff();
    v4u vraw[4];
#pragma unroll
    for (int i = 0; i < 4; ++i) vraw[i] = *(const v4u*)(vsrc + 8 * i);
#pragma unroll
    for (int h = 0; h < 4; ++h) {
        bfx8 wf[8];
        const bf16* wrow = Weff + ((size_t)(mode * 4 + h) * 128 + t) * 128 + 8 * hh;
#pragma unroll
        for (int ks = 0; ks < 8; ++ks) wf[ks] = *(const bfx8*)(wrow + 16 * ks);
        v2u uw[2][4];
#pragma unroll
        for (int dbi = 0; dbi < 2; ++dbi)
#pragma unroll
            for (int rg = 0; rg < 4; ++rg) uw[dbi][rg] = *(const v2u*)(zt + h * 128 + 32 * (2 * dh + dbi) + 8 * rg + 4 * hh);
        const float bias = C.in(13)[h * 128 + (mode ? (t & 15) : t)];
        v4f gvv[8];
        { const float* gvp = C.in(11) + h * 128 + q * 32;
#pragma unroll
          for (int i = 0; i < 8; ++i) gvv[i] = *(const v4f*)(gvp + 4 * i); }
        __syncthreads();
        {
            float v[32]; float s = 0.f;
#pragma unroll
            for (int i = 0; i < 4; ++i) { const v4u w = vraw[i];
                v[8 * i + 0] = bf_lo(w.x); v[8 * i + 1] = bf_hi(w.x); v[8 * i + 2] = bf_lo(w.y); v[8 * i + 3] = bf_hi(w.y);
                v[8 * i + 4] = bf_lo(w.z); v[8 * i + 5] = bf_hi(w.z); v[8 * i + 6] = bf_lo(w.w); v[8 * i + 7] = bf_hi(w.w); }
            if (h < 3) {
#pragma unroll
                for (int i = 0; i < 4; ++i) vraw[i] = *(const v4u*)(vsrc + (h + 1) * 128 + 8 * i);
            }
#pragma unroll
            for (int i = 0; i < 32; ++i) s += v[i] * v[i];
            s += __shfl_xor(s, 1); s += __shfl_xor(s, 2);
            const float r = rsqrtf(s * (1.f / 128.f) + EPS);
#pragma unroll
            for (int i = 0; i < 32; ++i) { v[i] = v[i] * r * gvv[i >> 2][i & 3]; VT[(q * 32 + i) * VT_STRIDE + row] = f2bf(v[i]); }
            if (mode) { float* ov = C.out() + OFF_V_S + (size_t)row * AW + h * 128 + q * 32;
#pragma unroll
                for (int i = 0; i < 8; ++i) *(v4f*)(ov + 4 * i) = (v4f){v[4 * i], v[4 * i + 1], v[4 * i + 2], v[4 * i + 3]}; }
        }
        __syncthreads();
#pragma unroll
        for (int dbi = 0; dbi < 2; ++dbi) {
            const int db = 2 * dh + dbi;
            v16f acc;
#pragma unroll
            for (int r = 0; r < 16; ++r) acc[r] = 0.f;
#pragma unroll
            for (int ks = 0; ks < 8; ++ks) {
                const bfx8 va = *(const LAS bfx8*)(VT + (32 * db + tl) * VT_STRIDE + 16 * ks + 8 * hh);
                acc = __builtin_amdgcn_mfma_f32_32x32x16_bf16(va, wf[ks], acc, 0, 0, 0);
            }
#pragma unroll
            for (int rg = 0; rg < 4; ++rg) {
                const v2u u2 = uw[dbi][rg];
                const float o0 = bf_lo(u2.x) * (acc[4 * rg + 0] + bias), o1 = bf_hi(u2.x) * (acc[4 * rg + 1] + bias);
                const float o2 = bf_lo(u2.y) * (acc[4 * rg + 2] + bias), o3 = bf_hi(u2.y) * (acc[4 * rg + 3] + bias);
                ssq += (o0 * o0 + o1 * o1) + (o2 * o2 + o3 * o3);
                outp[h][dbi][2 * rg] = cvt_pk_nv(o0, o1); outp[h][dbi][2 * rg + 1] = cvt_pk_nv(o2, o3);
            }
        }
    }
    ssq += __shfl_xor(ssq, 32);
    if (hh == 0) SSQ[t * 2 + dh] = ssq;
    __syncthreads();
    const float rstd = rsqrtf((SSQ[t * 2] + SSQ[t * 2 + 1]) * (1.f / 512.f) + EPS);
    const float* gap = C.in(24);
    LAS bf16* OT = (LAS bf16*)lds;
    __syncthreads();
#pragma unroll
    for (int h = 0; h < 4; ++h)
#pragma unroll
        for (int dbi = 0; dbi < 2; ++dbi)
#pragma unroll
            for (int rg = 0; rg < 4; ++rg) {
                const int c = h * 128 + 32 * (2 * dh + dbi) + 8 * rg + 4 * hh;
                const v4f ga = *(const v4f*)(gap + c);
                const unsigned w0 = outp[h][dbi][2 * rg], w1 = outp[h][dbi][2 * rg + 1];
                v2u o; o.x = cvt_pk_nv(bf_lo(w0) * rstd * ga.x, bf_hi(w0) * rstd * ga.y); o.y = cvt_pk_nv(bf_lo(w1) * rstd * ga.z, bf_hi(w1) * rstd * ga.w);
                *(LAS v2u*)(OT + t * OT_STRIDE + c) = o;
            }
    __syncthreads();
    {
        bf16* obase = C.MIX() + (size_t)r0 * DM;
#pragma unroll 4
        for (int i = 0; i < 16; ++i) { const int row = wave * 16 + i; *(v4u*)(obase + (size_t)row * DM + 8 * lane) = *(const LAS v4u*)(OT + row * OT_STRIDE + 8 * lane); }
    }
    __syncthreads();
}

#define FTID const int ftid_ = fresh_tid()
#define TID (ftid_)
#define LANE (ftid_ & 63)
#define WAVE (__builtin_amdgcn_readfirstlane(ftid_ >> 6))
#define GSZ ((int)gridDim.x)
#define BX ((int)blockIdx.x)
#define GWV (BX * NWAVES + WAVE)
#define NGWV (GSZ * NWAVES)
constexpr size_t WS_CTL = 0, CTL_ZERO_BYTES = 16384;
constexpr int MISC_OFF = LDS_BYTES - 64;
#define XB_TMO      128
#define XB_XCNT(j)  (256  + 64 * (j))
#define XB_XSUB(j)  (1280 + 64 * (j))
#define XB_XGEN(j)  (2304 + 64 * (j))
#define XB_TOP      3328
#define XB_TOPGEN   3392
#define XCD_BAR_WORDS 3456
#define XB_SPIN_CAP (1u << 18)

__device__ __forceinline__ unsigned xb_ld(unsigned* p)              { return __hip_atomic_load(p, __ATOMIC_RELAXED, __HIP_MEMORY_SCOPE_AGENT); }
__device__ __forceinline__ unsigned xb_add(unsigned* p, unsigned v) { return __hip_atomic_fetch_add(p, v, __ATOMIC_RELAXED, __HIP_MEMORY_SCOPE_AGENT); }
__device__ __forceinline__ unsigned xb_xcc_id() { return (unsigned)__builtin_amdgcn_s_getreg((3 << 11) | 20) & 0xFu; }
#define XB_SPIN(cond, bar) do { unsigned _sp = 0; while (cond) { __builtin_amdgcn_s_sleep(1); \
    if ((++_sp & 255u) == 0u) { if (xb_ld(&(bar)[XB_TMO])) break; if (_sp > XB_SPIN_CAP) { atomicAdd(&(bar)[XB_TMO], 1u); break; } } } } while (0)

struct XcdBarrier {
    unsigned* bar; unsigned x;
    volatile LAS unsigned* st;
};

__device__ __forceinline__ XcdBarrier xcd_barrier_post(unsigned* bar, volatile LAS unsigned* st) {
    XcdBarrier b; b.bar = bar; b.x = xb_xcc_id(); b.st = st;
    if (threadIdx.x == 0) (void)xb_add(&bar[XB_XCNT(b.x)], 1u);
    return b;
}
__device__ __forceinline__ void xcd_barrier_complete(unsigned* bar, unsigned x, unsigned& nloc, unsigned& nx) {
    const unsigned G = gridDim.x * gridDim.y * gridDim.z;
    unsigned sum, cnt, mine, sp = 0u;
    for (;;) {
        sum = 0u; cnt = 0u; mine = 0u;
#pragma unroll
        for (unsigned j = 0; j < 16; ++j) { const unsigned c = xb_ld(&bar[XB_XCNT(j)]); sum += c; cnt += (c > 0u) ? 1u : 0u; mine = (j == x) ? c : mine; }
        if (sum == G) break;
        __builtin_amdgcn_s_sleep(1);
        if ((++sp & 255u) == 0u) { if (xb_ld(&bar[XB_TMO])) break; if (sp > XB_SPIN_CAP) { atomicAdd(&bar[XB_TMO], 1u); break; } }
    }
    nloc = mine > 0u ? mine : 1u; nx = cnt > 0u ? cnt : 1u;
}

__device__ __forceinline__ void xcd_barrier(const XcdBarrier& b) {
    asm volatile("s_waitcnt vmcnt(0)" ::: "memory");
    __syncthreads();
    if (threadIdx.x == 0) {
        unsigned* bar = b.bar;
        __builtin_amdgcn_s_waitcnt(0);
        unsigned nloc = b.st[0], nx = b.st[1];
        if (nloc == 0u) { xcd_barrier_complete(bar, b.x, nloc, nx); b.st[0] = nloc; b.st[1] = nx; }
        const unsigned old = xb_add(&bar[XB_XSUB(b.x)], 1u);
        const unsigned gen = old / nloc;
        if (old + 1u == (gen + 1u) * nloc) {
            __builtin_amdgcn_fence(__ATOMIC_RELEASE, "agent");
            asm volatile("s_waitcnt vmcnt(0)" ::: "memory");
            const unsigned og = xb_add(&bar[XB_TOP], 1u);
            const unsigned tg = og / nx;
            if (og + 1u == (tg + 1u) * nx) xb_add(&bar[XB_TOPGEN], 1u);
            else XB_SPIN(xb_ld(&bar[XB_TOPGEN]) == tg, bar);
            __builtin_amdgcn_fence(__ATOMIC_ACQUIRE, "agent");
            xb_add(&bar[XB_XGEN(b.x)], 1u);
            asm volatile("s_waitcnt vmcnt(0)" ::: "memory");
        } else {
            XB_SPIN(xb_ld(&bar[XB_XGEN(b.x)]) == gen, bar);
            __builtin_amdgcn_fence(__ATOMIC_ACQUIRE, "agent");
            asm volatile("s_waitcnt vmcnt(0)" ::: "memory");
        }
    }
    __syncthreads();
}

template <int MODE>
__device__ __forceinline__ void small_gemm(LAS unsigned char* lds, const bf16* A, const bf16* Bt, int N, int K, bf16* O, int ldc, int act_cols, const float* bias, const bf16* Yv, int ldy, int it0, int it1) {
    FTID; const int wave = WAVE, lane = LANE, tl = lane & 31, hh = lane >> 5;
    LAS float* red = (LAS float*)lds;
    const int nct = N / 32, nitems = 4 * nct, kw = K / 8, nks = kw / 16;
    for (int it = it0; it < it1; ++it) {
        const int item = BX + it * GSZ; if (item >= nitems) break;
        const int rt = item & 3, ct = item >> 2;
        const int hc = 32 * ct + tl;
        const int brow = (MODE == 3) ? (256 * (hc >> 7) + (hc & 127)) : hc;
        const bf16* ap = A + (size_t)(32 * rt + tl) * K + wave * kw + 8 * hh;
        const bf16* bp = Bt + (size_t)brow * K + wave * kw + 8 * hh;
        v16f acc0, acc1;
#pragma unroll
        for (int r = 0; r < 16; ++r) { acc0[r] = 0.f; acc1[r] = 0.f; }
#pragma unroll 4
        for (int ks = 0; ks < nks; ++ks) {
            const bfx8 a = *(const bfx8*)(ap + 16 * ks);
            const bfx8 b0 = *(const bfx8*)(bp + 16 * ks);
            acc0 = __builtin_amdgcn_mfma_f32_32x32x16_bf16(b0, a, acc0, 0, 0, 0);
            if (MODE == 3) { const bfx8 b1 = *(const bfx8*)(bp + (size_t)128 * K + 16 * ks); acc1 = __builtin_amdgcn_mfma_f32_32x32x16_bf16(b1, a, acc1, 0, 0, 0); }
        }
        __syncthreads();
#pragma unroll
        for (int r = 0; r < 16; ++r) { red[(wave * 16 + r) * 64 + lane] = acc0[r]; if (MODE == 3) red[8192 + (wave * 16 + r) * 64 + lane] = acc1[r]; }
        __syncthreads();
        float v0[2], v1[2];
#pragma unroll
        for (int e = 0; e < 2; ++e) { float s0 = 0.f, s1 = 0.f;
#pragma unroll
            for (int w = 0; w < 8; ++w) { s0 += red[(w * 16 + 2 * wave + e) * 64 + lane]; if (MODE == 3) s1 += red[8192 + (w * 16 + 2 * wave + e) * 64 + lane]; }
            v0[e] = s0; v1[e] = s1; }
        const int reg = 2 * wave;
        const int col = 32 * ct + (reg & 3) + 8 * (reg >> 2) + 4 * hh;
        const size_t row = (size_t)(32 * rt + tl);
        float o0 = v0[0], o1 = v0[1];
        if (MODE == 1) { if (col < act_cols) { o0 = gelu_t(o0); o1 = gelu_t(o1); } }
        if (MODE == 2) { const unsigned y = *(const unsigned*)(Yv + row * ldy + col); o0 = bf_lo(y) * pg8::sigmoid_f(o0 + bias[col]); o1 = bf_hi(y) * pg8::sigmoid_f(o1 + bias[col + 1]); }
        if (MODE == 3) { o0 = pg8::silu_f(o0) * v1[0]; o1 = pg8::silu_f(o1) * v1[1]; }
        *(unsigned*)(O + row * ldc + col) = cvt_pk_bf16(o0, o1);
    }
    __syncthreads();
}
struct Args { const float* in[33]; float* out; unsigned char* ws; };
__global__ void __launch_bounds__(NTHREADS, 2) fwd_kernel(Args args) {
    extern __shared__ __attribute__((aligned(16))) unsigned char lds_raw[];
    cg::grid_group grid = cg::this_grid();
    LAS unsigned char* lds = (LAS unsigned char*)lds_raw;
    Ctx C;
    if (threadIdx.x < 16) ((volatile LAS unsigned*)(lds + MISC_OFF))[threadIdx.x] = 0u;
    __syncthreads();
    (void)xcd_barrier_post((unsigned*)(C.ws() + WS_CTL), (volatile LAS unsigned*)(lds + MISC_OFF));
#define XBAR() do { XcdBarrier b_; b_.bar = (unsigned*)(C.ws() + WS_CTL); b_.x = xb_xcc_id(); b_.st = (volatile LAS unsigned*)(lds + MISC_OFF); xcd_barrier(b_); } while (0)
    grid.sync();
    { FTID; p0_prologue(C, lds, WAVE, LANE, TID); }
    XBAR();
    { const int stg = (BX >> 3) & 3;
    small_gemm<3>(lds, C.XN() + (size_t)MPROMPT * DM, C.Wgu1(), DFF, DM, C.H() + (size_t)MPROMPT * DFF, DFF, 0, nullptr, nullptr, 0, 0, stg);
    { pg8::Gemm g{C.XN(), C.Wgu1(), MPROMPT, 2 * DFF, DM}; pg8::StaticOrder S; S.init(MPROMPT, 2 * DFF, GSZ, BX); pg8::EpiSwiglu E{C.H(), DFF};
      pg8::gemm_phase<pg8::EpiSwiglu, pg8::StaticOrder, true, true>(lds, g, S, E); }
    small_gemm<3>(lds, C.XN() + (size_t)MPROMPT * DM, C.Wgu1(), DFF, DM, C.H() + (size_t)MPROMPT * DFF, DFF, 0, nullptr, nullptr, 0, stg, 4); }
    XBAR();
    { const int stg = (BX >> 3) & 3;
    small_gemm<0>(lds, C.H() + (size_t)MPROMPT * DFF, C.Wd1(), DM, DFF, C.D() + (size_t)MPROMPT * DM, DM, 0, nullptr, nullptr, 0, 0, stg);
    { pg8::Gemm g{C.H(), C.Wd1(), MPROMPT, DM, DFF}; pg8::StaticOrder S; S.init(MPROMPT, DM, GSZ, BX); pg8::EpiBf16<0> E{C.D(), DM, 0, nullptr, nullptr, 0};
      pg8::gemm_phase<pg8::EpiBf16<0>, pg8::StaticOrder, true, true>(lds, g, S, E); }
    small_gemm<0>(lds, C.H() + (size_t)MPROMPT * DFF, C.Wd1(), DM, DFF, C.D() + (size_t)MPROMPT * DM, DM, 0, nullptr, nullptr, 0, stg, 4); }
    XBAR();
    { FTID; const float* gp = C.in(8); { const int gw_ = GWV, ngw_ = NGWV, nit = (MPROMPT + 4 * ngw_ - 1) / (4 * ngw_);
      for (int it = 0; it < nit - 1; ++it) rows_res<4, false, false>(C, gw_ + 4 * it * ngw_, ngw_, M, gp, 0.5f, LANE);
      rows_res<5, false, false>(C, gw_ + 4 * (nit - 1) * ngw_, ngw_, MPROMPT + gw_, gp, 0.5f, LANE);
      for (int ms = MPROMPT + gw_ + ngw_; ms < M; ms += ngw_) rows_res<5, false, false>(C, MPROMPT, ngw_, ms, gp, 0.5f, LANE); } }
    XBAR();
    { const int stg = (BX >> 3) & 3;
    small_gemm<1>(lds, C.XN() + (size_t)MPROMPT * DM, C.Win(), DIN, DM, C.Z() + (size_t)MPROMPT * DIN, DIN, 2 * AW, nullptr, nullptr, 0, 0, stg);
    { pg8::Gemm g{C.XN(), C.Win(), MPROMPT, DIN, DM}; pg8::StaticOrder S; S.init(MPROMPT, DIN, GSZ, BX); pg8::EpiBf16<1> E{C.Z(), DIN, 2 * AW, nullptr, nullptr, 0};
      pg8::gemm_phase<pg8::EpiBf16<1>, pg8::StaticOrder, true, true>(lds, g, S, E); }
    small_gemm<1>(lds, C.XN() + (size_t)MPROMPT * DM, C.Win(), DIN, DM, C.Z() + (size_t)MPROMPT * DIN, DIN, 2 * AW, nullptr, nullptr, 0, stg, 4); }
    XBAR();
    { FTID; for (int T = BX; T < NTILE - 1; T += GSZ) {
        s5_tile<false>(C, T, 0, 4, lds, WAVE, LANE);
        __syncthreads();
        gmlp_tile(C, T, lds, WAVE, LANE, TID);
    } }
    XBAR();
    { FTID; const bool swap0 = GSZ > 128;
      for (int T = BX; T < NTILE - 1; T += GSZ) { if (swap0 && T == 0) continue; s5_tile<true>(C, T, 0, 4, lds, WAVE, LANE); }
      if (swap0 && BX == 128) s5_tile<true>(C, 0, 0, 4, lds, WAVE, LANE);
      if (BX >= 1 && BX <= 4) s5_tile<true>(C, NTILE - 1, BX - 1, BX, lds, WAVE, LANE);
      if (BX == 0) { __syncthreads(); gmlp_tile(C, NTILE - 1, lds, WAVE, LANE, TID); } }
    XBAR();
    { const int stg = (BX >> 3) & 3;
    small_gemm<2>(lds, C.YB() + (size_t)MPROMPT * BWD, C.Wglu(), BWD, BWD, C.MIX() + (size_t)MPROMPT * DM + AW, DM, 0, C.in(23), C.YB() + (size_t)MPROMPT * BWD, BWD, 0, stg);
    { pg8::Gemm g{C.YB(), C.Wglu(), MPROMPT, BWD, BWD}; pg8::StaticOrder S; S.init(MPROMPT, BWD, GSZ, BX); pg8::EpiBf16<2> E{C.MIX() + AW, DM, 0, C.in(23), C.YB(), BWD};
      pg8::gemm_phase<pg8::EpiBf16<2>, pg8::StaticOrder, true, true>(lds, g, S, E); }
    small_gemm<2>(lds, C.YB() + (size_t)MPROMPT * BWD, C.Wglu(), BWD, BWD, C.MIX() + (size_t)MPROMPT * DM + AW, DM, 0, C.in(23), C.YB() + (size_t)MPROMPT * BWD, BWD, stg, 4); }
    XBAR();
    { FTID; const float* gb = C.in(25); bf16* bb_ = C.MIX() + AW; const int gw_ = GWV, ngw_ = NGWV, nit = (MPROMPT + 4 * ngw_ - 1) / (4 * ngw_);
      for (int it = 0; it < nit - 1; ++it) rows_norm512<4>(bb_, gw_ + 4 * it * ngw_, ngw_, M, gb, LANE);
      rows_norm512<5>(bb_, gw_ + 4 * (nit - 1) * ngw_, ngw_, MPROMPT + gw_, gb, LANE);
      for (int ms = MPROMPT + gw_ + ngw_; ms < M; ms += ngw_) rows_norm512<5>(bb_, MPROMPT, ngw_, ms, gb, LANE); }
    XBAR();
    { const int stg = (BX >> 3) & 3;
    small_gemm<0>(lds, C.MIX() + (size_t)MPROMPT * DM, C.Wout(), DM, DM, C.D() + (size_t)MPROMPT * DM, DM, 0, nullptr, nullptr, 0, 0, stg);
    { pg8::Gemm g{C.MIX(), C.Wout(), MPROMPT, DM, DM}; pg8::StaticOrder S; S.init(MPROMPT, DM, GSZ, BX); pg8::EpiBf16<0> E{C.D(), DM, 0, nullptr, nullptr, 0};
      pg8::gemm_phase<pg8::EpiBf16<0>, pg8::StaticOrder, true, true>(lds, g, S, E); }
    small_gemm<0>(lds, C.MIX() + (size_t)MPROMPT * DM, C.Wout(), DM, DM, C.D() + (size_t)MPROMPT * DM, DM, 0, nullptr, nullptr, 0, stg, 4); }
    XBAR();
    { FTID; const float* gp = C.in(27); { const int gw_ = GWV, ngw_ = NGWV, nit = (MPROMPT + 4 * ngw_ - 1) / (4 * ngw_);
      for (int it = 0; it < nit - 1; ++it) rows_res<4, false, false>(C, gw_ + 4 * it * ngw_, ngw_, M, gp, 1.0f, LANE);
      rows_res<5, false, false>(C, gw_ + 4 * (nit - 1) * ngw_, ngw_, MPROMPT + gw_, gp, 1.0f, LANE);
      for (int ms = MPROMPT + gw_ + ngw_; ms < M; ms += ngw_) rows_res<5, false, false>(C, MPROMPT, ngw_, ms, gp, 1.0f, LANE); } }
    XBAR();
    { const int stg = (BX >> 3) & 3;
    small_gemm<3>(lds, C.XN() + (size_t)MPROMPT * DM, C.Wgu2(), DFF, DM, C.H() + (size_t)MPROMPT * DFF, DFF, 0, nullptr, nullptr, 0, 0, stg);
    { pg8::Gemm g{C.XN(), C.Wgu2(), MPROMPT, 2 * DFF, DM}; pg8::StaticOrder S; S.init(MPROMPT, 2 * DFF, GSZ, BX); pg8::EpiSwiglu E{C.H(), DFF};
      pg8::gemm_phase<pg8::EpiSwiglu, pg8::StaticOrder, true, true>(lds, g, S, E); }
    small_gemm<3>(lds, C.XN() + (size_t)MPROMPT * DM, C.Wgu2(), DFF, DM, C.H() + (size_t)MPROMPT * DFF, DFF, 0, nullptr, nullptr, 0, stg, 4); }
    XBAR();
    { const int stg = (BX >> 3) & 3;
    small_gemm<0>(lds, C.H() + (size_t)MPROMPT * DFF, C.Wd2(), DM, DFF, C.D() + (size_t)MPROMPT * DM, DM, 0, nullptr, nullptr, 0, 0, stg);
    { pg8::Gemm g{C.H(), C.Wd2(), MPROMPT, DM, DFF}; pg8::StaticOrder S; S.init(MPROMPT, DM, GSZ, BX); pg8::EpiBf16<0> E{C.D(), DM, 0, nullptr, nullptr, 0};
      pg8::gemm_phase<pg8::EpiBf16<0>, pg8::StaticOrder, true, true>(lds, g, S, E); }
    small_gemm<0>(lds, C.H() + (size_t)MPROMPT * DFF, C.Wd2(), DM, DFF, C.D() + (size_t)MPROMPT * DM, DM, 0, nullptr, nullptr, 0, stg, 4); }
    XBAR();
    { FTID; const float* gp = C.in(32); { const int gw_ = GWV, ngw_ = NGWV, nit = (MPROMPT + 4 * ngw_ - 1) / (4 * ngw_);
      for (int it = 0; it < nit - 1; ++it) rows_res<4, false, true>(C, gw_ + 4 * it * ngw_, ngw_, M, gp, 0.5f, LANE);
      rows_res<5, false, true>(C, gw_ + 4 * (nit - 1) * ngw_, ngw_, MPROMPT + gw_, gp, 0.5f, LANE);
      for (int ms = MPROMPT + gw_ + ngw_; ms < M; ms += ngw_) rows_res<5, false, true>(C, MPROMPT, ngw_, ms, gp, 0.5f, LANE); } }
}

extern "C" void kernel_launch(void* const* d_in, const int* in_sizes, int n_in, void* d_out, int out_size, void* d_ws, size_t ws_size, hipStream_t stream) {
    static int grid = 0;
    if (grid == 0) {
        if (n_in != 33 || ws_size < WS_END) { fprintf(stderr, "kernel_launch: unexpected n_in %d / ws %zu\n", n_in, ws_size); grid = -1; return; }
        int dev = 0, cus = 0, per_cu = 0;
        hipGetDevice(&dev);
        hipDeviceGetAttribute(&cus, hipDeviceAttributeMultiprocessorCount, dev);
        hipFuncSetAttribute((const void*)fwd_kernel, hipFuncAttributeMaxDynamicSharedMemorySize, LDS_BYTES);
        hipOccupancyMaxActiveBlocksPerMultiprocessor(&per_cu, (const void*)fwd_kernel, NTHREADS, LDS_BYTES);
        if (per_cu < 1) { fprintf(stderr, "kernel_launch: occupancy query says %d blocks per CU\n", per_cu); per_cu = 1; }
        grid = cus * per_cu;
    }
    if (grid < 0) return;
    if (hipMemsetAsync((char*)d_ws + WS_CTL, 0, CTL_ZERO_BYTES, stream) != hipSuccess) { fprintf(stderr, "memset failed\n"); return; }
    Args a{};
    for (int i = 0; i < 33; ++i) a.in[i] = (const float*)d_in[i];
    a.out = (float*)d_out; a.ws = (unsigned char*)d_ws;
    void* params[] = {&a};
    hipError_t e = hipLaunchCooperativeKernel((const void*)fwd_kernel, dim3(grid), dim3(NTHREADS), params, LDS_BYTES, stream);
    if (e != hipSuccess) fprintf(stderr, "cooperative launch failed: %s (grid %d)\n", hipGetErrorString(e), grid);
}
```

```cpp
#include <hip/hip_runtime.h>
#include <hip/hip_cooperative_groups.h>
#include <cstdio>
#include <cstdint>
namespace cg = cooperative_groups;
__device__ __forceinline__ int fresh_tid() { int t = (int)threadIdx.x; asm volatile("" : "+v"(t)); return t; }
namespace pg8 {
#define PG8_LAS __attribute__((address_space(3)))
typedef unsigned short bf16_t;
typedef short bf16x8 __attribute__((ext_vector_type(8)));
typedef float f32x4 __attribute__((ext_vector_type(4)));
typedef unsigned u32x4 __attribute__((ext_vector_type(4)));
constexpr int BM = 256, BK = 64, HALF = 128, HTB = HALF * BK * 2  , STAGE_BYTES = 8 * HTB, NXCD = 8, WGM = 8;

__host__ __device__ __forceinline__ int lds_byte(int r, int c) { const int st = (r >> 4) * 2 + (c >> 5), rr = r & 15, cc = c & 31, ob = rr * 64 + cc * 2; return st * 1024 + (ob ^ (((ob >> 9) & 1) << 5)); }
__host__ __device__ __forceinline__ void stage_rc(int b, int& R, int& C) { const int st = b / 1024, sb = b % 1024, swz = sb ^ (((sb >> 9) & 1) << 5); R = (st >> 1) * 16 + swz / 64; C = (st & 1) * 32 + (swz % 64) / 2; }
__host__ __device__ __forceinline__ int perm32(int rho) { const int n = rho >> 4, i = rho & 15; return 8 * (i >> 2) + 4 * n + (i & 3); }

struct Unit { int pm, pn; };
struct Gemm { const bf16_t* A; const bf16_t* Bt; int M, N, K; };

struct StaticOrder {
    int nM, nN, nwg, G, c;
    __host__ __device__ void init(int M, int N, int G_, int c_) { nM = M / BM; nN = N / BM; nwg = nM * nN; G = G_; c = c_; }
    __host__ __device__ bool next(int i, Unit& u) const {
        const long L = (long)i * G + c; if (L >= nwg) return false;
        int wgid = (int)L; { const int q = nwg / NXCD, r = nwg % NXCD, xcd = wgid % NXCD, off = wgid / NXCD; wgid = (xcd < r ? xcd * (q + 1) : r * (q + 1) + (xcd - r) * q) + off; }
        const int nig = WGM * nN, gid = wgid / nig, fm = gid * WGM, gsz = (nM - fm) < WGM ? (nM - fm) : WGM;
        u.pm = fm + ((wgid % nig) % gsz); u.pn = (wgid % nig) / gsz; return true;
    }
    __device__ __forceinline__ void a_ready(const Unit&) const {}
    __device__ __forceinline__ void done(const Unit&) const {}
};

__device__ __forceinline__ unsigned cvt_pk_bf16(float lo, float hi) { unsigned r; asm volatile("v_cvt_pk_bf16_f32 %0, %1, %2" : "=v"(r) : "v"(lo), "v"(hi)); return r; }
__device__ __forceinline__ float bf_lo(unsigned w) { return __uint_as_float(w << 16); }
__device__ __forceinline__ float bf_hi(unsigned w) { return __uint_as_float(w & 0xffff0000u); }
__device__ __forceinline__ float sigmoid_f(float x) { return __builtin_amdgcn_rcpf(1.0f + __expf(-x)); }
__device__ __forceinline__ float silu_f(float x) { return x * sigmoid_f(x); }
__device__ __forceinline__ float gelu_t(float x) { const float u = 1.5957691216057308f * (x + 0.044715f * x * x * x); return x * sigmoid_f(u); }

struct EpiSwiglu {
    static constexpr bool PERM = true, AFTER_DRAIN = false;
    bf16_t* O; int ldc;
    __device__ __forceinline__ void operator()(const f32x4 (&acc)[2][2][4][2], const Unit& u, int wr, int wc, int fr, int fq) const {
        const int row0 = u.pm * BM + wr * 64 + fr; const int col0 = u.pn * HALF + wc * 32 + 8 * fq;
#pragma unroll
        for (int ai = 0; ai < 2; ++ai)
#pragma unroll
            for (int m = 0; m < 4; ++m) {
                bf16_t* rowp = O + (size_t)(row0 + ai * HALF + m * 16) * ldc + col0;
                const f32x4 g0 = acc[ai][0][m][0], g1 = acc[ai][0][m][1], u0 = acc[ai][1][m][0], u1 = acc[ai][1][m][1];
                u32x4 w;
                w.x = cvt_pk_bf16(silu_f(g0[0]) * u0[0], silu_f(g0[1]) * u0[1]); w.y = cvt_pk_bf16(silu_f(g0[2]) * u0[2], silu_f(g0[3]) * u0[3]);
                w.z = cvt_pk_bf16(silu_f(g1[0]) * u1[0], silu_f(g1[1]) * u1[1]); w.w = cvt_pk_bf16(silu_f(g1[2]) * u1[2], silu_f(g1[3]) * u1[3]);
                *(u32x4*)rowp = w;
            }
    }
};
template <int MODE> struct EpiBf16 {
    static constexpr bool PERM = true, AFTER_DRAIN = false;
    bf16_t* O; int ldc; int act_cols; const float* bias; const bf16_t* Y; int ldy;
    __device__ __forceinline__ void operator()(const f32x4 (&acc)[2][2][4][2], const Unit& u, int wr, int wc, int fr, int fq) const {
        const int row0 = u.pm * BM + wr * 64 + fr; const int col0 = u.pn * BM + wc * 32 + 8 * fq;
#pragma unroll
        for (int bj = 0; bj < 2; ++bj) {
            const int col = col0 + bj * HALF;
            f32x4 b0 = (f32x4){0.f, 0.f, 0.f, 0.f}, b1 = b0;
            if (MODE == 2) { b0 = *(const f32x4*)(bias + col); b1 = *(const f32x4*)(bias + col + 4); }
            const bool act = (MODE == 1) && (col < act_cols);
#pragma unroll
            for (int ai = 0; ai < 2; ++ai)
#pragma unroll
                for (int m = 0; m < 4; ++m) {
                    const size_t row = (size_t)(row0 + ai * HALF + m * 16);
                    f32x4 v0 = acc[ai][bj][m][0], v1 = acc[ai][bj][m][1];
                    if (MODE == 1) { if (act) {
#pragma unroll
                        for (int j = 0; j < 4; ++j) { v0[j] = gelu_t(v0[j]); v1[j] = gelu_t(v1[j]); } } }
                    if (MODE == 2) {
                        const u32x4 y = *(const u32x4*)(Y + row * ldy + col);
                        v0 = v0 + b0; v1 = v1 + b1;
                        v0[0] = bf_lo(y.x) * sigmoid_f(v0[0]); v0[1] = bf_hi(y.x) * sigmoid_f(v0[1]); v0[2] = bf_lo(y.y) * sigmoid_f(v0[2]); v0[3] = bf_hi(y.y) * sigmoid_f(v0[3]);
                        v1[0] = bf_lo(y.z) * sigmoid_f(v1[0]); v1[1] = bf_hi(y.z) * sigmoid_f(v1[1]); v1[2] = bf_lo(y.w) * sigmoid_f(v1[2]); v1[3] = bf_hi(y.w) * sigmoid_f(v1[3]);
                    }
                    u32x4 w; w.x = cvt_pk_bf16(v0[0], v0[1]); w.y = cvt_pk_bf16(v0[2], v0[3]); w.z = cvt_pk_bf16(v1[0], v1[1]); w.w = cvt_pk_bf16(v1[2], v1[3]);
                    *(u32x4*)(O + row * ldc + col) = w;
                }
        }
    }
};

template <class Epi, class Sched, bool ALIGN_EPI = false, bool SP2 = false>
__device__ __forceinline__ void gemm_phase(PG8_LAS unsigned char* lds, const Gemm g, const Sched& S, const Epi& E) {
    const int tid = fresh_tid(), wid = __builtin_amdgcn_readfirstlane(tid >> 6), lane = tid & 63, wr = wid >> 2, wc = wid & 3, fr = lane & 15, fq = lane >> 4;
    const int K = g.K, nt = K / BK;
    unsigned voffA[2], voffB[2];
#pragma unroll
    for (int i = 0; i < 2; ++i) { int R, C; stage_rc(tid * 16 + i * 8192, R, C); const int Rb = Epi::PERM ? ((R & ~31) + perm32(R & 31)) : R;
        voffA[i] = (unsigned)(R * K + C) * 2u; voffB[i] = (unsigned)(Rb * K + C) * 2u; }
    const size_t kstep = (size_t)(BK * 2);
    const size_t hstep = (size_t)HALF * K * 2;
    const size_t tstep = 2 * hstep;
    const unsigned ldsw = (unsigned)wid * 1024u;
    const int aoff = lds_byte(wr * 64 + fr, fq * 8), boff = lds_byte(wc * 32 + fr, fq * 8);
#define PG8_SA(b, h) (((b) * 2 + (h)) * HTB)
#define PG8_SB(b, h) ((4 + (b) * 2 + (h)) * HTB)
#define PG8_STAGE(bufoff, gbase, voff) do { _Pragma("unroll") for (int _i = 0; _i < 2; ++_i) \
        __builtin_amdgcn_global_load_lds((const unsigned*)((const char*)(gbase) + (voff)[_i]), (PG8_LAS unsigned*)(lds + (bufoff) + ldsw + _i * 8192), 16, 0, 0); } while (0)
#define PG8_LDA(dst, b, h) do { _Pragma("unroll") for (int m = 0; m < 4; ++m) _Pragma("unroll") for (int k = 0; k < 2; ++k) dst[m][k] = *(const PG8_LAS bf16x8*)(lds + PG8_SA(b, h) + aoff + m * 2048 + k * 1024); } while (0)
#define PG8_LDB(dst, b, h) do { _Pragma("unroll") for (int n = 0; n < 2; ++n) _Pragma("unroll") for (int k = 0; k < 2; ++k) dst[n][k] = *(const PG8_LAS bf16x8*)(lds + PG8_SB(b, h) + boff + n * 2048 + k * 1024); } while (0)
#define PG8_MMA(ai, bj, At, Bt) do { __builtin_amdgcn_s_setprio(1); _Pragma("unroll") for (int m = 0; m < 4; ++m) _Pragma("unroll") for (int n = 0; n < 2; ++n) _Pragma("unroll") for (int k = 0; k < 2; ++k) \
        acc[ai][bj][m][n] = __builtin_amdgcn_mfma_f32_16x16x32_bf16(Bt[n][k], At[m][k], acc[ai][bj][m][n], 0, 0, 0); __builtin_amdgcn_s_setprio(0); } while (0)
#define PG8_WAIT_V(n) asm volatile("s_waitcnt vmcnt(" #n ")" ::: "memory")
#define PG8_WAIT_L(n) asm volatile("s_waitcnt lgkmcnt(" #n ")" ::: "memory")
#define PG8_BAR __builtin_amdgcn_s_barrier()
#define PG8_SCHED __builtin_amdgcn_sched_barrier(0)
    Unit cur, nxt; int ui = 0;
    if (!S.next(0, cur)) return;
    f32x4 acc[2][2][4][2];
#pragma unroll
    for (int a = 0; a < 2; ++a)
#pragma unroll
        for (int b = 0; b < 2; ++b)
#pragma unroll
            for (int m = 0; m < 4; ++m)
#pragma unroll
                for (int n = 0; n < 2; ++n) acc[a][b][m][n] = (f32x4){0.f, 0.f, 0.f, 0.f};
    bf16x8 At[4][2], B0[2][2], B1[2][2];
    const char* cA = (const char*)g.A + (size_t)cur.pm * tstep; const char* cB = (const char*)g.Bt + (size_t)cur.pn * tstep;
    S.a_ready(cur);
    if constexpr (SP2) {
        PG8_STAGE(PG8_SB(0, 0), cB, voffB); PG8_STAGE(PG8_SB(0, 1), cB + hstep, voffB); PG8_STAGE(PG8_SA(0, 0), cA, voffA); PG8_STAGE(PG8_SA(0, 1), cA + hstep, voffA);
        if (wr == 1) PG8_BAR;
        PG8_WAIT_V(2); PG8_BAR;
        PG8_STAGE(PG8_SB(1, 0), cB + kstep, voffB); PG8_STAGE(PG8_SA(1, 0), cA + kstep, voffA); PG8_STAGE(PG8_SB(1, 1), cB + hstep + kstep, voffB);
        PG8_WAIT_V(6); PG8_BAR;
    } else {
        PG8_STAGE(PG8_SB(0, 0), cB, voffB); PG8_STAGE(PG8_SA(0, 0), cA, voffA); PG8_STAGE(PG8_SB(0, 1), cB + hstep, voffB); PG8_STAGE(PG8_SA(0, 1), cA + hstep, voffA);
        if (wr == 1) PG8_BAR;
        PG8_WAIT_V(4); PG8_BAR;
        PG8_STAGE(PG8_SB(1, 0), cB + kstep, voffB); PG8_STAGE(PG8_SA(1, 0), cA + kstep, voffA); PG8_STAGE(PG8_SB(1, 1), cB + hstep + kstep, voffB);
        PG8_WAIT_V(6); PG8_BAR;
    }
    for (;;) {
        const bool has_next = S.next(ui + 1, nxt);
        const char* nA = has_next ? (const char*)g.A + (size_t)nxt.pm * tstep : cA; const char* nB = has_next ? (const char*)g.Bt + (size_t)nxt.pn * tstep : cB;
        for (int t = 0; t < nt; t += 2) {
            const bool last = (t == nt - 2);
            const char* a1 = cA + (size_t)(t + 1) * kstep;
            const char* a2 = last ? nA : cA + (size_t)(t + 2) * kstep; const char* b2 = last ? nB : cB + (size_t)(t + 2) * kstep;
            const char* a3 = a2 + kstep; const char* b3 = b2 + kstep;
            if (last && has_next) S.a_ready(nxt);
            if constexpr (SP2) {
            PG8_LDB(B0, 0, 0); PG8_LDB(B1, 0, 1); PG8_SCHED; PG8_LDA(At, 0, 0); PG8_STAGE(PG8_SA(1, 1), a1 + hstep, voffA);
            PG8_WAIT_V(8); PG8_WAIT_L(0); PG8_BAR; PG8_MMA(0, 0, At, B0); PG8_MMA(0, 1, At, B1); PG8_BAR; PG8_SCHED;
            PG8_LDA(At, 0, 1); PG8_STAGE(PG8_SB(0, 0), b2, voffB); PG8_STAGE(PG8_SB(0, 1), b2 + hstep, voffB); PG8_STAGE(PG8_SA(0, 0), a2, voffA);
            PG8_WAIT_V(8); PG8_WAIT_L(0); PG8_BAR; PG8_MMA(1, 0, At, B0); PG8_MMA(1, 1, At, B1); PG8_BAR; PG8_SCHED;
            PG8_LDB(B0, 1, 0); PG8_LDB(B1, 1, 1); PG8_SCHED; PG8_LDA(At, 1, 0); PG8_STAGE(PG8_SA(0, 1), a2 + hstep, voffA);
            PG8_WAIT_V(8); PG8_WAIT_L(0); PG8_BAR; PG8_MMA(0, 0, At, B0); PG8_MMA(0, 1, At, B1); PG8_BAR; PG8_SCHED;
            PG8_LDA(At, 1, 1); PG8_STAGE(PG8_SB(1, 0), b3, voffB); PG8_STAGE(PG8_SB(1, 1), b3 + hstep, voffB); PG8_STAGE(PG8_SA(1, 0), a3, voffA);
            PG8_WAIT_V(8); PG8_WAIT_L(0); PG8_BAR; PG8_MMA(1, 0, At, B0); PG8_MMA(1, 1, At, B1); PG8_BAR; PG8_SCHED;
            } else {
            PG8_LDB(B0, 0, 0); PG8_SCHED; PG8_LDA(At, 0, 0); PG8_STAGE(PG8_SA(1, 1), a1 + hstep, voffA);
            PG8_WAIT_L(8); PG8_BAR; PG8_WAIT_L(0); PG8_MMA(0, 0, At, B0); PG8_BAR; PG8_SCHED;
            PG8_LDB(B1, 0, 1); PG8_STAGE(PG8_SB(0, 0), b2, voffB);
            PG8_BAR; PG8_WAIT_L(0); PG8_MMA(0, 1, At, B1); PG8_BAR;
            PG8_LDA(At, 0, 1); PG8_STAGE(PG8_SA(0, 0), a2, voffA);
            PG8_BAR; PG8_WAIT_L(0); PG8_MMA(1, 0, At, B0); PG8_BAR; PG8_SCHED;
            PG8_STAGE(PG8_SB(0, 1), b2 + hstep, voffB);
            PG8_WAIT_V(6); PG8_BAR; PG8_MMA(1, 1, At, B1); PG8_BAR;
            PG8_LDB(B0, 1, 0); PG8_SCHED; PG8_LDA(At, 1, 0); PG8_STAGE(PG8_SA(0, 1), a2 + hstep, voffA);
            PG8_WAIT_L(8); PG8_BAR; PG8_WAIT_L(0); PG8_MMA(0, 0, At, B0); PG8_BAR; PG8_SCHED;
            PG8_LDB(B1, 1, 1); PG8_STAGE(PG8_SB(1, 0), b3, voffB);
            PG8_BAR; PG8_WAIT_L(0); PG8_MMA(0, 1, At, B1); PG8_BAR;
            PG8_LDA(At, 1, 1); PG8_STAGE(PG8_SA(1, 0), a3, voffA);
            PG8_BAR; PG8_WAIT_L(0); PG8_MMA(1, 0, At, B0); PG8_BAR; PG8_SCHED;
            PG8_STAGE(PG8_SB(1, 1), b3 + hstep, voffB);
            PG8_WAIT_V(6); PG8_BAR; PG8_MMA(1, 1, At, B1); PG8_BAR;
            }
        }
        if constexpr (ALIGN_EPI) { if (wr == 0) PG8_BAR; }
        if constexpr (!Epi::AFTER_DRAIN) { E(acc, cur, wr, wc, fr, fq); S.done(cur); }
        if (!has_next) break;
#pragma unroll
        for (int a = 0; a < 2; ++a)
#pragma unroll
            for (int b = 0; b < 2; ++b)
#pragma unroll
                for (int m = 0; m < 4; ++m)
#pragma unroll
                    for (int n = 0; n < 2; ++n) acc[a][b][m][n] = (f32x4){0.f, 0.f, 0.f, 0.f};
        cur = nxt; cA = nA; cB = nB; ++ui;
        if constexpr (ALIGN_EPI) { if (wr == 1) PG8_BAR; }
    }
    PG8_WAIT_V(0);
    if constexpr (!ALIGN_EPI) { if (wr == 0) PG8_BAR; }
    PG8_BAR;
    if constexpr (Epi::AFTER_DRAIN) { E.fused(acc, cur, wr, wc, fr, fq, lds, wid, lane); S.done(cur); }
#undef PG8_SA
#undef PG8_SB
#undef PG8_STAGE
#undef PG8_LDA
#undef PG8_LDB
#undef PG8_MMA
#undef PG8_WAIT_V
#undef PG8_WAIT_L
#undef PG8_BAR
#undef PG8_SCHED
}
}

constexpr int DM = 1024, SEQ = 16384, NBATCH = 2, MPROMPT = NBATCH * SEQ, DEC_B = 8, DEC_S = 16;
constexpr int M = MPROMPT + DEC_B * DEC_S;
constexpr int MPAD = 33024;
constexpr int DFF = 2816, DIN = 1536, AW = 512, BWD = 512, NG = 32, NP = 64, GN = 16;
constexpr int NTILE = M / 128;
constexpr float EPS = 1e-6f;
constexpr int NWAVES = 8, NTHREADS = 512;

constexpr size_t MiB = 1u << 20;
constexpr size_t WS_WGU1 = 1 * MiB, WS_WD1 = 12 * MiB, WS_WIN = 18 * MiB, WS_WGLU = 21 * MiB, WS_WOUT = 22 * MiB, WS_WGU2 = 24 * MiB, WS_WD2 = 35 * MiB;
constexpr size_t WS_WEFF = 41 * MiB, WS_BB = 42 * MiB, WS_CM = 42 * MiB + 131072, WS_LAM = 42 * MiB + 262144, WS_RS = 42 * MiB + 524288, WS_E = 43 * MiB;
constexpr size_t WS_XN = 48 * MiB, WS_D = 113 * MiB, WS_H = 178 * MiB, WS_Z = 178 * MiB, WS_YB = 275 * MiB, WS_MIX = 356 * MiB, WS_END = 421 * MiB;
static_assert(WS_XN + (size_t)MPAD * DM * 2 <= WS_D && WS_D + (size_t)MPAD * DM * 2 <= WS_H && WS_H + (size_t)MPAD * DFF * 2 <= WS_MIX, "ws map");
static_assert(WS_Z + (size_t)MPAD * DIN * 2 <= WS_YB && WS_YB + (size_t)MPAD * BWD * 2 <= WS_H + (size_t)MPAD * DFF * 2 && WS_MIX + (size_t)MPAD * DM * 2 <= WS_END, "ws map 2");
static_assert(WS_E + (size_t)NTILE * NG * NP * 8 <= WS_XN, "ws map 3");

constexpr size_t OFF_Y = 0, OFF_SRE_P = (size_t)M * DM, OFF_SIM_P = OFF_SRE_P + NBATCH * NG * NP, OFF_SRE_S = OFF_SIM_P + NBATCH * NG * NP,
                 OFF_SIM_S = OFF_SRE_S + DEC_B * NG * NP, OFF_V_S = OFF_SIM_S + DEC_B * NG * NP;

constexpr int OT_STRIDE = 520;
constexpr int VT_STRIDE = 136;
constexpr int LDS_BYTES = 147456;
static_assert(128 * VT_STRIDE * 2 + 4096 <= LDS_BYTES - 64 && 128 * OT_STRIDE * 2 <= LDS_BYTES - 64, "lds map");

#define LAS __attribute__((address_space(3)))
typedef unsigned short bf16;
typedef float v4f __attribute__((ext_vector_type(4)));
typedef float v2f __attribute__((ext_vector_type(2)));
typedef float v16f __attribute__((ext_vector_type(16)));
typedef unsigned v4u __attribute__((ext_vector_type(4)));
typedef unsigned v2u __attribute__((ext_vector_type(2)));
typedef short bfx8 __attribute__((ext_vector_type(8)));
#define LDS_FENCE() asm volatile("s_waitcnt lgkmcnt(0)" ::: "memory")

using pg8::cvt_pk_bf16; using pg8::bf_lo; using pg8::bf_hi; using pg8::gelu_t;

__device__ __forceinline__ float wave_sum(float v) {
#pragma unroll
    for (int o = 1; o < 64; o <<= 1) v += __shfl_xor(v, o);
    return v;
}
typedef __bf16 bf16x2_t __attribute__((ext_vector_type(2)));
__device__ __forceinline__ unsigned cvt_pk_c(float lo, float hi) { const v2f v = {lo, hi}; const bf16x2_t b = __builtin_convertvector(v, bf16x2_t); return __builtin_bit_cast(unsigned, b); }
__device__ __forceinline__ unsigned cvt_pk_nv(float lo, float hi) { unsigned r; asm("v_cvt_pk_bf16_f32 %0, %1, %2" : "=v"(r) : "v"(lo), "v"(hi)); return r; }
__device__ __forceinline__ bf16 f2bf(float f) { return (bf16)(cvt_pk_nv(f, 0.f) & 0xffffu); }


__device__ __forceinline__ double dexp(double x) {
    const double y = x * (1.0 / 256.0); double t = 1.0;
#pragma unroll
    for (int i = 12; i >= 1; --i) t = 1.0 + t * y * (1.0 / (double)i);
#pragma unroll
    for (int i = 0; i < 8; ++i) t = t * t;
    return t;
}
__device__ __forceinline__ void dsincos(double x, double& s, double& c) {
    const double twopi = 6.283185307179586476925286766559;
    const double k = rint(x * (1.0 / twopi)); const double r = x - k * twopi, r2 = r * r;
    double ts = r, tc = 1.0; s = r; c = 1.0;
#pragma unroll
    for (int i = 1; i <= 15; ++i) { tc = -tc * r2 * (1.0 / (double)((2 * i - 1) * (2 * i))); ts = -ts * r2 * (1.0 / (double)((2 * i) * (2 * i + 1))); c += tc; s += ts; }
}

typedef const float* cfp_t;
typedef __attribute__((address_space(4))) cfp_t const* kin_t;
__device__ __forceinline__ const float* karg_in(int i) {
    auto k = __builtin_amdgcn_kernarg_segment_ptr();
    asm volatile("" : "+s"(k));
    return ((kin_t)k)[i];
}
struct Ctx {
    __device__ __forceinline__ const float* in(int i) const { return karg_in(i); }
    __device__ __forceinline__ float* out() const { return (float*)karg_in(33); }
    __device__ __forceinline__ unsigned char* ws() const { return (unsigned char*)karg_in(34); }
#define WSP(name, T, off) __device__ __forceinline__ T* name() const { return (T*)(ws() + (off)); }
    WSP(Wgu1, bf16, WS_WGU1) WSP(Wd1, bf16, WS_WD1) WSP(Win, bf16, WS_WIN) WSP(Wglu, bf16, WS_WGLU) WSP(Wout, bf16, WS_WOUT) WSP(Wgu2, bf16, WS_WGU2) WSP(Wd2, bf16, WS_WD2)
    WSP(Weff, bf16, WS_WEFF) WSP(BB, bf16, WS_BB) WSP(CM, bf16, WS_CM) WSP(XN, bf16, WS_XN) WSP(D, bf16, WS_D) WSP(H, bf16, WS_H) WSP(Z, bf16, WS_Z) WSP(YB, bf16, WS_YB) WSP(MIX, bf16, WS_MIX)
    WSP(LAM, float, WS_LAM) WSP(E, float, WS_E) WSP(RS, float, WS_RS)
#undef WSP
};

__device__ __forceinline__ void p0_block_item(const float* W, const float* gk, int K, int N, bf16* WT, int mode, int item, LAS float* tile, int tid) {
    const int nblk = N / 256, kb = item / nblk, nb = item % nblk, k0 = 64 * kb, n0 = 256 * nb;
    const int lr = tid >> 6, lc = 4 * (tid & 63);
    v4f v[8];
#pragma unroll
    for (int i = 0; i < 8; ++i) v[i] = __builtin_nontemporal_load((const v4f*)(W + (size_t)(k0 + lr + 8 * i) * N + n0 + lc));
    if (gk) {
#pragma unroll
        for (int i = 0; i < 8; ++i) v[i] = v[i] * gk[k0 + lr + 8 * i];
    }
    __syncthreads();
#pragma unroll
    for (int i = 0; i < 8; ++i) { LAS float* p = tile + (lr + 8 * i) * 257 + lc; p[0] = v[i].x; p[1] = v[i].y; p[2] = v[i].z; p[3] = v[i].w; }
    __syncthreads();
    const int c = tid & 7;
#pragma unroll
    for (int j = 0; j < 4; ++j) {
        const int n = (tid >> 3) + 64 * j, ng = n0 + n;
        const int drow = (mode == 0) ? ng : (256 * (ng >> 7) + (ng & 127) + (mode == 2 ? 128 : 0));
        const LAS float* sp = tile + (8 * c) * 257 + n;
        v4u o; o.x = cvt_pk_nv(sp[0 * 257], sp[1 * 257]); o.y = cvt_pk_nv(sp[2 * 257], sp[3 * 257]); o.z = cvt_pk_nv(sp[4 * 257], sp[5 * 257]); o.w = cvt_pk_nv(sp[6 * 257], sp[7 * 257]);
        *(v4u*)(WT + (size_t)drow * K + k0 + 8 * c) = o;
    }
}
__device__ __forceinline__ const float* xrow_ptr(const Ctx& C, int row) { return row < MPROMPT ? C.in(0) + (size_t)row * DM : C.in(1) + (size_t)(row - MPROMPT) * DM; }

__device__ __forceinline__ v4f ld4_f32(const float* p) { return *(const v4f*)p; }
__device__ __forceinline__ v4f ld4_bf16(const bf16* p) { const v2u w = *(const v2u*)p; return (v4f){bf_lo(w.x), bf_hi(w.x), bf_lo(w.y), bf_hi(w.y)}; }
__device__ __forceinline__ void st4_bf16(bf16* p, v4f o) { v2u w; w.x = cvt_pk_nv(o.x, o.y); w.y = cvt_pk_nv(o.z, o.w); *(v2u*)p = w; }
__device__ __forceinline__ float ssq4(v4f v) { return (v.x * v.x + v.y * v.y) + (v.z * v.z + v.w * v.w); }
template <int R>
__device__ __forceinline__ void rows_x0(const Ctx& C, int m0, int stride, int mx, int lane) {
    v4f v[R][4]; float ss[R]; int mr[R]; bool ok[R];
#pragma unroll
    for (int r = 0; r < R; ++r) { mr[r] = (r == 4) ? mx : m0 + r * stride; ok[r] = (r == 4) ? (mx < M) : (mr[r] < MPROMPT); const float* x = xrow_ptr(C, ok[r] ? mr[r] : 0);
#pragma unroll
        for (int j = 0; j < 4; ++j) v[r][j] = __builtin_nontemporal_load((const v4f*)(x + 4 * lane + 256 * j)); }
    bf16* XN = C.XN();
#pragma unroll
    for (int r = 0; r < R; ++r) { float s = 0.f;
#pragma unroll
        for (int j = 0; j < 4; ++j) s += ssq4(v[r][j]);
        ss[r] = s; }
    float* rs = C.RS();
#pragma unroll
    for (int r = 0; r < R; ++r) ss[r] = wave_sum(ss[r]) * (1.f / DM) + EPS;
#pragma unroll
    for (int r = 0; r < R; ++r) { const float rstd = rsqrtf(ss[r]);
#pragma unroll
        for (int j = 0; j < 4; ++j) if (ok[r]) st4_bf16(XN + (size_t)mr[r] * DM + 4 * lane + 256 * j, v[r][j] * rstd);
        if (lane == 0 && ok[r]) rs[mr[r]] = sqrtf(ss[r]); }
}
template <int R, bool BASE_F32, bool OUT_F32>
__device__ __forceinline__ void rows_res(const Ctx& C, int m0, int stride, int mx, const float* gpost, float scale, int lane) {
    v4f d[R][4], b[R][4]; int mr[R]; bool ok[R]; float r1[R];
    const bf16* D = C.D(); bf16* XN = C.XN();
#pragma unroll
    for (int r = 0; r < R; ++r) { mr[r] = (r == 4) ? mx : m0 + r * stride; ok[r] = (r == 4) ? (mx < M) : (mr[r] < MPROMPT); const int mm = ok[r] ? mr[r] : 0;
#pragma unroll
        for (int j = 0; j < 4; ++j) d[r][j] = ld4_bf16(D + (size_t)mm * DM + 4 * lane + 256 * j);
        if (BASE_F32) { const float* x = xrow_ptr(C, mm);
#pragma unroll
            for (int j = 0; j < 4; ++j) b[r][j] = ld4_f32(x + 4 * lane + 256 * j);
        } else { const float inv = C.RS()[mm];
#pragma unroll
            for (int j = 0; j < 4; ++j) b[r][j] = ld4_bf16(XN + (size_t)mm * DM + 4 * lane + 256 * j) * inv;
        } }
#pragma unroll
    for (int r = 0; r < R; ++r) { float s = 0.f;
#pragma unroll
        for (int j = 0; j < 4; ++j) s += ssq4(d[r][j]);
        r1[r] = s; }
#pragma unroll
    for (int r = 0; r < R; ++r) r1[r] = rsqrtf(wave_sum(r1[r]) * (1.f / DM) + EPS) * scale;
#pragma unroll
    for (int j = 0; j < 4; ++j) { const v4f gp = ld4_f32(gpost + 4 * lane + 256 * j);
#pragma unroll
        for (int r = 0; r < R; ++r) d[r][j] = b[r][j] + d[r][j] * r1[r] * gp; }
    if (OUT_F32) { float* Y = C.out();
#pragma unroll
        for (int r = 0; r < R; ++r)
#pragma unroll
            for (int j = 0; j < 4; ++j) if (ok[r]) *(v4f*)(Y + (size_t)mr[r] * DM + 4 * lane + 256 * j) = d[r][j];
    } else { float* rs = C.RS(); float t[R];
#pragma unroll
        for (int r = 0; r < R; ++r) { float s = 0.f;
#pragma unroll
            for (int j = 0; j < 4; ++j) s += ssq4(d[r][j]);
            t[r] = s; }
#pragma unroll
        for (int r = 0; r < R; ++r) t[r] = wave_sum(t[r]) * (1.f / DM) + EPS;
#pragma unroll
        for (int r = 0; r < R; ++r) { const float rstd = rsqrtf(t[r]);
#pragma unroll
            for (int j = 0; j < 4; ++j) if (ok[r]) st4_bf16(XN + (size_t)mr[r] * DM + 4 * lane + 256 * j, d[r][j] * rstd);
            if (lane == 0 && ok[r]) rs[mr[r]] = sqrtf(t[r]); }
    }
}
template <int R>
__device__ __forceinline__ void rows_norm512(bf16* base, int m0, int stride, int mx, const float* g, int lane) {
    v4u w[R]; float ss[R]; int mr[R]; bool ok[R];
#pragma unroll
    for (int r = 0; r < R; ++r) { mr[r] = (r == 4) ? mx : m0 + r * stride; ok[r] = (r == 4) ? (mx < M) : (mr[r] < MPROMPT);
        w[r] = *(const v4u*)(base + (size_t)(ok[r] ? mr[r] : 0) * DM + 8 * lane); }
    const v4f g0 = *(const v4f*)(g + 8 * lane), g1 = *(const v4f*)(g + 8 * lane + 4);
#pragma unroll
    for (int r = 0; r < R; ++r) { const v4u x = w[r];
        ss[r] = (bf_lo(x.x) * bf_lo(x.x) + bf_hi(x.x) * bf_hi(x.x)) + (bf_lo(x.y) * bf_lo(x.y) + bf_hi(x.y) * bf_hi(x.y)) + (bf_lo(x.z) * bf_lo(x.z) + bf_hi(x.z) * bf_hi(x.z)) + (bf_lo(x.w) * bf_lo(x.w) + bf_hi(x.w) * bf_hi(x.w)); }
#pragma unroll
    for (int r = 0; r < R; ++r) ss[r] = rsqrtf(wave_sum(ss[r]) * (1.f / 512.f) + EPS);
#pragma unroll
    for (int r = 0; r < R; ++r) { const v4u x = w[r]; const float q = ss[r];
        v4u o; o.x = cvt_pk_nv(bf_lo(x.x) * q * g0.x, bf_hi(x.x) * q * g0.y); o.y = cvt_pk_nv(bf_lo(x.y) * q * g0.z, bf_hi(x.y) * q * g0.w);
        o.z = cvt_pk_nv(bf_lo(x.z) * q * g1.x, bf_hi(x.z) * q * g1.y); o.w = cvt_pk_nv(bf_lo(x.w) * q * g1.z, bf_hi(x.w) * q * g1.w);
        if (ok[r]) *(v4u*)(base + (size_t)mr[r] * DM + 8 * lane) = o; }
}

__device__ __forceinline__ void p0_prologue(const Ctx& C, LAS unsigned char* lds, int wave, int lane, int tid) {
    LAS float* tile = (LAS float*)lds;
    const int gw = blockIdx.x * NWAVES + wave, NGW = gridDim.x * NWAVES;
    constexpr int I_GU = (DM / 64) * (DFF / 256), I_D = (DFF / 64) * (DM / 256), I_IN = (DM / 64) * (DIN / 256), I_GLU = (BWD / 64) * (BWD / 256), I_OUT = (DM / 64) * (DM / 256);
    constexpr int NITEMS = 4 * I_GU + 2 * I_D + I_IN + I_GLU + I_OUT;
    for (int it = blockIdx.x; it < NITEMS; it += gridDim.x) {
        int r = it;
        if (r < I_GU) { p0_block_item(C.in(5), C.in(4), DM, DFF, C.Wgu1(), 1, r, tile, tid); continue; } r -= I_GU;
        if (r < I_GU) { p0_block_item(C.in(6), C.in(4), DM, DFF, C.Wgu1(), 2, r, tile, tid); continue; } r -= I_GU;
        if (r < I_GU) { p0_block_item(C.in(29), C.in(28), DM, DFF, C.Wgu2(), 1, r, tile, tid); continue; } r -= I_GU;
        if (r < I_GU) { p0_block_item(C.in(30), C.in(28), DM, DFF, C.Wgu2(), 2, r, tile, tid); continue; } r -= I_GU;
        if (r < I_D) { p0_block_item(C.in(7), nullptr, DFF, DM, C.Wd1(), 0, r, tile, tid); continue; } r -= I_D;
        if (r < I_D) { p0_block_item(C.in(31), nullptr, DFF, DM, C.Wd2(), 0, r, tile, tid); continue; } r -= I_D;
        if (r < I_IN) { p0_block_item(C.in(10), C.in(9), DM, DIN, C.Win(), 0, r, tile, tid); continue; } r -= I_IN;
        if (r < I_GLU) { p0_block_item(C.in(22), nullptr, BWD, BWD, C.Wglu(), 0, r, tile, tid); continue; } r -= I_GLU;
        p0_block_item(C.in(26), nullptr, DM, DM, C.Wout(), 0, r, tile, tid);
    }
    { const int nit = (MPROMPT + 4 * NGW - 1) / (4 * NGW);
      for (int it = 0; it < nit - 1; ++it) rows_x0<4>(C, gw + 4 * it * NGW, NGW, M, lane);
      rows_x0<5>(C, gw + 4 * (nit - 1) * NGW, NGW, MPROMPT + gw, lane);
      for (int ms = MPROMPT + gw + NGW; ms < M; ms += NGW) rows_x0<5>(C, MPROMPT, NGW, ms, lane); }
    const int gt = blockIdx.x * NTHREADS + tid, NGT = gridDim.x * NTHREADS;
    for (int idx = (tid < 8 ? blockIdx.x * 8 + tid : NG * NP); idx < NG * NP; idx += gridDim.x * 8) {
        const int g = idx / NP, p = idx % NP;
        const double lr = (double)C.in(14)[idx], li = (double)C.in(15)[idx], dt = dexp((double)C.in(16)[g]);
        double s1, c1, s8, c8; dsincos(li * dt, s1, c1); dsincos(li * dt * 128.0, s8, c8);
        const double er = dexp(lr * dt), lbr = er * c1, lbi = er * s1;
        const double e8 = dexp(lr * dt * 128.0), l8r = e8 * c8, l8i = e8 * s8;
        C.LAM()[0 * 2048 + idx] = (float)lbr; C.LAM()[1 * 2048 + idx] = (float)lbi; C.LAM()[2 * 2048 + idx] = (float)l8r; C.LAM()[3 * 2048 + idx] = (float)l8i;
        const double a = lbr - 1.0, b = lbi, den = lr * lr + li * li, cr = (a * lr + b * li) / den, ci = (b * lr - a * li) / den;
        for (int n = 0; n < GN; ++n) {
            const double br = (double)C.in(17)[(size_t)idx * GN + n], bi = (double)C.in(18)[(size_t)idx * GN + n];
            C.BB()[((size_t)g * 128 + 2 * p) * GN + n] = f2bf((float)(cr * br - ci * bi));
            C.BB()[((size_t)g * 128 + 2 * p + 1) * GN + n] = f2bf((float)(cr * bi + ci * br));
            C.CM()[((size_t)g * GN + n) * 128 + 2 * p] = f2bf(C.in(19)[((size_t)g * GN + n) * NP + p]);
            C.CM()[((size_t)g * GN + n) * 128 + 2 * p + 1] = f2bf(-C.in(20)[((size_t)g * GN + n) * NP + p]);
        }
    }
    for (int idx = gt; idx < 2 * 4 * 128 * 128; idx += NGT) {
        const int s = idx & 127, t = (idx >> 7) & 127, h = (idx >> 14) & 3, mode = idx >> 16;
        float v;
        if (mode == 0) v = (s <= t) ? C.in(12)[((size_t)h * 128 + t) * 128 + s] : 0.f;
        else v = ((s >> 4) == (t >> 4) && (s & 15) <= (t & 15)) ? C.in(12)[((size_t)h * 128 + (t & 15)) * 128 + (s & 15)] : 0.f;
        C.Weff()[idx] = f2bf(v);
    }
}

constexpr int XU_STRIDE = 72;
constexpr int BH_STRIDE = 136;
constexpr int S5W_BYTES = 32 * XU_STRIDE * 2 + 32 * BH_STRIDE * 2;
static_assert(NWAVES * S5W_BYTES <= LDS_BYTES - 64, "s5 lds");
template <bool PASS2>
__device__ __forceinline__ void s5_tile(const Ctx& C, int T, int sb_lo, int sb_hi, LAS unsigned char* lds, int wave, int lane) {
    const bool sample = (T == NTILE - 1);
    const int r0 = T * 128;
    LAS bf16* XU = (LAS bf16*)(lds + wave * S5W_BYTES);
    LAS bf16* BH = XU + 32 * XU_STRIDE;
    const int tl = lane & 31, hh = lane >> 5, fr = lane & 15, kq = lane >> 4, xrow = lane >> 3, xpart = lane & 7;
    const float* LAM = C.LAM();
    const bf16* Zb = C.Z() + (size_t)1024 + 64 * wave;
    float sr[4], si[4], lr[4], li[4], dsk[4];
#pragma unroll
    for (int gi = 0; gi < 4; ++gi) { const int g = wave * 4 + gi; sr[gi] = 0.f; si[gi] = 0.f; lr[gi] = LAM[0 * 2048 + g * 64 + lane]; li[gi] = LAM[1 * 2048 + g * 64 + lane];
        dsk[gi] = PASS2 ? C.in(21)[16 * g + fr] : 0.f; }
    if (PASS2 && !sample) {
        const int k = T & 127, tb = T - k;
        float l8r[4], l8i[4];
#pragma unroll
        for (int gi = 0; gi < 4; ++gi) { l8r[gi] = LAM[2 * 2048 + (wave * 4 + gi) * 64 + lane]; l8i[gi] = LAM[3 * 2048 + (wave * 4 + gi) * 64 + lane]; }
        const v2f* Ep = (const v2f*)C.E() + ((size_t)tb * NG + wave * 4) * NP + lane;
        const int nb = (k + 15) >> 4, j0 = k - 16 * nb;
        for (int jb = 0; jb < nb; ++jb) {
#pragma unroll
            for (int u = 0; u < 16; ++u) {
                const int j = j0 + 16 * jb + u; const bool ok = j >= 0; const int jc = ok ? j : 0;
#pragma unroll
                for (int gi = 0; gi < 4; ++gi) { v2f e = Ep[(size_t)jc * NG * NP + gi * NP]; if (!ok) e = (v2f){0.f, 0.f};
                    const float nr = fmaf(l8r[gi], sr[gi], fmaf(-l8i[gi], si[gi], e.x)), ni = fmaf(l8r[gi], si[gi], fmaf(l8i[gi], sr[gi], e.y)); sr[gi] = nr; si[gi] = ni; }
            }
        }
    }
    v4u xn[4];
    {
        const int sb0 = sb_lo;
#pragma unroll
        for (int i = 0; i < 4; ++i) xn[i] = *(const v4u*)(Zb + (size_t)(r0 + 32 * sb0 + xrow + 8 * i) * DIN + 8 * xpart);
    }
    const bf16* BBt = C.BB(); const bf16* CMt = C.CM();
    bfx8 bbn[4], cmn[4];
#pragma unroll
    for (int cb = 0; cb < 4; ++cb) bbn[cb] = *(const bfx8*)(BBt + ((size_t)(wave * 4 * 128 + cb * 32 + tl)) * GN + 8 * hh);
    if (PASS2) {
#pragma unroll
        for (int ks = 0; ks < 4; ++ks) cmn[ks] = *(const bfx8*)(CMt + ((size_t)(wave * 4 * GN + fr)) * 128 + 32 * ks + 8 * kq);
    }
    for (int sb = sb_lo; sb < sb_hi; ++sb) {
        const int rb0 = r0 + 32 * sb;
#pragma unroll
        for (int i = 0; i < 4; ++i) *(LAS v4u*)(XU + (xrow + 8 * i) * XU_STRIDE + 8 * xpart) = xn[i];
        if (sb + 1 < sb_hi) {
#pragma unroll
            for (int i = 0; i < 4; ++i) xn[i] = *(const v4u*)(Zb + (size_t)(rb0 + 32 + xrow + 8 * i) * DIN + 8 * xpart);
        }
        LDS_FENCE();
#pragma unroll
        for (int gi = 0; gi < 4; ++gi) {
            const int g = wave * 4 + gi, gnx = wave * 4 + ((gi + 1) & 3);
            bfx8 bb[4], cm[4];
#pragma unroll
            for (int cb = 0; cb < 4; ++cb) { bb[cb] = bbn[cb]; bbn[cb] = *(const bfx8*)(BBt + ((size_t)(gnx * 128 + cb * 32 + tl)) * GN + 8 * hh); }
            if (PASS2) {
#pragma unroll
                for (int ks = 0; ks < 4; ++ks) { cm[ks] = cmn[ks]; cmn[ks] = *(const bfx8*)(CMt + ((size_t)(gnx * GN + fr)) * 128 + 32 * ks + 8 * kq); }
            }
            float s0ar = 0.f, s0ai = 0.f, s0br = 0.f, s0bi = 0.f;
            if (sample) { const size_t o0 = ((size_t)(2 * sb) * NG + g) * NP + lane, o1 = o0 + (size_t)NG * NP;
                s0ar = C.in(2)[o0]; s0ai = C.in(3)[o0]; s0br = C.in(2)[o1]; s0bi = C.in(3)[o1]; }
            const bfx8 a = *(const LAS bfx8*)(XU + tl * XU_STRIDE + 16 * gi + 8 * hh);
#pragma unroll
            for (int cb = 0; cb < 4; ++cb) {
                v16f acc;
#pragma unroll
                for (int r = 0; r < 16; ++r) acc[r] = 0.f;
                acc = __builtin_amdgcn_mfma_f32_32x32x16_bf16(bb[cb], a, acc, 0, 0, 0);
#pragma unroll
                for (int rg = 0; rg < 4; ++rg) { v2u w; w.x = cvt_pk_c(acc[4 * rg], acc[4 * rg + 1]); w.y = cvt_pk_c(acc[4 * rg + 2], acc[4 * rg + 3]);
                    *(LAS v2u*)(BH + tl * BH_STRIDE + cb * 32 + 8 * rg + 4 * hh) = w; }
            }
            LDS_FENCE();
            {
                unsigned bu[32];
#pragma unroll
                for (int t = 0; t < 32; ++t) bu[t] = *(const LAS unsigned*)(BH + t * BH_STRIDE + 2 * lane);
                LDS_FENCE();
                float xr = sr[gi], xi = si[gi];
#pragma unroll
                for (int t = 0; t < 32; ++t) {
                    if (sample && t == 0) { xr = s0ar; xi = s0ai; }
                    if (sample && t == 16) { xr = s0br; xi = s0bi; }
                    const float nr = fmaf(lr[gi], xr, fmaf(-li[gi], xi, bf_lo(bu[t]))), ni = fmaf(lr[gi], xi, fmaf(li[gi], xr, bf_hi(bu[t])));
                    xr = nr; xi = ni;
                    if (PASS2) {
                        *(LAS unsigned*)(BH + t * BH_STRIDE + 2 * lane) = cvt_pk_nv(xr, xi);
                        if (sample && (t & 15) == 15) { const int seq = 2 * sb + (t >> 4);
                            C.out()[OFF_SRE_S + ((size_t)seq * NG + g) * NP + lane] = xr; C.out()[OFF_SIM_S + ((size_t)seq * NG + g) * NP + lane] = xi; }
                    }
                }
                sr[gi] = xr; si[gi] = xi;
            }
            LDS_FENCE();
            if (PASS2) {
#pragma unroll
                for (int rb = 0; rb < 2; ++rb) {
                    v4f acc = (v4f){0.f, 0.f, 0.f, 0.f};
#pragma unroll
                    for (int ks = 0; ks < 4; ++ks) {
                        const bfx8 sa = *(const LAS bfx8*)(BH + (16 * rb + fr) * BH_STRIDE + 32 * ks + 8 * kq);
                        acc = __builtin_amdgcn_mfma_f32_16x16x32_bf16(sa, cm[ks], acc, 0, 0, 0);
                    }
#pragma unroll
                    for (int r = 0; r < 4; ++r) {
                        LAS bf16* up = XU + (16 * rb + 4 * kq + r) * XU_STRIDE + 16 * gi + fr;
                        const float u = __uint_as_float((unsigned)(*up) << 16);
                        *up = f2bf(gelu_t(acc[r] + dsk[gi] * u));
                    }
                }
                LDS_FENCE();
            }
        }
        if (PASS2) {
#pragma unroll
            for (int i = 0; i < 4; ++i) *(v4u*)(C.YB() + (size_t)(rb0 + xrow + 8 * i) * BWD + 64 * wave + 8 * xpart) = *(const LAS v4u*)(XU + (xrow + 8 * i) * XU_STRIDE + 8 * xpart);
            LDS_FENCE();
        }
    }
#pragma unroll
    for (int gi = 0; gi < 4; ++gi) {
        const int g = wave * 4 + gi;
        if (!PASS2) { v2f* Ep = (v2f*)C.E() + ((size_t)T * NG + g) * NP + lane; *Ep = (v2f){sr[gi], si[gi]}; }
        else if (!sample && (T & 127) == 127) { const int b = T >> 7;
            C.out()[OFF_SRE_P + ((size_t)b * NG + g) * NP + lane] = sr[gi]; C.out()[OFF_SIM_P + ((size_t)b * NG + g) * NP + lane] = si[gi]; }
    }
}

__device__ __forceinline__ void gmlp_tile(const Ctx& C, int T, LAS unsigned char* lds, int wave, int lane, int tid) {
    const int mode = (T == NTILE - 1) ? 1 : 0;
    const int r0 = T * 128;
    LAS bf16* VT = (LAS bf16*)lds;
    LAS float* SSQ = (LAS float*)(lds + 128 * VT_STRIDE * 2);
    const int tb = wave & 3, dh = wave >> 2, tl = lane & 31, hh = lane >> 5;
    const int t = 32 * tb + tl;
    unsigned outp[4][2][8]; float ssq = 0.f;
    const bf16* zt = C.Z() + (size_t)(r0 + t) * DIN;
    const int row = tid >> 2, q = tid & 3;
    const bf16* vsrc = C.Z() + (size_t)(r0 + row) * DIN + 512 + q * 32;
    const bf16* Weff = C.Weff();
    v4u vraw[4];
#pragma unroll
    for (int i = 0; i < 4; ++i) vraw[i] = *(const v4u*)(vsrc + 8 * i);
#pragma unroll
    for (int h = 0; h < 4; ++h) {
        bfx8 wf[8];
        const bf16* wrow = Weff + ((size_t)(mode * 4 + h) * 128 + t) * 128 + 8 * hh;
#pragma unroll
        for (int ks = 0; ks < 8; ++ks) wf[ks] = *(const bfx8*)(wrow + 16 * ks);
        v2u uw[2][4];
#pragma unroll
        for (int dbi = 0; dbi < 2; ++dbi)
#pragma unroll
            for (int rg = 0; rg < 4; ++rg) uw[dbi][rg] = *(const v2u*)(zt + h * 128 + 32 * (2 * dh + dbi) + 8 * rg + 4 * hh);
        const float bias = C.in(13)[h * 128 + (mode ? (t & 15) : t)];
        v4f gvv[8];
        { const float* gvp = C.in(11) + h * 128 + q * 32;
#pragma unroll
          for (int i = 0; i < 8; ++i) gvv[i] = *(const v4f*)(gvp + 4 * i); }
        __syncthreads();
        {
            float v[32]; float s = 0.f;
#pragma unroll
            for (int i = 0; i < 4; ++i) { const v4u w = vraw[i];
                v[8 * i + 0] = bf_lo(w.x); v[8 * i + 1] = bf_hi(w.x); v[8 * i + 2] = bf_lo(w.y); v[8 * i + 3] = bf_hi(w.y);
                v[8 * i + 4] = bf_lo(w.z); v[8 * i + 5] = bf_hi(w.z); v[8 * i + 6] = bf_lo(w.w); v[8 * i + 7] = bf_hi(w.w); }
            if (h < 3) {
#pragma unroll
                for (int i = 0; i < 4; ++i) vraw[i] = *(const v4u*)(vsrc + (h + 1) * 128 + 8 * i);
            }
#pragma unroll
            for (int i = 0; i < 32; ++i) s += v[i] * v[i];
            s += __shfl_xor(s, 1); s += __shfl_xor(s, 2);
            const float r = rsqrtf(s * (1.f / 128.f) + EPS);
#pragma unroll
            for (int i = 0; i < 32; ++i) { v[i] = v[i] * r * gvv[i >> 2][i & 3]; VT[(q * 32 + i) * VT_STRIDE + row] = f2bf(v[i]); }
            if (mode) { float* ov = C.out() + OFF_V_S + (size_t)row * AW + h * 128 + q * 32;
#pragma unroll
                for (int i = 0; i < 8; ++i) *(v4f*)(ov + 4 * i) = (v4f){v[4 * i], v[4 * i + 1], v[4 * i + 2], v[4 * i + 3]}; }
        }
        __syncthreads();
#pragma unroll
        for (int dbi = 0; dbi < 2; ++dbi) {
            const int db = 2 * dh + dbi;
            v16f acc;
#pragma unroll
            for (int r = 0; r < 16; ++r) acc[r] = 0.f;
#pragma unroll
            for (int ks = 0; ks < 8; ++ks) {
                const bfx8 va = *(const LAS bfx8*)(VT + (32 * db + tl) * VT_STRIDE + 16 * ks + 8 * hh);
                acc = __builtin_amdgcn_mfma_f32_32x32x16_bf16(va, wf[ks], acc, 0, 0, 0);
            }
#pragma unroll
            for (int rg = 0; rg < 4; ++rg) {
                const v2u u2 = uw[dbi][rg];
                const float o0 = bf_lo(u2.x) * (acc[4 * rg + 0] + bias), o1 = bf_hi(u2.x) * (acc[4 * rg + 1] + bias);
                const float o2 = bf_lo(u2.y) * (acc[4 * rg + 2] + bias), o3 = bf_hi(u2.y) * (acc[4 * rg + 3] + bias);
                ssq += (o0 * o0 + o1 * o1) + (o2 * o2 + o3 * o3);
                outp[h][dbi][2 * rg] = cvt_pk_nv(o0, o1); outp[h][dbi][2 * rg + 1] = cvt_pk_nv(o2, o3);
            }
        }
    }
    ssq += __shfl_xor(ssq, 32);
    if (hh == 0) SSQ[t * 2 + dh] = ssq;
    __syncthreads();
    const float rstd = rsqrtf((SSQ[t * 2] + SSQ[t * 2 + 1]) * (1.f / 512.f) + EPS);
    const float* gap = C.in(24);
    LAS bf16* OT = (LAS bf16*)lds;
    __syncthreads();
#pragma unroll
    for (int h = 0; h < 4; ++h)
#pragma unroll
        for (int dbi = 0; dbi < 2; ++dbi)
#pragma unroll
            for (int rg = 0; rg < 4; ++rg) {
                const int c = h * 128 + 32 * (2 * dh + dbi) + 8 * rg + 4 * hh;
                const v4f ga = *(const v4f*)(gap + c);
                const unsigned w0 = outp[h][dbi][2 * rg], w1 = outp[h][dbi][2 * rg + 1];
                v2u o; o.x = cvt_pk_nv(bf_lo(w0) * rstd * ga.x, bf_hi(w0) * rstd * ga.y); o.y = cvt_pk_nv(bf_lo(w1) * rstd * ga.z, bf_hi(w1) * rstd * ga.w);
                *(LAS v2u*)(OT + t * OT_STRIDE + c) = o;
            }
    __syncthreads();
    {
        bf16* obase = C.MIX() + (size_t)r0 * DM;
#pragma unroll 4
        for (int i = 0; i < 16; ++i) { const int row = wave * 16 + i; *(v4u*)(obase + (size_t)row * DM + 8 * lane) = *(const LAS v4u*)(OT + row * OT_STRIDE + 8 * lane); }
    }
    __syncthreads();
}

#define FTID const int ftid_ = fresh_tid()
#define TID (ftid_)
#define LANE (ftid_ & 63)
#define WAVE (__builtin_amdgcn_readfirstlane(ftid_ >> 6))
#define GSZ ((int)gridDim.x)
#define BX ((int)blockIdx.x)
#define GWV (BX * NWAVES + WAVE)
#define NGWV (GSZ * NWAVES)
constexpr size_t WS_CTL = 0, CTL_ZERO_BYTES = 16384;
constexpr int MISC_OFF = LDS_BYTES - 64;
#define XB_TMO      128
#define XB_XCNT(j)  (256  + 64 * (j))
#define XB_XSUB(j)  (1280 + 64 * (j))
#define XB_XGEN(j)  (2304 + 64 * (j))
#define XB_TOP      3328
#define XB_TOPGEN   3392
#define XCD_BAR_WORDS 3456
#define XB_SPIN_CAP (1u << 18)

__device__ __forceinline__ unsigned xb_ld(unsigned* p)              { return __hip_atomic_load(p, __ATOMIC_RELAXED, __HIP_MEMORY_SCOPE_AGENT); }
__device__ __forceinline__ unsigned xb_add(unsigned* p, unsigned v) { return __hip_atomic_fetch_add(p, v, __ATOMIC_RELAXED, __HIP_MEMORY_SCOPE_AGENT); }
__device__ __forceinline__ unsigned xb_xcc_id() { return (unsigned)__builtin_amdgcn_s_getreg((3 << 11) | 20) & 0xFu; }
#define XB_SPIN(cond, bar) do { unsigned _sp = 0; while (cond) { __builtin_amdgcn_s_sleep(1); \
    if ((++_sp & 255u) == 0u) { if (xb_ld(&(bar)[XB_TMO])) break; if (_sp > XB_SPIN_CAP) { atomicAdd(&(bar)[XB_TMO], 1u); break; } } } } while (0)

struct XcdBarrier {
    unsigned* bar; unsigned x;
    volatile LAS unsigned* st;
};

__device__ __forceinline__ XcdBarrier xcd_barrier_post(unsigned* bar, volatile LAS unsigned* st) {
    XcdBarrier b; b.bar = bar; b.x = xb_xcc_id(); b.st = st;
    if (threadIdx.x == 0) (void)xb_add(&bar[XB_XCNT(b.x)], 1u);
    return b;
}
__device__ __forceinline__ void xcd_barrier_complete(unsigned* bar, unsigned x, unsigned& nloc, unsigned& nx) {
    const unsigned G = gridDim.x * gridDim.y * gridDim.z;
    unsigned sum, cnt, mine, sp = 0u;
    for (;;) {
        sum = 0u; cnt = 0u; mine = 0u;
#pragma unroll
        for (unsigned j = 0; j < 16; ++j) { const unsigned c = xb_ld(&bar[XB_XCNT(j)]); sum += c; cnt += (c > 0u) ? 1u : 0u; mine = (j == x) ? c : mine; }
        if (sum == G) break;
        __builtin_amdgcn_s_sleep(1);
        if ((++sp & 255u) == 0u) { if (xb_ld(&bar[XB_TMO])) break; if (sp > XB_SPIN_CAP) { atomicAdd(&bar[XB_TMO], 1u); break; } }
    }
    nloc = mine > 0u ? mine : 1u; nx = cnt > 0u ? cnt : 1u;
}

__device__ __forceinline__ void xcd_barrier(const XcdBarrier& b) {
    asm volatile("s_waitcnt vmcnt(0)" ::: "memory");
    __syncthreads();
    if (threadIdx.x == 0) {
        unsigned* bar = b.bar;
        __builtin_amdgcn_s_waitcnt(0);
        unsigned nloc = b.st[0], nx = b.st[1];
        if (nloc == 0u) { xcd_barrier_complete(bar, b.x, nloc, nx); b.st[0] = nloc; b.st[1] = nx; }
        const unsigned old = xb_add(&bar[XB_XSUB(b.x)], 1u);
        const unsigned gen = old / nloc;
        if (old + 1u == (gen + 1u) * nloc) {
            __builtin_amdgcn_fence(__ATOMIC_RELEASE, "agent");
            asm volatile("s_waitcnt vmcnt(0)" ::: "memory");
            const unsigned og = xb_add(&bar[XB_TOP], 1u);
            const unsigned tg = og / nx;
            if (og + 1u == (tg + 1u) * nx) xb_add(&bar[XB_TOPGEN], 1u);
            else XB_SPIN(xb_ld(&bar[XB_TOPGEN]) == tg, bar);
            __builtin_amdgcn_fence(__ATOMIC_ACQUIRE, "agent");
            xb_add(&bar[XB_XGEN(b.x)], 1u);
            asm volatile("s_waitcnt vmcnt(0)" ::: "memory");
        } else {
            XB_SPIN(xb_ld(&bar[XB_XGEN(b.x)]) == gen, bar);
            __builtin_amdgcn_fence(__ATOMIC_ACQUIRE, "agent");
            asm volatile("s_waitcnt vmcnt(0)" ::: "memory");
        }
    }
    __syncthreads();
}

template <int MODE>
__device__ __forceinline__ void small_gemm(LAS unsigned char* lds, const bf16* A, const bf16* Bt, int N, int K, bf16* O, int ldc, int act_cols, const float* bias, const bf16* Yv, int ldy, int it0, int it1) {
    FTID; const int wave = WAVE, lane = LANE, tl = lane & 31, hh = lane >> 5;
    LAS float* red = (LAS float*)lds;
    const int nct = N / 32, nitems = 4 * nct, kw = K / 8, nks = kw / 16;
    for (int it = it0; it < it1; ++it) {
        const int item = BX + it * GSZ; if (item >= nitems) break;
        const int rt = item & 3, ct = item >> 2;
        const int hc = 32 * ct + tl;
        const int brow = (MODE == 3) ? (256 * (hc >> 7) + (hc & 127)) : hc;
        const bf16* ap = A + (size_t)(32 * rt + tl) * K + wave * kw + 8 * hh;
        const bf16* bp = Bt + (size_t)brow * K + wave * kw + 8 * hh;
        v16f acc0, acc1;
#pragma unroll
        for (int r = 0; r < 16; ++r) { acc0[r] = 0.f; acc1[r] = 0.f; }
#pragma unroll 4
        for (int ks = 0; ks < nks; ++ks) {
            const bfx8 a = *(const bfx8*)(ap + 16 * ks);
            const bfx8 b0 = *(const bfx8*)(bp + 16 * ks);
            acc0 = __builtin_amdgcn_mfma_f32_32x32x16_bf16(b0, a, acc0, 0, 0, 0);
            if (MODE == 3) { const bfx8 b1 = *(const bfx8*)(bp + (size_t)128 * K + 16 * ks); acc1 = __builtin_amdgcn_mfma_f32_32x32x16_bf16(b1, a, acc1, 0, 0, 0); }
        }
        __syncthreads();
#pragma unroll
        for (int r = 0; r < 16; ++r) { red[(wave * 16 + r) * 64 + lane] = acc0[r]; if (MODE == 3) red[8192 + (wave * 16 + r) * 64 + lane] = acc1[r]; }
        __syncthreads();
        float v0[2], v1[2];
#pragma unroll
        for (int e = 0; e < 2; ++e) { float s0 = 0.f, s1 = 0.f;
#pragma unroll
            for (int w = 0; w < 8; ++w) { s0 += red[(w * 16 + 2 * wave + e) * 64 + lane]; if (MODE == 3) s1 += red[8192 + (w * 16 + 2 * wave + e) * 64 + lane]; }
            v0[e] = s0; v1[e] = s1; }
        const int reg = 2 * wave;
        const int col = 32 * ct + (reg & 3) + 8 * (reg >> 2) + 4 * hh;
        const size_t row = (size_t)(32 * rt + tl);
        float o0 = v0[0], o1 = v0[1];
        if (MODE == 1) { if (col < act_cols) { o0 = gelu_t(o0); o1 = gelu_t(o1); } }
        if (MODE == 2) { const unsigned y = *(const unsigned*)(Yv + row * ldy + col); o0 = bf_lo(y) * pg8::sigmoid_f(o0 + bias[col]); o1 = bf_hi(y) * pg8::sigmoid_f(o1 + bias[col + 1]); }
        if (MODE == 3) { o0 = pg8::silu_f(o0) * v1[0]; o1 = pg8::silu_f(o1) * v1[1]; }
        *(unsigned*)(O + row * ldc + col) = cvt_pk_bf16(o0, o1);
    }
    __syncthreads();
}
struct Args { const float* in[33]; float* out; unsigned char* ws; };
__global__ void __launch_bounds__(NTHREADS, 2) fwd_kernel(Args args) {
    extern __shared__ __attribute__((aligned(16))) unsigned char lds_raw[];
    cg::grid_group grid = cg::this_grid();
    LAS unsigned char* lds = (LAS unsigned char*)lds_raw;
    Ctx C;
    if (threadIdx.x < 16) ((volatile LAS unsigned*)(lds + MISC_OFF))[threadIdx.x] = 0u;
    __syncthreads();
    (void)xcd_barrier_post((unsigned*)(C.ws() + WS_CTL), (volatile LAS unsigned*)(lds + MISC_OFF));
#define XBAR() do { XcdBarrier b_; b_.bar = (unsigned*)(C.ws() + WS_CTL); b_.x = xb_xcc_id(); b_.st = (volatile LAS unsigned*)(lds + MISC_OFF); xcd_barrier(b_); } while (0)
    grid.sync();
    { FTID; p0_prologue(C, lds, WAVE, LANE, TID); }
    XBAR();
    { const int stg = (BX >> 3) & 3;
    small_gemm<3>(lds, C.XN() + (size_t)MPROMPT * DM, C.Wgu1(), DFF, DM, C.H() + (size_t)MPROMPT * DFF, DFF, 0, nullptr, nullptr, 0, 0, stg);
    { pg8::Gemm g{C.XN(), C.Wgu1(), MPROMPT, 2 * DFF, DM}; pg8::StaticOrder S; S.init(MPROMPT, 2 * DFF, GSZ, BX); pg8::EpiSwiglu E{C.H(), DFF};
      pg8::gemm_phase<pg8::EpiSwiglu, pg8::StaticOrder, true, true>(lds, g, S, E); }
    small_gemm<3>(lds, C.XN() + (size_t)MPROMPT * DM, C.Wgu1(), DFF, DM, C.H() + (size_t)MPROMPT * DFF, DFF, 0, nullptr, nullptr, 0, stg, 4); }
    XBAR();
    { const int stg = (BX >> 3) & 3;
    small_gemm<0>(lds, C.H() + (size_t)MPROMPT * DFF, C.Wd1(), DM, DFF, C.D() + (size_t)MPROMPT * DM, DM, 0, nullptr, nullptr, 0, 0, stg);
    { pg8::Gemm g{C.H(), C.Wd1(), MPROMPT, DM, DFF}; pg8::StaticOrder S; S.init(MPROMPT, DM, GSZ, BX); pg8::EpiBf16<0> E{C.D(), DM, 0, nullptr, nullptr, 0};
      pg8::gemm_phase<pg8::EpiBf16<0>, pg8::StaticOrder, true, true>(lds, g, S, E); }
    small_gemm<0>(lds, C.H() + (size_t)MPROMPT * DFF, C.Wd1(), DM, DFF, C.D() + (size_t)MPROMPT * DM, DM, 0, nullptr, nullptr, 0, stg, 4); }
    XBAR();
    { FTID; const float* gp = C.in(8); { const int gw_ = GWV, ngw_ = NGWV, nit = (MPROMPT + 4 * ngw_ - 1) / (4 * ngw_);
      for (int it = 0; it < nit - 1; ++it) rows_res<4, false, false>(C, gw_ + 4 * it * ngw_, ngw_, M, gp, 0.5f, LANE);
      rows_res<5, false, false>(C, gw_ + 4 * (nit - 1) * ngw_, ngw_, MPROMPT + gw_, gp, 0.5f, LANE);
      for (int ms = MPROMPT + gw_ + ngw_; ms < M; ms += ngw_) rows_res<5, false, false>(C, MPROMPT, ngw_, ms, gp, 0.5f, LANE); } }
    XBAR();
    { const int stg = (BX >> 3) & 3;
    small_gemm<1>(lds, C.XN() + (size_t)MPROMPT * DM, C.Win(), DIN, DM, C.Z() + (size_t)MPROMPT * DIN, DIN, 2 * AW, nullptr, nullptr, 0, 0, stg);
    { pg8::Gemm g{C.XN(), C.Win(), MPROMPT, DIN, DM}; pg8::StaticOrder S; S.init(MPROMPT, DIN, GSZ, BX); pg8::EpiBf16<1> E{C.Z(), DIN, 2 * AW, nullptr, nullptr, 0};
      pg8::gemm_phase<pg8::EpiBf16<1>, pg8::StaticOrder, true, true>(lds, g, S, E); }
    small_gemm<1>(lds, C.XN() + (size_t)MPROMPT * DM, C.Win(), DIN, DM, C.Z() + (size_t)MPROMPT * DIN, DIN, 2 * AW, nullptr, nullptr, 0, stg, 4); }
    XBAR();
    { FTID; for (int T = BX; T < NTILE - 1; T += GSZ) {
        s5_tile<false>(C, T, 0, 4, lds, WAVE, LANE);
        __syncthreads();
        gmlp_tile(C, T, lds, WAVE, LANE, TID);
    } }
    XBAR();
    { FTID; const bool swap0 = GSZ > 128;
      for (int T = BX; T < NTILE - 1; T += GSZ) { if (swap0 && T == 0) continue; s5_tile<true>(C, T, 0, 4, lds, WAVE, LANE); }
      if (swap0 && BX == 128) s5_tile<true>(C, 0, 0, 4, lds, WAVE, LANE);
      if (BX >= 1 && BX <= 4) s5_tile<true>(C, NTILE - 1, BX - 1, BX, lds, WAVE, LANE);
      if (BX == 0) { __syncthreads(); gmlp_tile(C, NTILE - 1, lds, WAVE, LANE, TID); } }
    XBAR();
    { const int stg = (BX >> 3) & 3;
    small_gemm<2>(lds, C.YB() + (size_t)MPROMPT * BWD, C.Wglu(), BWD, BWD, C.MIX() + (size_t)MPROMPT * DM + AW, DM, 0, C.in(23), C.YB() + (size_t)MPROMPT * BWD, BWD, 0, stg);
    { pg8::Gemm g{C.YB(), C.Wglu(), MPROMPT, BWD, BWD}; pg8::StaticOrder S; S.init(MPROMPT, BWD, GSZ, BX); pg8::EpiBf16<2> E{C.MIX() + AW, DM, 0, C.in(23), C.YB(), BWD};
      pg8::gemm_phase<pg8::EpiBf16<2>, pg8::StaticOrder, true, true>(lds, g, S, E); }
    small_gemm<2>(lds, C.YB() + (size_t)MPROMPT * BWD, C.Wglu(), BWD, BWD, C.MIX() + (size_t)MPROMPT * DM + AW, DM, 0, C.in(23), C.YB() + (size_t)MPROMPT * BWD, BWD, stg, 4); }
    XBAR();
    { FTID; const float* gb = C.in(25); bf16* bb_ = C.MIX() + AW; const int gw_ = GWV, ngw_ = NGWV, nit = (MPROMPT + 4 * ngw_ - 1) / (4 * ngw_);
      for (int it = 0; it < nit - 1; ++it) rows_norm512<4>(bb_, gw_ + 4 * it * ngw_, ngw_, M, gb, LANE);
      rows_norm512<5>(bb_, gw_ + 4 * (nit - 1) * ngw_, ngw_, MPROMPT + gw_, gb, LANE);
      for (int ms = MPROMPT + gw_ + ngw_; ms < M; ms += ngw_) rows_norm512<5>(bb_, MPROMPT, ngw_, ms, gb, LANE); }
    XBAR();
    { const int stg = (BX >> 3) & 3;
    small_gemm<0>(lds, C.MIX() + (size_t)MPROMPT * DM, C.Wout(), DM, DM, C.D() + (size_t)MPROMPT * DM, DM, 0, nullptr, nullptr, 0, 0, stg);
    { pg8::Gemm g{C.MIX(), C.Wout(), MPROMPT, DM, DM}; pg8::StaticOrder S; S.init(MPROMPT, DM, GSZ, BX); pg8::EpiBf16<0> E{C.D(), DM, 0, nullptr, nullptr, 0};
      pg8::gemm_phase<pg8::EpiBf16<0>, pg8::StaticOrder, true, true>(lds, g, S, E); }
    small_gemm<0>(lds, C.MIX() + (size_t)MPROMPT * DM, C.Wout(), DM, DM, C.D() + (size_t)MPROMPT * DM, DM, 0, nullptr, nullptr, 0, stg, 4); }
    XBAR();
    { FTID; const float* gp = C.in(27); { const int gw_ = GWV, ngw_ = NGWV, nit = (MPROMPT + 4 * ngw_ - 1) / (4 * ngw_);
      for (int it = 0; it < nit - 1; ++it) rows_res<4, false, false>(C, gw_ + 4 * it * ngw_, ngw_, M, gp, 1.0f, LANE);
      rows_res<5, false, false>(C, gw_ + 4 * (nit - 1) * ngw_, ngw_, MPROMPT + gw_, gp, 1.0f, LANE);
      for (int ms = MPROMPT + gw_ + ngw_; ms < M; ms += ngw_) rows_res<5, false, false>(C, MPROMPT, ngw_, ms, gp, 1.0f, LANE); } }
    XBAR();
    { const int stg = (BX >> 3) & 3;
    small_gemm<3>(lds, C.XN() + (size_t)MPROMPT * DM, C.Wgu2(), DFF, DM, C.H() + (size_t)MPROMPT * DFF, DFF, 0, nullptr, nullptr, 0, 0, stg);
    { pg8::Gemm g{C.XN(), C.Wgu2(), MPROMPT, 2 * DFF, DM}; pg8::StaticOrder S; S.init(MPROMPT, 2 * DFF, GSZ, BX); pg8::EpiSwiglu E{C.H(), DFF};
      pg8::gemm_phase<pg8::EpiSwiglu, pg8::StaticOrder, true, true>(lds, g, S, E); }
    small_gemm<3>(lds, C.XN() + (size_t)MPROMPT * DM, C.Wgu2(), DFF, DM, C.H() + (size_t)MPROMPT * DFF, DFF, 0, nullptr, nullptr, 0, stg, 4); }
    XBAR();
    { const int stg = (BX >> 3) & 3;
    small_gemm<0>(lds, C.H() + (size_t)MPROMPT * DFF, C.Wd2(), DM, DFF, C.D() + (size_t)MPROMPT * DM, DM, 0, nullptr, nullptr, 0, 0, stg);
    { pg8::Gemm g{C.H(), C.Wd2(), MPROMPT, DM, DFF}; pg8::StaticOrder S; S.init(MPROMPT, DM, GSZ, BX); pg8::EpiBf16<0> E{C.D(), DM, 0, nullptr, nullptr, 0};
      pg8::gemm_phase<pg8::EpiBf16<0>, pg8::StaticOrder, true, true>(lds, g, S, E); }
    small_gemm<0>(lds, C.H() + (size_t)MPROMPT * DFF, C.Wd2(), DM, DFF, C.D() + (size_t)MPROMPT * DM, DM, 0, nullptr, nullptr, 0, stg, 4); }
    XBAR();
    { FTID; const float* gp = C.in(32); { const int gw_ = GWV, ngw_ = NGWV, nit = (MPROMPT + 4 * ngw_ - 1) / (4 * ngw_);
      for (int it = 0; it < nit - 1; ++it) rows_res<4, false, true>(C, gw_ + 4 * it * ngw_, ngw_, M, gp, 0.5f, LANE);
      rows_res<5, false, true>(C, gw_ + 4 * (nit - 1) * ngw_, ngw_, MPROMPT + gw_, gp, 0.5f, LANE);
      for (int ms = MPROMPT + gw_ + ngw_; ms < M; ms += ngw_) rows_res<5, false, true>(C, MPROMPT, ngw_, ms, gp, 0.5f, LANE); } }
}

extern "C" void kernel_launch(void* const* d_in, const int* in_sizes, int n_in, void* d_out, int out_size, void* d_ws, size_t ws_size, hipStream_t stream) {
    static int grid = 0;
    if (grid == 0) {
        if (n_in != 33 || ws_size < WS_END) { fprintf(stderr, "kernel_launch: unexpected n_in %d / ws %zu\n", n_in, ws_size); grid = -1; return; }
        int dev = 0, cus = 0, per_cu = 0;
        hipGetDevice(&dev);
        hipDeviceGetAttribute(&cus, hipDeviceAttributeMultiprocessorCount, dev);
        hipFuncSetAttribute((const void*)fwd_kernel, hipFuncAttributeMaxDynamicSharedMemorySize, LDS_BYTES);
        hipOccupancyMaxActiveBlocksPerMultiprocessor(&per_cu, (const void*)fwd_kernel, NTHREADS, LDS_BYTES);
        if (per_cu < 1) { fprintf(stderr, "kernel_launch: occupancy query says %d blocks per CU\n", per_cu); per_cu = 1; }
        grid = cus * per_cu;
    }
    if (grid < 0) return;
    if (hipMemsetAsync((char*)d_ws + WS_CTL, 0, CTL_ZERO_BYTES, stream) != hipSuccess) { fprintf(stderr, "memset failed\n"); return; }
    Args a{};
    for (int i = 0; i < 33; ++i) a.in[i] = (const float*)d_in[i];
    a.out = (float*)d_out; a.ws = (unsigned char*)d_ws;
    void* params[] = {&a};
    hipError_t e = hipLaunchCooperativeKernel((const void*)fwd_kernel, dim3(grid), dim3(NTHREADS), params, LDS_BYTES, stream);
    if (e != hipSuccess) fprintf(stderr, "cooperative launch failed: %s (grid %d)\n", hipGetErrorString(e), grid);
}
```
